# Optimizing an MI355X kernel written in HIP

```python
import math
import jax
import jax.numpy as jnp
from jax import lax
import numpy as np

D_MODEL = 1024
BATCH = 32
SEQ = 2048
DEPTH = 2

N_META = 16
RMS_EPS = 1e-6
MASK_VALUE = -1e30
LB_FLOOR = 1e-30

S5_WIDTH = D_MODEL // 4
S5_GROUP_CH = 16
S5_GROUPS = S5_WIDTH // S5_GROUP_CH
S5_STATE = 64
S5_DT_MIN = 1e-3
S5_DT_MAX = 1e-1

HGRN_WIDTH = D_MODEL // 4
HGRN_HEADS = 4
HGRN_HEAD_DIM = HGRN_WIDTH // HGRN_HEADS
HGRN_CHUNK = 64

ATTN_WIDTH = D_MODEL // 2
ATTN_HEADS = 4
ATTN_V_DIM = ATTN_WIDTH // ATTN_HEADS
ATTN_QK_DIM = ATTN_V_DIM // 2
ATTN_BLOCK = 128
ROPE_THETA = 10000.0

MIX_WIDTH = S5_WIDTH + HGRN_WIDTH + ATTN_WIDTH
IN_SECTION_WIDTHS = (S5_WIDTH, HGRN_WIDTH, HGRN_WIDTH, HGRN_WIDTH, HGRN_WIDTH, ATTN_WIDTH, ATTN_WIDTH, ATTN_WIDTH)
IN_WIDTH = sum(IN_SECTION_WIDTHS)

MOE_GROUPS = 4
MOE_EXPERTS_PER_GROUP = 4
MOE_EXPERTS = MOE_GROUPS * MOE_EXPERTS_PER_GROUP
MOE_TOP_K = 2
MOE_FF = 512

kernel_name = 'hymba_s5_hgrn2_diffattn_hmoe'


def rms_norm(x, gain):
    xf = x.astype(jnp.float32)
    y = xf * lax.rsqrt(jnp.mean(xf * xf, axis=-1, keepdims=True) + RMS_EPS)
    return (y * gain.astype(jnp.float32)).astype(x.dtype)


def rotary_tables(length):
    inv_freq = 1.0 / (ROPE_THETA ** (jnp.arange(0, ATTN_QK_DIM, 2, dtype=jnp.float32) / ATTN_QK_DIM))
    ang = jnp.arange(length, dtype=jnp.float32)[:, None] * inv_freq[None, :]
    ang = jnp.concatenate([ang, ang], axis=-1)
    return jnp.cos(ang), jnp.sin(ang)


def apply_rope(t, cos, sin):
    tf = t.astype(jnp.float32)
    t1, t2 = jnp.split(tf, 2, axis=-1)
    rot = jnp.concatenate([-t2, t1], axis=-1)
    c = cos[:, None, None, :]
    s = sin[:, None, None, :]
    return (tf * c + rot * s).astype(t.dtype)


def _cmul(ar, ai, br, bi):
    return ar * br - ai * bi, ar * bi + ai * br


def s5_mixer(u, lam_re, lam_im, log_dt, b_re, b_im, c_re, c_im, d_skip, w_glu):
    f32 = jnp.float32
    bsz, length, _ = u.shape
    uf = u.astype(f32).reshape(bsz, length, S5_GROUPS, S5_GROUP_CH)
    lr = lam_re.astype(f32)
    li = lam_im.astype(f32)
    dt = jnp.exp(log_dt.astype(f32))[:, None]
    mag = jnp.exp(lr * dt)
    abar_r = mag * jnp.cos(li * dt)
    abar_i = mag * jnp.sin(li * dt)
    den = lr * lr + li * li
    zr = abar_r - 1.0
    zi = abar_i
    fr = (zr * lr + zi * li) / den
    fi = (zi * lr - zr * li) / den
    bb_r, bb_i = _cmul(fr[..., None], fi[..., None], b_re.astype(f32), b_im.astype(f32))
    xr = jnp.einsum('blgc,gnc->blgn', uf, bb_r)
    xi = jnp.einsum('blgc,gnc->blgn', uf, bb_i)
    ar = jnp.broadcast_to(abar_r[None, None], (1, length, S5_GROUPS, S5_STATE))
    ai = jnp.broadcast_to(abar_i[None, None], (1, length, S5_GROUPS, S5_STATE))

    def combine(e1, e2):
        a1r, a1i, s1r, s1i = e1
        a2r, a2i, s2r, s2i = e2
        na_r, na_i = _cmul(a2r, a2i, a1r, a1i)
        ns_r, ns_i = _cmul(a2r, a2i, s1r, s1i)
        return na_r, na_i, ns_r + s2r, ns_i + s2i

    _, _, sr, si = lax.associative_scan(combine, (ar, ai, xr, xi), axis=1)
    y = jnp.einsum('blgn,gcn->blgc', sr, c_re.astype(f32)) - jnp.einsum('blgn,gcn->blgc', si, c_im.astype(f32))
    y = y.reshape(bsz, length, S5_WIDTH) + d_skip.astype(f32) * u.astype(f32)
    g = jax.nn.gelu(y)
    gl = g @ w_glu.astype(f32)
    out = gl[..., :S5_WIDTH] * jax.nn.sigmoid(gl[..., S5_WIDTH:])
    return out.astype(u.dtype)


def _gla_chunk(state, q, k, v, log_f):
    c = q.shape[2]
    cum = jnp.cumsum(log_f, axis=2)
    causal = jnp.tril(jnp.ones((c, c), dtype=bool))[None, None, :, :, None]
    rel = cum[:, :, :, None, :] - cum[:, :, None, :, :]
    decay = jnp.where(causal, jnp.exp(jnp.where(causal, rel, 0.0)), 0.0)
    scores = jnp.einsum('bhtd,bhsd,bhtsd->bhts', q, k, decay)
    out = jnp.einsum('bhts,bhsv->bhtv', scores, v) + jnp.einsum('bhtd,bhdv->bhtv', q * jnp.exp(cum), state)
    last = cum[:, :, -1:, :]
    new_state = jnp.exp(last[:, :, 0, :, None]) * state + jnp.einsum('bhsd,bhsv->bhdv', k * jnp.exp(last - cum), v)
    return new_state, out


def hgrn2_mixer(zq, zf, zi, zg, lower_bound, norm_g):
    f32 = jnp.float32
    bsz, length, _ = zq.shape

    def heads(t):
        return t.astype(f32).reshape(bsz, length, HGRN_HEADS, HGRN_HEAD_DIM).transpose(0, 2, 1, 3)

    q = jax.nn.silu(heads(zq))
    v = heads(zi)
    lb = lower_bound.astype(f32).reshape(1, HGRN_HEADS, 1, HGRN_HEAD_DIM)
    log_f = jnp.logaddexp(jnp.log(jnp.maximum(lb, LB_FLOOR)), jnp.log1p(-lb) + jax.nn.log_sigmoid(heads(zf)))
    k = -jnp.expm1(log_f)
    state0 = jnp.zeros((bsz, HGRN_HEADS, HGRN_HEAD_DIM, HGRN_HEAD_DIM), f32)
    state, o_meta = _gla_chunk(state0, q[:, :, :N_META], k[:, :, :N_META], v[:, :, :N_META], log_f[:, :, :N_META])
    n_chunks = (length - N_META) // HGRN_CHUNK

    def to_chunks(t):
        return t[:, :, N_META:].reshape(bsz, HGRN_HEADS, n_chunks, HGRN_CHUNK, -1).transpose(2, 0, 1, 3, 4)

    def step(s, xs):
        return _gla_chunk(s, *xs)

    _, o_rest = lax.scan(step, state, (to_chunks(q), to_chunks(k), to_chunks(v), to_chunks(log_f)))
    o_rest = o_rest.transpose(1, 2, 0, 3, 4).reshape(bsz, HGRN_HEADS, length - N_META, HGRN_HEAD_DIM)
    o = jnp.concatenate([o_meta, o_rest], axis=2).transpose(0, 2, 1, 3)
    o = rms_norm(o, norm_g).reshape(bsz, length, HGRN_WIDTH) * jax.nn.silu(zg.astype(f32))
    return o.astype(zq.dtype)


def diff_attention(zq, zk, zv, lq1, lk1, lq2, lk2, subln_g, lam_init, cos, sin):
    f32 = jnp.float32
    bsz, length, _ = zq.shape
    q = apply_rope(zq.reshape(bsz, length, ATTN_HEADS, 2, ATTN_QK_DIM), cos, sin)
    k = apply_rope(zk.reshape(bsz, length, ATTN_HEADS, 2, ATTN_QK_DIM), cos, sin)
    v = zv.reshape(bsz, length, ATTN_HEADS, ATTN_V_DIM)
    lam = (jnp.exp(jnp.sum(lq1.astype(f32) * lk1.astype(f32)))
           - jnp.exp(jnp.sum(lq2.astype(f32) * lk2.astype(f32))) + lam_init)
    scale = ATTN_QK_DIM ** -0.5
    bounds = [(0, N_META)] + [(s, s + ATTN_BLOCK) for s in range(N_META, length, ATTN_BLOCK)]
    outs = []
    for qs, qe in bounds:
        s = jnp.einsum('bqhcd,bkhcd->bhcqk', q[:, qs:qe], k[:, :qe]).astype(f32) * scale
        causal = jnp.arange(qe)[None, :] <= jnp.arange(qs, qe)[:, None]
        p = jax.nn.softmax(jnp.where(causal, s, MASK_VALUE), axis=-1)
        a = p[:, :, 0] - lam * p[:, :, 1]
        outs.append(jnp.einsum('bhqk,bkhv->bqhv', a.astype(v.dtype), v[:, :qe]))
    o = jnp.concatenate(outs, axis=1)
    o = rms_norm(o, subln_g) * (1.0 - lam_init)
    return o.reshape(bsz, length, ATTN_WIDTH)


def hier_moe(h, w_group, b_group, w_expert, b_expert, w_gate, w_up, w_down):
    f32 = jnp.float32
    bsz, length, d = h.shape
    t = h.reshape(-1, d)
    group_prob = jax.nn.softmax((t @ w_group).astype(f32) + b_group.astype(f32), axis=-1)
    gp, gi = lax.top_k(group_prob, 1)
    exp_logits = ((t @ w_expert).astype(f32) + b_expert.astype(f32)).reshape(-1, MOE_GROUPS, MOE_EXPERTS_PER_GROUP)
    in_group = jnp.einsum('tg,tge->te', jax.nn.one_hot(gi[:, 0], MOE_GROUPS, dtype=f32), exp_logits)
    ev, ei = lax.top_k(in_group, MOE_TOP_K)
    ew = jax.nn.softmax(ev, axis=-1) * gp
    expert_id = gi * MOE_EXPERTS_PER_GROUP + ei
    gates = jnp.einsum('tke,tk->te', jax.nn.one_hot(expert_id, MOE_EXPERTS, dtype=f32), ew).astype(t.dtype)
    y = jnp.zeros_like(t)
    for e in range(MOE_EXPERTS):
        he = jax.nn.silu(t @ w_gate[e]) * (t @ w_up[e])
        y = y + gates[:, e:e + 1] * (he @ w_down[e])
    return y.reshape(bsz, length, d)


def setup_inputs(seed: int = 0) -> dict:
    key = jax.random.key(seed)
    ks = jax.random.split(key, 32)
    f32 = jnp.float32

    def nrm(k, shape, scale):
        return scale * jax.random.normal(k, shape, f32)

    n_idx = jnp.arange(S5_STATE, dtype=f32)
    return {
        'x': nrm(ks[0], (BATCH, SEQ, D_MODEL), 1.0),
        'meta_tokens': nrm(ks[1], (N_META, D_MODEL), 1.0),
        'norm_mix_g': 1.0 + nrm(ks[2], (DEPTH, D_MODEL), 0.02),
        'w_in': nrm(ks[3], (DEPTH, D_MODEL, IN_WIDTH), D_MODEL ** -0.5),
        's5_lambda_re': -0.5 + nrm(ks[4], (DEPTH, S5_GROUPS, S5_STATE), 0.01),
        's5_lambda_im': math.pi * n_idx + nrm(ks[5], (DEPTH, S5_GROUPS, S5_STATE), 0.01),
        's5_log_dt': jax.random.uniform(ks[6], (DEPTH, S5_GROUPS), f32, math.log(S5_DT_MIN), math.log(S5_DT_MAX)),
        's5_b_re': nrm(ks[7], (DEPTH, S5_GROUPS, S5_STATE, S5_GROUP_CH), (2 * S5_GROUP_CH) ** -0.5),
        's5_b_im': nrm(ks[8], (DEPTH, S5_GROUPS, S5_STATE, S5_GROUP_CH), (2 * S5_GROUP_CH) ** -0.5),
        's5_c_re': nrm(ks[9], (DEPTH, S5_GROUPS, S5_GROUP_CH, S5_STATE), S5_STATE ** -0.5),
        's5_c_im': nrm(ks[10], (DEPTH, S5_GROUPS, S5_GROUP_CH, S5_STATE), S5_STATE ** -0.5),
        's5_d': nrm(ks[11], (DEPTH, S5_WIDTH), 1.0),
        's5_w_glu': nrm(ks[12], (DEPTH, S5_WIDTH, 2 * S5_WIDTH), S5_WIDTH ** -0.5),
        'hgrn_lower_bounds': nrm(ks[13], (DEPTH, HGRN_WIDTH), 0.1),
        'hgrn_norm_g': 1.0 + nrm(ks[14], (DEPTH, HGRN_HEAD_DIM), 0.02),
        'diff_lambda_q1': nrm(ks[15], (DEPTH, ATTN_QK_DIM), 0.1),
        'diff_lambda_k1': nrm(ks[16], (DEPTH, ATTN_QK_DIM), 0.1),
        'diff_lambda_q2': nrm(ks[17], (DEPTH, ATTN_QK_DIM), 0.1),
        'diff_lambda_k2': nrm(ks[18], (DEPTH, ATTN_QK_DIM), 0.1),
        'diff_subln_g': 1.0 + nrm(ks[19], (DEPTH, ATTN_V_DIM), 0.02),
        'w_out': nrm(ks[20], (DEPTH, MIX_WIDTH, D_MODEL), MIX_WIDTH ** -0.5),
        'norm_ffn_g': 1.0 + nrm(ks[21], (DEPTH, D_MODEL), 0.02),
        'moe_w_group': nrm(ks[22], (DEPTH, D_MODEL, MOE_GROUPS), D_MODEL ** -0.5),
        'moe_b_group': nrm(ks[23], (DEPTH, MOE_GROUPS), 0.01),
        'moe_w_expert': nrm(ks[24], (DEPTH, D_MODEL, MOE_EXPERTS), D_MODEL ** -0.5),
        'moe_b_expert': nrm(ks[25], (DEPTH, MOE_EXPERTS), 0.01),
        'moe_w_gate': nrm(ks[26], (DEPTH, MOE_EXPERTS, D_MODEL, MOE_FF), D_MODEL ** -0.5),
        'moe_w_up': nrm(ks[27], (DEPTH, MOE_EXPERTS, D_MODEL, MOE_FF), D_MODEL ** -0.5),
        'moe_w_down': nrm(ks[28], (DEPTH, MOE_EXPERTS, MOE_FF, D_MODEL), MOE_FF ** -0.5),
        'final_norm_g': 1.0 + nrm(ks[29], (D_MODEL,), 0.02),
    }


def reference(x, meta_tokens, norm_mix_g, w_in, s5_lambda_re, s5_lambda_im, s5_log_dt, s5_b_re, s5_b_im,
              s5_c_re, s5_c_im, s5_d, s5_w_glu, hgrn_lower_bounds, hgrn_norm_g, diff_lambda_q1, diff_lambda_k1,
              diff_lambda_q2, diff_lambda_k2, diff_subln_g, w_out, norm_ffn_g, moe_w_group, moe_b_group,
              moe_w_expert, moe_b_expert, moe_w_gate, moe_w_up, moe_w_down, final_norm_g):
    bsz = x.shape[0]
    meta = jnp.broadcast_to(meta_tokens.astype(x.dtype)[None], (bsz, N_META, D_MODEL))
    h = jnp.concatenate([meta, x], axis=1)
    length = h.shape[1]
    cos, sin = rotary_tables(length)
    lb_w = jax.nn.softmax(hgrn_lower_bounds.astype(jnp.float32), axis=0)
    lower_bounds = jnp.cumsum(lb_w, axis=0) - lb_w[0:1]
    split_points = [int(p) for p in np.cumsum(IN_SECTION_WIDTHS)[:-1]]
    for layer in range(DEPTH):
        lam_init = 0.8 - 0.6 * math.exp(-0.3 * layer)
        proj = rms_norm(h, norm_mix_g[layer]) @ w_in[layer]
        u, hq, hf, hi, hg, aq, ak, av = jnp.split(proj, split_points, axis=-1)
        y_ssm = s5_mixer(u, s5_lambda_re[layer], s5_lambda_im[layer], s5_log_dt[layer], s5_b_re[layer],
                         s5_b_im[layer], s5_c_re[layer], s5_c_im[layer], s5_d[layer], s5_w_glu[layer])
        y_rec = hgrn2_mixer(hq, hf, hi, hg, lower_bounds[layer], hgrn_norm_g[layer])
        y_att = diff_attention(aq, ak, av, diff_lambda_q1[layer], diff_lambda_k1[layer], diff_lambda_q2[layer],
                               diff_lambda_k2[layer], diff_subln_g[layer], lam_init, cos, sin)
        mixed = jnp.concatenate([y_ssm.astype(h.dtype), y_rec.astype(h.dtype), y_att.astype(h.dtype)], axis=-1)
        h = h + mixed @ w_out[layer]
        h = h + hier_moe(rms_norm(h, norm_ffn_g[layer]), moe_w_group[layer], moe_b_group[layer],
                         moe_w_expert[layer], moe_b_expert[layer], moe_w_gate[layer], moe_w_up[layer],
                         moe_w_down[layer])
    h = rms_norm(h, final_norm_g)
    return h[:, N_META:]
```

```cpp
#include <hip/hip_runtime.h>
#include <stdint.h>
#include <stdio.h>

#ifndef N_LAUNCH_MODE
#define N_LAUNCH_MODE 0
#endif
#ifndef LAST_PHASE
#define LAST_PHASE 20
#endif
#ifndef RUN_MASK
#define RUN_MASK 0xFFFFFu
#endif
#ifndef MIXSEL
#define MIXSEL 7u
#endif

#define GAS __attribute__((address_space(1)))
#define LAS __attribute__((address_space(3)))
typedef unsigned short bf16;
typedef short bf16x8 __attribute__((ext_vector_type(8)));
typedef short s16x4 __attribute__((ext_vector_type(4)));
typedef float f32x2 __attribute__((ext_vector_type(2)));
typedef float f32x4 __attribute__((ext_vector_type(4)));
typedef float f32x16 __attribute__((ext_vector_type(16)));
typedef unsigned u32x2 __attribute__((ext_vector_type(2)));
typedef unsigned u32x4 __attribute__((ext_vector_type(4)));

constexpr int NB = 32, LT = 2064, NMETA = 16, SEQ = 2048, T = NB * LT;
constexpr int D = 1024, NI = 2816, MT = T / 256;
constexpr int C_U = 0, C_HQ = 256, C_HF = 512, C_HI = 768, C_HG = 1024, C_AQ = 1280, C_AK = 1792, C_AV = 2304;
constexpr int NCH = 129;
constexpr int S5R = NB * NCH;
constexpr int S5RP = 17 * 256;
constexpr int HCH = 33;
constexpr int NCLS = 24;
constexpr float RMS_EPS = 1e-6f;
constexpr float QSCALE = 0.125f * 1.4426950408889634f;

constexpr size_t al256(size_t x) { return (x + 255) & ~(size_t)255; }
constexpr size_t CTL_BYTES = 1u << 20;
constexpr size_t WS_WIN = CTL_BYTES;
constexpr size_t WS_WOUT = WS_WIN + al256((size_t)2 * NI * D * 2);
constexpr size_t WS_WGLU = WS_WOUT + al256((size_t)2 * D * D * 2);
constexpr size_t WS_WGU = WS_WGLU + al256((size_t)2 * 512 * 256 * 2);
constexpr size_t WS_WDN = WS_WGU + al256((size_t)2 * 16 * 1024 * 1024 * 2);
constexpr size_t WS_WR = WS_WDN + al256((size_t)2 * 16 * 1024 * 512 * 2);
constexpr size_t WS_S5TQ = WS_WR + al256((size_t)2 * 2 * 32 * 1024 * 2);
constexpr size_t WS_S5P = WS_S5TQ + al256((size_t)2 * 16 * 256 * 384 * 2);
constexpr size_t WS_S5A = WS_S5P + al256((size_t)2 * 16 * 256 * 256 * 2);
constexpr size_t WS_ROPE = WS_S5A + al256((size_t)2 * 16 * 64 * 8);
constexpr size_t WS_SS16 = WS_ROPE + al256((size_t)LT * 32 * 4 * 2);
constexpr size_t WS_RSTD = WS_SS16 + al256((size_t)T * 16 * 4);
constexpr size_t WS_GATE = WS_RSTD + al256((size_t)T * 4);
constexpr size_t WS_BUCK = WS_GATE + al256((size_t)T * 8);
constexpr size_t WS_H = WS_BUCK + al256((size_t)NCLS * T * 4);
constexpr size_t WS_HB = WS_H + al256((size_t)T * D * 4);
constexpr size_t WS_PROJ = WS_HB + al256((size_t)T * D * 2);
constexpr size_t WS_MIXED = WS_PROJ + al256((size_t)T * NI * 2);
constexpr size_t WS_END = WS_MIXED + al256((size_t)T * D * 2);
constexpr size_t OS_E = 0;
constexpr size_t OS_X = OS_E + al256((size_t)16 * S5RP * 128 * 4);
constexpr size_t OS_G = OS_X + al256((size_t)16 * S5RP * 384 * 2);
constexpr size_t OS_UT = OS_G + al256((size_t)T * 256 * 2);
constexpr size_t OS_DEC = OS_UT + al256((size_t)NB * 4 * HCH * 4096 * 4);
constexpr size_t OS_SP = OS_DEC + al256((size_t)NB * 4 * HCH * 64 * 4);
constexpr size_t OS_END = OS_SP + al256((size_t)NB * 4 * HCH * 4096 * 2);
static_assert(OS_END <= (size_t)NB * SEQ * D * 4, "mixer scratch must fit in d_out");
static_assert((size_t)(MT + NCLS) * 256 * 1024 * 2 <= (size_t)T * NI * 2, "he overlay fits in proj");

constexpr int CW_BAR = 4096, CW_CNT = 16384;

constexpr int LDS_BYTES = 147456;
constexpr int RING_BYTES = 131072;
constexpr int TAB_OFF = RING_BYTES;
constexpr int MISC_OFF = LDS_BYTES - 1024;

__device__ __forceinline__ unsigned f2bf(float f) { unsigned u = __builtin_bit_cast(unsigned, f); return (u + 0x7fffu + ((u >> 16) & 1u)) >> 16; }
__device__ __forceinline__ float bf2f(unsigned b) { return __builtin_bit_cast(float, (b & 0xffffu) << 16); }
__device__ __forceinline__ unsigned pk2(float lo, float hi) { return f2bf(lo) | (f2bf(hi) << 16); }
__device__ __forceinline__ unsigned cvt_pk_bf16(float lo, float hi) { unsigned r; asm volatile("v_cvt_pk_bf16_f32 %0, %1, %2" : "=v"(r) : "v"(lo), "v"(hi)); return r; }
__device__ __forceinline__ float wave_sum(float v) {
#pragma unroll
    for (int o = 1; o < 64; o <<= 1) v += __shfl_xor(v, o);
    return v;
}
__device__ __forceinline__ float sigmoidf_(float x) { return 1.f / (1.f + __expf(-x)); }
__device__ __forceinline__ float siluf_(float x) { return x / (1.f + __expf(-x)); }
__device__ __forceinline__ float gelu_tanh(float x) { const float u = 0.7978845608028654f * (x + 0.044715f * x * x * x); return x / (1.f + __expf(-2.f * u)); }
#define LAUNDER(x) asm volatile("" : "+v"(x))
#define LDS_WAIT() asm volatile("s_waitcnt lgkmcnt(0)" ::: "memory")
#define VM_WAIT() asm volatile("s_waitcnt vmcnt(0)" ::: "memory")

#define XB_TMO      128
#define XB_XCNT(j)  (256  + 64 * (j))
#define XB_XSUB(j)  (1280 + 64 * (j))
#define XB_XGEN(j)  (2304 + 64 * (j))
#define XB_TOP      3328
#define XB_TOPGEN   3392
#define XCD_BAR_WORDS 3456
#define XB_SPIN_CAP (1u << 18)
__device__ __forceinline__ unsigned xb_ld(unsigned* p)              { return __hip_atomic_load(p, __ATOMIC_RELAXED, __HIP_MEMORY_SCOPE_AGENT); }
__device__ __forceinline__ unsigned xb_add(unsigned* p, unsigned v) { return __hip_atomic_fetch_add(p, v, __ATOMIC_RELAXED, __HIP_MEMORY_SCOPE_AGENT); }
__device__ __forceinline__ unsigned xb_xcc_id() { return (unsigned)__builtin_amdgcn_s_getreg((3 << 11) | 20) & 0xFu; }
#define XB_SPIN(cond, bar) do { unsigned _sp = 0; while (cond) { __builtin_amdgcn_s_sleep(1); \
    if ((++_sp & 255u) == 0u) { if (xb_ld(&(bar)[XB_TMO])) break; if (_sp > XB_SPIN_CAP) { atomicAdd(&(bar)[XB_TMO], 1u); break; } } } } while (0)
struct XcdBarrier { unsigned* bar; unsigned x; volatile LAS unsigned* st; };
__device__ __forceinline__ XcdBarrier xcd_barrier_post(unsigned* bar, volatile LAS unsigned* st) {
    XcdBarrier b; b.bar = bar; b.x = xb_xcc_id(); b.st = st;
    if (threadIdx.x == 0) (void)xb_add(&bar[XB_XCNT(b.x)], 1u);
    return b;
}
__device__ __forceinline__ void xcd_barrier_complete(unsigned* bar, unsigned x, unsigned& nloc, unsigned& nx) {
    const unsigned G = gridDim.x * gridDim.y * gridDim.z;
    unsigned sum, cnt, mine, sp = 0u;
    for (;;) {
        sum = 0u; cnt = 0u; mine = 0u;
#pragma unroll
        for (unsigned j = 0; j < 16; ++j) { const unsigned c = xb_ld(&bar[XB_XCNT(j)]); sum += c; cnt += (c > 0u) ? 1u : 0u; mine = (j == x) ? c : mine; }
        if (sum == G) break;
        __builtin_amdgcn_s_sleep(1);
        if ((++sp & 255u) == 0u) { if (xb_ld(&bar[XB_TMO])) break; if (sp > XB_SPIN_CAP) { atomicAdd(&bar[XB_TMO], 1u); break; } }
    }
    nloc = mine > 0u ? mine : 1u; nx = cnt > 0u ? cnt : 1u;
}
__device__ __forceinline__ void xcd_barrier(const XcdBarrier& b) {
    asm volatile("s_waitcnt vmcnt(0)" ::: "memory");
    __syncthreads();
    if (threadIdx.x == 0) {
        unsigned* bar = b.bar;
        __builtin_amdgcn_s_waitcnt(0);
        unsigned nloc = b.st[0], nx = b.st[1];
        if (nloc == 0u) { xcd_barrier_complete(bar, b.x, nloc, nx); b.st[0] = nloc; b.st[1] = nx; }
        const unsigned old = xb_add(&bar[XB_XSUB(b.x)], 1u);
        const unsigned gen = old / nloc;
        if (old + 1u == (gen + 1u) * nloc) {
            __builtin_amdgcn_fence(__ATOMIC_RELEASE, "agent");
            asm volatile("s_waitcnt vmcnt(0)" ::: "memory");
            const unsigned og = xb_add(&bar[XB_TOP], 1u);
            const unsigned tg = og / nx;
            if (og + 1u == (tg + 1u) * nx) xb_add(&bar[XB_TOPGEN], 1u);
            else XB_SPIN(xb_ld(&bar[XB_TOPGEN]) == tg, bar);
            __builtin_amdgcn_fence(__ATOMIC_ACQUIRE, "agent");
            xb_add(&bar[XB_XGEN(b.x)], 1u);
            asm volatile("s_waitcnt vmcnt(0)" ::: "memory");
        } else {
            XB_SPIN(xb_ld(&bar[XB_XGEN(b.x)]) == gen, bar);
            __builtin_amdgcn_fence(__ATOMIC_ACQUIRE, "agent");
            asm volatile("s_waitcnt vmcnt(0)" ::: "memory");
        }
    }
    __syncthreads();
}

namespace pg8 {
constexpr int BM = 256, BK = 64, HALF = 128, HTB = HALF * BK * 2, NXCD = 8, WGM = 8;
__host__ __device__ __forceinline__ int lds_byte(int r, int c) { const int st = (r >> 4) * 2 + (c >> 5), rr = r & 15, cc = c & 31, ob = rr * 64 + cc * 2; return st * 1024 + (ob ^ (((ob >> 9) & 1) << 5)); }
__host__ __device__ __forceinline__ void stage_rc(int b, int& R, int& C) { const int st = b / 1024, sb = b % 1024, swz = sb ^ (((sb >> 9) & 1) << 5); R = (st >> 1) * 16 + swz / 64; C = (st & 1) * 32 + (swz % 64) / 2; }
__host__ __device__ __forceinline__ int perm32(int rho) { const int n = rho >> 4, i = rho & 15; return 8 * (i >> 2) + 4 * n + (i & 3); }

struct TileOrder {
    int nM, nN, nwg, G, c;
    __device__ __forceinline__ void init(int nM_, int nN_, int G_, int c_) { nM = nM_; nN = nN_; nwg = nM * nN; G = G_; c = c_; }
    __device__ __forceinline__ bool get(int i, int& pm, int& pn) const {
        const long Lx = (long)i * G + c; if (Lx >= nwg) return false;
        int wgid = (int)Lx; { const int q = nwg / NXCD, r = nwg % NXCD, xcd = wgid % NXCD, off = wgid / NXCD; wgid = (xcd < r ? xcd * (q + 1) : r * (q + 1) + (xcd - r) * q) + off; }
        const int nig = WGM * nN, gid = wgid / nig, fm = gid * WGM, gsz = (nM - fm) < WGM ? (nM - fm) : WGM;
        pm = fm + ((wgid % nig) % gsz); pn = (wgid % nig) / gsz; return true;
    }
};

template <class P>
__device__ __forceinline__ void gemm_phase(LAS unsigned char* lds, const P& S) {
    typedef typename P::Unit Unit;
    int tid_ = threadIdx.x; LAUNDER(tid_);
    const int tid = tid_, wid = __builtin_amdgcn_readfirstlane(tid >> 6), lane = tid & 63, wr = wid >> 2, wc = wid & 3, fr = lane & 15, fq = lane >> 4;
    constexpr int nt = P::NT; constexpr int LDB = P::LDB;
    int Rs[2], Cs[2]; unsigned voffB[2];
#pragma unroll
    for (int i = 0; i < 2; ++i) { int R, C; stage_rc(tid * 16 + i * 8192, R, C); Rs[i] = R; Cs[i] = C; const int Rb = (R & ~31) + perm32(R & 31); voffB[i] = (unsigned)(Rb * LDB + C) * 2u; }
    const size_t hstepB = (size_t)HALF * LDB * 2;
    const unsigned ldsw = (unsigned)wid * 1024u;
    const int aoff = lds_byte(wr * 64 + fr, fq * 8), boff = lds_byte(wc * 32 + fr, fq * 8);
#define PG8_SA(b, h) (((b) * 2 + (h)) * HTB)
#define PG8_SB(b, h) ((4 + (b) * 2 + (h)) * HTB)
#define PG8_STAGE1(bufoff, gptr, v0, v1) do { \
        __builtin_amdgcn_global_load_lds((const unsigned*)((const char*)(gptr) + (v0)), (LAS unsigned*)(lds + (bufoff) + ldsw), 16, 0, 0); \
        __builtin_amdgcn_global_load_lds((const unsigned*)((const char*)(gptr) + (v1)), (LAS unsigned*)(lds + (bufoff) + ldsw + 8192), 16, 0, 0); } while (0)
#define PG8_STAGEB(bufoff, gptr) PG8_STAGE1(bufoff, gptr, voffB[0], voffB[1])
#define PG8_LDA(dst, b, h) do { _Pragma("unroll") for (int m = 0; m < 4; ++m) _Pragma("unroll") for (int k = 0; k < 2; ++k) dst[m][k] = *(const LAS bf16x8*)(lds + PG8_SA(b, h) + aoff + m * 2048 + k * 1024); } while (0)
#define PG8_LDB(dst, b, h) do { _Pragma("unroll") for (int n = 0; n < 2; ++n) _Pragma("unroll") for (int k = 0; k < 2; ++k) dst[n][k] = *(const LAS bf16x8*)(lds + PG8_SB(b, h) + boff + n * 2048 + k * 1024); } while (0)
#define PG8_MMA(ai, bj, At, Bt) do { __builtin_amdgcn_s_setprio(1); _Pragma("unroll") for (int m = 0; m < 4; ++m) _Pragma("unroll") for (int n = 0; n < 2; ++n) _Pragma("unroll") for (int k = 0; k < 2; ++k) \
        acc[ai][bj][m][n] = __builtin_amdgcn_mfma_f32_16x16x32_bf16(Bt[n][k], At[m][k], acc[ai][bj][m][n], 0, 0, 0); __builtin_amdgcn_s_setprio(0); } while (0)
#define PG8_WAIT_V(n) asm volatile("s_waitcnt vmcnt(" #n ")" ::: "memory")
#define PG8_WAIT_L(n) asm volatile("s_waitcnt lgkmcnt(" #n ")" ::: "memory")
#define PG8_BAR __builtin_amdgcn_s_barrier()
#define PG8_SCHED __builtin_amdgcn_sched_barrier(0)
    Unit cur, nxt; int ui = 0;
    if (!S.next(0, cur)) return;
    f32x4 acc[2][2][4][2];
#pragma unroll
    for (int a = 0; a < 2; ++a)
#pragma unroll
        for (int b = 0; b < 2; ++b)
#pragma unroll
            for (int m = 0; m < 4; ++m)
#pragma unroll
                for (int n = 0; n < 2; ++n) acc[a][b][m][n] = (f32x4){0.f, 0.f, 0.f, 0.f};
    bf16x8 At[4][2], B0[2][2], B1[2][2];
#define PG8_STAGEA(bufoff, uidx, uu, tt, hh) S.stage_a(lds + (bufoff) + ldsw, uidx, uu, tt, hh, Rs, Cs)
    {
        const char* pB0 = S.b_ptr(cur, 0); const char* pB1 = S.b_ptr(cur, 1);
        PG8_STAGEB(PG8_SB(0, 0), pB0); PG8_STAGEB(PG8_SB(0, 1), pB0 + hstepB); PG8_STAGEA(PG8_SA(0, 0), 0, cur, 0, 0); PG8_STAGEA(PG8_SA(0, 1), 0, cur, 0, 1);
        if (wr == 1) PG8_BAR;
        PG8_WAIT_V(2); PG8_BAR;
        PG8_STAGEB(PG8_SB(1, 0), pB1); PG8_STAGEA(PG8_SA(1, 0), 0, cur, 1, 0); PG8_STAGEB(PG8_SB(1, 1), pB1 + hstepB);
        PG8_WAIT_V(6); PG8_BAR;
    }
    for (;;) {
        const bool has_next = S.next(ui + 1, nxt);
        if (!has_next) nxt = cur;
        const int uin = has_next ? ui + 1 : ui;
#pragma unroll 1
        for (int t = 0; t < nt; t += 2) {
            const bool last = (t == nt - 2);
            const Unit& u2 = last ? nxt : cur; const int ui2 = last ? uin : ui; const int t2 = last ? 0 : t + 2;
            const char* b2 = S.b_ptr(u2, t2); const char* b3 = S.b_ptr(u2, t2 + 1);
            PG8_LDB(B0, 0, 0); PG8_LDB(B1, 0, 1); PG8_SCHED; PG8_LDA(At, 0, 0); PG8_STAGEA(PG8_SA(1, 1), ui, cur, t + 1, 1);
            PG8_WAIT_V(8); PG8_WAIT_L(0); PG8_BAR; PG8_MMA(0, 0, At, B0); PG8_MMA(0, 1, At, B1); PG8_BAR; PG8_SCHED;
            PG8_LDA(At, 0, 1); PG8_STAGEB(PG8_SB(0, 0), b2); PG8_STAGEB(PG8_SB(0, 1), b2 + hstepB); PG8_STAGEA(PG8_SA(0, 0), ui2, u2, t2, 0);
            PG8_WAIT_V(8); PG8_WAIT_L(0); PG8_BAR; PG8_MMA(1, 0, At, B0); PG8_MMA(1, 1, At, B1); PG8_BAR; PG8_SCHED;
            PG8_LDB(B0, 1, 0); PG8_LDB(B1, 1, 1); PG8_SCHED; PG8_LDA(At, 1, 0); PG8_STAGEA(PG8_SA(0, 1), ui2, u2, t2, 1);
            PG8_WAIT_V(8); PG8_WAIT_L(0); PG8_BAR; PG8_MMA(0, 0, At, B0); PG8_MMA(0, 1, At, B1); PG8_BAR; PG8_SCHED;
            PG8_LDA(At, 1, 1); PG8_STAGEB(PG8_SB(1, 0), b3); PG8_STAGEB(PG8_SB(1, 1), b3 + hstepB); PG8_STAGEA(PG8_SA(1, 0), ui2, u2, t2 + 1, 0);
            PG8_WAIT_V(8); PG8_WAIT_L(0); PG8_BAR; PG8_MMA(1, 0, At, B0); PG8_MMA(1, 1, At, B1); PG8_BAR; PG8_SCHED;
        }
        if (wr == 0) PG8_BAR;
        S.epi(acc, cur, wr, wc, fr, fq, ui);
        PG8_SCHED;
        if (!has_next) break;
#pragma unroll
        for (int a = 0; a < 2; ++a)
#pragma unroll
            for (int b = 0; b < 2; ++b)
#pragma unroll
                for (int m = 0; m < 4; ++m)
#pragma unroll
                    for (int n = 0; n < 2; ++n) acc[a][b][m][n] = (f32x4){0.f, 0.f, 0.f, 0.f};
        cur = nxt; ++ui;
        if (wr == 1) PG8_BAR;
    }
    PG8_WAIT_V(0);
    PG8_BAR;
#undef PG8_SA
#undef PG8_SB
#undef PG8_STAGE1
#undef PG8_STAGEB
#undef PG8_STAGEA
#undef PG8_LDA
#undef PG8_LDB
#undef PG8_MMA
#undef PG8_WAIT_V
#undef PG8_WAIT_L
#undef PG8_BAR
#undef PG8_SCHED
}
}
typedef f32x4 AccT[2][2][4][2];

struct Args { const float* in[30]; float* out; unsigned char* ws; int ph_lo, ph_hi; };

struct Frame {
    LAS unsigned char* lds;
    int tid, lane, wave, G, wg;
    const float* const* in;
    unsigned char* ws; unsigned char* os;
};
#define IN_X 0
#define IN_META 1
#define IN_NMG 2
#define IN_WIN 3
#define IN_LRE 4
#define IN_LIM 5
#define IN_LDT 6
#define IN_BRE 7
#define IN_BIM 8
#define IN_CRE 9
#define IN_CIM 10
#define IN_S5D 11
#define IN_WGLU 12
#define IN_HLB 13
#define IN_HNG 14
#define IN_LQ1 15
#define IN_LK1 16
#define IN_LQ2 17
#define IN_LK2 18
#define IN_SUBLN 19
#define IN_WOUT 20
#define IN_NFG 21
#define IN_WGRP 22
#define IN_BGRP 23
#define IN_WEXP 24
#define IN_BEXP 25
#define IN_WGATE 26
#define IN_WUP 27
#define IN_WDOWN 28
#define IN_FNG 29

template <class ColMap>
__device__ __forceinline__ void conv_item(const float* W, int ldw, const float* kscale, bf16* WT, int ldt, int k0, int n0, LAS float* scr, int lane, ColMap cm) {
    const int sc = cm(n0 + (lane & 31));
#pragma unroll 8
    for (int i = 0; i < 32; ++i) { const int kk = 2 * i + (lane >> 5); float v = W[(size_t)(k0 + kk) * ldw + sc]; if (kscale) v *= kscale[k0 + kk]; scr[kk * 33 + (lane & 31)] = v; }
    LDS_WAIT(); asm volatile("" ::: "memory");
    const int c = lane & 7;
#pragma unroll
    for (int j = 0; j < 4; ++j) { const int n = (lane >> 3) + 8 * j; const LAS float* s = scr + (8 * c) * 33 + n;
        u32x4 o; o.x = pk2(s[0 * 33], s[1 * 33]); o.y = pk2(s[2 * 33], s[3 * 33]); o.z = pk2(s[4 * 33], s[5 * 33]); o.w = pk2(s[6 * 33], s[7 * 33]);
        *(GAS u32x4*)(WT + (size_t)(n0 + n) * ldt + k0 + 8 * c) = o; }
    LDS_WAIT(); asm volatile("" ::: "memory");
}

__device__ __forceinline__ void p0_prologue(const Frame& F0) {
    Frame F = F0; LAUNDER(F.tid); F.lane = F.tid & 63;
    LAS float* scr = (LAS float*)(F.lds + F.wave * 16384);
    const int gw = F.wg * 8 + F.wave, NGW = F.G * 8, lane = F.lane;
    constexpr int I_IN = 16 * (NI / 32), I_OUT = 16 * 32, I_GLU = 4 * 16, I_GU = 16 * 16 * 32, I_DN = 16 * 8 * 32;
    constexpr int I_L = I_IN + I_OUT + I_GLU + I_GU + I_DN;
    for (int it = gw; it < 2 * I_L; it += NGW) {
        const int l = it / I_L; int r = it % I_L;
        if (r < I_IN) {
            const int kb = r / (NI / 32), nb = r % (NI / 32);
            conv_item(F.in[IN_WIN] + (size_t)l * D * NI, NI, F.in[IN_NMG] + l * D, (bf16*)(F.ws + WS_WIN) + (size_t)l * NI * D, D, kb * 64, nb * 32, scr, lane,
                      [](int n) { if (n >= C_AQ && n < C_AV) { const int p = n & 63, j = p >> 3, e = p & 7; return (n & ~63) + 4 * j + (e & 3) + 32 * (e >> 2); } return n; });
            continue; }
        r -= I_IN;
        if (r < I_OUT) {
            const int kb = r / 32, nb = r % 32;
            conv_item(F.in[IN_WOUT] + (size_t)l * D * D, D, nullptr, (bf16*)(F.ws + WS_WOUT) + (size_t)l * D * D, D, kb * 64, nb * 32, scr, lane, [](int n) { return n; });
            continue; }
        r -= I_OUT;
        if (r < I_GLU) {
            const int kb = r / 16, nb = r % 16;
            conv_item(F.in[IN_WGLU] + (size_t)l * 256 * 512, 512, nullptr, (bf16*)(F.ws + WS_WGLU) + (size_t)l * 512 * 256, 256, kb * 64, nb * 32, scr, lane,
                      [](int n) { const int pn = n >> 8, bj = (n >> 7) & 1, c = n & 127; return bj * 256 + pn * 128 + c; });
            continue; }
        r -= I_GLU;
        if (r < I_GU) {
            const int e = r / (16 * 32), q = r % (16 * 32), kb = q / 32, nb = q % 32, n0 = nb * 32, bj = (n0 >> 7) & 1;
            const float* src = (bj ? F.in[IN_WUP] : F.in[IN_WGATE]) + ((size_t)l * 16 + e) * 1024 * 512;
            conv_item(src, 512, F.in[IN_NFG] + l * D, (bf16*)(F.ws + WS_WGU) + ((size_t)l * 16 + e) * 1024 * 1024, 1024, kb * 64, n0, scr, lane,
                      [](int n) { const int pn = n >> 8, c = n & 127; return pn * 128 + c; });
            continue; }
        r -= I_GU;
        {
            const int e = r / (8 * 32), q = r % (8 * 32), kb = q / 32, nb = q % 32;
            conv_item(F.in[IN_WDOWN] + ((size_t)l * 16 + e) * 512 * 1024, 1024, nullptr, (bf16*)(F.ws + WS_WDN) + ((size_t)l * 16 + e) * 1024 * 512, 512, kb * 64, nb * 32, scr, lane, [](int n) { return n; });
        }
    }
    for (int idx = gw * 64 + lane; idx < 2 * 32 * 1024; idx += NGW * 64) {
        const int l = idx / (32 * 1024), j = (idx / 1024) % 32, k = idx % 1024;
        float w = 0.f;
        if (j < 4) w = F.in[IN_WGRP][((size_t)l * D + k) * 4 + j]; else if (j < 20) w = F.in[IN_WEXP][((size_t)l * D + k) * 16 + (j - 4)];
        w *= F.in[IN_NFG][l * D + k];
        const unsigned hi = f2bf(w); const float lo = w - bf2f(hi);
        bf16* wr = (bf16*)(F.ws + WS_WR) + (size_t)l * 2 * 32 * 1024;
        wr[j * 1024 + k] = (bf16)hi; wr[32 * 1024 + j * 1024 + k] = (bf16)f2bf(lo);
    }
    for (int idx = gw * 64 + lane; idx < LT * 32; idx += NGW * 64) {
        const int pos = idx / 32, i = idx % 32;
        const double inv = pow(10000.0, -(double)(2 * i) / 64.0); const double a = (double)pos * inv;
        ((float*)(F.ws + WS_ROPE))[idx] = (float)cos(a); ((float*)(F.ws + WS_ROPE))[LT * 32 + idx] = (float)sin(a);
    }
    for (int m = gw; m < T; m += NGW) {
        const int b = m / LT, t = m % LT;
        const float* src = (t < NMETA) ? F.in[IN_META] + (size_t)t * D : F.in[IN_X] + ((size_t)b * SEQ + (t - NMETA)) * D;
        const GAS f32x4* xr = (const GAS f32x4*)src + lane;
        GAS f32x4* hr = (GAS f32x4*)((float*)(F.ws + WS_H) + (size_t)m * D) + lane;
        GAS u32x2* hb = (GAS u32x2*)((bf16*)(F.ws + WS_HB) + (size_t)m * D) + lane;
        float s = 0.f;
#pragma unroll
        for (int j = 0; j < 4; ++j) { const f32x4 v = xr[64 * j]; hr[64 * j] = v; s += (v.x * v.x + v.y * v.y) + (v.z * v.z + v.w * v.w);
            u32x2 o; o.x = pk2(v.x, v.y); o.y = pk2(v.z, v.w); hb[64 * j] = o; }
        s = wave_sum(s);
        if (lane < 16) ((float*)(F.ws + WS_SS16))[(size_t)m * 16 + lane] = (lane == 0) ? s : 0.f;
    }
    for (int it = F.wg; it < 32; it += F.G) {
        const int l = it / 16, g = it % 16;
        LAS f32x2* Ap = (LAS f32x2*)(F.lds);
        LAS f32x2* Bb = Ap + 17 * 64;
        LAS f32x2* Cc = Bb + 64 * 16;
        LAS float* Kj = (LAS float*)(Cc + 16 * 64);
        __syncthreads();
        const double dt = exp((double)F.in[IN_LDT][l * 16 + g]);
        for (int idx = F.tid; idx < 17 * 64; idx += 512) { const int j = idx / 64, n = idx % 64;
            const double lr = F.in[IN_LRE][(l * 16 + g) * 64 + n], li = F.in[IN_LIM][(l * 16 + g) * 64 + n];
            const double mg = exp(j * lr * dt), an = j * li * dt; Ap[idx] = (f32x2){(float)(mg * cos(an)), (float)(mg * sin(an))}; }
        for (int idx = F.tid; idx < 64 * 16; idx += 512) { const int n = idx / 16, c = idx % 16;
            const double lr = F.in[IN_LRE][(l * 16 + g) * 64 + n], li = F.in[IN_LIM][(l * 16 + g) * 64 + n];
            const double mg = exp(lr * dt), ar = mg * cos(li * dt), ai = mg * sin(li * dt), den = lr * lr + li * li, zr = ar - 1.0, zi = ai;
            const double fr = (zr * lr + zi * li) / den, fi = (zi * lr - zr * li) / den;
            const double br = F.in[IN_BRE][((size_t)(l * 16 + g) * 64 + n) * 16 + c], bi = F.in[IN_BIM][((size_t)(l * 16 + g) * 64 + n) * 16 + c];
            Bb[idx] = (f32x2){(float)(fr * br - fi * bi), (float)(fr * bi + fi * br)}; }
        for (int idx = F.tid; idx < 16 * 64; idx += 512) { const int c = idx / 64, n = idx % 64;
            Cc[idx] = (f32x2){F.in[IN_CRE][((size_t)(l * 16 + g) * 16 + c) * 64 + n], F.in[IN_CIM][((size_t)(l * 16 + g) * 16 + c) * 64 + n]}; }
        __syncthreads();
        for (int idx = F.tid; idx < 4096; idx += 512) { const int j = idx >> 8, co = (idx >> 4) & 15, ci = idx & 15; float s = 0.f;
            for (int n = 0; n < 64; ++n) { const f32x2 a = Ap[j * 64 + n], b = Bb[n * 16 + ci], c = Cc[co * 64 + n];
                const float abr = a.x * b.x - a.y * b.y, abi = a.x * b.y + a.y * b.x; s += c.x * abr - c.y * abi; }
            Kj[idx] = s; }
        if (F.tid < 64) ((f32x2*)(F.ws + WS_S5A))[(l * 16 + g) * 64 + F.tid] = Ap[16 * 64 + F.tid];
        __syncthreads();
        bf16* TQ = (bf16*)(F.ws + WS_S5TQ) + (size_t)(l * 16 + g) * 256 * 384;
        for (int idx = F.tid; idx < 256 * 384; idx += 512) { const int nn = idx / 384, k = idx % 384, t = nn >> 4, co = nn & 15; float v;
            if (k < 256) { const int s = k >> 4, ci = k & 15; v = (s <= t) ? Kj[((t - s) << 8) + (co << 4) + ci] : 0.f; }
            else { const int kk = k - 256, n = kk >> 1; const f32x2 a = Ap[(t + 1) * 64 + n], c = Cc[co * 64 + n];
                const float zr = c.x * a.x - c.y * a.y, zi = c.x * a.y + c.y * a.x; v = (kk & 1) ? -zi : zr; }
            TQ[idx] = (bf16)f2bf(v); }
        bf16* PM = (bf16*)(F.ws + WS_S5P) + (size_t)(l * 16 + g) * 256 * 256;
        for (int idx = F.tid; idx < 256 * 256; idx += 512) { const int nn = idx >> 8, k = idx & 255; float v = 0.f;
            if (nn < 128) { const int n = nn >> 1, s = k >> 4, ci = k & 15; const f32x2 a = Ap[(15 - s) * 64 + n], b = Bb[n * 16 + ci];
                v = (nn & 1) ? (a.x * b.y + a.y * b.x) : (a.x * b.x - a.y * b.y); }
            PM[idx] = (bf16)f2bf(v); }
        __syncthreads();
    }
}

template <class V> __device__ __forceinline__ V ldg(const void* sbase, unsigned voff) { return *(const GAS V*)((const char*)sbase + voff); }
template <class V> __device__ __forceinline__ void stg(void* sbase, unsigned voff, V v) { *(GAS V*)((char*)sbase + voff) = v; }
#define GLDS2(p0, p1, dst) do { __builtin_amdgcn_global_load_lds((const unsigned*)(p0), (LAS unsigned*)(dst), 16, 0, 0); __builtin_amdgcn_global_load_lds((const unsigned*)(p1), (LAS unsigned*)((dst) + 8192), 16, 0, 0); } while (0)
#define EPI_FENCE() __builtin_amdgcn_sched_barrier(0)
struct UnitT { int pm, pn; };

struct PolIn {
    typedef UnitT Unit; static constexpr int NT = 16, LDB = 1024;
    pg8::TileOrder ord; const bf16* A; const bf16* B; bf16* proj; const float* ss16; const float* rope;
    __device__ __forceinline__ bool next(int i, Unit& u) const { return ord.get(i, u.pm, u.pn); }
    __device__ __forceinline__ void stage_a(LAS unsigned char* dst, int, const Unit& u, int t, int h, const int (&R)[2], const int (&C)[2]) const {
        const char* bp = (const char*)(A + (size_t)(u.pm * 256 + h * 128) * 1024) + t * 128;
        GLDS2(bp + (unsigned)((R[0] * 1024 + C[0]) * 2), bp + (unsigned)((R[1] * 1024 + C[1]) * 2), dst); }
    __device__ __forceinline__ const char* b_ptr(const Unit& u, int t) const { return (const char*)(B + (size_t)u.pn * 256 * 1024) + t * 128; }
    __device__ __forceinline__ void epi(const AccT& acc, const Unit& u, int wr, int wc, int fr, int fq, int) const {
        const bool isrope = (u.pn >= 5 && u.pn <= 8); const float qs = (u.pn == 5 || u.pn == 6) ? QSCALE : 1.f;
        const unsigned fi = 4u * (4u * (wc & 1) + fq);
        const unsigned vo_p = (unsigned)((fr * NI + u.pn * 256 + wc * 32 + 8 * fq) * 2), vo_s = (unsigned)(fr * 64);
#pragma unroll
        for (int ai = 0; ai < 2; ++ai)
#pragma unroll
            for (int m = 0; m < 4; ++m) {
                const int rowu = u.pm * 256 + ai * 128 + wr * 64 + m * 16;
                const float* sp = ss16 + (size_t)rowu * 16;
                const f32x4 s0 = ldg<f32x4>(sp, vo_s), s1 = ldg<f32x4>(sp, vo_s + 16), s2 = ldg<f32x4>(sp, vo_s + 32), s3 = ldg<f32x4>(sp, vo_s + 48);
                const float ss = ((s0.x + s0.y) + (s0.z + s0.w)) + ((s1.x + s1.y) + (s1.z + s1.w)) + ((s2.x + s2.y) + (s2.z + s2.w)) + ((s3.x + s3.y) + (s3.z + s3.w));
                const float rstd = rsqrtf(ss * (1.f / 1024.f) + RMS_EPS);
                f32x4 cs = (f32x4){1.f, 1.f, 1.f, 1.f}, sn = (f32x4){0.f, 0.f, 0.f, 0.f};
                if (isrope) { const unsigned pos = (unsigned)(rowu + fr) % (unsigned)LT; cs = ldg<f32x4>(rope, (pos * 32 + fi) * 4); sn = ldg<f32x4>(rope, (LT * 32 + pos * 32 + fi) * 4); }
                bf16* rowp = proj + (size_t)rowu * NI;
#pragma unroll
                for (int bj = 0; bj < 2; ++bj) {
                    f32x4 v0 = acc[ai][bj][m][0] * rstd, v1 = acc[ai][bj][m][1] * rstd;
                    if (isrope) { const f32x4 o0 = (v0 * cs - v1 * sn) * qs, o1 = (v1 * cs + v0 * sn) * qs; v0 = o0; v1 = o1; }
                    u32x4 w; w.x = cvt_pk_bf16(v0[0], v0[1]); w.y = cvt_pk_bf16(v0[2], v0[3]); w.z = cvt_pk_bf16(v1[0], v1[1]); w.w = cvt_pk_bf16(v1[2], v1[3]);
                    stg<u32x4>(rowp, vo_p + bj * 256, w);
                }
                EPI_FENCE();
            }
    }
};

struct UnitS5 { int g, mt; };
struct PolS5E {
    typedef UnitS5 Unit; static constexpr int NT = 4, LDB = 256;
    int G, c; const bf16* proj; const bf16* B; float* E;
    __device__ __forceinline__ bool next(int i, Unit& u) const { const int Lx = i * G + c; if (Lx >= 16 * 17) return false; u.g = Lx / 17; u.mt = Lx % 17; return true; }
    __device__ __forceinline__ void stage_a(LAS unsigned char* dst, int, const Unit& u, int t, int h, const int (&R)[2], const int (&C)[2]) const {
        const char* bp = (const char*)(proj + ((size_t)(16 * (256 * u.mt + 128 * h) + 4 * t)) * NI + C_U + u.g * 16);
        GLDS2(bp + (unsigned)(((16 * R[0] + (C[0] >> 4)) * NI + (C[0] & 15)) * 2), bp + (unsigned)(((16 * R[1] + (C[1] >> 4)) * NI + (C[1] & 15)) * 2), dst); }
    __device__ __forceinline__ const char* b_ptr(const Unit& u, int t) const { return (const char*)(B + (size_t)u.g * 256 * 256) + t * 128; }
    __device__ __forceinline__ void epi(const AccT& acc, const Unit& u, int wr, int wc, int fr, int fq, int) const {
        const unsigned vo = (unsigned)((fr * 128 + wc * 32 + 8 * fq) * 4);
#pragma unroll
        for (int ai = 0; ai < 2; ++ai)
#pragma unroll
            for (int m = 0; m < 4; ++m) { float* ep = E + ((size_t)u.g * S5RP + u.mt * 256 + ai * 128 + wr * 64 + m * 16) * 128;
                stg<f32x4>(ep, vo, acc[ai][0][m][0]); stg<f32x4>(ep, vo + 16, acc[ai][0][m][1]); }
    }
};

struct PolS5Y {
    typedef UnitS5 Unit; static constexpr int NT = 6, LDB = 384;
    int G, c; const bf16* X; const bf16* B; const bf16* proj; const float* dsk; bf16* Gout;
    __device__ __forceinline__ bool next(int i, Unit& u) const { const int Lx = i * G + c; if (Lx >= 16 * 17) return false; u.g = Lx / 17; u.mt = Lx % 17; return true; }
    __device__ __forceinline__ void stage_a(LAS unsigned char* dst, int, const Unit& u, int t, int h, const int (&R)[2], const int (&C)[2]) const {
        const char* bp = (const char*)(X + ((size_t)u.g * S5RP + 256 * u.mt + 128 * h) * 384) + t * 128;
        GLDS2(bp + (unsigned)((R[0] * 384 + C[0]) * 2), bp + (unsigned)((R[1] * 384 + C[1]) * 2), dst); }
    __device__ __forceinline__ const char* b_ptr(const Unit& u, int t) const { return (const char*)(B + (size_t)u.g * 256 * 384) + t * 128; }
    __device__ __forceinline__ void epi(const AccT& acc, const Unit& u, int wr, int wc, int fr, int fq, int) const {
        const int ch = u.g * 16 + 8 * (fq & 1);
        const f32x4 d0 = ldg<f32x4>(dsk, (unsigned)ch * 4), d1 = ldg<f32x4>(dsk, (unsigned)ch * 4 + 16);
        const unsigned vo_u = (unsigned)(((16 * fr + (fq >> 1)) * NI + C_U + ch) * 2), vo_g = (unsigned)(((16 * fr + (fq >> 1)) * 256 + ch) * 2);
#pragma unroll
        for (int ai = 0; ai < 2; ++ai)
#pragma unroll
            for (int m = 0; m < 4; ++m) { const int Ru = u.mt * 256 + ai * 128 + wr * 64 + m * 16;
                if (Ru + fr < S5R) {
#pragma unroll
                    for (int bj = 0; bj < 2; ++bj) { const size_t toku = (size_t)16 * Ru + 8 * bj + 2 * wc;
                        const u32x4 uu = ldg<u32x4>(proj + toku * NI, vo_u);
                        f32x4 v0 = acc[ai][bj][m][0], v1 = acc[ai][bj][m][1];
                        v0[0] += d0[0] * bf2f(uu.x); v0[1] += d0[1] * bf2f(uu.x >> 16); v0[2] += d0[2] * bf2f(uu.y); v0[3] += d0[3] * bf2f(uu.y >> 16);
                        v1[0] += d1[0] * bf2f(uu.z); v1[1] += d1[1] * bf2f(uu.z >> 16); v1[2] += d1[2] * bf2f(uu.w); v1[3] += d1[3] * bf2f(uu.w >> 16);
                        u32x4 w; w.x = pk2(gelu_tanh(v0[0]), gelu_tanh(v0[1])); w.y = pk2(gelu_tanh(v0[2]), gelu_tanh(v0[3]));
                        w.z = pk2(gelu_tanh(v1[0]), gelu_tanh(v1[1])); w.w = pk2(gelu_tanh(v1[2]), gelu_tanh(v1[3]));
                        stg<u32x4>(Gout + toku * 256, vo_g, w); }
                }
                EPI_FENCE();
            }
    }
};

struct PolGlu {
    typedef UnitT Unit; static constexpr int NT = 4, LDB = 256;
    pg8::TileOrder ord; const bf16* A; const bf16* B; bf16* mixed;
    __device__ __forceinline__ bool next(int i, Unit& u) const { return ord.get(i, u.pm, u.pn); }
    __device__ __forceinline__ void stage_a(LAS unsigned char* dst, int, const Unit& u, int t, int h, const int (&R)[2], const int (&C)[2]) const {
        const char* bp = (const char*)(A + (size_t)(u.pm * 256 + h * 128) * 256) + t * 128;
        GLDS2(bp + (unsigned)((R[0] * 256 + C[0]) * 2), bp + (unsigned)((R[1] * 256 + C[1]) * 2), dst); }
    __device__ __forceinline__ const char* b_ptr(const Unit& u, int t) const { return (const char*)(B + (size_t)u.pn * 256 * 256) + t * 128; }
    __device__ __forceinline__ void epi(const AccT& acc, const Unit& u, int wr, int wc, int fr, int fq, int) const {
        const unsigned vo = (unsigned)((fr * D + u.pn * 128 + wc * 32 + 8 * fq) * 2);
#pragma unroll
        for (int ai = 0; ai < 2; ++ai)
#pragma unroll
            for (int m = 0; m < 4; ++m) { bf16* rp = mixed + (size_t)(u.pm * 256 + ai * 128 + wr * 64 + m * 16) * D;
                const f32x4 a0 = acc[ai][0][m][0], a1 = acc[ai][0][m][1], b0 = acc[ai][1][m][0], b1 = acc[ai][1][m][1];
                u32x4 w; w.x = pk2(a0[0] * sigmoidf_(b0[0]), a0[1] * sigmoidf_(b0[1])); w.y = pk2(a0[2] * sigmoidf_(b0[2]), a0[3] * sigmoidf_(b0[3]));
                w.z = pk2(a1[0] * sigmoidf_(b1[0]), a1[1] * sigmoidf_(b1[1])); w.w = pk2(a1[2] * sigmoidf_(b1[2]), a1[3] * sigmoidf_(b1[3]));
                stg<u32x4>(rp, vo, w);
                EPI_FENCE(); }
    }
};

__device__ __forceinline__ void residual_rows(const AccT& acc, int ai, int m, unsigned vrow, bool valid, int pn, int wc, int fq, float* hrow, bf16* brow, float* srow) {
    const unsigned colb = (unsigned)(pn * 256 + wc * 32 + 8 * fq);
    const unsigned vh = (vrow * D + colb) * 4, vb = (vrow * D + colb) * 2;
    float ssq = 0.f;
    if (valid) {
#pragma unroll
        for (int bj = 0; bj < 2; ++bj) {
            f32x4 h0 = ldg<f32x4>(hrow, vh + bj * 512), h1 = ldg<f32x4>(hrow, vh + bj * 512 + 16);
            h0 += acc[ai][bj][m][0]; h1 += acc[ai][bj][m][1];
            stg<f32x4>(hrow, vh + bj * 512, h0); stg<f32x4>(hrow, vh + bj * 512 + 16, h1);
            u32x4 w; w.x = cvt_pk_bf16(h0[0], h0[1]); w.y = cvt_pk_bf16(h0[2], h0[3]); w.z = cvt_pk_bf16(h1[0], h1[1]); w.w = cvt_pk_bf16(h1[2], h1[3]);
            stg<u32x4>(brow, vb + bj * 256, w);
            ssq += (h0[0] * h0[0] + h0[1] * h0[1]) + (h0[2] * h0[2] + h0[3] * h0[3]) + (h1[0] * h1[0] + h1[1] * h1[1]) + (h1[2] * h1[2] + h1[3] * h1[3]);
        }
    }
    ssq += __shfl_xor(ssq, 16); ssq += __shfl_xor(ssq, 32);
    if (valid && fq == 0) stg<float>(srow, (vrow * 16 + pn * 4 + wc) * 4, ssq);
}

struct PolOut {
    typedef UnitT Unit; static constexpr int NT = 16, LDB = 1024;
    pg8::TileOrder ord; const bf16* A; const bf16* B; float* H; bf16* HB; float* ss16;
    __device__ __forceinline__ bool next(int i, Unit& u) const { return ord.get(i, u.pm, u.pn); }
    __device__ __forceinline__ void stage_a(LAS unsigned char* dst, int, const Unit& u, int t, int h, const int (&R)[2], const int (&C)[2]) const {
        const char* bp = (const char*)(A + (size_t)(u.pm * 256 + h * 128) * 1024) + t * 128;
        GLDS2(bp + (unsigned)((R[0] * 1024 + C[0]) * 2), bp + (unsigned)((R[1] * 1024 + C[1]) * 2), dst); }
    __device__ __forceinline__ const char* b_ptr(const Unit& u, int t) const { return (const char*)(B + (size_t)u.pn * 256 * 1024) + t * 128; }
    __device__ __forceinline__ void epi(const AccT& acc, const Unit& u, int wr, int wc, int fr, int fq, int) const {
#pragma unroll
        for (int ai = 0; ai < 2; ++ai)
#pragma unroll
            for (int m = 0; m < 4; ++m) { const size_t rowu = (size_t)(u.pm * 256 + ai * 128 + wr * 64 + m * 16);
                residual_rows(acc, ai, m, (unsigned)fr, true, u.pn, wc, fq, H + rowu * D, HB + rowu * D, ss16 + rowu * 16);
                EPI_FENCE(); }
    }
};

struct MoeList {
    LAS const int* cnt;
    __device__ __forceinline__ int ntiles() const { int s = 0; for (int c = 0; c < NCLS; ++c) s += (cnt[c] + 255) >> 8; return __builtin_amdgcn_readfirstlane(s); }
    __device__ __forceinline__ void decode(int gt, int& c, int& ti, int& nvalid) const {
        int s = 0, cc = 0, tt = 0, nv = 0;
        for (int k = 0; k < NCLS; ++k) { const int n = (cnt[k] + 255) >> 8; if (gt >= s && gt < s + n) { cc = k; tt = gt - s; nv = cnt[k] - 256 * tt; } s += n; }
        c = __builtin_amdgcn_readfirstlane(cc); ti = __builtin_amdgcn_readfirstlane(tt); nvalid = __builtin_amdgcn_readfirstlane(nv > 256 ? 256 : nv);
    }
};
__device__ __forceinline__ void class_experts(int c, int& ea, int& eb) {
    const int g = c / 6, p = c % 6; const int a = (p < 3) ? 0 : (p < 5 ? 1 : 2); const int b = (p < 3) ? p + 1 : (p < 5 ? p - 1 : 3);
    ea = g * 4 + a; eb = g * 4 + b;
}
struct UnitM { int gt, pn, c; };

struct PolGU {
    typedef UnitM Unit; static constexpr int NT = 16, LDB = 1024;
    int G, c, ntl; MoeList ml; LAS const int* tab;
    const bf16* HB; const bf16* W; bf16* he; const float* rstd; const float* gate;
    __device__ __forceinline__ bool next(int i, Unit& u) const { const int Lx = i * G + c; if (Lx >= ntl * 8) return false; u.gt = Lx >> 3; u.pn = Lx & 7; int ti, nv; ml.decode(u.gt, u.c, ti, nv); return true; }
    __device__ __forceinline__ void stage_a(LAS unsigned char* dst, int ui, const Unit&, int t, int h, const int (&R)[2], const int (&C)[2]) const {
        const char* bp = (const char*)HB + t * 128;
        const int t0 = tab[ui * 256 + 128 * h + R[0]], t1 = tab[ui * 256 + 128 * h + R[1]];
        GLDS2(bp + (unsigned)((t0 < 0 ? 0 : t0) * 2048 + C[0] * 2), bp + (unsigned)((t1 < 0 ? 0 : t1) * 2048 + C[1] * 2), dst); }
    __device__ __forceinline__ const char* b_ptr(const Unit& u, int t) const { int ea, eb; class_experts(u.c, ea, eb); const int e = (u.pn >> 2) ? eb : ea;
        return (const char*)(W + ((size_t)e * 1024 + (u.pn & 3) * 256) * 1024) + t * 128; }
    __device__ __forceinline__ void epi(const AccT& acc, const Unit& u, int wr, int wc, int fr, int fq, int ui) const {
        const int sel = u.pn >> 2;
        const unsigned vo = (unsigned)((fr * 1024 + sel * 512 + (u.pn & 3) * 128 + wc * 32 + 8 * fq) * 2);
#pragma unroll
        for (int ai = 0; ai < 2; ++ai)
#pragma unroll
            for (int m = 0; m < 4; ++m) { const int ru = ai * 128 + wr * 64 + m * 16; const int tk = tab[ui * 256 + ru + fr];
                float rs = 0.f, gw = 0.f; if (tk >= 0) { rs = ldg<float>(rstd, (unsigned)tk * 4); gw = ldg<float>(gate, (unsigned)(2 * tk + sel) * 4); }
                const f32x4 g0 = acc[ai][0][m][0] * rs, g1 = acc[ai][0][m][1] * rs, u0 = acc[ai][1][m][0] * (rs * gw), u1 = acc[ai][1][m][1] * (rs * gw);
                u32x4 w; w.x = pk2(siluf_(g0[0]) * u0[0], siluf_(g0[1]) * u0[1]); w.y = pk2(siluf_(g0[2]) * u0[2], siluf_(g0[3]) * u0[3]);
                w.z = pk2(siluf_(g1[0]) * u1[0], siluf_(g1[1]) * u1[1]); w.w = pk2(siluf_(g1[2]) * u1[2], siluf_(g1[3]) * u1[3]);
                stg<u32x4>(he + ((size_t)u.gt * 256 + ru) * 1024, vo, w);
                EPI_FENCE(); }
    }
};

struct PolDN {
    typedef UnitM Unit; static constexpr int NT = 16, LDB = 512;
    int G, c, ntl; MoeList ml; LAS const int* tab;
    const bf16* he; const bf16* W; float* H; bf16* HB; float* ss16;
    __device__ __forceinline__ bool next(int i, Unit& u) const { const int Lx = i * G + c; if (Lx >= ntl * 4) return false; u.gt = Lx >> 2; u.pn = Lx & 3; int ti, nv; ml.decode(u.gt, u.c, ti, nv); return true; }
    __device__ __forceinline__ void stage_a(LAS unsigned char* dst, int, const Unit& u, int t, int h, const int (&R)[2], const int (&C)[2]) const {
        const char* bp = (const char*)(he + (size_t)(u.gt * 256 + h * 128) * 1024) + t * 128;
        GLDS2(bp + (unsigned)((R[0] * 1024 + C[0]) * 2), bp + (unsigned)((R[1] * 1024 + C[1]) * 2), dst); }
    __device__ __forceinline__ const char* b_ptr(const Unit& u, int t) const { int ea, eb; class_experts(u.c, ea, eb); const int e = (t >= 8) ? eb : ea;
        return (const char*)(W + ((size_t)e * 1024 + u.pn * 256) * 512) + (t & 7) * 128; }
    __device__ __forceinline__ void epi(const AccT& acc, const Unit& u, int wr, int wc, int fr, int fq, int ui) const {
#pragma unroll
        for (int ai = 0; ai < 2; ++ai)
#pragma unroll
            for (int m = 0; m < 4; ++m) { const int tk = tab[ui * 256 + ai * 128 + wr * 64 + m * 16 + fr];
                residual_rows(acc, ai, m, (unsigned)(tk < 0 ? 0 : tk), tk >= 0, u.pn, wc, fq, H, HB, ss16);
                EPI_FENCE(); }
    }
};

#define MFMA16(a, b, c) __builtin_amdgcn_mfma_f32_16x16x32_bf16(a, b, c, 0, 0, 0)
#define MFMA32(a, b, c) __builtin_amdgcn_mfma_f32_32x32x16_bf16(a, b, c, 0, 0, 0)

__device__ __forceinline__ void s5_scan(const Frame& F0, int l) {
    Frame F = F0; LAUNDER(F.tid); F.lane = F.tid & 63;
    const bf16* proj = (const bf16*)(F.ws + WS_PROJ); const float* E = (const float*)(F.os + OS_E); bf16* X = (bf16*)(F.os + OS_X);
    const int lane = F.lane;
    for (int it = F.wg + F.G * F.wave; it < NB * 16; it += F.G * 8) {
        const int b = it >> 4, g = it & 15;
        const f32x2 A16 = ((const f32x2*)(F.ws + WS_S5A))[(l * 16 + g) * 64 + lane];
        float sr = 0.f, si = 0.f;
        for (int r0 = 0; r0 < NCH; r0 += 16) {
            f32x2 e[16]; u32x2 u4[16];
#pragma unroll
            for (int j = 0; j < 16; ++j) if (r0 + j < NCH) { const size_t R = (size_t)b * NCH + r0 + j;
                e[j] = *(const GAS f32x2*)(E + ((size_t)g * S5RP + R) * 128 + 2 * lane);
                u4[j] = *(const GAS u32x2*)(proj + (16 * R + (lane >> 2)) * NI + C_U + g * 16 + 4 * (lane & 3)); }
#pragma unroll
            for (int j = 0; j < 16; ++j) if (r0 + j < NCH) { const size_t R = (size_t)b * NCH + r0 + j;
                bf16* xr = X + ((size_t)g * S5RP + R) * 384;
                *(GAS unsigned*)(xr + 256 + 2 * lane) = pk2(sr, si);
                *(GAS u32x2*)(xr + 4 * lane) = u4[j];
                const float nr = A16.x * sr - A16.y * si + e[j].x, ni = A16.x * si + A16.y * sr + e[j].y; sr = nr; si = ni; }
        }
    }
}

__device__ __forceinline__ float hgrn_lb(const float* hlb, int l, int j) {
    if (l == 0) return 0.f;
    const float x0 = hlb[j], x1 = hlb[256 + j], mx = fmaxf(x0, x1), e0 = __expf(x0 - mx), e1 = __expf(x1 - mx);
    return e1 / (e0 + e1);
}
__device__ __forceinline__ float hgrn_logf(float z, float lb) {
    const float a = __logf(fmaxf(lb, 1e-30f));
    const float ls = fminf(z, 0.f) - __logf(1.f + __expf(-fabsf(z)));
    const float b = log1pf(-lb) + ls;
    return fmaxf(a, b) + __logf(1.f + __expf(-fabsf(a - b)));
}
constexpr int HG_HALF = 72960, HG_LF = 0, HG_SEG = 16640, HG_T0 = 17664, HG_TS = 9216;

__device__ __forceinline__ void hgrn_a(const Frame& F0, int l) {
    Frame F = F0; LAUNDER(F.tid); F.lane = F.tid & 63;
    const bf16* proj = (const bf16*)(F.ws + WS_PROJ); float* UT = (float*)(F.os + OS_UT); float* DEC = (float*)(F.os + OS_DEC);
    const int half = F.tid >> 8, ht = F.tid & 255, hw = F.wave & 3, lane = F.lane;
    LAS unsigned char* base = F.lds + half * HG_HALF;
    LAS float* LF = (LAS float*)(base + HG_LF); LAS float* SEG = (LAS float*)(base + HG_SEG);
    LAS bf16* vT = (LAS bf16*)(base + HG_T0); LAS bf16* KDT = (LAS bf16*)(base + HG_T0 + HG_TS);
    for (int p = F.wg; p < NB * 4 * HCH / 2; p += F.G) {
        const int item = 2 * p + half, c = item % HCH, bh = item / HCH, b = bh >> 2, h = bh & 3;
        const size_t tok0 = (size_t)b * LT + (c == 0 ? 0 : 16 + 64 * (c - 1)); const int nrows = (c == 0) ? 16 : 64;
#pragma unroll
        for (int e = 0; e < 2; ++e) { const int idx = ht + 256 * e, t = idx >> 3, c8 = idx & 7; const bool valid = t < nrows;
            u32x4 zf = (u32x4){0u, 0u, 0u, 0u}, zi = zf;
            if (valid) { zf = *(const GAS u32x4*)(proj + (tok0 + t) * NI + C_HF + h * 64 + 8 * c8); zi = *(const GAS u32x4*)(proj + (tok0 + t) * NI + C_HI + h * 64 + 8 * c8); }
#pragma unroll
            for (int jj = 0; jj < 8; ++jj) { const int d = 8 * c8 + jj; const unsigned wf = (jj & 1) ? (zf[jj >> 1] >> 16) : (zf[jj >> 1] & 0xffffu); const unsigned wi = (jj & 1) ? (zi[jj >> 1] >> 16) : (zi[jj >> 1] & 0xffffu);
                LF[t * 65 + d] = valid ? hgrn_logf(bf2f(wf), hgrn_lb(F.in[IN_HLB], l, h * 64 + d)) : 0.f;
                vT[d * 72 + t] = (bf16)wi; }
        }
        __syncthreads();
        const int d = ht & 63, seg = ht >> 6;
        { float run = 0.f;
#pragma unroll
          for (int i = 0; i < 16; ++i) { run += LF[(16 * seg + i) * 65 + d]; LF[(16 * seg + i) * 65 + d] = run; }
          SEG[seg * 64 + d] = run; }
        __syncthreads();
        { float offs = 0.f, last = 0.f;
#pragma unroll
          for (int s = 0; s < 4; ++s) { const float v = SEG[s * 64 + d]; if (s < seg) offs += v; last += v; }
          float prev = 0.f;
#pragma unroll
          for (int i = 0; i < 16; ++i) { const int t = 16 * seg + i; const float cl = LF[t * 65 + d], lf = cl - prev; prev = cl;
              const float k = -expm1f(lf); KDT[d * 72 + t] = (bf16)f2bf(k * __expf(last - (cl + offs))); }
          if (seg == 0) DEC[(size_t)item * 64 + d] = __expf(last); }
        __syncthreads();
        f32x4 acc[4];
#pragma unroll
        for (int nt = 0; nt < 4; ++nt) acc[nt] = (f32x4){0.f, 0.f, 0.f, 0.f};
#pragma unroll
        for (int ks = 0; ks < 2; ++ks) { const bf16x8 a = *(const LAS bf16x8*)(vT + (16 * hw + (lane & 15)) * 72 + 32 * ks + 8 * (lane >> 4));
#pragma unroll
            for (int nt = 0; nt < 4; ++nt) { const bf16x8 bb = *(const LAS bf16x8*)(KDT + (16 * nt + (lane & 15)) * 72 + 32 * ks + 8 * (lane >> 4)); acc[nt] = MFMA16(a, bb, acc[nt]); } }
#pragma unroll
        for (int nt = 0; nt < 4; ++nt)
#pragma unroll
            for (int j = 0; j < 4; ++j) UT[(size_t)item * 4096 + (16 * hw + 4 * (lane >> 4) + j) * 64 + 16 * nt + (lane & 15)] = acc[nt][j];
        __syncthreads();
    }
}

__device__ __forceinline__ void hgrn_b(const Frame& F0) {
    Frame F = F0; LAUNDER(F.tid); F.lane = F.tid & 63;
    const float* UT = (const float*)(F.os + OS_UT); const float* DEC = (const float*)(F.os + OS_DEC); bf16* SP = (bf16*)(F.os + OS_SP);
    for (int blk = F.wg; blk < NB * 4 * 8; blk += F.G) {
        const int bh = blk >> 3, e = (blk & 7) * 512 + F.tid, d = e & 63;
        float S = 0.f;
        for (int c0 = 0; c0 < HCH; c0 += 11) {
            float ut[11], dc[11];
#pragma unroll
            for (int j = 0; j < 11; ++j) { const size_t item = (size_t)bh * HCH + c0 + j; ut[j] = UT[item * 4096 + e]; dc[j] = DEC[item * 64 + d]; }
#pragma unroll
            for (int j = 0; j < 11; ++j) { const size_t item = (size_t)bh * HCH + c0 + j; SP[item * 4096 + e] = (bf16)f2bf(S); S = dc[j] * S + ut[j]; }
        }
    }
}

__device__ __forceinline__ void hgrn_c(const Frame& F0, int l) {
    Frame F = F0; LAUNDER(F.tid); F.lane = F.tid & 63;
    const bf16* proj = (const bf16*)(F.ws + WS_PROJ); const bf16* SPg = (const bf16*)(F.os + OS_SP); bf16* mixed = (bf16*)(F.ws + WS_MIXED);
    const int half = F.tid >> 8, ht = F.tid & 255, hw = F.wave & 3, lane = F.lane;
    LAS unsigned char* base = F.lds + half * HG_HALF;
    LAS float* LF = (LAS float*)(base + HG_LF); LAS float* SEG = (LAS float*)(base + HG_SEG);
    LAS bf16* vT = (LAS bf16*)(base + HG_T0); LAS bf16* QT = vT + HG_TS / 2; LAS bf16* KT = QT + HG_TS / 2; LAS bf16* QS = KT + HG_TS / 2; LAS bf16* SPt = QS + HG_TS / 2; LAS bf16* P = SPt + HG_TS / 2;
    const float* ng = F.in[IN_HNG] + l * 64;
    for (int p = F.wg; p < NB * 4 * HCH / 2; p += F.G) {
        const int item = 2 * p + half, c = item % HCH, bh = item / HCH, b = bh >> 2, h = bh & 3;
        const size_t tok0 = (size_t)b * LT + (c == 0 ? 0 : 16 + 64 * (c - 1)); const int nrows = (c == 0) ? 16 : 64;
        float qv[16], lfv[16];
#pragma unroll
        for (int e = 0; e < 2; ++e) { const int idx = ht + 256 * e, t = idx >> 3, c8 = idx & 7; const bool valid = t < nrows;
            u32x4 zq = (u32x4){0u, 0u, 0u, 0u}, zf = zq, zi = zq;
            if (valid) { const bf16* rp = proj + (tok0 + t) * NI + h * 64 + 8 * c8; zq = *(const GAS u32x4*)(rp + C_HQ); zf = *(const GAS u32x4*)(rp + C_HF); zi = *(const GAS u32x4*)(rp + C_HI); }
            const u32x4 sp = *(const GAS u32x4*)(SPg + (size_t)item * 4096 + t * 64 + 8 * c8);
            *(LAS u32x4*)(SPt + t * 72 + 8 * c8) = sp;
#pragma unroll
            for (int jj = 0; jj < 8; ++jj) { const int d = 8 * c8 + jj; const unsigned wq = (jj & 1) ? (zq[jj >> 1] >> 16) : (zq[jj >> 1] & 0xffffu);
                const unsigned wf = (jj & 1) ? (zf[jj >> 1] >> 16) : (zf[jj >> 1] & 0xffffu); const unsigned wi = (jj & 1) ? (zi[jj >> 1] >> 16) : (zi[jj >> 1] & 0xffffu);
                const float lf = valid ? hgrn_logf(bf2f(wf), hgrn_lb(F.in[IN_HLB], l, h * 64 + d)) : 0.f;
                LF[t * 65 + d] = lf; lfv[8 * e + jj] = lf; qv[8 * e + jj] = valid ? siluf_(bf2f(wq)) : 0.f;
                vT[d * 72 + t] = (bf16)wi; }
        }
        __syncthreads();
        { const int d = ht & 63, seg = ht >> 6; float run = 0.f;
#pragma unroll
          for (int i = 0; i < 16; ++i) { run += LF[(16 * seg + i) * 65 + d]; LF[(16 * seg + i) * 65 + d] = run; }
          SEG[seg * 64 + d] = run; }
        __syncthreads();
#pragma unroll
        for (int e = 0; e < 2; ++e) { const int idx = ht + 256 * e, t = idx >> 3, c8 = idx & 7, seg = t >> 4;
            unsigned wq[4], wk[4], ws[4];
#pragma unroll
            for (int jp = 0; jp < 4; ++jp) { float qt[2], kt[2], qs[2];
#pragma unroll
                for (int u = 0; u < 2; ++u) { const int jj = 2 * jp + u, d = 8 * c8 + jj;
                    float offs = 0.f;
#pragma unroll
                    for (int s = 0; s < 3; ++s) if (s < seg) offs += SEG[s * 64 + d];
                    const float cum = LF[t * 65 + d] + offs, mid = LF[31 * 65 + d] + SEG[d];
                    const float q = qv[8 * e + jj], k = -expm1f(lfv[8 * e + jj]);
                    qt[u] = q * __expf(cum - mid); kt[u] = k * __expf(mid - cum); qs[u] = q * __expf(cum); }
                wq[jp] = pk2(qt[0], qt[1]); wk[jp] = pk2(kt[0], kt[1]); ws[jp] = pk2(qs[0], qs[1]); }
            *(LAS u32x4*)(QT + t * 72 + 8 * c8) = (u32x4){wq[0], wq[1], wq[2], wq[3]};
            *(LAS u32x4*)(KT + t * 72 + 8 * c8) = (u32x4){wk[0], wk[1], wk[2], wk[3]};
            *(LAS u32x4*)(QS + t * 72 + 8 * c8) = (u32x4){ws[0], ws[1], ws[2], ws[3]};
        }
        __syncthreads();
        const int ar = (16 * hw + (lane & 15)) * 72 + 8 * (lane >> 4);
        {
            f32x4 sc[4];
#pragma unroll
            for (int nt = 0; nt < 4; ++nt) sc[nt] = (f32x4){0.f, 0.f, 0.f, 0.f};
#pragma unroll
            for (int ks = 0; ks < 2; ++ks) { const bf16x8 a = *(const LAS bf16x8*)(QT + ar + 32 * ks);
#pragma unroll
                for (int nt = 0; nt < 4; ++nt) { const bf16x8 bb = *(const LAS bf16x8*)(KT + (16 * nt + (lane & 15)) * 72 + 32 * ks + 8 * (lane >> 4)); sc[nt] = MFMA16(a, bb, sc[nt]); } }
#pragma unroll
            for (int nt = 0; nt < 4; ++nt)
#pragma unroll
                for (int j = 0; j < 4; ++j) { const int t = 16 * hw + 4 * (lane >> 4) + j, s = 16 * nt + (lane & 15); P[t * 72 + s] = (bf16)f2bf(s <= t ? sc[nt][j] : 0.f); }
        }
        __syncthreads();
        f32x4 o[4];
#pragma unroll
        for (int nt = 0; nt < 4; ++nt) o[nt] = (f32x4){0.f, 0.f, 0.f, 0.f};
#pragma unroll
        for (int ks = 0; ks < 2; ++ks) { const bf16x8 a = *(const LAS bf16x8*)(P + ar + 32 * ks), a2 = *(const LAS bf16x8*)(QS + ar + 32 * ks);
#pragma unroll
            for (int nt = 0; nt < 4; ++nt) { const int br = (16 * nt + (lane & 15)) * 72 + 32 * ks + 8 * (lane >> 4);
                o[nt] = MFMA16(a, *(const LAS bf16x8*)(vT + br), o[nt]); o[nt] = MFMA16(a2, *(const LAS bf16x8*)(SPt + br), o[nt]); } }
#pragma unroll
        for (int j = 0; j < 4; ++j) { const int t = 16 * hw + 4 * (lane >> 4) + j;
            float ssq = o[0][j] * o[0][j] + o[1][j] * o[1][j] + o[2][j] * o[2][j] + o[3][j] * o[3][j];
            ssq += __shfl_xor(ssq, 1); ssq += __shfl_xor(ssq, 2); ssq += __shfl_xor(ssq, 4); ssq += __shfl_xor(ssq, 8);
            const float rn = rsqrtf(ssq * (1.f / 64.f) + RMS_EPS);
            if (t < nrows) {
#pragma unroll
                for (int nt = 0; nt < 4; ++nt) { const int v = 16 * nt + (lane & 15);
                    const float zg = bf2f(proj[(tok0 + t) * NI + C_HG + h * 64 + v]);
                    mixed[(tok0 + t) * D + 256 + h * 64 + v] = (bf16)f2bf(o[nt][j] * rn * ng[v] * siluf_(zg)); } } }
        __syncthreads();
    }
}

constexpr int AT_K = 0, AT_V = 2 * 9216, AT_KB = 9216, AT_VB = 18432;
__device__ __forceinline__ int crow(int r, int hi) { return (r & 3) + 8 * (r >> 2) + 4 * hi; }
__device__ __forceinline__ void attn_unit(const Frame& F, int b, int h, int j, float lam, float oscale, const float* subg) {
    const bf16* proj = (const bf16*)(F.ws + WS_PROJ); bf16* mixed = (bf16*)(F.ws + WS_MIXED);
    const int tid = F.tid, lane = F.lane, w = F.wave, r32 = lane & 31, hi = lane >> 5;
    const int qbase = (j == 0) ? 0 : 16 + 256 * (j - 1), ntile = (j == 0) ? 1 : 4 * j + 1;
    const int qrow = qbase + 32 * w + r32;
    const bf16* pb = proj + (size_t)b * LT * NI + h * 128;
    bf16* ob = mixed + ((size_t)b * LT + qbase + 32 * w) * D + 512 + h * 128;
    const unsigned vo_o = (unsigned)((r32 * D + 4 * hi) * 2);
    const bool rowok = (j > 0) || (32 * w + r32 < 16);
    LAS bf16* Kl = (LAS bf16*)(F.lds + AT_K); LAS bf16* Vl = (LAS bf16*)(F.lds + AT_V);
    const int kkey = tid >> 3, kc8 = tid & 7;
    const unsigned vo_k = (unsigned)((kkey * NI + C_AK + 8 * kc8) * 2);
    const unsigned vo_v0 = (unsigned)(((tid >> 4) * NI + C_AV + 8 * (tid & 15)) * 2), vo_v1 = vo_v0 + (unsigned)(32 * NI * 2);
#pragma unroll 1
    for (int comp = 0; comp < 2; ++comp) {
        bf16x8 qf[4];
        { const unsigned vq = (unsigned)((qrow * NI + C_AQ + comp * 64 + 8 * hi) * 2);
#pragma unroll
          for (int ks = 0; ks < 4; ++ks) qf[ks] = ldg<bf16x8>(pb, vq + 32 * ks); }
        f32x16 O[4];
#pragma unroll
        for (int vb = 0; vb < 4; ++vb)
#pragma unroll
            for (int r = 0; r < 16; ++r) O[vb][r] = 0.f;
        float mrun = -1e30f, lrun = 0.f;
        u32x4 kreg, vreg0, vreg1;
#define AT_ISSUE(i_) do { const int kb_ = ((i_) == 0) ? 0 : 16 + 64 * ((i_) - 1); const bf16* tb_ = pb + (size_t)kb_ * NI; \
            kreg = ldg<u32x4>(tb_ + comp * 64, vo_k); vreg0 = ldg<u32x4>(tb_, vo_v0); vreg1 = ldg<u32x4>(tb_, vo_v1); } while (0)
#define AT_COMMIT(buf_) do { *(LAS u32x4*)(Kl + (buf_) * (AT_KB / 2) + kkey * 72 + 8 * kc8) = kreg; \
            _Pragma("unroll") for (int jj = 0; jj < 8; ++jj) { \
                const unsigned w0 = (jj & 1) ? (vreg0[jj >> 1] >> 16) : (vreg0[jj >> 1] & 0xffffu), w1 = (jj & 1) ? (vreg1[jj >> 1] >> 16) : (vreg1[jj >> 1] & 0xffffu); \
                Vl[(buf_) * (AT_VB / 2) + (8 * (tid & 15) + jj) * 72 + (tid >> 4)] = (bf16)w0; Vl[(buf_) * (AT_VB / 2) + (8 * (tid & 15) + jj) * 72 + (tid >> 4) + 32] = (bf16)w1; } } while (0)
        __syncthreads();
        AT_ISSUE(0); AT_COMMIT(0);
        __syncthreads();
#pragma unroll 1
        for (int i = 0; i < ntile; ++i) {
            const int buf = i & 1, kb = (i == 0) ? 0 : 16 + 64 * (i - 1);
            if (i + 1 < ntile) AT_ISSUE(i + 1);
            const LAS bf16* Kb = Kl + buf * (AT_KB / 2); const LAS bf16* Vb = Vl + buf * (AT_VB / 2);
            f32x16 sT[2];
#pragma unroll
            for (int kblk = 0; kblk < 2; ++kblk) {
#pragma unroll
                for (int r = 0; r < 16; ++r) sT[kblk][r] = 0.f;
#pragma unroll
                for (int ks = 0; ks < 4; ++ks) { const bf16x8 kf = *(const LAS bf16x8*)(Kb + (32 * kblk + r32) * 72 + 16 * ks + 8 * hi); sT[kblk] = MFMA32(kf, qf[ks], sT[kblk]); }
            }
            if (i == 0 || i >= ntile - 4) {
#pragma unroll
                for (int kblk = 0; kblk < 2; ++kblk)
#pragma unroll
                    for (int r = 0; r < 16; ++r) { const int kl = 32 * kblk + crow(r, hi); const bool ok = (kb + kl <= qrow) && (i > 0 || kl < 16); if (!ok) sT[kblk][r] = -INFINITY; }
            }
            float mx = sT[0][0];
#pragma unroll
            for (int r = 1; r < 16; ++r) mx = fmaxf(mx, sT[0][r]);
#pragma unroll
            for (int r = 0; r < 16; ++r) mx = fmaxf(mx, sT[1][r]);
            mx = fmaxf(mx, __shfl_xor(mx, 32));
            const float mnew = fmaxf(mrun, mx), alpha = __builtin_amdgcn_exp2f(mrun - mnew);
            float psum = 0.f;
#pragma unroll
            for (int kblk = 0; kblk < 2; ++kblk)
#pragma unroll
                for (int r = 0; r < 16; ++r) { const float pv = __builtin_amdgcn_exp2f(sT[kblk][r] - mnew); sT[kblk][r] = pv; psum += pv; }
            psum += __shfl_xor(psum, 32);
            lrun = lrun * alpha + psum; mrun = mnew;
#pragma unroll
            for (int vb = 0; vb < 4; ++vb)
#pragma unroll
                for (int r = 0; r < 16; ++r) O[vb][r] *= alpha;
#pragma unroll
            for (int kblk = 0; kblk < 2; ++kblk)
#pragma unroll
                for (int s = 0; s < 2; ++s) {
                    u32x4 pw; pw.x = cvt_pk_bf16(sT[kblk][8 * s + 0], sT[kblk][8 * s + 1]); pw.y = cvt_pk_bf16(sT[kblk][8 * s + 2], sT[kblk][8 * s + 3]);
                    pw.z = cvt_pk_bf16(sT[kblk][8 * s + 4], sT[kblk][8 * s + 5]); pw.w = cvt_pk_bf16(sT[kblk][8 * s + 6], sT[kblk][8 * s + 7]);
                    const bf16x8 pf = __builtin_bit_cast(bf16x8, pw);
#pragma unroll
                    for (int vb = 0; vb < 4; ++vb) { const LAS bf16* vp = Vb + (32 * vb + r32) * 72 + 32 * kblk + 16 * s + 4 * hi;
                        const u32x2 lo = *(const LAS u32x2*)(vp), hh = *(const LAS u32x2*)(vp + 8);
                        const bf16x8 vf = __builtin_bit_cast(bf16x8, (u32x4){lo.x, lo.y, hh.x, hh.y});
                        O[vb] = MFMA32(vf, pf, O[vb]); }
                }
            if (i + 1 < ntile) AT_COMMIT(buf ^ 1);
            __syncthreads();
        }
#undef AT_ISSUE
#undef AT_COMMIT
        const float linv = 1.f / lrun;
        if (comp == 0) {
#pragma unroll
            for (int vb = 0; vb < 4; ++vb)
#pragma unroll
                for (int g4 = 0; g4 < 4; ++g4) {
                    u32x2 wv; wv.x = pk2(O[vb][4 * g4 + 0] * linv, O[vb][4 * g4 + 1] * linv); wv.y = pk2(O[vb][4 * g4 + 2] * linv, O[vb][4 * g4 + 3] * linv);
                    if (rowok) stg<u32x2>(ob, vo_o + (unsigned)((32 * vb + 8 * g4) * 2), wv); }
        } else {
            float ssq = 0.f;
#pragma unroll
            for (int vb = 0; vb < 4; ++vb)
#pragma unroll
                for (int g4 = 0; g4 < 4; ++g4) {
                    u32x2 o0 = (u32x2){0u, 0u}; if (rowok) o0 = ldg<u32x2>(ob, vo_o + (unsigned)((32 * vb + 8 * g4) * 2));
                    const float a0 = bf2f(o0.x) - lam * (O[vb][4 * g4 + 0] * linv), a1 = bf2f(o0.x >> 16) - lam * (O[vb][4 * g4 + 1] * linv);
                    const float a2 = bf2f(o0.y) - lam * (O[vb][4 * g4 + 2] * linv), a3 = bf2f(o0.y >> 16) - lam * (O[vb][4 * g4 + 3] * linv);
                    O[vb][4 * g4 + 0] = a0; O[vb][4 * g4 + 1] = a1; O[vb][4 * g4 + 2] = a2; O[vb][4 * g4 + 3] = a3;
                    ssq += (a0 * a0 + a1 * a1) + (a2 * a2 + a3 * a3); }
            ssq += __shfl_xor(ssq, 32);
            const float rn = rsqrtf(ssq * (1.f / 128.f) + RMS_EPS) * oscale;
            if (rowok) {
#pragma unroll
                for (int vb = 0; vb < 4; ++vb)
#pragma unroll
                    for (int g4 = 0; g4 < 4; ++g4) { const f32x4 sg = ldg<f32x4>(subg, (unsigned)((32 * vb + 8 * g4 + 4 * hi) * 4));
                        u32x2 wv; wv.x = pk2(O[vb][4 * g4 + 0] * rn * sg[0], O[vb][4 * g4 + 1] * rn * sg[1]); wv.y = pk2(O[vb][4 * g4 + 2] * rn * sg[2], O[vb][4 * g4 + 3] * rn * sg[3]);
                        stg<u32x2>(ob, vo_o + (unsigned)((32 * vb + 8 * g4) * 2), wv); }
            }
        }
    }
}
__device__ __forceinline__ void attn_phase(const Frame& F0, int l) {
    Frame F = F0; LAUNDER(F.tid); F.lane = F.tid & 63;
    float s1 = 0.f, s2 = 0.f;
    for (int i = 0; i < 64; ++i) { s1 += F.in[IN_LQ1][l * 64 + i] * F.in[IN_LK1][l * 64 + i]; s2 += F.in[IN_LQ2][l * 64 + i] * F.in[IN_LK2][l * 64 + i]; }
    const float lam_init = 0.8f - 0.6f * expf(-0.3f * (float)l);
    const float lam = expf(s1) - expf(s2) + lam_init, oscale = 1.f - lam_init;
    const float* subg = F.in[IN_SUBLN] + l * 128;
    const int npair = (512 - F.wg + F.G - 1) / F.G, nmeta = (F.wg < NB * 4) ? (NB * 4 - F.wg + F.G - 1) / F.G : 0;
#pragma unroll 1
    for (int k = 0; k < 2 * npair + nmeta; ++k) {
        int bh, j;
        if (k < 2 * npair) { const int p = F.wg + (k >> 1) * F.G; bh = p >> 2; const int s = p & 3; j = (k & 1) ? s + 1 : 8 - s; }
        else { bh = F.wg + (k - 2 * npair) * F.G; j = 0; }
        attn_unit(F, bh >> 2, bh & 3, j, lam, oscale, subg);
    }
}

__device__ __forceinline__ void router_phase(const Frame& F0, int l) {
    Frame F = F0; LAUNDER(F.tid); F.lane = F.tid & 63;
    const float* H = (const float*)(F.ws + WS_H); const bf16* WR = (const bf16*)(F.ws + WS_WR) + (size_t)l * 2 * 32 * 1024;
    float* rstd = (float*)(F.ws + WS_RSTD); float* gate = (float*)(F.ws + WS_GATE); int* buck = (int*)(F.ws + WS_BUCK);
    unsigned* gcnt = (unsigned*)F.ws + CW_CNT + l * 64;
    LAS float* LG = (LAS float*)F.lds;
    LAS int* lcnt = (LAS int*)(F.lds + 32768);
    LAS int* lbase = lcnt + 32;
    LAS int* tcls = lbase + 32;
    LAS int* tpos = tcls + 272;
    const int lane = F.lane, w = F.wave, fr = lane & 15, fq = lane >> 4;
    for (int rng = F.wg; rng < MT; rng += F.G) {
        const int m0 = rng * 256;
        if (F.tid < 32) lcnt[F.tid] = 0;
        __syncthreads();
        for (int itx = 0; itx < 2; ++itx) {
            const int task = itx * 8 + w;
            const size_t mrow = (size_t)m0 + task * 16 + fr;
            f32x4 acc[2]; acc[0] = (f32x4){0.f, 0.f, 0.f, 0.f}; acc[1] = acc[0];
            float ssq = 0.f;
#pragma unroll 4
            for (int ks = 0; ks < 32; ++ks) {
                const f32x4 x0 = *(const GAS f32x4*)(H + mrow * D + 32 * ks + 8 * fq), x1 = *(const GAS f32x4*)(H + mrow * D + 32 * ks + 8 * fq + 4);
                ssq += (x0[0] * x0[0] + x0[1] * x0[1]) + (x0[2] * x0[2] + x0[3] * x0[3]) + (x1[0] * x1[0] + x1[1] * x1[1]) + (x1[2] * x1[2] + x1[3] * x1[3]);
                unsigned hw_[4], lw_[4];
#pragma unroll
                for (int q = 0; q < 4; ++q) { const float a = (q < 2) ? x0[2 * q] : x1[2 * q - 4], bq = (q < 2) ? x0[2 * q + 1] : x1[2 * q - 3];
                    const unsigned ha = f2bf(a), hb = f2bf(bq); hw_[q] = ha | (hb << 16); lw_[q] = pk2(a - bf2f(ha), bq - bf2f(hb)); }
                const bf16x8 ahi = __builtin_bit_cast(bf16x8, (u32x4){hw_[0], hw_[1], hw_[2], hw_[3]}), alo = __builtin_bit_cast(bf16x8, (u32x4){lw_[0], lw_[1], lw_[2], lw_[3]});
#pragma unroll
                for (int nt = 0; nt < 2; ++nt) { const bf16x8 bh_ = *(const GAS bf16x8*)(WR + (16 * nt + fr) * 1024 + 32 * ks + 8 * fq), bl_ = *(const GAS bf16x8*)(WR + 32 * 1024 + (16 * nt + fr) * 1024 + 32 * ks + 8 * fq);
                    acc[nt] = MFMA16(ahi, bh_, acc[nt]); acc[nt] = MFMA16(alo, bh_, acc[nt]); acc[nt] = MFMA16(ahi, bl_, acc[nt]); }
            }
            ssq += __shfl_xor(ssq, 16); ssq += __shfl_xor(ssq, 32);
            const float rs = rsqrtf(ssq * (1.f / 1024.f) + RMS_EPS);
#pragma unroll
            for (int nt = 0; nt < 2; ++nt)
#pragma unroll
                for (int j = 0; j < 4; ++j) LG[w * 16 * 33 + (4 * fq + j) * 33 + 16 * nt + fr] = acc[nt][j];
            LDS_WAIT(); asm volatile("" ::: "memory");
            if (lane < 16) {
                const int tl = task * 16 + lane; const size_t m = (size_t)m0 + tl;
                const float rsm = __shfl(rs, lane);
                const LAS float* lg = LG + w * 16 * 33 + lane * 33;
                float gl[4]; float gm = -1e30f; int gi = 0;
#pragma unroll
                for (int q = 0; q < 4; ++q) { gl[q] = lg[q] * rsm + F.in[IN_BGRP][l * 4 + q]; if (gl[q] > gm) { gm = gl[q]; gi = q; } }
                float gs = 0.f;
#pragma unroll
                for (int q = 0; q < 4; ++q) gs += __expf(gl[q] - gm);
                const float gp = 1.f / gs;
                float el[4];
#pragma unroll
                for (int q = 0; q < 4; ++q) { float v = 0.f;
#pragma unroll
                    for (int g2 = 0; g2 < 4; ++g2) if (g2 == gi) v = lg[4 + 4 * g2 + q] * rsm + F.in[IN_BEXP][l * 16 + 4 * g2 + q];
                    el[q] = v; }
                int i1 = 0; float v1 = el[0];
#pragma unroll
                for (int q = 1; q < 4; ++q) if (el[q] > v1) { v1 = el[q]; i1 = q; }
                int i2 = -1; float v2 = -1e30f;
#pragma unroll
                for (int q = 0; q < 4; ++q) if (q != i1 && el[q] > v2) { v2 = el[q]; i2 = q; }
                const float e2 = __expf(v2 - v1), w1 = gp / (1.f + e2), w2 = gp * e2 / (1.f + e2);
                const int a = i1 < i2 ? i1 : i2, bq = i1 < i2 ? i2 : i1;
                const int pidx = (a == 0) ? (bq - 1) : (a == 1 ? bq + 1 : 5);
                const int cls = gi * 6 + pidx;
                rstd[m] = rsm; gate[2 * m] = (a == i1) ? w1 : w2; gate[2 * m + 1] = (a == i1) ? w2 : w1;
                tcls[tl] = cls; tpos[tl] = atomicAdd((int*)&lcnt[cls], 1);
            }
        }
        __syncthreads();
        if (F.tid < NCLS) lbase[F.tid] = (int)atomicAdd(&gcnt[F.tid], (unsigned)lcnt[F.tid]);
        __syncthreads();
        if (F.tid < 256) { const int cls = tcls[F.tid]; buck[(size_t)cls * T + lbase[cls] + tpos[F.tid]] = m0 + F.tid; }
        __syncthreads();
    }
}

__device__ __forceinline__ void final_phase(const Frame& F0, float* out) {
    Frame F = F0; LAUNDER(F.tid); F.lane = F.tid & 63;
    const float* H = (const float*)(F.ws + WS_H); const float* g = F.in[IN_FNG];
    const int gw = F.wg * 8 + F.wave, NGW = F.G * 8, lane = F.lane;
    for (int r = gw; r < NB * SEQ; r += NGW) {
        const int b = r / SEQ, t = r % SEQ; const size_t m = (size_t)b * LT + NMETA + t;
        const GAS f32x4* hr = (const GAS f32x4*)(H + m * D) + lane; GAS f32x4* orow = (GAS f32x4*)(out + (size_t)r * D) + lane;
        f32x4 v[4]; float s = 0.f;
#pragma unroll
        for (int j = 0; j < 4; ++j) { v[j] = hr[64 * j]; s += (v[j].x * v[j].x + v[j].y * v[j].y) + (v[j].z * v[j].z + v[j].w * v[j].w); }
        const float rs = rsqrtf(wave_sum(s) * (1.f / 1024.f) + RMS_EPS);
#pragma unroll
        for (int j = 0; j < 4; ++j) { const f32x4 gg = *((const GAS f32x4*)g + lane + 64 * j); orow[64 * j] = v[j] * rs * gg; }
    }
}

template <int NPN>
__device__ __forceinline__ int moe_prepare(const Frame& F0, int l, LAS int* cntl, LAS int* tab) {
    Frame F = F0; LAUNDER(F.tid); F.lane = F.tid & 63;
    const unsigned* gcnt = (const unsigned*)F.ws + CW_CNT + l * 64; const int* buck = (const int*)(F.ws + WS_BUCK);
    __syncthreads();
    if (F.tid < NCLS) cntl[F.tid] = (int)gcnt[F.tid];
    __syncthreads();
    MoeList ml{cntl}; const int ntl = ml.ntiles();
    for (int i = 0;; ++i) { const int Lx = i * F.G + F.wg; if (Lx >= ntl * NPN) break;
        int c, ti, nv; ml.decode(Lx / NPN, c, ti, nv);
        if (F.tid < 256) tab[i * 256 + F.tid] = (F.tid < nv) ? buck[(size_t)c * T + ti * 256 + F.tid] : -1; }
    __syncthreads();
    return ntl;
}

__global__ void __launch_bounds__(512, 2) hymba_fwd(Args args) {
    extern __shared__ __attribute__((aligned(16))) unsigned char lds_raw[];
    Frame F;
    F.lds = (LAS unsigned char*)lds_raw;
    F.tid = threadIdx.x; F.lane = F.tid & 63; F.wave = __builtin_amdgcn_readfirstlane(F.tid >> 6);
    F.G = gridDim.x; F.wg = blockIdx.x; F.in = args.in; F.ws = args.ws; F.os = (unsigned char*)args.out;
    volatile LAS unsigned* MISC = (volatile LAS unsigned*)(F.lds + MISC_OFF);
    if (F.tid < 256) MISC[F.tid] = 0u;
    __syncthreads();
    const int lo = args.ph_lo, hi = args.ph_hi;
    const bool one = (hi - lo) > 1;
    XcdBarrier bar; bar.bar = (unsigned*)F.ws + CW_BAR; bar.x = 0; bar.st = nullptr;
    if (one) bar = xcd_barrier_post((unsigned*)F.ws + CW_BAR, MISC + 8);
#ifndef ONLY_MASK
#define ONLY_MASK 0xFFFFFFFFu
#endif
#define IN(k) (lo <= (k) && (k) < hi)
#define EN(j) ((ONLY_MASK >> (j)) & 1u)
#ifndef SUBMASK
#define SUBMASK 3u
#endif
#define SEAM(k) do { if (IN(k) && IN((k) + 1)) xcd_barrier(bar); } while (0)
    bf16* proj = (bf16*)(F.ws + WS_PROJ); bf16* mixed = (bf16*)(F.ws + WS_MIXED); float* H = (float*)(F.ws + WS_H); bf16* HB = (bf16*)(F.ws + WS_HB);
    float* ss16 = (float*)(F.ws + WS_SS16);
    LAS int* tab = (LAS int*)(F.lds + TAB_OFF); LAS int* cntl = (LAS int*)(F.lds + TAB_OFF + 12 * 1024);

    if (EN(0) && IN(0)) { p0_prologue(F); } SEAM(0);
#pragma unroll 1
    for (int l = 0; l < 2; ++l) {
        const int pb = 1 + 9 * l;
        if (EN(1) && IN(pb + 0)) {
            PolIn P; P.ord.init(MT, NI / 256, F.G, F.wg); P.A = HB; P.B = (const bf16*)(F.ws + WS_WIN) + (size_t)l * NI * D; P.proj = proj; P.ss16 = ss16; P.rope = (const float*)(F.ws + WS_ROPE);
            pg8::gemm_phase(F.lds, P); }
        SEAM(pb + 0);
        if (EN(2) && IN(pb + 1)) {
            PolS5E P; P.G = F.G; P.c = F.wg; P.proj = proj; P.B = (const bf16*)(F.ws + WS_S5P) + (size_t)l * 16 * 256 * 256; P.E = (float*)(F.os + OS_E);
            if (MIXSEL & 1u) pg8::gemm_phase(F.lds, P);
            __syncthreads();
            if (MIXSEL & 2u) hgrn_a(F, l); }
        SEAM(pb + 1);
        if (EN(3) && IN(pb + 2)) { if (MIXSEL & 1u) s5_scan(F, l); if (MIXSEL & 2u) hgrn_b(F); }
        SEAM(pb + 2);
        if (EN(4) && IN(pb + 3)) {
            PolS5Y P; P.G = F.G; P.c = F.wg; P.X = (const bf16*)(F.os + OS_X); P.B = (const bf16*)(F.ws + WS_S5TQ) + (size_t)l * 16 * 256 * 384; P.proj = proj; P.dsk = F.in[IN_S5D] + l * 256; P.Gout = (bf16*)(F.os + OS_G);
            if ((SUBMASK & 1u) && (MIXSEL & 1u)) pg8::gemm_phase(F.lds, P);
            __syncthreads();
            if ((SUBMASK & 2u) && (MIXSEL & 2u)) hgrn_c(F, l); }
        SEAM(pb + 3);
        if (EN(5) && IN(pb + 4)) {
            PolGlu P; P.ord.init(MT, 2, F.G, F.wg); P.A = (const bf16*)(F.os + OS_G); P.B = (const bf16*)(F.ws + WS_WGLU) + (size_t)l * 512 * 256; P.mixed = mixed;
            if ((SUBMASK & 1u) && (MIXSEL & 1u)) pg8::gemm_phase(F.lds, P);
            __syncthreads();
            if ((SUBMASK & 2u) && (MIXSEL & 4u)) attn_phase(F, l); }
        SEAM(pb + 4);
        if (EN(6) && IN(pb + 5)) {
            PolOut P; P.ord.init(MT, 4, F.G, F.wg); P.A = mixed; P.B = (const bf16*)(F.ws + WS_WOUT) + (size_t)l * D * D; P.H = H; P.HB = HB; P.ss16 = ss16;
            pg8::gemm_phase(F.lds, P); }
        SEAM(pb + 5);
        if (EN(7) && IN(pb + 6)) { router_phase(F, l); }
        SEAM(pb + 6);
        if (EN(8) && IN(pb + 7)) {
            PolGU P; P.G = F.G; P.c = F.wg; P.ntl = moe_prepare<8>(F, l, cntl, tab); P.ml = MoeList{cntl}; P.tab = tab;
            P.HB = HB; P.W = (const bf16*)(F.ws + WS_WGU) + (size_t)l * 16 * 1024 * 1024; P.he = proj; P.rstd = (const float*)(F.ws + WS_RSTD); P.gate = (const float*)(F.ws + WS_GATE);
            pg8::gemm_phase(F.lds, P); }
        SEAM(pb + 7);
        if (EN(9) && IN(pb + 8)) {
            PolDN P; P.G = F.G; P.c = F.wg; P.ntl = moe_prepare<4>(F, l, cntl, tab); P.ml = MoeList{cntl}; P.tab = tab;
            P.he = proj; P.W = (const bf16*)(F.ws + WS_WDN) + (size_t)l * 16 * 1024 * 512; P.H = H; P.HB = HB; P.ss16 = ss16;
            pg8::gemm_phase(F.lds, P); }
        SEAM(pb + 8);
    }
    if (EN(10) && IN(19)) final_phase(F, args.out);
#undef IN
#undef SEAM
}

extern "C" void kernel_launch(void* const* d_in, const int* in_sizes, int n_in, void* d_out, int out_size, void* d_ws, size_t ws_size, hipStream_t stream) {
    static int grid = 0;
    if (grid == 0) {
        if (n_in != 30 || ws_size < WS_END) { fprintf(stderr, "kernel_launch: unexpected inputs (n_in %d, ws %zu < %zu)\n", n_in, ws_size, (size_t)WS_END); grid = -1; return; }
        int dev = 0, cus = 0, per_cu = 0;
        (void)hipGetDevice(&dev); (void)hipDeviceGetAttribute(&cus, hipDeviceAttributeMultiprocessorCount, dev);
        (void)hipFuncSetAttribute((const void*)hymba_fwd, hipFuncAttributeMaxDynamicSharedMemorySize, LDS_BYTES);
        (void)hipOccupancyMaxActiveBlocksPerMultiprocessor(&per_cu, (const void*)hymba_fwd, 512, LDS_BYTES);
        (void)hipGetLastError();
        grid = cus > 0 ? cus : 256;
    }
    if (grid < 0) return;
    (void)hipMemsetAsync(d_ws, 0, CTL_BYTES, stream);
    Args a{};
    for (int i = 0; i < 30; ++i) a.in[i] = (const float*)d_in[i];
    a.out = (float*)d_out; a.ws = (unsigned char*)d_ws;
#if N_LAUNCH_MODE == 1
    a.ph_lo = 0; a.ph_hi = LAST_PHASE;
    hipLaunchKernelGGL(hymba_fwd, dim3(grid), dim3(512), LDS_BYTES, stream, a);
#else
    if (MIXSEL != 7u) (void)hipMemsetAsync((char*)d_ws + WS_MIXED, 0, (size_t)T * D * 2, stream);
    for (int p = 0; p < LAST_PHASE; ++p) { if (!((RUN_MASK >> p) & 1u)) continue; a.ph_lo = p; a.ph_hi = p + 1; hipLaunchKernelGGL(hymba_fwd, dim3(grid), dim3(512), LDS_BYTES, stream, a); }
#endif
}
```

```cpp
#include <hip/hip_runtime.h>
#include <stdint.h>
#include <stdio.h>

#ifndef N_LAUNCH_MODE
#define N_LAUNCH_MODE 1
#endif
#ifndef LAST_PHASE
#define LAST_PHASE 20
#endif
#ifndef RUN_MASK
#define RUN_MASK 0xFFFFFu
#endif
#ifndef MIXSEL
#define MIXSEL 7u
#endif

#define GAS __attribute__((address_space(1)))
#define LAS __attribute__((address_space(3)))
typedef unsigned short bf16;
typedef short bf16x8 __attribute__((ext_vector_type(8)));
typedef short s16x4 __attribute__((ext_vector_type(4)));
typedef float f32x2 __attribute__((ext_vector_type(2)));
typedef float f32x4 __attribute__((ext_vector_type(4)));
typedef float f32x16 __attribute__((ext_vector_type(16)));
typedef unsigned u32x2 __attribute__((ext_vector_type(2)));
typedef unsigned u32x4 __attribute__((ext_vector_type(4)));

constexpr int NB = 32, LT = 2064, NMETA = 16, SEQ = 2048, T = NB * LT;
constexpr int D = 1024, NI = 2816, MT = T / 256;
constexpr int C_U = 0, C_HQ = 256, C_HF = 512, C_HI = 768, C_HG = 1024, C_AQ = 1280, C_AK = 1792, C_AV = 2304;
constexpr int NCH = 129;
constexpr int S5R = NB * NCH;
constexpr int S5RP = 17 * 256;
constexpr int HCH = 33;
constexpr int NCLS = 24;
constexpr float RMS_EPS = 1e-6f;
constexpr float QSCALE = 0.125f * 1.4426950408889634f;

constexpr size_t al256(size_t x) { return (x + 255) & ~(size_t)255; }
constexpr size_t CTL_BYTES = 1u << 20;
constexpr size_t WS_WIN = CTL_BYTES;
constexpr size_t WS_WOUT = WS_WIN + al256((size_t)2 * NI * D * 2);
constexpr size_t WS_WGLU = WS_WOUT + al256((size_t)2 * D * D * 2);
constexpr size_t WS_WGU = WS_WGLU + al256((size_t)2 * 512 * 256 * 2);
constexpr size_t WS_WDN = WS_WGU + al256((size_t)2 * 16 * 1024 * 1024 * 2);
constexpr size_t WS_WR = WS_WDN + al256((size_t)2 * 16 * 1024 * 512 * 2);
constexpr size_t WS_S5TQ = WS_WR + al256((size_t)2 * 2 * 32 * 1024 * 2);
constexpr size_t WS_S5P = WS_S5TQ + al256((size_t)2 * 16 * 256 * 384 * 2);
constexpr size_t WS_S5A = WS_S5P + al256((size_t)2 * 16 * 256 * 256 * 2);
constexpr size_t WS_ROPE = WS_S5A + al256((size_t)2 * 16 * 64 * 8);
constexpr size_t WS_SS16 = WS_ROPE + al256((size_t)LT * 32 * 4 * 2);
constexpr size_t WS_RSTD = WS_SS16 + al256((size_t)T * 16 * 4);
constexpr size_t WS_GATE = WS_RSTD + al256((size_t)T * 4);
constexpr size_t WS_BUCK = WS_GATE + al256((size_t)T * 8);
constexpr size_t WS_H = WS_BUCK + al256((size_t)NCLS * T * 4);
constexpr size_t WS_HB = WS_H + al256((size_t)T * D * 4);
constexpr size_t WS_PROJ = WS_HB + al256((size_t)T * D * 2);
constexpr size_t WS_MIXED = WS_PROJ + al256((size_t)T * NI * 2);
constexpr size_t WS_END = WS_MIXED + al256((size_t)T * D * 2);
constexpr size_t OS_E = 0;
constexpr size_t OS_X = OS_E + al256((size_t)16 * S5RP * 128 * 4);
constexpr size_t OS_G = OS_X + al256((size_t)16 * S5RP * 384 * 2);
constexpr size_t OS_UT = OS_G + al256((size_t)T * 256 * 2);
constexpr size_t OS_DEC = OS_UT + al256((size_t)NB * 4 * HCH * 4096 * 4);
constexpr size_t OS_SP = OS_DEC + al256((size_t)NB * 4 * HCH * 64 * 4);
constexpr size_t OS_END = OS_SP + al256((size_t)NB * 4 * HCH * 4096 * 2);
static_assert(OS_END <= (size_t)NB * SEQ * D * 4, "mixer scratch must fit in d_out");
static_assert((size_t)(MT + NCLS) * 256 * 1024 * 2 <= (size_t)T * NI * 2, "he overlay fits in proj");

constexpr int CW_BAR = 4096, CW_CNT = 16384;

constexpr int LDS_BYTES = 147456;
constexpr int RING_BYTES = 131072;
constexpr int TAB_OFF = RING_BYTES;
constexpr int MISC_OFF = LDS_BYTES - 1024;

__device__ __forceinline__ unsigned f2bf(float f) { unsigned u = __builtin_bit_cast(unsigned, f); return (u + 0x7fffu + ((u >> 16) & 1u)) >> 16; }
__device__ __forceinline__ float bf2f(unsigned b) { return __builtin_bit_cast(float, (b & 0xffffu) << 16); }
__device__ __forceinline__ unsigned pk2(float lo, float hi) { return f2bf(lo) | (f2bf(hi) << 16); }
__device__ __forceinline__ unsigned cvt_pk_bf16(float lo, float hi) { unsigned r; asm volatile("v_cvt_pk_bf16_f32 %0, %1, %2" : "=v"(r) : "v"(lo), "v"(hi)); return r; }
__device__ __forceinline__ float wave_sum(float v) {
#pragma unroll
    for (int o = 1; o < 64; o <<= 1) v += __shfl_xor(v, o);
    return v;
}
__device__ __forceinline__ float sigmoidf_(float x) { return 1.f / (1.f + __expf(-x)); }
__device__ __forceinline__ float siluf_(float x) { return x / (1.f + __expf(-x)); }
__device__ __forceinline__ float gelu_tanh(float x) { const float u = 0.7978845608028654f * (x + 0.044715f * x * x * x); return x / (1.f + __expf(-2.f * u)); }
#define LAUNDER(x) asm volatile("" : "+v"(x))
#define LDS_WAIT() asm volatile("s_waitcnt lgkmcnt(0)" ::: "memory")
#define VM_WAIT() asm volatile("s_waitcnt vmcnt(0)" ::: "memory")

#define XB_TMO      128
#define XB_XCNT(j)  (256  + 64 * (j))
#define XB_XSUB(j)  (1280 + 64 * (j))
#define XB_XGEN(j)  (2304 + 64 * (j))
#define XB_TOP      3328
#define XB_TOPGEN   3392
#define XCD_BAR_WORDS 3456
#define XB_SPIN_CAP (1u << 18)
__device__ __forceinline__ unsigned xb_ld(unsigned* p)              { return __hip_atomic_load(p, __ATOMIC_RELAXED, __HIP_MEMORY_SCOPE_AGENT); }
__device__ __forceinline__ unsigned xb_add(unsigned* p, unsigned v) { return __hip_atomic_fetch_add(p, v, __ATOMIC_RELAXED, __HIP_MEMORY_SCOPE_AGENT); }
__device__ __forceinline__ unsigned xb_xcc_id() { return (unsigned)__builtin_amdgcn_s_getreg((3 << 11) | 20) & 0xFu; }
#define XB_SPIN(cond, bar) do { unsigned _sp = 0; while (cond) { __builtin_amdgcn_s_sleep(1); \
    if ((++_sp & 255u) == 0u) { if (xb_ld(&(bar)[XB_TMO])) break; if (_sp > XB_SPIN_CAP) { atomicAdd(&(bar)[XB_TMO], 1u); break; } } } } while (0)
struct XcdBarrier { unsigned* bar; unsigned x; volatile LAS unsigned* st; };
__device__ __forceinline__ XcdBarrier xcd_barrier_post(unsigned* bar, volatile LAS unsigned* st) {
    XcdBarrier b; b.bar = bar; b.x = xb_xcc_id(); b.st = st;
    if (threadIdx.x == 0) (void)xb_add(&bar[XB_XCNT(b.x)], 1u);
    return b;
}
__device__ __forceinline__ void xcd_barrier_complete(unsigned* bar, unsigned x, unsigned& nloc, unsigned& nx) {
    const unsigned G = gridDim.x * gridDim.y * gridDim.z;
    unsigned sum, cnt, mine, sp = 0u;
    for (;;) {
        sum = 0u; cnt = 0u; mine = 0u;
#pragma unroll
        for (unsigned j = 0; j < 16; ++j) { const unsigned c = xb_ld(&bar[XB_XCNT(j)]); sum += c; cnt += (c > 0u) ? 1u : 0u; mine = (j == x) ? c : mine; }
        if (sum == G) break;
        __builtin_amdgcn_s_sleep(1);
        if ((++sp & 255u) == 0u) { if (xb_ld(&bar[XB_TMO])) break; if (sp > XB_SPIN_CAP) { atomicAdd(&bar[XB_TMO], 1u); break; } }
    }
    nloc = mine > 0u ? mine : 1u; nx = cnt > 0u ? cnt : 1u;
}
__device__ __forceinline__ void xcd_barrier(const XcdBarrier& b) {
    asm volatile("s_waitcnt vmcnt(0)" ::: "memory");
    __syncthreads();
    if (threadIdx.x == 0) {
        unsigned* bar = b.bar;
        __builtin_amdgcn_s_waitcnt(0);
        unsigned nloc = b.st[0], nx = b.st[1];
        if (nloc == 0u) { xcd_barrier_complete(bar, b.x, nloc, nx); b.st[0] = nloc; b.st[1] = nx; }
        const unsigned old = xb_add(&bar[XB_XSUB(b.x)], 1u);
        const unsigned gen = old / nloc;
        if (old + 1u == (gen + 1u) * nloc) {
            __builtin_amdgcn_fence(__ATOMIC_RELEASE, "agent");
            asm volatile("s_waitcnt vmcnt(0)" ::: "memory");
            const unsigned og = xb_add(&bar[XB_TOP], 1u);
            const unsigned tg = og / nx;
            if (og + 1u == (tg + 1u) * nx) xb_add(&bar[XB_TOPGEN], 1u);
            else XB_SPIN(xb_ld(&bar[XB_TOPGEN]) == tg, bar);
            __builtin_amdgcn_fence(__ATOMIC_ACQUIRE, "agent");
            xb_add(&bar[XB_XGEN(b.x)], 1u);
            asm volatile("s_waitcnt vmcnt(0)" ::: "memory");
        } else {
            XB_SPIN(xb_ld(&bar[XB_XGEN(b.x)]) == gen, bar);
            __builtin_amdgcn_fence(__ATOMIC_ACQUIRE, "agent");
            asm volatile("s_waitcnt vmcnt(0)" ::: "memory");
        }
    }
    __syncthreads();
}

namespace pg8 {
constexpr int BM = 256, BK = 64, HALF = 128, HTB = HALF * BK * 2, NXCD = 8, WGM = 8;
__host__ __device__ __forceinline__ int lds_byte(int r, int c) { const int st = (r >> 4) * 2 + (c >> 5), rr = r & 15, cc = c & 31, ob = rr * 64 + cc * 2; return st * 1024 + (ob ^ (((ob >> 9) & 1) << 5)); }
__host__ __device__ __forceinline__ void stage_rc(int b, int& R, int& C) { const int st = b / 1024, sb = b % 1024, swz = sb ^ (((sb >> 9) & 1) << 5); R = (st >> 1) * 16 + swz / 64; C = (st & 1) * 32 + (swz % 64) / 2; }
__host__ __device__ __forceinline__ int perm32(int rho) { const int n = rho >> 4, i = rho & 15; return 8 * (i >> 2) + 4 * n + (i & 3); }

struct TileOrder {
    int nM, nN, nwg, G, c;
    __device__ __forceinline__ void init(int nM_, int nN_, int G_, int c_) { nM = nM_; nN = nN_; nwg = nM * nN; G = G_; c = c_; }
    __device__ __forceinline__ bool get(int i, int& pm, int& pn) const {
        const long Lx = (long)i * G + c; if (Lx >= nwg) return false;
        int wgid = (int)Lx; { const int q = nwg / NXCD, r = nwg % NXCD, xcd = wgid % NXCD, off = wgid / NXCD; wgid = (xcd < r ? xcd * (q + 1) : r * (q + 1) + (xcd - r) * q) + off; }
        const int nig = WGM * nN, gid = wgid / nig, fm = gid * WGM, gsz = (nM - fm) < WGM ? (nM - fm) : WGM;
        pm = fm + ((wgid % nig) % gsz); pn = (wgid % nig) / gsz; return true;
    }
};

template <class P>
__device__ __forceinline__ void gemm_phase(LAS unsigned char* lds, const P& S) {
    typedef typename P::Unit Unit;
    int tid_ = threadIdx.x; LAUNDER(tid_);
    const int tid = tid_, wid = __builtin_amdgcn_readfirstlane(tid >> 6), lane = tid & 63, wr = wid >> 2, wc = wid & 3, fr = lane & 15, fq = lane >> 4;
    constexpr int nt = P::NT; constexpr int LDB = P::LDB;
    int Rs[2], Cs[2]; unsigned voffB[2];
#pragma unroll
    for (int i = 0; i < 2; ++i) { int R, C; stage_rc(tid * 16 + i * 8192, R, C); Rs[i] = R; Cs[i] = C; const int Rb = (R & ~31) + perm32(R & 31); voffB[i] = (unsigned)(Rb * LDB + C) * 2u; }
    const size_t hstepB = (size_t)HALF * LDB * 2;
    const unsigned ldsw = (unsigned)wid * 1024u;
    const int aoff = lds_byte(wr * 64 + fr, fq * 8), boff = lds_byte(wc * 32 + fr, fq * 8);
#define PG8_SA(b, h) (((b) * 2 + (h)) * HTB)
#define PG8_SB(b, h) ((4 + (b) * 2 + (h)) * HTB)
#define PG8_STAGE1(bufoff, gptr, v0, v1) do { \
        __builtin_amdgcn_global_load_lds((const unsigned*)((const char*)(gptr) + (v0)), (LAS unsigned*)(lds + (bufoff) + ldsw), 16, 0, 0); \
        __builtin_amdgcn_global_load_lds((const unsigned*)((const char*)(gptr) + (v1)), (LAS unsigned*)(lds + (bufoff) + ldsw + 8192), 16, 0, 0); } while (0)
#define PG8_STAGEB(bufoff, gptr) PG8_STAGE1(bufoff, gptr, voffB[0], voffB[1])
#define PG8_LDA(dst, b, h) do { _Pragma("unroll") for (int m = 0; m < 4; ++m) _Pragma("unroll") for (int k = 0; k < 2; ++k) dst[m][k] = *(const LAS bf16x8*)(lds + PG8_SA(b, h) + aoff + m * 2048 + k * 1024); } while (0)
#define PG8_LDB(dst, b, h) do { _Pragma("unroll") for (int n = 0; n < 2; ++n) _Pragma("unroll") for (int k = 0; k < 2; ++k) dst[n][k] = *(const LAS bf16x8*)(lds + PG8_SB(b, h) + boff + n * 2048 + k * 1024); } while (0)
#define PG8_MMA(ai, bj, At, Bt) do { __builtin_amdgcn_s_setprio(1); _Pragma("unroll") for (int m = 0; m < 4; ++m) _Pragma("unroll") for (int n = 0; n < 2; ++n) _Pragma("unroll") for (int k = 0; k < 2; ++k) \
        acc[ai][bj][m][n] = __builtin_amdgcn_mfma_f32_16x16x32_bf16(Bt[n][k], At[m][k], acc[ai][bj][m][n], 0, 0, 0); __builtin_amdgcn_s_setprio(0); } while (0)
#define PG8_WAIT_V(n) asm volatile("s_waitcnt vmcnt(" #n ")" ::: "memory")
#define PG8_WAIT_L(n) asm volatile("s_waitcnt lgkmcnt(" #n ")" ::: "memory")
#define PG8_BAR __builtin_amdgcn_s_barrier()
#define PG8_SCHED __builtin_amdgcn_sched_barrier(0)
    Unit cur, nxt; int ui = 0;
    if (!S.next(0, cur)) return;
    f32x4 acc[2][2][4][2];
#pragma unroll
    for (int a = 0; a < 2; ++a)
#pragma unroll
        for (int b = 0; b < 2; ++b)
#pragma unroll
            for (int m = 0; m < 4; ++m)
#pragma unroll
                for (int n = 0; n < 2; ++n) acc[a][b][m][n] = (f32x4){0.f, 0.f, 0.f, 0.f};
    bf16x8 At[4][2], B0[2][2], B1[2][2];
#define PG8_STAGEA(bufoff, uidx, uu, tt, hh) S.stage_a(lds + (bufoff) + ldsw, uidx, uu, tt, hh, Rs, Cs)
    {
        const char* pB0 = S.b_ptr(cur, 0); const char* pB1 = S.b_ptr(cur, 1);
        PG8_STAGEB(PG8_SB(0, 0), pB0); PG8_STAGEB(PG8_SB(0, 1), pB0 + hstepB); PG8_STAGEA(PG8_SA(0, 0), 0, cur, 0, 0); PG8_STAGEA(PG8_SA(0, 1), 0, cur, 0, 1);
        if (wr == 1) PG8_BAR;
        PG8_WAIT_V(2); PG8_BAR;
        PG8_STAGEB(PG8_SB(1, 0), pB1); PG8_STAGEA(PG8_SA(1, 0), 0, cur, 1, 0); PG8_STAGEB(PG8_SB(1, 1), pB1 + hstepB);
        PG8_WAIT_V(6); PG8_BAR;
    }
    for (;;) {
        const bool has_next = S.next(ui + 1, nxt);
        if (!has_next) nxt = cur;
        const int uin = has_next ? ui + 1 : ui;
#pragma unroll 1
        for (int t = 0; t < nt; t += 2) {
            const bool last = (t == nt - 2);
            const Unit& u2 = last ? nxt : cur; const int ui2 = last ? uin : ui; const int t2 = last ? 0 : t + 2;
            const char* b2 = S.b_ptr(u2, t2); const char* b3 = S.b_ptr(u2, t2 + 1);
            PG8_LDB(B0, 0, 0); PG8_LDB(B1, 0, 1); PG8_SCHED; PG8_LDA(At, 0, 0); PG8_STAGEA(PG8_SA(1, 1), ui, cur, t + 1, 1);
            PG8_WAIT_V(8); PG8_WAIT_L(0); PG8_BAR; PG8_MMA(0, 0, At, B0); PG8_MMA(0, 1, At, B1); PG8_BAR; PG8_SCHED;
            PG8_LDA(At, 0, 1); PG8_STAGEB(PG8_SB(0, 0), b2); PG8_STAGEB(PG8_SB(0, 1), b2 + hstepB); PG8_STAGEA(PG8_SA(0, 0), ui2, u2, t2, 0);
            PG8_WAIT_V(8); PG8_WAIT_L(0); PG8_BAR; PG8_MMA(1, 0, At, B0); PG8_MMA(1, 1, At, B1); PG8_BAR; PG8_SCHED;
            PG8_LDB(B0, 1, 0); PG8_LDB(B1, 1, 1); PG8_SCHED; PG8_LDA(At, 1, 0); PG8_STAGEA(PG8_SA(0, 1), ui2, u2, t2, 1);
            PG8_WAIT_V(8); PG8_WAIT_L(0); PG8_BAR; PG8_MMA(0, 0, At, B0); PG8_MMA(0, 1, At, B1); PG8_BAR; PG8_SCHED;
            PG8_LDA(At, 1, 1); PG8_STAGEB(PG8_SB(1, 0), b3); PG8_STAGEB(PG8_SB(1, 1), b3 + hstepB); PG8_STAGEA(PG8_SA(1, 0), ui2, u2, t2 + 1, 0);
            PG8_WAIT_V(8); PG8_WAIT_L(0); PG8_BAR; PG8_MMA(1, 0, At, B0); PG8_MMA(1, 1, At, B1); PG8_BAR; PG8_SCHED;
        }
        if (wr == 0) PG8_BAR;
        S.epi(acc, cur, wr, wc, fr, fq, ui);
        PG8_SCHED;
        if (!has_next) break;
#pragma unroll
        for (int a = 0; a < 2; ++a)
#pragma unroll
            for (int b = 0; b < 2; ++b)
#pragma unroll
                for (int m = 0; m < 4; ++m)
#pragma unroll
                    for (int n = 0; n < 2; ++n) acc[a][b][m][n] = (f32x4){0.f, 0.f, 0.f, 0.f};
        cur = nxt; ++ui;
        if (wr == 1) PG8_BAR;
    }
    PG8_WAIT_V(0);
    PG8_BAR;
#undef PG8_SA
#undef PG8_SB
#undef PG8_STAGE1
#undef PG8_STAGEB
#undef PG8_STAGEA
#undef PG8_LDA
#undef PG8_LDB
#undef PG8_MMA
#undef PG8_WAIT_V
#undef PG8_WAIT_L
#undef PG8_BAR
#undef PG8_SCHED
}
}
typedef f32x4 AccT[2][2][4][2];

struct Args { const float* in[30]; float* out; unsigned char* ws; int ph_lo, ph_hi; };

struct Frame {
    LAS unsigned char* lds;
    int tid, lane, wave, G, wg;
    const float* const* in;
    unsigned char* ws; unsigned char* os;
};
#define IN_X 0
#define IN_META 1
#define IN_NMG 2
#define IN_WIN 3
#define IN_LRE 4
#define IN_LIM 5
#define IN_LDT 6
#define IN_BRE 7
#define IN_BIM 8
#define IN_CRE 9
#define IN_CIM 10
#define IN_S5D 11
#define IN_WGLU 12
#define IN_HLB 13
#define IN_HNG 14
#define IN_LQ1 15
#define IN_LK1 16
#define IN_LQ2 17
#define IN_LK2 18
#define IN_SUBLN 19
#define IN_WOUT 20
#define IN_NFG 21
#define IN_WGRP 22
#define IN_BGRP 23
#define IN_WEXP 24
#define IN_BEXP 25
#define IN_WGATE 26
#define IN_WUP 27
#define IN_WDOWN 28
#define IN_FNG 29

template <class ColMap>
__device__ __forceinline__ void conv_item(const float* W, int ldw, const float* kscale, bf16* WT, int ldt, int k0, int n0, LAS float* scr, int lane, ColMap cm) {
    const int sc = cm(n0 + (lane & 31));
#pragma unroll 8
    for (int i = 0; i < 32; ++i) { const int kk = 2 * i + (lane >> 5); float v = W[(size_t)(k0 + kk) * ldw + sc]; if (kscale) v *= kscale[k0 + kk]; scr[kk * 33 + (lane & 31)] = v; }
    LDS_WAIT(); asm volatile("" ::: "memory");
    const int c = lane & 7;
#pragma unroll
    for (int j = 0; j < 4; ++j) { const int n = (lane >> 3) + 8 * j; const LAS float* s = scr + (8 * c) * 33 + n;
        u32x4 o; o.x = pk2(s[0 * 33], s[1 * 33]); o.y = pk2(s[2 * 33], s[3 * 33]); o.z = pk2(s[4 * 33], s[5 * 33]); o.w = pk2(s[6 * 33], s[7 * 33]);
        *(GAS u32x4*)(WT + (size_t)(n0 + n) * ldt + k0 + 8 * c) = o; }
    LDS_WAIT(); asm volatile("" ::: "memory");
}

__device__ __forceinline__ void p0_prologue(const Frame& F0) {
    Frame F = F0; LAUNDER(F.tid); F.lane = F.tid & 63;
    LAS float* scr = (LAS float*)(F.lds + F.wave * 16384);
    const int gw = F.wg * 8 + F.wave, NGW = F.G * 8, lane = F.lane;
    constexpr int I_IN = 16 * (NI / 32), I_OUT = 16 * 32, I_GLU = 4 * 16, I_GU = 16 * 16 * 32, I_DN = 16 * 8 * 32;
    constexpr int I_L = I_IN + I_OUT + I_GLU + I_GU + I_DN;
    for (int it = gw; it < 2 * I_L; it += NGW) {
        const int l = it / I_L; int r = it % I_L;
        if (r < I_IN) {
            const int kb = r / (NI / 32), nb = r % (NI / 32);
            conv_item(F.in[IN_WIN] + (size_t)l * D * NI, NI, F.in[IN_NMG] + l * D, (bf16*)(F.ws + WS_WIN) + (size_t)l * NI * D, D, kb * 64, nb * 32, scr, lane,
                      [](int n) { if (n >= C_AQ && n < C_AV) { const int p = n & 63, j = p >> 3, e = p & 7; return (n & ~63) + 4 * j + (e & 3) + 32 * (e >> 2); } return n; });
            continue; }
        r -= I_IN;
        if (r < I_OUT) {
            const int kb = r / 32, nb = r % 32;
            conv_item(F.in[IN_WOUT] + (size_t)l * D * D, D, nullptr, (bf16*)(F.ws + WS_WOUT) + (size_t)l * D * D, D, kb * 64, nb * 32, scr, lane, [](int n) { return n; });
            continue; }
        r -= I_OUT;
        if (r < I_GLU) {
            const int kb = r / 16, nb = r % 16;
            conv_item(F.in[IN_WGLU] + (size_t)l * 256 * 512, 512, nullptr, (bf16*)(F.ws + WS_WGLU) + (size_t)l * 512 * 256, 256, kb * 64, nb * 32, scr, lane,
                      [](int n) { const int pn = n >> 8, bj = (n >> 7) & 1, c = n & 127; return bj * 256 + pn * 128 + c; });
            continue; }
        r -= I_GLU;
        if (r < I_GU) {
            const int e = r / (16 * 32), q = r % (16 * 32), kb = q / 32, nb = q % 32, n0 = nb * 32, bj = (n0 >> 7) & 1;
            const float* src = (bj ? F.in[IN_WUP] : F.in[IN_WGATE]) + ((size_t)l * 16 + e) * 1024 * 512;
            conv_item(src, 512, F.in[IN_NFG] + l * D, (bf16*)(F.ws + WS_WGU) + ((size_t)l * 16 + e) * 1024 * 1024, 1024, kb * 64, n0, scr, lane,
                      [](int n) { const int pn = n >> 8, c = n & 127; return pn * 128 + c; });
            continue; }
        r -= I_GU;
        {
            const int e = r / (8 * 32), q = r % (8 * 32), kb = q / 32, nb = q % 32;
            conv_item(F.in[IN_WDOWN] + ((size_t)l * 16 + e) * 512 * 1024, 1024, nullptr, (bf16*)(F.ws + WS_WDN) + ((size_t)l * 16 + e) * 1024 * 512, 512, kb * 64, nb * 32, scr, lane, [](int n) { return n; });
        }
    }
    for (int idx = gw * 64 + lane; idx < 2 * 32 * 1024; idx += NGW * 64) {
        const int l = idx / (32 * 1024), j = (idx / 1024) % 32, k = idx % 1024;
        float w = 0.f;
        if (j < 4) w = F.in[IN_WGRP][((size_t)l * D + k) * 4 + j]; else if (j < 20) w = F.in[IN_WEXP][((size_t)l * D + k) * 16 + (j - 4)];
        w *= F.in[IN_NFG][l * D + k];
        const unsigned hi = f2bf(w); const float lo = w - bf2f(hi);
        bf16* wr = (bf16*)(F.ws + WS_WR) + (size_t)l * 2 * 32 * 1024;
        wr[j * 1024 + k] = (bf16)hi; wr[32 * 1024 + j * 1024 + k] = (bf16)f2bf(lo);
    }
    for (int idx = gw * 64 + lane; idx < LT * 32; idx += NGW * 64) {
        const int pos = idx / 32, i = idx % 32;
        const double inv = pow(10000.0, -(double)(2 * i) / 64.0); const double a = (double)pos * inv;
        ((float*)(F.ws + WS_ROPE))[idx] = (float)cos(a); ((float*)(F.ws + WS_ROPE))[LT * 32 + idx] = (float)sin(a);
    }
    for (int m = gw; m < T; m += NGW) {
        const int b = m / LT, t = m % LT;
        const float* src = (t < NMETA) ? F.in[IN_META] + (size_t)t * D : F.in[IN_X] + ((size_t)b * SEQ + (t - NMETA)) * D;
        const GAS f32x4* xr = (const GAS f32x4*)src + lane;
        GAS f32x4* hr = (GAS f32x4*)((float*)(F.ws + WS_H) + (size_t)m * D) + lane;
        GAS u32x2* hb = (GAS u32x2*)((bf16*)(F.ws + WS_HB) + (size_t)m * D) + lane;
        float s = 0.f;
#pragma unroll
        for (int j = 0; j < 4; ++j) { const f32x4 v = xr[64 * j]; hr[64 * j] = v; s += (v.x * v.x + v.y * v.y) + (v.z * v.z + v.w * v.w);
            u32x2 o; o.x = pk2(v.x, v.y); o.y = pk2(v.z, v.w); hb[64 * j] = o; }
        s = wave_sum(s);
        if (lane < 16) ((float*)(F.ws + WS_SS16))[(size_t)m * 16 + lane] = (lane == 0) ? s : 0.f;
    }
    for (int it = F.wg; it < 32; it += F.G) {
        const int l = it / 16, g = it % 16;
        LAS f32x2* Ap = (LAS f32x2*)(F.lds);
        LAS f32x2* Bb = Ap + 17 * 64;
        LAS f32x2* Cc = Bb + 64 * 16;
        LAS float* Kj = (LAS float*)(Cc + 16 * 64);
        __syncthreads();
        const double dt = exp((double)F.in[IN_LDT][l * 16 + g]);
        for (int idx = F.tid; idx < 17 * 64; idx += 512) { const int j = idx / 64, n = idx % 64;
            const double lr = F.in[IN_LRE][(l * 16 + g) * 64 + n], li = F.in[IN_LIM][(l * 16 + g) * 64 + n];
            const double mg = exp(j * lr * dt), an = j * li * dt; Ap[idx] = (f32x2){(float)(mg * cos(an)), (float)(mg * sin(an))}; }
        for (int idx = F.tid; idx < 64 * 16; idx += 512) { const int n = idx / 16, c = idx % 16;
            const double lr = F.in[IN_LRE][(l * 16 + g) * 64 + n], li = F.in[IN_LIM][(l * 16 + g) * 64 + n];
            const double mg = exp(lr * dt), ar = mg * cos(li * dt), ai = mg * sin(li * dt), den = lr * lr + li * li, zr = ar - 1.0, zi = ai;
            const double fr = (zr * lr + zi * li) / den, fi = (zi * lr - zr * li) / den;
            const double br = F.in[IN_BRE][((size_t)(l * 16 + g) * 64 + n) * 16 + c], bi = F.in[IN_BIM][((size_t)(l * 16 + g) * 64 + n) * 16 + c];
            Bb[idx] = (f32x2){(float)(fr * br - fi * bi), (float)(fr * bi + fi * br)}; }
        for (int idx = F.tid; idx < 16 * 64; idx += 512) { const int c = idx / 64, n = idx % 64;
            Cc[idx] = (f32x2){F.in[IN_CRE][((size_t)(l * 16 + g) * 16 + c) * 64 + n], F.in[IN_CIM][((size_t)(l * 16 + g) * 16 + c) * 64 + n]}; }
        __syncthreads();
        for (int idx = F.tid; idx < 4096; idx += 512) { const int j = idx >> 8, co = (idx >> 4) & 15, ci = idx & 15; float s = 0.f;
            for (int n = 0; n < 64; ++n) { const f32x2 a = Ap[j * 64 + n], b = Bb[n * 16 + ci], c = Cc[co * 64 + n];
                const float abr = a.x * b.x - a.y * b.y, abi = a.x * b.y + a.y * b.x; s += c.x * abr - c.y * abi; }
            Kj[idx] = s; }
        if (F.tid < 64) ((f32x2*)(F.ws + WS_S5A))[(l * 16 + g) * 64 + F.tid] = Ap[16 * 64 + F.tid];
        __syncthreads();
        bf16* TQ = (bf16*)(F.ws + WS_S5TQ) + (size_t)(l * 16 + g) * 256 * 384;
        for (int idx = F.tid; idx < 256 * 384; idx += 512) { const int nn = idx / 384, k = idx % 384, t = nn >> 4, co = nn & 15; float v;
            if (k < 256) { const int s = k >> 4, ci = k & 15; v = (s <= t) ? Kj[((t - s) << 8) + (co << 4) + ci] : 0.f; }
            else { const int kk = k - 256, n = kk >> 1; const f32x2 a = Ap[(t + 1) * 64 + n], c = Cc[co * 64 + n];
                const float zr = c.x * a.x - c.y * a.y, zi = c.x * a.y + c.y * a.x; v = (kk & 1) ? -zi : zr; }
            TQ[idx] = (bf16)f2bf(v); }
        bf16* PM = (bf16*)(F.ws + WS_S5P) + (size_t)(l * 16 + g) * 256 * 256;
        for (int idx = F.tid; idx < 256 * 256; idx += 512) { const int nn = idx >> 8, k = idx & 255; float v = 0.f;
            if (nn < 128) { const int n = nn >> 1, s = k >> 4, ci = k & 15; const f32x2 a = Ap[(15 - s) * 64 + n], b = Bb[n * 16 + ci];
                v = (nn & 1) ? (a.x * b.y + a.y * b.x) : (a.x * b.x - a.y * b.y); }
            PM[idx] = (bf16)f2bf(v); }
        __syncthreads();
    }
}

template <class V> __device__ __forceinline__ V ldg(const void* sbase, unsigned voff) { return *(const GAS V*)((const char*)sbase + voff); }
template <class V> __device__ __forceinline__ void stg(void* sbase, unsigned voff, V v) { *(GAS V*)((char*)sbase + voff) = v; }
#define GLDS2(p0, p1, dst) do { __builtin_amdgcn_global_load_lds((const unsigned*)(p0), (LAS unsigned*)(dst), 16, 0, 0); __builtin_amdgcn_global_load_lds((const unsigned*)(p1), (LAS unsigned*)((dst) + 8192), 16, 0, 0); } while (0)
#define EPI_FENCE() __builtin_amdgcn_sched_barrier(0)
struct UnitT { int pm, pn; };

struct PolIn {
    typedef UnitT Unit; static constexpr int NT = 16, LDB = 1024;
    pg8::TileOrder ord; const bf16* A; const bf16* B; bf16* proj; const float* ss16; const float* rope;
    __device__ __forceinline__ bool next(int i, Unit& u) const { return ord.get(i, u.pm, u.pn); }
    __device__ __forceinline__ void stage_a(LAS unsigned char* dst, int, const Unit& u, int t, int h, const int (&R)[2], const int (&C)[2]) const {
        const char* bp = (const char*)(A + (size_t)(u.pm * 256 + h * 128) * 1024) + t * 128;
        GLDS2(bp + (unsigned)((R[0] * 1024 + C[0]) * 2), bp + (unsigned)((R[1] * 1024 + C[1]) * 2), dst); }
    __device__ __forceinline__ const char* b_ptr(const Unit& u, int t) const { return (const char*)(B + (size_t)u.pn * 256 * 1024) + t * 128; }
    __device__ __forceinline__ void epi(const AccT& acc, const Unit& u, int wr, int wc, int fr, int fq, int) const {
        const bool isrope = (u.pn >= 5 && u.pn <= 8); const float qs = (u.pn == 5 || u.pn == 6) ? QSCALE : 1.f;
        const unsigned fi = 4u * (4u * (wc & 1) + fq);
        const unsigned vo_p = (unsigned)((fr * NI + u.pn * 256 + wc * 32 + 8 * fq) * 2), vo_s = (unsigned)(fr * 64);
#pragma unroll
        for (int ai = 0; ai < 2; ++ai)
#pragma unroll
            for (int m = 0; m < 4; ++m) {
                const int rowu = u.pm * 256 + ai * 128 + wr * 64 + m * 16;
                const float* sp = ss16 + (size_t)rowu * 16;
                const f32x4 s0 = ldg<f32x4>(sp, vo_s), s1 = ldg<f32x4>(sp, vo_s + 16), s2 = ldg<f32x4>(sp, vo_s + 32), s3 = ldg<f32x4>(sp, vo_s + 48);
                const float ss = ((s0.x + s0.y) + (s0.z + s0.w)) + ((s1.x + s1.y) + (s1.z + s1.w)) + ((s2.x + s2.y) + (s2.z + s2.w)) + ((s3.x + s3.y) + (s3.z + s3.w));
                const float rstd = rsqrtf(ss * (1.f / 1024.f) + RMS_EPS);
                f32x4 cs = (f32x4){1.f, 1.f, 1.f, 1.f}, sn = (f32x4){0.f, 0.f, 0.f, 0.f};
                if (isrope) { const unsigned pos = (unsigned)(rowu + fr) % (unsigned)LT; cs = ldg<f32x4>(rope, (pos * 32 + fi) * 4); sn = ldg<f32x4>(rope, (LT * 32 + pos * 32 + fi) * 4); }
                bf16* rowp = proj + (size_t)rowu * NI;
#pragma unroll
                for (int bj = 0; bj < 2; ++bj) {
                    f32x4 v0 = acc[ai][bj][m][0] * rstd, v1 = acc[ai][bj][m][1] * rstd;
                    if (isrope) { const f32x4 o0 = (v0 * cs - v1 * sn) * qs, o1 = (v1 * cs + v0 * sn) * qs; v0 = o0; v1 = o1; }
                    u32x4 w; w.x = cvt_pk_bf16(v0[0], v0[1]); w.y = cvt_pk_bf16(v0[2], v0[3]); w.z = cvt_pk_bf16(v1[0], v1[1]); w.w = cvt_pk_bf16(v1[2], v1[3]);
                    stg<u32x4>(rowp, vo_p + bj * 256, w);
                }
                EPI_FENCE();
            }
    }
};

struct UnitS5 { int g, mt; };
struct PolS5E {
    typedef UnitS5 Unit; static constexpr int NT = 4, LDB = 256;
    int G, c; const bf16* proj; const bf16* B; float* E;
    __device__ __forceinline__ bool next(int i, Unit& u) const { const int Lx = i * G + c; if (Lx >= 16 * 17) return false; u.g = Lx / 17; u.mt = Lx % 17; return true; }
    __device__ __forceinline__ void stage_a(LAS unsigned char* dst, int, const Unit& u, int t, int h, const int (&R)[2], const int (&C)[2]) const {
        const char* bp = (const char*)(proj + ((size_t)(16 * (256 * u.mt + 128 * h) + 4 * t)) * NI + C_U + u.g * 16);
        GLDS2(bp + (unsigned)(((16 * R[0] + (C[0] >> 4)) * NI + (C[0] & 15)) * 2), bp + (unsigned)(((16 * R[1] + (C[1] >> 4)) * NI + (C[1] & 15)) * 2), dst); }
    __device__ __forceinline__ const char* b_ptr(const Unit& u, int t) const { return (const char*)(B + (size_t)u.g * 256 * 256) + t * 128; }
    __device__ __forceinline__ void epi(const AccT& acc, const Unit& u, int wr, int wc, int fr, int fq, int) const {
        const unsigned vo = (unsigned)((fr * 128 + wc * 32 + 8 * fq) * 4);
#pragma unroll
        for (int ai = 0; ai < 2; ++ai)
#pragma unroll
            for (int m = 0; m < 4; ++m) { float* ep = E + ((size_t)u.g * S5RP + u.mt * 256 + ai * 128 + wr * 64 + m * 16) * 128;
                stg<f32x4>(ep, vo, acc[ai][0][m][0]); stg<f32x4>(ep, vo + 16, acc[ai][0][m][1]); }
    }
};

struct PolS5Y {
    typedef UnitS5 Unit; static constexpr int NT = 6, LDB = 384;
    int G, c; const bf16* X; const bf16* B; const bf16* proj; const float* dsk; bf16* Gout;
    __device__ __forceinline__ bool next(int i, Unit& u) const { const int Lx = i * G + c; if (Lx >= 16 * 17) return false; u.g = Lx / 17; u.mt = Lx % 17; return true; }
    __device__ __forceinline__ void stage_a(LAS unsigned char* dst, int, const Unit& u, int t, int h, const int (&R)[2], const int (&C)[2]) const {
        const char* bp = (const char*)(X + ((size_t)u.g * S5RP + 256 * u.mt + 128 * h) * 384) + t * 128;
        GLDS2(bp + (unsigned)((R[0] * 384 + C[0]) * 2), bp + (unsigned)((R[1] * 384 + C[1]) * 2), dst); }
    __device__ __forceinline__ const char* b_ptr(const Unit& u, int t) const { return (const char*)(B + (size_t)u.g * 256 * 384) + t * 128; }
    __device__ __forceinline__ void epi(const AccT& acc, const Unit& u, int wr, int wc, int fr, int fq, int) const {
        const int ch = u.g * 16 + 8 * (fq & 1);
        const f32x4 d0 = ldg<f32x4>(dsk, (unsigned)ch * 4), d1 = ldg<f32x4>(dsk, (unsigned)ch * 4 + 16);
        const unsigned vo_u = (unsigned)(((16 * fr + (fq >> 1)) * NI + C_U + ch) * 2), vo_g = (unsigned)(((16 * fr + (fq >> 1)) * 256 + ch) * 2);
#pragma unroll
        for (int ai = 0; ai < 2; ++ai)
#pragma unroll
            for (int m = 0; m < 4; ++m) { const int Ru = u.mt * 256 + ai * 128 + wr * 64 + m * 16;
                if (Ru + fr < S5R) {
#pragma unroll
                    for (int bj = 0; bj < 2; ++bj) { const size_t toku = (size_t)16 * Ru + 8 * bj + 2 * wc;
                        const u32x4 uu = ldg<u32x4>(proj + toku * NI, vo_u);
                        f32x4 v0 = acc[ai][bj][m][0], v1 = acc[ai][bj][m][1];
                        v0[0] += d0[0] * bf2f(uu.x); v0[1] += d0[1] * bf2f(uu.x >> 16); v0[2] += d0[2] * bf2f(uu.y); v0[3] += d0[3] * bf2f(uu.y >> 16);
                        v1[0] += d1[0] * bf2f(uu.z); v1[1] += d1[1] * bf2f(uu.z >> 16); v1[2] += d1[2] * bf2f(uu.w); v1[3] += d1[3] * bf2f(uu.w >> 16);
                        u32x4 w; w.x = pk2(gelu_tanh(v0[0]), gelu_tanh(v0[1])); w.y = pk2(gelu_tanh(v0[2]), gelu_tanh(v0[3]));
                        w.z = pk2(gelu_tanh(v1[0]), gelu_tanh(v1[1])); w.w = pk2(gelu_tanh(v1[2]), gelu_tanh(v1[3]));
                        stg<u32x4>(Gout + toku * 256, vo_g, w); }
                }
                EPI_FENCE();
            }
    }
};

struct PolGlu {
    typedef UnitT Unit; static constexpr int NT = 4, LDB = 256;
    pg8::TileOrder ord; const bf16* A; const bf16* B; bf16* mixed;
    __device__ __forceinline__ bool next(int i, Unit& u) const { return ord.get(i, u.pm, u.pn); }
    __device__ __forceinline__ void stage_a(LAS unsigned char* dst, int, const Unit& u, int t, int h, const int (&R)[2], const int (&C)[2]) const {
        const char* bp = (const char*)(A + (size_t)(u.pm * 256 + h * 128) * 256) + t * 128;
        GLDS2(bp + (unsigned)((R[0] * 256 + C[0]) * 2), bp + (unsigned)((R[1] * 256 + C[1]) * 2), dst); }
    __device__ __forceinline__ const char* b_ptr(const Unit& u, int t) const { return (const char*)(B + (size_t)u.pn * 256 * 256) + t * 128; }
    __device__ __forceinline__ void epi(const AccT& acc, const Unit& u, int wr, int wc, int fr, int fq, int) const {
        const unsigned vo = (unsigned)((fr * D + u.pn * 128 + wc * 32 + 8 * fq) * 2);
#pragma unroll
        for (int ai = 0; ai < 2; ++ai)
#pragma unroll
            for (int m = 0; m < 4; ++m) { bf16* rp = mixed + (size_t)(u.pm * 256 + ai * 128 + wr * 64 + m * 16) * D;
                const f32x4 a0 = acc[ai][0][m][0], a1 = acc[ai][0][m][1], b0 = acc[ai][1][m][0], b1 = acc[ai][1][m][1];
                u32x4 w; w.x = pk2(a0[0] * sigmoidf_(b0[0]), a0[1] * sigmoidf_(b0[1])); w.y = pk2(a0[2] * sigmoidf_(b0[2]), a0[3] * sigmoidf_(b0[3]));
                w.z = pk2(a1[0] * sigmoidf_(b1[0]), a1[1] * sigmoidf_(b1[1])); w.w = pk2(a1[2] * sigmoidf_(b1[2]), a1[3] * sigmoidf_(b1[3]));
                stg<u32x4>(rp, vo, w);
                EPI_FENCE(); }
    }
};

__device__ __forceinline__ void residual_rows(const AccT& acc, int ai, int m, unsigned vrow, bool valid, int pn, int wc, int fq, float* hrow, bf16* brow, float* srow) {
    const unsigned colb = (unsigned)(pn * 256 + wc * 32 + 8 * fq);
    const unsigned vh = (vrow * D + colb) * 4, vb = (vrow * D + colb) * 2;
    float ssq = 0.f;
    if (valid) {
#pragma unroll
        for (int bj = 0; bj < 2; ++bj) {
            f32x4 h0 = ldg<f32x4>(hrow, vh + bj * 512), h1 = ldg<f32x4>(hrow, vh + bj * 512 + 16);
            h0 += acc[ai][bj][m][0]; h1 += acc[ai][bj][m][1];
            stg<f32x4>(hrow, vh + bj * 512, h0); stg<f32x4>(hrow, vh + bj * 512 + 16, h1);
            u32x4 w; w.x = cvt_pk_bf16(h0[0], h0[1]); w.y = cvt_pk_bf16(h0[2], h0[3]); w.z = cvt_pk_bf16(h1[0], h1[1]); w.w = cvt_pk_bf16(h1[2], h1[3]);
            stg<u32x4>(brow, vb + bj * 256, w);
            ssq += (h0[0] * h0[0] + h0[1] * h0[1]) + (h0[2] * h0[2] + h0[3] * h0[3]) + (h1[0] * h1[0] + h1[1] * h1[1]) + (h1[2] * h1[2] + h1[3] * h1[3]);
        }
    }
    ssq += __shfl_xor(ssq, 16); ssq += __shfl_xor(ssq, 32);
    if (valid && fq == 0) stg<float>(srow, (vrow * 16 + pn * 4 + wc) * 4, ssq);
}

struct PolOut {
    typedef UnitT Unit; static constexpr int NT = 16, LDB = 1024;
    pg8::TileOrder ord; const bf16* A; const bf16* B; float* H; bf16* HB; float* ss16;
    __device__ __forceinline__ bool next(int i, Unit& u) const { return ord.get(i, u.pm, u.pn); }
    __device__ __forceinline__ void stage_a(LAS unsigned char* dst, int, const Unit& u, int t, int h, const int (&R)[2], const int (&C)[2]) const {
        const char* bp = (const char*)(A + (size_t)(u.pm * 256 + h * 128) * 1024) + t * 128;
        GLDS2(bp + (unsigned)((R[0] * 1024 + C[0]) * 2), bp + (unsigned)((R[1] * 1024 + C[1]) * 2), dst); }
    __device__ __forceinline__ const char* b_ptr(const Unit& u, int t) const { return (const char*)(B + (size_t)u.pn * 256 * 1024) + t * 128; }
    __device__ __forceinline__ void epi(const AccT& acc, const Unit& u, int wr, int wc, int fr, int fq, int) const {
#pragma unroll
        for (int ai = 0; ai < 2; ++ai)
#pragma unroll
            for (int m = 0; m < 4; ++m) { const size_t rowu = (size_t)(u.pm * 256 + ai * 128 + wr * 64 + m * 16);
                residual_rows(acc, ai, m, (unsigned)fr, true, u.pn, wc, fq, H + rowu * D, HB + rowu * D, ss16 + rowu * 16);
                EPI_FENCE(); }
    }
};

struct MoeList {
    LAS const int* cnt;
    __device__ __forceinline__ int ntiles() const { int s = 0; for (int c = 0; c < NCLS; ++c) s += (cnt[c] + 255) >> 8; return __builtin_amdgcn_readfirstlane(s); }
    __device__ __forceinline__ void decode(int gt, int& c, int& ti, int& nvalid) const {
        int s = 0, cc = 0, tt = 0, nv = 0;
        for (int k = 0; k < NCLS; ++k) { const int n = (cnt[k] + 255) >> 8; if (gt >= s && gt < s + n) { cc = k; tt = gt - s; nv = cnt[k] - 256 * tt; } s += n; }
        c = __builtin_amdgcn_readfirstlane(cc); ti = __builtin_amdgcn_readfirstlane(tt); nvalid = __builtin_amdgcn_readfirstlane(nv > 256 ? 256 : nv);
    }
};
__device__ __forceinline__ void class_experts(int c, int& ea, int& eb) {
    const int g = c / 6, p = c % 6; const int a = (p < 3) ? 0 : (p < 5 ? 1 : 2); const int b = (p < 3) ? p + 1 : (p < 5 ? p - 1 : 3);
    ea = g * 4 + a; eb = g * 4 + b;
}
struct UnitM { int gt, pn, c; };

struct PolGU {
    typedef UnitM Unit; static constexpr int NT = 16, LDB = 1024;
    int G, c, ntl; MoeList ml; LAS const int* tab;
    const bf16* HB; const bf16* W; bf16* he; const float* rstd; const float* gate;
    __device__ __forceinline__ bool next(int i, Unit& u) const { const int Lx = i * G + c; if (Lx >= ntl * 8) return false; u.gt = Lx >> 3; u.pn = Lx & 7; int ti, nv; ml.decode(u.gt, u.c, ti, nv); return true; }
    __device__ __forceinline__ void stage_a(LAS unsigned char* dst, int ui, const Unit&, int t, int h, const int (&R)[2], const int (&C)[2]) const {
        const char* bp = (const char*)HB + t * 128;
        const int t0 = tab[ui * 256 + 128 * h + R[0]], t1 = tab[ui * 256 + 128 * h + R[1]];
        GLDS2(bp + (unsigned)((t0 < 0 ? 0 : t0) * 2048 + C[0] * 2), bp + (unsigned)((t1 < 0 ? 0 : t1) * 2048 + C[1] * 2), dst); }
    __device__ __forceinline__ const char* b_ptr(const Unit& u, int t) const { int ea, eb; class_experts(u.c, ea, eb); const int e = (u.pn >> 2) ? eb : ea;
        return (const char*)(W + ((size_t)e * 1024 + (u.pn & 3) * 256) * 1024) + t * 128; }
    __device__ __forceinline__ void epi(const AccT& acc, const Unit& u, int wr, int wc, int fr, int fq, int ui) const {
        const int sel = u.pn >> 2;
        const unsigned vo = (unsigned)((fr * 1024 + sel * 512 + (u.pn & 3) * 128 + wc * 32 + 8 * fq) * 2);
#pragma unroll
        for (int ai = 0; ai < 2; ++ai)
#pragma unroll
            for (int m = 0; m < 4; ++m) { const int ru = ai * 128 + wr * 64 + m * 16; const int tk = tab[ui * 256 + ru + fr];
                float rs = 0.f, gw = 0.f; if (tk >= 0) { rs = ldg<float>(rstd, (unsigned)tk * 4); gw = ldg<float>(gate, (unsigned)(2 * tk + sel) * 4); }
                const f32x4 g0 = acc[ai][0][m][0] * rs, g1 = acc[ai][0][m][1] * rs, u0 = acc[ai][1][m][0] * (rs * gw), u1 = acc[ai][1][m][1] * (rs * gw);
                u32x4 w; w.x = pk2(siluf_(g0[0]) * u0[0], siluf_(g0[1]) * u0[1]); w.y = pk2(siluf_(g0[2]) * u0[2], siluf_(g0[3]) * u0[3]);
                w.z = pk2(siluf_(g1[0]) * u1[0], siluf_(g1[1]) * u1[1]); w.w = pk2(siluf_(g1[2]) * u1[2], siluf_(g1[3]) * u1[3]);
                stg<u32x4>(he + ((size_t)u.gt * 256 + ru) * 1024, vo, w);
                EPI_FENCE(); }
    }
};

struct PolDN {
    typedef UnitM Unit; static constexpr int NT = 16, LDB = 512;
    int G, c, ntl; MoeList ml; LAS const int* tab;
    const bf16* he; const bf16* W; float* H; bf16* HB; float* ss16;
    __device__ __forceinline__ bool next(int i, Unit& u) const { const int Lx = i * G + c; if (Lx >= ntl * 4) return false; u.gt = Lx >> 2; u.pn = Lx & 3; int ti, nv; ml.decode(u.gt, u.c, ti, nv); return true; }
    __device__ __forceinline__ void stage_a(LAS unsigned char* dst, int, const Unit& u, int t, int h, const int (&R)[2], const int (&C)[2]) const {
        const char* bp = (const char*)(he + (size_t)(u.gt * 256 + h * 128) * 1024) + t * 128;
        GLDS2(bp + (unsigned)((R[0] * 1024 + C[0]) * 2), bp + (unsigned)((R[1] * 1024 + C[1]) * 2), dst); }
    __device__ __forceinline__ const char* b_ptr(const Unit& u, int t) const { int ea, eb; class_experts(u.c, ea, eb); const int e = (t >= 8) ? eb : ea;
        return (const char*)(W + ((size_t)e * 1024 + u.pn * 256) * 512) + (t & 7) * 128; }
    __device__ __forceinline__ void epi(const AccT& acc, const Unit& u, int wr, int wc, int fr, int fq, int ui) const {
#pragma unroll
        for (int ai = 0; ai < 2; ++ai)
#pragma unroll
            for (int m = 0; m < 4; ++m) { const int tk = tab[ui * 256 + ai * 128 + wr * 64 + m * 16 + fr];
                residual_rows(acc, ai, m, (unsigned)(tk < 0 ? 0 : tk), tk >= 0, u.pn, wc, fq, H, HB, ss16);
                EPI_FENCE(); }
    }
};

#define MFMA16(a, b, c) __builtin_amdgcn_mfma_f32_16x16x32_bf16(a, b, c, 0, 0, 0)
#define MFMA32(a, b, c) __builtin_amdgcn_mfma_f32_32x32x16_bf16(a, b, c, 0, 0, 0)

__device__ __forceinline__ void s5_scan(const Frame& F0, int l) {
    Frame F = F0; LAUNDER(F.tid); F.lane = F.tid & 63;
    const bf16* proj = (const bf16*)(F.ws + WS_PROJ); const float* E = (const float*)(F.os + OS_E); bf16* X = (bf16*)(F.os + OS_X);
    const int lane = F.lane;
    for (int it = F.wg + F.G * F.wave; it < NB * 16; it += F.G * 8) {
        const int b = it >> 4, g = it & 15;
        const f32x2 A16 = ((const f32x2*)(F.ws + WS_S5A))[(l * 16 + g) * 64 + lane];
        float sr = 0.f, si = 0.f;
        for (int r0 = 0; r0 < NCH; r0 += 16) {
            f32x2 e[16]; u32x2 u4[16];
#pragma unroll
            for (int j = 0; j < 16; ++j) if (r0 + j < NCH) { const size_t R = (size_t)b * NCH + r0 + j;
                e[j] = *(const GAS f32x2*)(E + ((size_t)g * S5RP + R) * 128 + 2 * lane);
                u4[j] = *(const GAS u32x2*)(proj + (16 * R + (lane >> 2)) * NI + C_U + g * 16 + 4 * (lane & 3)); }
#pragma unroll
            for (int j = 0; j < 16; ++j) if (r0 + j < NCH) { const size_t R = (size_t)b * NCH + r0 + j;
                bf16* xr = X + ((size_t)g * S5RP + R) * 384;
                *(GAS unsigned*)(xr + 256 + 2 * lane) = pk2(sr, si);
                *(GAS u32x2*)(xr + 4 * lane) = u4[j];
                const float nr = A16.x * sr - A16.y * si + e[j].x, ni = A16.x * si + A16.y * sr + e[j].y; sr = nr; si = ni; }
        }
    }
}

__device__ __forceinline__ float hgrn_lb(const float* hlb, int l, int j) {
    if (l == 0) return 0.f;
    const float x0 = hlb[j], x1 = hlb[256 + j], mx = fmaxf(x0, x1), e0 = __expf(x0 - mx), e1 = __expf(x1 - mx);
    return e1 / (e0 + e1);
}
__device__ __forceinline__ float hgrn_logf(float z, float lb) {
    const float a = __logf(fmaxf(lb, 1e-30f));
    const float ls = fminf(z, 0.f) - __logf(1.f + __expf(-fabsf(z)));
    const float b = log1pf(-lb) + ls;
    return fmaxf(a, b) + __logf(1.f + __expf(-fabsf(a - b)));
}
constexpr int HG_HALF = 72960, HG_LF = 0, HG_SEG = 16640, HG_T0 = 17664, HG_TS = 9216;

__device__ __forceinline__ void hgrn_a(const Frame& F0, int l) {
    Frame F = F0; LAUNDER(F.tid); F.lane = F.tid & 63;
    const bf16* proj = (const bf16*)(F.ws + WS_PROJ); float* UT = (float*)(F.os + OS_UT); float* DEC = (float*)(F.os + OS_DEC);
    const int half = F.tid >> 8, ht = F.tid & 255, hw = F.wave & 3, lane = F.lane;
    LAS unsigned char* base = F.lds + half * HG_HALF;
    LAS float* LF = (LAS float*)(base + HG_LF); LAS float* SEG = (LAS float*)(base + HG_SEG);
    LAS bf16* vT = (LAS bf16*)(base + HG_T0); LAS bf16* KDT = (LAS bf16*)(base + HG_T0 + HG_TS);
    for (int p = F.wg; p < NB * 4 * HCH / 2; p += F.G) {
        const int item = 2 * p + half, c = item % HCH, bh = item / HCH, b = bh >> 2, h = bh & 3;
        const size_t tok0 = (size_t)b * LT + (c == 0 ? 0 : 16 + 64 * (c - 1)); const int nrows = (c == 0) ? 16 : 64;
#pragma unroll
        for (int e = 0; e < 2; ++e) { const int idx = ht + 256 * e, t = idx >> 3, c8 = idx & 7; const bool valid = t < nrows;
            u32x4 zf = (u32x4){0u, 0u, 0u, 0u}, zi = zf;
            if (valid) { zf = *(const GAS u32x4*)(proj + (tok0 + t) * NI + C_HF + h * 64 + 8 * c8); zi = *(const GAS u32x4*)(proj + (tok0 + t) * NI + C_HI + h * 64 + 8 * c8); }
#pragma unroll
            for (int jj = 0; jj < 8; ++jj) { const int d = 8 * c8 + jj; const unsigned wf = (jj & 1) ? (zf[jj >> 1] >> 16) : (zf[jj >> 1] & 0xffffu); const unsigned wi = (jj & 1) ? (zi[jj >> 1] >> 16) : (zi[jj >> 1] & 0xffffu);
                LF[t * 65 + d] = valid ? hgrn_logf(bf2f(wf), hgrn_lb(F.in[IN_HLB], l, h * 64 + d)) : 0.f;
                vT[d * 72 + t] = (bf16)wi; }
        }
        __syncthreads();
        const int d = ht & 63, seg = ht >> 6;
        { float run = 0.f;
#pragma unroll
          for (int i = 0; i < 16; ++i) { run += LF[(16 * seg + i) * 65 + d]; LF[(16 * seg + i) * 65 + d] = run; }
          SEG[seg * 64 + d] = run; }
        __syncthreads();
        { float offs = 0.f, last = 0.f;
#pragma unroll
          for (int s = 0; s < 4; ++s) { const float v = SEG[s * 64 + d]; if (s < seg) offs += v; last += v; }
          float prev = 0.f;
#pragma unroll
          for (int i = 0; i < 16; ++i) { const int t = 16 * seg + i; const float cl = LF[t * 65 + d], lf = cl - prev; prev = cl;
              const float k = -expm1f(lf); KDT[d * 72 + t] = (bf16)f2bf(k * __expf(last - (cl + offs))); }
          if (seg == 0) DEC[(size_t)item * 64 + d] = __expf(last); }
        __syncthreads();
        f32x4 acc[4];
#pragma unroll
        for (int nt = 0; nt < 4; ++nt) acc[nt] = (f32x4){0.f, 0.f, 0.f, 0.f};
#pragma unroll
        for (int ks = 0; ks < 2; ++ks) { const bf16x8 a = *(const LAS bf16x8*)(vT + (16 * hw + (lane & 15)) * 72 + 32 * ks + 8 * (lane >> 4));
#pragma unroll
            for (int nt = 0; nt < 4; ++nt) { const bf16x8 bb = *(const LAS bf16x8*)(KDT + (16 * nt + (lane & 15)) * 72 + 32 * ks + 8 * (lane >> 4)); acc[nt] = MFMA16(a, bb, acc[nt]); } }
#pragma unroll
        for (int nt = 0; nt < 4; ++nt)
#pragma unroll
            for (int j = 0; j < 4; ++j) UT[(size_t)item * 4096 + (16 * hw + 4 * (lane >> 4) + j) * 64 + 16 * nt + (lane & 15)] = acc[nt][j];
        __syncthreads();
    }
}

__device__ __forceinline__ void hgrn_b(const Frame& F0) {
    Frame F = F0; LAUNDER(F.tid); F.lane = F.tid & 63;
    const float* UT = (const float*)(F.os + OS_UT); const float* DEC = (const float*)(F.os + OS_DEC); bf16* SP = (bf16*)(F.os + OS_SP);
    for (int blk = F.wg; blk < NB * 4 * 8; blk += F.G) {
        const int bh = blk >> 3, e = (blk & 7) * 512 + F.tid, d = e & 63;
        float S = 0.f;
        for (int c0 = 0; c0 < HCH; c0 += 11) {
            float ut[11], dc[11];
#pragma unroll
            for (int j = 0; j < 11; ++j) { const size_t item = (size_t)bh * HCH + c0 + j; ut[j] = UT[item * 4096 + e]; dc[j] = DEC[item * 64 + d]; }
#pragma unroll
            for (int j = 0; j < 11; ++j) { const size_t item = (size_t)bh * HCH + c0 + j; SP[item * 4096 + e] = (bf16)f2bf(S); S = dc[j] * S + ut[j]; }
        }
    }
}

__device__ __forceinline__ void hgrn_c(const Frame& F0, int l) {
    Frame F = F0; LAUNDER(F.tid); F.lane = F.tid & 63;
    const bf16* proj = (const bf16*)(F.ws + WS_PROJ); const bf16* SPg = (const bf16*)(F.os + OS_SP); bf16* mixed = (bf16*)(F.ws + WS_MIXED);
    const int half = F.tid >> 8, ht = F.tid & 255, hw = F.wave & 3, lane = F.lane;
    LAS unsigned char* base = F.lds + half * HG_HALF;
    LAS float* LF = (LAS float*)(base + HG_LF); LAS float* SEG = (LAS float*)(base + HG_SEG);
    LAS bf16* vT = (LAS bf16*)(base + HG_T0); LAS bf16* QT = vT + HG_TS / 2; LAS bf16* KT = QT + HG_TS / 2; LAS bf16* QS = KT + HG_TS / 2; LAS bf16* SPt = QS + HG_TS / 2; LAS bf16* P = SPt + HG_TS / 2;
    const float* ng = F.in[IN_HNG] + l * 64;
    for (int p = F.wg; p < NB * 4 * HCH / 2; p += F.G) {
        const int item = 2 * p + half, c = item % HCH, bh = item / HCH, b = bh >> 2, h = bh & 3;
        const size_t tok0 = (size_t)b * LT + (c == 0 ? 0 : 16 + 64 * (c - 1)); const int nrows = (c == 0) ? 16 : 64;
        float qv[16], lfv[16];
#pragma unroll
        for (int e = 0; e < 2; ++e) { const int idx = ht + 256 * e, t = idx >> 3, c8 = idx & 7; const bool valid = t < nrows;
            u32x4 zq = (u32x4){0u, 0u, 0u, 0u}, zf = zq, zi = zq;
            if (valid) { const bf16* rp = proj + (tok0 + t) * NI + h * 64 + 8 * c8; zq = *(const GAS u32x4*)(rp + C_HQ); zf = *(const GAS u32x4*)(rp + C_HF); zi = *(const GAS u32x4*)(rp + C_HI); }
            const u32x4 sp = *(const GAS u32x4*)(SPg + (size_t)item * 4096 + t * 64 + 8 * c8);
            *(LAS u32x4*)(SPt + t * 72 + 8 * c8) = sp;
#pragma unroll
            for (int jj = 0; jj < 8; ++jj) { const int d = 8 * c8 + jj; const unsigned wq = (jj & 1) ? (zq[jj >> 1] >> 16) : (zq[jj >> 1] & 0xffffu);
                const unsigned wf = (jj & 1) ? (zf[jj >> 1] >> 16) : (zf[jj >> 1] & 0xffffu); const unsigned wi = (jj & 1) ? (zi[jj >> 1] >> 16) : (zi[jj >> 1] & 0xffffu);
                const float lf = valid ? hgrn_logf(bf2f(wf), hgrn_lb(F.in[IN_HLB], l, h * 64 + d)) : 0.f;
                LF[t * 65 + d] = lf; lfv[8 * e + jj] = lf; qv[8 * e + jj] = valid ? siluf_(bf2f(wq)) : 0.f;
                vT[d * 72 + t] = (bf16)wi; }
        }
        __syncthreads();
        { const int d = ht & 63, seg = ht >> 6; float run = 0.f;
#pragma unroll
          for (int i = 0; i < 16; ++i) { run += LF[(16 * seg + i) * 65 + d]; LF[(16 * seg + i) * 65 + d] = run; }
          SEG[seg * 64 + d] = run; }
        __syncthreads();
#pragma unroll
        for (int e = 0; e < 2; ++e) { const int idx = ht + 256 * e, t = idx >> 3, c8 = idx & 7, seg = t >> 4;
            unsigned wq[4], wk[4], ws[4];
#pragma unroll
            for (int jp = 0; jp < 4; ++jp) { float qt[2], kt[2], qs[2];
#pragma unroll
                for (int u = 0; u < 2; ++u) { const int jj = 2 * jp + u, d = 8 * c8 + jj;
                    float offs = 0.f;
#pragma unroll
                    for (int s = 0; s < 3; ++s) if (s < seg) offs += SEG[s * 64 + d];
                    const float cum = LF[t * 65 + d] + offs, mid = LF[31 * 65 + d] + SEG[d];
                    const float q = qv[8 * e + jj], k = -expm1f(lfv[8 * e + jj]);
                    qt[u] = q * __expf(cum - mid); kt[u] = k * __expf(mid - cum); qs[u] = q * __expf(cum); }
                wq[jp] = pk2(qt[0], qt[1]); wk[jp] = pk2(kt[0], kt[1]); ws[jp] = pk2(qs[0], qs[1]); }
            *(LAS u32x4*)(QT + t * 72 + 8 * c8) = (u32x4){wq[0], wq[1], wq[2], wq[3]};
            *(LAS u32x4*)(KT + t * 72 + 8 * c8) = (u32x4){wk[0], wk[1], wk[2], wk[3]};
            *(LAS u32x4*)(QS + t * 72 + 8 * c8) = (u32x4){ws[0], ws[1], ws[2], ws[3]};
        }
        __syncthreads();
        const int ar = (16 * hw + (lane & 15)) * 72 + 8 * (lane >> 4);
        {
            f32x4 sc[4];
#pragma unroll
            for (int nt = 0; nt < 4; ++nt) sc[nt] = (f32x4){0.f, 0.f, 0.f, 0.f};
#pragma unroll
            for (int ks = 0; ks < 2; ++ks) { const bf16x8 a = *(const LAS bf16x8*)(QT + ar + 32 * ks);
#pragma unroll
                for (int nt = 0; nt < 4; ++nt) { const bf16x8 bb = *(const LAS bf16x8*)(KT + (16 * nt + (lane & 15)) * 72 + 32 * ks + 8 * (lane >> 4)); sc[nt] = MFMA16(a, bb, sc[nt]); } }
#pragma unroll
            for (int nt = 0; nt < 4; ++nt)
#pragma unroll
                for (int j = 0; j < 4; ++j) { const int t = 16 * hw + 4 * (lane >> 4) + j, s = 16 * nt + (lane & 15); P[t * 72 + s] = (bf16)f2bf(s <= t ? sc[nt][j] : 0.f); }
        }
        __syncthreads();
        f32x4 o[4];
#pragma unroll
        for (int nt = 0; nt < 4; ++nt) o[nt] = (f32x4){0.f, 0.f, 0.f, 0.f};
#pragma unroll
        for (int ks = 0; ks < 2; ++ks) { const bf16x8 a = *(const LAS bf16x8*)(P + ar + 32 * ks), a2 = *(const LAS bf16x8*)(QS + ar + 32 * ks);
#pragma unroll
            for (int nt = 0; nt < 4; ++nt) { const int br = (16 * nt + (lane & 15)) * 72 + 32 * ks + 8 * (lane >> 4);
                o[nt] = MFMA16(a, *(const LAS bf16x8*)(vT + br), o[nt]); o[nt] = MFMA16(a2, *(const LAS bf16x8*)(SPt + br), o[nt]); } }
#pragma unroll
        for (int j = 0; j < 4; ++j) { const int t = 16 * hw + 4 * (lane >> 4) + j;
            float ssq = o[0][j] * o[0][j] + o[1][j] * o[1][j] + o[2][j] * o[2][j] + o[3][j] * o[3][j];
            ssq += __shfl_xor(ssq, 1); ssq += __shfl_xor(ssq, 2); ssq += __shfl_xor(ssq, 4); ssq += __shfl_xor(ssq, 8);
            const float rn = rsqrtf(ssq * (1.f / 64.f) + RMS_EPS);
            if (t < nrows) {
#pragma unroll
                for (int nt = 0; nt < 4; ++nt) { const int v = 16 * nt + (lane & 15);
                    const float zg = bf2f(proj[(tok0 + t) * NI + C_HG + h * 64 + v]);
                    mixed[(tok0 + t) * D + 256 + h * 64 + v] = (bf16)f2bf(o[nt][j] * rn * ng[v] * siluf_(zg)); } } }
        __syncthreads();
    }
}

constexpr int AT_K = 0, AT_V = 2 * 9216, AT_KB = 9216, AT_VB = 18432;
__device__ __forceinline__ int crow(int r, int hi) { return (r & 3) + 8 * (r >> 2) + 4 * hi; }
__device__ __forceinline__ void attn_unit(const Frame& F, int b, int h, int j, float lam, float oscale, const float* subg) {
    const bf16* proj = (const bf16*)(F.ws + WS_PROJ); bf16* mixed = (bf16*)(F.ws + WS_MIXED);
    const int tid = F.tid, lane = F.lane, w = F.wave, r32 = lane & 31, hi = lane >> 5;
    const int qbase = (j == 0) ? 0 : 16 + 256 * (j - 1), ntile = (j == 0) ? 1 : 4 * j + 1;
    const int qrow = qbase + 32 * w + r32;
    const bf16* pb = proj + (size_t)b * LT * NI + h * 128;
    bf16* ob = mixed + ((size_t)b * LT + qbase + 32 * w) * D + 512 + h * 128;
    const unsigned vo_o = (unsigned)((r32 * D + 4 * hi) * 2);
    const bool rowok = (j > 0) || (32 * w + r32 < 16);
    LAS bf16* Kl = (LAS bf16*)(F.lds + AT_K); LAS bf16* Vl = (LAS bf16*)(F.lds + AT_V);
    const int kkey = tid >> 3, kc8 = tid & 7;
    const unsigned vo_k = (unsigned)((kkey * NI + C_AK + 8 * kc8) * 2);
    const unsigned vo_v0 = (unsigned)(((tid >> 4) * NI + C_AV + 8 * (tid & 15)) * 2), vo_v1 = vo_v0 + (unsigned)(32 * NI * 2);
#pragma unroll 1
    for (int comp = 0; comp < 2; ++comp) {
        bf16x8 qf[4];
        { const unsigned vq = (unsigned)((qrow * NI + C_AQ + comp * 64 + 8 * hi) * 2);
#pragma unroll
          for (int ks = 0; ks < 4; ++ks) qf[ks] = ldg<bf16x8>(pb, vq + 32 * ks); }
        f32x16 O[4];
#pragma unroll
        for (int vb = 0; vb < 4; ++vb)
#pragma unroll
            for (int r = 0; r < 16; ++r) O[vb][r] = 0.f;
        float mrun = -1e30f, lrun = 0.f;
        u32x4 kreg, vreg0, vreg1;
#define AT_ISSUE(i_) do { const int kb_ = ((i_) == 0) ? 0 : 16 + 64 * ((i_) - 1); const bf16* tb_ = pb + (size_t)kb_ * NI; \
            kreg = ldg<u32x4>(tb_ + comp * 64, vo_k); vreg0 = ldg<u32x4>(tb_, vo_v0); vreg1 = ldg<u32x4>(tb_, vo_v1); } while (0)
#define AT_COMMIT(buf_) do { *(LAS u32x4*)(Kl + (buf_) * (AT_KB / 2) + kkey * 72 + 8 * kc8) = kreg; \
            _Pragma("unroll") for (int jj = 0; jj < 8; ++jj) { \
                const unsigned w0 = (jj & 1) ? (vreg0[jj >> 1] >> 16) : (vreg0[jj >> 1] & 0xffffu), w1 = (jj & 1) ? (vreg1[jj >> 1] >> 16) : (vreg1[jj >> 1] & 0xffffu); \
                Vl[(buf_) * (AT_VB / 2) + (8 * (tid & 15) + jj) * 72 + (tid >> 4)] = (bf16)w0; Vl[(buf_) * (AT_VB / 2) + (8 * (tid & 15) + jj) * 72 + (tid >> 4) + 32] = (bf16)w1; } } while (0)
        __syncthreads();
        AT_ISSUE(0); AT_COMMIT(0);
        __syncthreads();
#pragma unroll 1
        for (int i = 0; i < ntile; ++i) {
            const int buf = i & 1, kb = (i == 0) ? 0 : 16 + 64 * (i - 1);
            if (i + 1 < ntile) AT_ISSUE(i + 1);
            const LAS bf16* Kb = Kl + buf * (AT_KB / 2); const LAS bf16* Vb = Vl + buf * (AT_VB / 2);
            f32x16 sT[2];
#pragma unroll
            for (int kblk = 0; kblk < 2; ++kblk) {
#pragma unroll
                for (int r = 0; r < 16; ++r) sT[kblk][r] = 0.f;
#pragma unroll
                for (int ks = 0; ks < 4; ++ks) { const bf16x8 kf = *(const LAS bf16x8*)(Kb + (32 * kblk + r32) * 72 + 16 * ks + 8 * hi); sT[kblk] = MFMA32(kf, qf[ks], sT[kblk]); }
            }
            if (i == 0 || i >= ntile - 4) {
#pragma unroll
                for (int kblk = 0; kblk < 2; ++kblk)
#pragma unroll
                    for (int r = 0; r < 16; ++r) { const int kl = 32 * kblk + crow(r, hi); const bool ok = (kb + kl <= qrow) && (i > 0 || kl < 16); if (!ok) sT[kblk][r] = -INFINITY; }
            }
            float mx = sT[0][0];
#pragma unroll
            for (int r = 1; r < 16; ++r) mx = fmaxf(mx, sT[0][r]);
#pragma unroll
            for (int r = 0; r < 16; ++r) mx = fmaxf(mx, sT[1][r]);
            mx = fmaxf(mx, __shfl_xor(mx, 32));
            const float mnew = fmaxf(mrun, mx), alpha = __builtin_amdgcn_exp2f(mrun - mnew);
            float psum = 0.f;
#pragma unroll
            for (int kblk = 0; kblk < 2; ++kblk)
#pragma unroll
                for (int r = 0; r < 16; ++r) { const float pv = __builtin_amdgcn_exp2f(sT[kblk][r] - mnew); sT[kblk][r] = pv; psum += pv; }
            psum += __shfl_xor(psum, 32);
            lrun = lrun * alpha + psum; mrun = mnew;
#pragma unroll
            for (int vb = 0; vb < 4; ++vb)
#pragma unroll
                for (int r = 0; r < 16; ++r) O[vb][r] *= alpha;
#pragma unroll
            for (int kblk = 0; kblk < 2; ++kblk)
#pragma unroll
                for (int s = 0; s < 2; ++s) {
                    u32x4 pw; pw.x = cvt_pk_bf16(sT[kblk][8 * s + 0], sT[kblk][8 * s + 1]); pw.y = cvt_pk_bf16(sT[kblk][8 * s + 2], sT[kblk][8 * s + 3]);
                    pw.z = cvt_pk_bf16(sT[kblk][8 * s + 4], sT[kblk][8 * s + 5]); pw.w = cvt_pk_bf16(sT[kblk][8 * s + 6], sT[kblk][8 * s + 7]);
                    const bf16x8 pf = __builtin_bit_cast(bf16x8, pw);
#pragma unroll
                    for (int vb = 0; vb < 4; ++vb) { const LAS bf16* vp = Vb + (32 * vb + r32) * 72 + 32 * kblk + 16 * s + 4 * hi;
                        const u32x2 lo = *(const LAS u32x2*)(vp), hh = *(const LAS u32x2*)(vp + 8);
                        const bf16x8 vf = __builtin_bit_cast(bf16x8, (u32x4){lo.x, lo.y, hh.x, hh.y});
                        O[vb] = MFMA32(vf, pf, O[vb]); }
                }
            if (i + 1 < ntile) AT_COMMIT(buf ^ 1);
            __syncthreads();
        }
#undef AT_ISSUE
#undef AT_COMMIT
        const float linv = 1.f / lrun;
        if (comp == 0) {
#pragma unroll
            for (int vb = 0; vb < 4; ++vb)
#pragma unroll
                for (int g4 = 0; g4 < 4; ++g4) {
                    u32x2 wv; wv.x = pk2(O[vb][4 * g4 + 0] * linv, O[vb][4 * g4 + 1] * linv); wv.y = pk2(O[vb][4 * g4 + 2] * linv, O[vb][4 * g4 + 3] * linv);
                    if (rowok) stg<u32x2>(ob, vo_o + (unsigned)((32 * vb + 8 * g4) * 2), wv); }
        } else {
            float ssq = 0.f;
#pragma unroll
            for (int vb = 0; vb < 4; ++vb)
#pragma unroll
                for (int g4 = 0; g4 < 4; ++g4) {
                    u32x2 o0 = (u32x2){0u, 0u}; if (rowok) o0 = ldg<u32x2>(ob, vo_o + (unsigned)((32 * vb + 8 * g4) * 2));
                    const float a0 = bf2f(o0.x) - lam * (O[vb][4 * g4 + 0] * linv), a1 = bf2f(o0.x >> 16) - lam * (O[vb][4 * g4 + 1] * linv);
                    const float a2 = bf2f(o0.y) - lam * (O[vb][4 * g4 + 2] * linv), a3 = bf2f(o0.y >> 16) - lam * (O[vb][4 * g4 + 3] * linv);
                    O[vb][4 * g4 + 0] = a0; O[vb][4 * g4 + 1] = a1; O[vb][4 * g4 + 2] = a2; O[vb][4 * g4 + 3] = a3;
                    ssq += (a0 * a0 + a1 * a1) + (a2 * a2 + a3 * a3); }
            ssq += __shfl_xor(ssq, 32);
            const float rn = rsqrtf(ssq * (1.f / 128.f) + RMS_EPS) * oscale;
            if (rowok) {
#pragma unroll
                for (int vb = 0; vb < 4; ++vb)
#pragma unroll
                    for (int g4 = 0; g4 < 4; ++g4) { const f32x4 sg = ldg<f32x4>(subg, (unsigned)((32 * vb + 8 * g4 + 4 * hi) * 4));
                        u32x2 wv; wv.x = pk2(O[vb][4 * g4 + 0] * rn * sg[0], O[vb][4 * g4 + 1] * rn * sg[1]); wv.y = pk2(O[vb][4 * g4 + 2] * rn * sg[2], O[vb][4 * g4 + 3] * rn * sg[3]);
                        stg<u32x2>(ob, vo_o + (unsigned)((32 * vb + 8 * g4) * 2), wv); }
            }
        }
    }
}
__device__ __forceinline__ void attn_phase(const Frame& F0, int l) {
    Frame F = F0; LAUNDER(F.tid); F.lane = F.tid & 63;
    float s1 = 0.f, s2 = 0.f;
    for (int i = 0; i < 64; ++i) { s1 += F.in[IN_LQ1][l * 64 + i] * F.in[IN_LK1][l * 64 + i]; s2 += F.in[IN_LQ2][l * 64 + i] * F.in[IN_LK2][l * 64 + i]; }
    const float lam_init = 0.8f - 0.6f * expf(-0.3f * (float)l);
    const float lam = expf(s1) - expf(s2) + lam_init, oscale = 1.f - lam_init;
    const float* subg = F.in[IN_SUBLN] + l * 128;
    const int npair = (512 - F.wg + F.G - 1) / F.G, nmeta = (F.wg < NB * 4) ? (NB * 4 - F.wg + F.G - 1) / F.G : 0;
#pragma unroll 1
    for (int k = 0; k < 2 * npair + nmeta; ++k) {
        int bh, j;
        if (k < 2 * npair) { const int p = F.wg + (k >> 1) * F.G; bh = p >> 2; const int s = p & 3; j = (k & 1) ? s + 1 : 8 - s; }
        else { bh = F.wg + (k - 2 * npair) * F.G; j = 0; }
        attn_unit(F, bh >> 2, bh & 3, j, lam, oscale, subg);
    }
}

__device__ __forceinline__ void router_phase(const Frame& F0, int l) {
    Frame F = F0; LAUNDER(F.tid); F.lane = F.tid & 63;
    const float* H = (const float*)(F.ws + WS_H); const bf16* WR = (const bf16*)(F.ws + WS_WR) + (size_t)l * 2 * 32 * 1024;
    float* rstd = (float*)(F.ws + WS_RSTD); float* gate = (float*)(F.ws + WS_GATE); int* buck = (int*)(F.ws + WS_BUCK);
    unsigned* gcnt = (unsigned*)F.ws + CW_CNT + l * 64;
    LAS float* LG = (LAS float*)F.lds;
    LAS int* lcnt = (LAS int*)(F.lds + 32768);
    LAS int* lbase = lcnt + 32;
    LAS int* tcls = lbase + 32;
    LAS int* tpos = tcls + 272;
    const int lane = F.lane, w = F.wave, fr = lane & 15, fq = lane >> 4;
    for (int rng = F.wg; rng < MT; rng += F.G) {
        const int m0 = rng * 256;
        if (F.tid < 32) lcnt[F.tid] = 0;
        __syncthreads();
        for (int itx = 0; itx < 2; ++itx) {
            const int task = itx * 8 + w;
            const size_t mrow = (size_t)m0 + task * 16 + fr;
            f32x4 acc[2]; acc[0] = (f32x4){0.f, 0.f, 0.f, 0.f}; acc[1] = acc[0];
            float ssq = 0.f;
#pragma unroll 4
            for (int ks = 0; ks < 32; ++ks) {
                const f32x4 x0 = *(const GAS f32x4*)(H + mrow * D + 32 * ks + 8 * fq), x1 = *(const GAS f32x4*)(H + mrow * D + 32 * ks + 8 * fq + 4);
                ssq += (x0[0] * x0[0] + x0[1] * x0[1]) + (x0[2] * x0[2] + x0[3] * x0[3]) + (x1[0] * x1[0] + x1[1] * x1[1]) + (x1[2] * x1[2] + x1[3] * x1[3]);
                unsigned hw_[4], lw_[4];
#pragma unroll
                for (int q = 0; q < 4; ++q) { const float a = (q < 2) ? x0[2 * q] : x1[2 * q - 4], bq = (q < 2) ? x0[2 * q + 1] : x1[2 * q - 3];
                    const unsigned ha = f2bf(a), hb = f2bf(bq); hw_[q] = ha | (hb << 16); lw_[q] = pk2(a - bf2f(ha), bq - bf2f(hb)); }
                const bf16x8 ahi = __builtin_bit_cast(bf16x8, (u32x4){hw_[0], hw_[1], hw_[2], hw_[3]}), alo = __builtin_bit_cast(bf16x8, (u32x4){lw_[0], lw_[1], lw_[2], lw_[3]});
#pragma unroll
                for (int nt = 0; nt < 2; ++nt) { const bf16x8 bh_ = *(const GAS bf16x8*)(WR + (16 * nt + fr) * 1024 + 32 * ks + 8 * fq), bl_ = *(const GAS bf16x8*)(WR + 32 * 1024 + (16 * nt + fr) * 1024 + 32 * ks + 8 * fq);
                    acc[nt] = MFMA16(ahi, bh_, acc[nt]); acc[nt] = MFMA16(alo, bh_, acc[nt]); acc[nt] = MFMA16(ahi, bl_, acc[nt]); }
            }
            ssq += __shfl_xor(ssq, 16); ssq += __shfl_xor(ssq, 32);
            const float rs = rsqrtf(ssq * (1.f / 1024.f) + RMS_EPS);
#pragma unroll
            for (int nt = 0; nt < 2; ++nt)
#pragma unroll
                for (int j = 0; j < 4; ++j) LG[w * 16 * 33 + (4 * fq + j) * 33 + 16 * nt + fr] = acc[nt][j];
            LDS_WAIT(); asm volatile("" ::: "memory");
            if (lane < 16) {
                const int tl = task * 16 + lane; const size_t m = (size_t)m0 + tl;
                const float rsm = __shfl(rs, lane);
                const LAS float* lg = LG + w * 16 * 33 + lane * 33;
                float gl[4]; float gm = -1e30f; int gi = 0;
#pragma unroll
                for (int q = 0; q < 4; ++q) { gl[q] = lg[q] * rsm + F.in[IN_BGRP][l * 4 + q]; if (gl[q] > gm) { gm = gl[q]; gi = q; } }
                float gs = 0.f;
#pragma unroll
                for (int q = 0; q < 4; ++q) gs += __expf(gl[q] - gm);
                const float gp = 1.f / gs;
                float el[4];
#pragma unroll
                for (int q = 0; q < 4; ++q) { float v = 0.f;
#pragma unroll
                    for (int g2 = 0; g2 < 4; ++g2) if (g2 == gi) v = lg[4 + 4 * g2 + q] * rsm + F.in[IN_BEXP][l * 16 + 4 * g2 + q];
                    el[q] = v; }
                int i1 = 0; float v1 = el[0];
#pragma unroll
                for (int q = 1; q < 4; ++q) if (el[q] > v1) { v1 = el[q]; i1 = q; }
                int i2 = -1; float v2 = -1e30f;
#pragma unroll
                for (int q = 0; q < 4; ++q) if (q != i1 && el[q] > v2) { v2 = el[q]; i2 = q; }
                const float e2 = __expf(v2 - v1), w1 = gp / (1.f + e2), w2 = gp * e2 / (1.f + e2);
                const int a = i1 < i2 ? i1 : i2, bq = i1 < i2 ? i2 : i1;
                const int pidx = (a == 0) ? (bq - 1) : (a == 1 ? bq + 1 : 5);
                const int cls = gi * 6 + pidx;
                rstd[m] = rsm; gate[2 * m] = (a == i1) ? w1 : w2; gate[2 * m + 1] = (a == i1) ? w2 : w1;
                tcls[tl] = cls; tpos[tl] = atomicAdd((int*)&lcnt[cls], 1);
            }
        }
        __syncthreads();
        if (F.tid < NCLS) lbase[F.tid] = (int)atomicAdd(&gcnt[F.tid], (unsigned)lcnt[F.tid]);
        __syncthreads();
        if (F.tid < 256) { const int cls = tcls[F.tid]; buck[(size_t)cls * T + lbase[cls] + tpos[F.tid]] = m0 + F.tid; }
        __syncthreads();
    }
}

__device__ __forceinline__ void final_phase(const Frame& F0, float* out) {
    Frame F = F0; LAUNDER(F.tid); F.lane = F.tid & 63;
    const float* H = (const float*)(F.ws + WS_H); const float* g = F.in[IN_FNG];
    const int gw = F.wg * 8 + F.wave, NGW = F.G * 8, lane = F.lane;
    for (int r = gw; r < NB * SEQ; r += NGW) {
        const int b = r / SEQ, t = r % SEQ; const size_t m = (size_t)b * LT + NMETA + t;
        const GAS f32x4* hr = (const GAS f32x4*)(H + m * D) + lane; GAS f32x4* orow = (GAS f32x4*)(out + (size_t)r * D) + lane;
        f32x4 v[4]; float s = 0.f;
#pragma unroll
        for (int j = 0; j < 4; ++j) { v[j] = hr[64 * j]; s += (v[j].x * v[j].x + v[j].y * v[j].y) + (v[j].z * v[j].z + v[j].w * v[j].w); }
        const float rs = rsqrtf(wave_sum(s) * (1.f / 1024.f) + RMS_EPS);
#pragma unroll
        for (int j = 0; j < 4; ++j) { const f32x4 gg = *((const GAS f32x4*)g + lane + 64 * j); orow[64 * j] = v[j] * rs * gg; }
    }
}

template <int NPN>
__device__ __forceinline__ int moe_prepare(const Frame& F0, int l, LAS int* cntl, LAS int* tab) {
    Frame F = F0; LAUNDER(F.tid); F.lane = F.tid & 63;
    const unsigned* gcnt = (const unsigned*)F.ws + CW_CNT + l * 64; const int* buck = (const int*)(F.ws + WS_BUCK);
    __syncthreads();
    if (F.tid < NCLS) cntl[F.tid] = (int)gcnt[F.tid];
    __syncthreads();
    MoeList ml{cntl}; const int ntl = ml.ntiles();
    for (int i = 0;; ++i) { const int Lx = i * F.G + F.wg; if (Lx >= ntl * NPN) break;
        int c, ti, nv; ml.decode(Lx / NPN, c, ti, nv);
        if (F.tid < 256) tab[i * 256 + F.tid] = (F.tid < nv) ? buck[(size_t)c * T + ti * 256 + F.tid] : -1; }
    __syncthreads();
    return ntl;
}

__global__ void __launch_bounds__(512, 2) hymba_fwd(Args args) {
    extern __shared__ __attribute__((aligned(16))) unsigned char lds_raw[];
    Frame F;
    F.lds = (LAS unsigned char*)lds_raw;
    F.tid = threadIdx.x; F.lane = F.tid & 63; F.wave = __builtin_amdgcn_readfirstlane(F.tid >> 6);
    F.G = gridDim.x; F.wg = blockIdx.x; F.in = args.in; F.ws = args.ws; F.os = (unsigned char*)args.out;
    volatile LAS unsigned* MISC = (volatile LAS unsigned*)(F.lds + MISC_OFF);
    if (F.tid < 256) MISC[F.tid] = 0u;
    __syncthreads();
    const int lo = args.ph_lo, hi = args.ph_hi;
    const bool one = (hi - lo) > 1;
    XcdBarrier bar; bar.bar = (unsigned*)F.ws + CW_BAR; bar.x = 0; bar.st = nullptr;
    if (one) bar = xcd_barrier_post((unsigned*)F.ws + CW_BAR, MISC + 8);
#ifndef ONLY_MASK
#define ONLY_MASK 0xFFFFFFFFu
#endif
#define IN(k) (lo <= (k) && (k) < hi)
#define EN(j) ((ONLY_MASK >> (j)) & 1u)
#ifndef SUBMASK
#define SUBMASK 3u
#endif
#define SEAM(k) do { if (IN(k) && IN((k) + 1)) xcd_barrier(bar); } while (0)
    bf16* proj = (bf16*)(F.ws + WS_PROJ); bf16* mixed = (bf16*)(F.ws + WS_MIXED); float* H = (float*)(F.ws + WS_H); bf16* HB = (bf16*)(F.ws + WS_HB);
    float* ss16 = (float*)(F.ws + WS_SS16);
    LAS int* tab = (LAS int*)(F.lds + TAB_OFF); LAS int* cntl = (LAS int*)(F.lds + TAB_OFF + 12 * 1024);

    if (EN(0) && IN(0)) { p0_prologue(F); } SEAM(0);
#pragma unroll 1
    for (int l = 0; l < 2; ++l) {
        const int pb = 1 + 9 * l;
        if (EN(1) && IN(pb + 0)) {
            PolIn P; P.ord.init(MT, NI / 256, F.G, F.wg); P.A = HB; P.B = (const bf16*)(F.ws + WS_WIN) + (size_t)l * NI * D; P.proj = proj; P.ss16 = ss16; P.rope = (const float*)(F.ws + WS_ROPE);
            pg8::gemm_phase(F.lds, P); }
        SEAM(pb + 0);
        if (EN(2) && IN(pb + 1)) {
            PolS5E P; P.G = F.G; P.c = F.wg; P.proj = proj; P.B = (const bf16*)(F.ws + WS_S5P) + (size_t)l * 16 * 256 * 256; P.E = (float*)(F.os + OS_E);
            if (MIXSEL & 1u) pg8::gemm_phase(F.lds, P);
            __syncthreads();
            if (MIXSEL & 2u) hgrn_a(F, l); }
        SEAM(pb + 1);
        if (EN(3) && IN(pb + 2)) { if (MIXSEL & 1u) s5_scan(F, l); if (MIXSEL & 2u) hgrn_b(F); }
        SEAM(pb + 2);
        if (EN(4) && IN(pb + 3)) {
            PolS5Y P; P.G = F.G; P.c = F.wg; P.X = (const bf16*)(F.os + OS_X); P.B = (const bf16*)(F.ws + WS_S5TQ) + (size_t)l * 16 * 256 * 384; P.proj = proj; P.dsk = F.in[IN_S5D] + l * 256; P.Gout = (bf16*)(F.os + OS_G);
            if ((SUBMASK & MIXSEL & 1u) != 0u) pg8::gemm_phase(F.lds, P);
            __syncthreads();
            if ((SUBMASK & MIXSEL & 2u) != 0u) hgrn_c(F, l); }
        SEAM(pb + 3);
        if (EN(5) && IN(pb + 4)) {
            PolGlu P; P.ord.init(MT, 2, F.G, F.wg); P.A = (const bf16*)(F.os + OS_G); P.B = (const bf16*)(F.ws + WS_WGLU) + (size_t)l * 512 * 256; P.mixed = mixed;
            if ((SUBMASK & MIXSEL & 1u) != 0u) pg8::gemm_phase(F.lds, P);
            __syncthreads();
            if ((SUBMASK & 2u) != 0u && (MIXSEL & 4u) != 0u) attn_phase(F, l); }
        SEAM(pb + 4);
        if (EN(6) && IN(pb + 5)) {
            PolOut P; P.ord.init(MT, 4, F.G, F.wg); P.A = mixed; P.B = (const bf16*)(F.ws + WS_WOUT) + (size_t)l * D * D; P.H = H; P.HB = HB; P.ss16 = ss16;
            pg8::gemm_phase(F.lds, P); }
        SEAM(pb + 5);
        if (EN(7) && IN(pb + 6)) { router_phase(F, l); }
        SEAM(pb + 6);
        if (EN(8) && IN(pb + 7)) {
            PolGU P; P.G = F.G; P.c = F.wg; P.ntl = moe_prepare<8>(F, l, cntl, tab); P.ml = MoeList{cntl}; P.tab = tab;
            P.HB = HB; P.W = (const bf16*)(F.ws + WS_WGU) + (size_t)l * 16 * 1024 * 1024; P.he = proj; P.rstd = (const float*)(F.ws + WS_RSTD); P.gate = (const float*)(F.ws + WS_GATE);
            pg8::gemm_phase(F.lds, P); }
        SEAM(pb + 7);
        if (EN(9) && IN(pb + 8)) {
            PolDN P; P.G = F.G; P.c = F.wg; P.ntl = moe_prepare<4>(F, l, cntl, tab); P.ml = MoeList{cntl}; P.tab = tab;
            P.he = proj; P.W = (const bf16*)(F.ws + WS_WDN) + (size_t)l * 16 * 1024 * 512; P.H = H; P.HB = HB; P.ss16 = ss16;
            pg8::gemm_phase(F.lds, P); }
        SEAM(pb + 8);
    }
    if (EN(10) && IN(19)) final_phase(F, args.out);
#undef IN
#undef SEAM
}

extern "C" void kernel_launch(void* const* d_in, const int* in_sizes, int n_in, void* d_out, int out_size, void* d_ws, size_t ws_size, hipStream_t stream) {
    static int grid = 0;
    if (grid == 0) {
        if (n_in != 30 || ws_size < WS_END) { fprintf(stderr, "kernel_launch: unexpected inputs (n_in %d, ws %zu < %zu)\n", n_in, ws_size, (size_t)WS_END); grid = -1; return; }
        int dev = 0, cus = 0, per_cu = 0;
        (void)hipGetDevice(&dev); (void)hipDeviceGetAttribute(&cus, hipDeviceAttributeMultiprocessorCount, dev);
        (void)hipFuncSetAttribute((const void*)hymba_fwd, hipFuncAttributeMaxDynamicSharedMemorySize, LDS_BYTES);
        (void)hipOccupancyMaxActiveBlocksPerMultiprocessor(&per_cu, (const void*)hymba_fwd, 512, LDS_BYTES);
        (void)hipGetLastError();
        grid = cus > 0 ? cus : 256;
    }
    if (grid < 0) return;
    (void)hipMemsetAsync(d_ws, 0, CTL_BYTES, stream);
    Args a{};
    for (int i = 0; i < 30; ++i) a.in[i] = (const float*)d_in[i];
    a.out = (float*)d_out; a.ws = (unsigned char*)d_ws;
#if N_LAUNCH_MODE == 1
    a.ph_lo = 0; a.ph_hi = LAST_PHASE;
    hipLaunchKernelGGL(hymba_fwd, dim3(grid), dim3(512), LDS_BYTES, stream, a);
#else
    if (MIXSEL != 7u) (void)hipMemsetAsync((char*)d_ws + WS_MIXED, 0, (size_t)T * D * 2, stream);
    for (int p = 0; p < LAST_PHASE; ++p) { if (!((RUN_MASK >> p) & 1u)) continue; a.ph_lo = p; a.ph_hi = p + 1; hipLaunchKernelGGL(hymba_fwd, dim3(grid), dim3(512), LDS_BYTES, stream, a); }
#endif
}
```

```cpp
#include <hip/hip_runtime.h>
#include <stdint.h>
#include <stdio.h>

#ifndef N_LAUNCH_MODE
#define N_LAUNCH_MODE 1
#endif
#ifndef LAST_PHASE
#define LAST_PHASE 20
#endif
#ifndef RUN_MASK
#define RUN_MASK 0xFFFFFu
#endif
#ifndef REPMASK
#define REPMASK 0u
#endif
#define NREP(j) (((REPMASK >> (j)) & 1u) ? 2 : 1)
#ifndef MIXSEL
#define MIXSEL 7u
#endif

#define GAS __attribute__((address_space(1)))
#define LAS __attribute__((address_space(3)))
typedef unsigned short bf16;
typedef short bf16x8 __attribute__((ext_vector_type(8)));
typedef short s16x4 __attribute__((ext_vector_type(4)));
typedef float f32x2 __attribute__((ext_vector_type(2)));
typedef float f32x4 __attribute__((ext_vector_type(4)));
typedef float f32x16 __attribute__((ext_vector_type(16)));
typedef unsigned u32x2 __attribute__((ext_vector_type(2)));
typedef unsigned u32x4 __attribute__((ext_vector_type(4)));

constexpr int NB = 32, LT = 2064, NMETA = 16, SEQ = 2048, T = NB * LT;
constexpr int D = 1024, NI = 2816, MT = T / 256;
constexpr int C_U = 0, C_HQ = 256, C_HF = 512, C_HI = 768, C_HG = 1024, C_AQ = 1280, C_AK = 1792, C_AV = 2304;
constexpr int NCH = 129;
constexpr int S5R = NB * NCH;
constexpr int S5RP = 17 * 256;
constexpr int HCH = 33;
constexpr int NCLS = 24;
constexpr float RMS_EPS = 1e-6f;
constexpr float QSCALE = 0.125f * 1.4426950408889634f;

constexpr size_t al256(size_t x) { return (x + 255) & ~(size_t)255; }
constexpr size_t CTL_BYTES = 1u << 20;
constexpr size_t WS_WIN = CTL_BYTES;
constexpr size_t WS_WOUT = WS_WIN + al256((size_t)2 * NI * D * 2);
constexpr size_t WS_WGLU = WS_WOUT + al256((size_t)2 * D * D * 2);
constexpr size_t WS_WGU = WS_WGLU + al256((size_t)2 * 512 * 256 * 2);
constexpr size_t WS_WDN = WS_WGU + al256((size_t)2 * 16 * 1024 * 1024 * 2);
constexpr size_t WS_WR = WS_WDN + al256((size_t)2 * 16 * 1024 * 512 * 2);
constexpr size_t WS_S5TQ = WS_WR + al256((size_t)2 * 2 * 32 * 1024 * 2);
constexpr size_t WS_S5P = WS_S5TQ + al256((size_t)2 * 16 * 256 * 384 * 2);
constexpr size_t WS_S5A = WS_S5P + al256((size_t)2 * 16 * 256 * 256 * 2);
constexpr size_t WS_ROPE = WS_S5A + al256((size_t)2 * 16 * 64 * 8);
constexpr size_t WS_SS16 = WS_ROPE + al256((size_t)LT * 32 * 4 * 2);
constexpr size_t WS_RSTD = WS_SS16 + al256((size_t)T * 16 * 4);
constexpr size_t WS_GATE = WS_RSTD + al256((size_t)T * 4);
constexpr size_t WS_BUCK = WS_GATE + al256((size_t)T * 8);
constexpr size_t WS_H = WS_BUCK + al256((size_t)NCLS * T * 4);
constexpr size_t WS_HB = WS_H + al256((size_t)T * D * 4);
constexpr size_t WS_PROJ = WS_HB + al256((size_t)T * D * 2);
constexpr size_t WS_MIXED = WS_PROJ + al256((size_t)T * NI * 2);
constexpr size_t WS_END = WS_MIXED + al256((size_t)T * D * 2);
constexpr size_t OS_E = 0;
constexpr size_t OS_X = OS_E + al256((size_t)16 * S5RP * 128 * 4);
constexpr size_t OS_G = OS_X + al256((size_t)16 * S5RP * 384 * 2);
constexpr size_t OS_UT = OS_G + al256((size_t)T * 256 * 2);
constexpr size_t OS_DEC = OS_UT + al256((size_t)NB * 4 * HCH * 4096 * 4);
constexpr size_t OS_SP = OS_DEC + al256((size_t)NB * 4 * HCH * 64 * 4);
constexpr size_t OS_END = OS_SP + al256((size_t)NB * 4 * HCH * 4096 * 2);
static_assert(OS_END <= (size_t)NB * SEQ * D * 4, "mixer scratch must fit in d_out");
static_assert((size_t)(MT + NCLS) * 256 * 1024 * 2 <= (size_t)T * NI * 2, "he overlay fits in proj");

constexpr int CW_BAR = 4096, CW_CNT = 16384;

constexpr int LDS_BYTES = 147456;
constexpr int RING_BYTES = 131072;
constexpr int TAB_OFF = RING_BYTES;
constexpr int MISC_OFF = LDS_BYTES - 1024;

__device__ __forceinline__ unsigned f2bf(float f) { unsigned u = __builtin_bit_cast(unsigned, f); return (u + 0x7fffu + ((u >> 16) & 1u)) >> 16; }
__device__ __forceinline__ float bf2f(unsigned b) { return __builtin_bit_cast(float, (b & 0xffffu) << 16); }
__device__ __forceinline__ unsigned pk2(float lo, float hi) { return f2bf(lo) | (f2bf(hi) << 16); }
__device__ __forceinline__ unsigned cvt_pk_bf16(float lo, float hi) { unsigned r; asm volatile("v_cvt_pk_bf16_f32 %0, %1, %2" : "=v"(r) : "v"(lo), "v"(hi)); return r; }
__device__ __forceinline__ float wave_sum(float v) {
#pragma unroll
    for (int o = 1; o < 64; o <<= 1) v += __shfl_xor(v, o);
    return v;
}
__device__ __forceinline__ float sigmoidf_(float x) { return 1.f / (1.f + __expf(-x)); }
__device__ __forceinline__ float siluf_(float x) { return x / (1.f + __expf(-x)); }
__device__ __forceinline__ float gelu_tanh(float x) { const float u = 0.7978845608028654f * (x + 0.044715f * x * x * x); return x / (1.f + __expf(-2.f * u)); }
#define LAUNDER(x) asm volatile("" : "+v"(x))
#define LDS_WAIT() asm volatile("s_waitcnt lgkmcnt(0)" ::: "memory")
#define VM_WAIT() asm volatile("s_waitcnt vmcnt(0)" ::: "memory")

#define XB_TMO      128
#define XB_XCNT(j)  (256  + 64 * (j))
#define XB_XSUB(j)  (1280 + 64 * (j))
#define XB_XGEN(j)  (2304 + 64 * (j))
#define XB_TOP      3328
#define XB_TOPGEN   3392
#define XCD_BAR_WORDS 3456
#define XB_SPIN_CAP (1u << 18)
__device__ __forceinline__ unsigned xb_ld(unsigned* p)              { return __hip_atomic_load(p, __ATOMIC_RELAXED, __HIP_MEMORY_SCOPE_AGENT); }
__device__ __forceinline__ unsigned xb_add(unsigned* p, unsigned v) { return __hip_atomic_fetch_add(p, v, __ATOMIC_RELAXED, __HIP_MEMORY_SCOPE_AGENT); }
__device__ __forceinline__ unsigned xb_xcc_id() { return (unsigned)__builtin_amdgcn_s_getreg((3 << 11) | 20) & 0xFu; }
#define XB_SPIN(cond, bar) do { unsigned _sp = 0; while (cond) { __builtin_amdgcn_s_sleep(1); \
    if ((++_sp & 255u) == 0u) { if (xb_ld(&(bar)[XB_TMO])) break; if (_sp > XB_SPIN_CAP) { atomicAdd(&(bar)[XB_TMO], 1u); break; } } } } while (0)
struct XcdBarrier { unsigned* bar; unsigned x; volatile LAS unsigned* st; };
__device__ __forceinline__ XcdBarrier xcd_barrier_post(unsigned* bar, volatile LAS unsigned* st) {
    XcdBarrier b; b.bar = bar; b.x = xb_xcc_id(); b.st = st;
    if (threadIdx.x == 0) (void)xb_add(&bar[XB_XCNT(b.x)], 1u);
    return b;
}
__device__ __forceinline__ void xcd_barrier_complete(unsigned* bar, unsigned x, unsigned& nloc, unsigned& nx) {
    const unsigned G = gridDim.x * gridDim.y * gridDim.z;
    unsigned sum, cnt, mine, sp = 0u;
    for (;;) {
        sum = 0u; cnt = 0u; mine = 0u;
#pragma unroll
        for (unsigned j = 0; j < 16; ++j) { const unsigned c = xb_ld(&bar[XB_XCNT(j)]); sum += c; cnt += (c > 0u) ? 1u : 0u; mine = (j == x) ? c : mine; }
        if (sum == G) break;
        __builtin_amdgcn_s_sleep(1);
        if ((++sp & 255u) == 0u) { if (xb_ld(&bar[XB_TMO])) break; if (sp > XB_SPIN_CAP) { atomicAdd(&bar[XB_TMO], 1u); break; } }
    }
    nloc = mine > 0u ? mine : 1u; nx = cnt > 0u ? cnt : 1u;
}
__device__ __forceinline__ void xcd_barrier(const XcdBarrier& b) {
    asm volatile("s_waitcnt vmcnt(0)" ::: "memory");
    __syncthreads();
    if (threadIdx.x == 0) {
        unsigned* bar = b.bar;
        __builtin_amdgcn_s_waitcnt(0);
        unsigned nloc = b.st[0], nx = b.st[1];
        if (nloc == 0u) { xcd_barrier_complete(bar, b.x, nloc, nx); b.st[0] = nloc; b.st[1] = nx; }
        const unsigned old = xb_add(&bar[XB_XSUB(b.x)], 1u);
        const unsigned gen = old / nloc;
        if (old + 1u == (gen + 1u) * nloc) {
            __builtin_amdgcn_fence(__ATOMIC_RELEASE, "agent");
            asm volatile("s_waitcnt vmcnt(0)" ::: "memory");
            const unsigned og = xb_add(&bar[XB_TOP], 1u);
            const unsigned tg = og / nx;
            if (og + 1u == (tg + 1u) * nx) xb_add(&bar[XB_TOPGEN], 1u);
            else XB_SPIN(xb_ld(&bar[XB_TOPGEN]) == tg, bar);
            __builtin_amdgcn_fence(__ATOMIC_ACQUIRE, "agent");
            xb_add(&bar[XB_XGEN(b.x)], 1u);
            asm volatile("s_waitcnt vmcnt(0)" ::: "memory");
        } else {
            XB_SPIN(xb_ld(&bar[XB_XGEN(b.x)]) == gen, bar);
            __builtin_amdgcn_fence(__ATOMIC_ACQUIRE, "agent");
            asm volatile("s_waitcnt vmcnt(0)" ::: "memory");
        }
    }
    __syncthreads();
}

namespace pg8 {
constexpr int BM = 256, BK = 64, HALF = 128, HTB = HALF * BK * 2, NXCD = 8, WGM = 8;
__host__ __device__ __forceinline__ int lds_byte(int r, int c) { const int st = (r >> 4) * 2 + (c >> 5), rr = r & 15, cc = c & 31, ob = rr * 64 + cc * 2; return st * 1024 + (ob ^ (((ob >> 9) & 1) << 5)); }
__host__ __device__ __forceinline__ void stage_rc(int b, int& R, int& C) { const int st = b / 1024, sb = b % 1024, swz = sb ^ (((sb >> 9) & 1) << 5); R = (st >> 1) * 16 + swz / 64; C = (st & 1) * 32 + (swz % 64) / 2; }
__host__ __device__ __forceinline__ int perm32(int rho) { const int n = rho >> 4, i = rho & 15; return 8 * (i >> 2) + 4 * n + (i & 3); }

struct TileOrder {
    int nM, nN, nwg, G, c;
    __device__ __forceinline__ void init(int nM_, int nN_, int G_, int c_) { nM = nM_; nN = nN_; nwg = nM * nN; G = G_; c = c_; }
    __device__ __forceinline__ bool get(int i, int& pm, int& pn) const {
        const long Lx = (long)i * G + c; if (Lx >= nwg) return false;
        int wgid = (int)Lx; { const int q = nwg / NXCD, r = nwg % NXCD, xcd = wgid % NXCD, off = wgid / NXCD; wgid = (xcd < r ? xcd * (q + 1) : r * (q + 1) + (xcd - r) * q) + off; }
        const int nig = WGM * nN, gid = wgid / nig, fm = gid * WGM, gsz = (nM - fm) < WGM ? (nM - fm) : WGM;
        pm = fm + ((wgid % nig) % gsz); pn = (wgid % nig) / gsz; return true;
    }
};

template <class P>
__device__ __forceinline__ void gemm_phase(LAS unsigned char* lds, const P& S) {
    typedef typename P::Unit Unit;
    int tid_ = threadIdx.x; LAUNDER(tid_);
    const int tid = tid_, wid = __builtin_amdgcn_readfirstlane(tid >> 6), lane = tid & 63, wr = wid >> 2, wc = wid & 3, fr = lane & 15, fq = lane >> 4;
    constexpr int nt = P::NT; constexpr int LDB = P::LDB;
    int Rs[2], Cs[2]; unsigned voffB[2];
#pragma unroll
    for (int i = 0; i < 2; ++i) { int R, C; stage_rc(tid * 16 + i * 8192, R, C); Rs[i] = R; Cs[i] = C; const int Rb = (R & ~31) + perm32(R & 31); voffB[i] = (unsigned)(Rb * LDB + C) * 2u; }
    const size_t hstepB = (size_t)HALF * LDB * 2;
    const unsigned ldsw = (unsigned)wid * 1024u;
    const int aoff = lds_byte(wr * 64 + fr, fq * 8), boff = lds_byte(wc * 32 + fr, fq * 8);
#define PG8_SA(b, h) (((b) * 2 + (h)) * HTB)
#define PG8_SB(b, h) ((4 + (b) * 2 + (h)) * HTB)
#define PG8_STAGE1(bufoff, gptr, v0, v1) do { \
        __builtin_amdgcn_global_load_lds((const unsigned*)((const char*)(gptr) + (v0)), (LAS unsigned*)(lds + (bufoff) + ldsw), 16, 0, 0); \
        __builtin_amdgcn_global_load_lds((const unsigned*)((const char*)(gptr) + (v1)), (LAS unsigned*)(lds + (bufoff) + ldsw + 8192), 16, 0, 0); } while (0)
#define PG8_STAGEB(bufoff, gptr) PG8_STAGE1(bufoff, gptr, voffB[0], voffB[1])
#define PG8_LDA(dst, b, h) do { _Pragma("unroll") for (int m = 0; m < 4; ++m) _Pragma("unroll") for (int k = 0; k < 2; ++k) dst[m][k] = *(const LAS bf16x8*)(lds + PG8_SA(b, h) + aoff + m * 2048 + k * 1024); } while (0)
#define PG8_LDB(dst, b, h) do { _Pragma("unroll") for (int n = 0; n < 2; ++n) _Pragma("unroll") for (int k = 0; k < 2; ++k) dst[n][k] = *(const LAS bf16x8*)(lds + PG8_SB(b, h) + boff + n * 2048 + k * 1024); } while (0)
#define PG8_MMA(ai, bj, At, Bt) do { __builtin_amdgcn_s_setprio(1); _Pragma("unroll") for (int m = 0; m < 4; ++m) _Pragma("unroll") for (int n = 0; n < 2; ++n) _Pragma("unroll") for (int k = 0; k < 2; ++k) \
        acc[ai][bj][m][n] = __builtin_amdgcn_mfma_f32_16x16x32_bf16(Bt[n][k], At[m][k], acc[ai][bj][m][n], 0, 0, 0); __builtin_amdgcn_s_setprio(0); } while (0)
#define PG8_WAIT_V(n) asm volatile("s_waitcnt vmcnt(" #n ")" ::: "memory")
#define PG8_WAIT_L(n) asm volatile("s_waitcnt lgkmcnt(" #n ")" ::: "memory")
#define PG8_BAR __builtin_amdgcn_s_barrier()
#define PG8_SCHED __builtin_amdgcn_sched_barrier(0)
    Unit cur, nxt; int ui = 0;
    if (!S.next(0, cur)) return;
    f32x4 acc[2][2][4][2];
#pragma unroll
    for (int a = 0; a < 2; ++a)
#pragma unroll
        for (int b = 0; b < 2; ++b)
#pragma unroll
            for (int m = 0; m < 4; ++m)
#pragma unroll
                for (int n = 0; n < 2; ++n) acc[a][b][m][n] = (f32x4){0.f, 0.f, 0.f, 0.f};
    bf16x8 At[4][2], B0[2][2], B1[2][2];
#define PG8_STAGEA(bufoff, uidx, uu, tt, hh) S.stage_a(lds + (bufoff) + ldsw, uidx, uu, tt, hh, Rs, Cs)
    {
        const char* pB0 = S.b_ptr(cur, 0); const char* pB1 = S.b_ptr(cur, 1);
        PG8_STAGEB(PG8_SB(0, 0), pB0); PG8_STAGEB(PG8_SB(0, 1), pB0 + hstepB); PG8_STAGEA(PG8_SA(0, 0), 0, cur, 0, 0); PG8_STAGEA(PG8_SA(0, 1), 0, cur, 0, 1);
        if (wr == 1) PG8_BAR;
        PG8_WAIT_V(2); PG8_BAR;
        PG8_STAGEB(PG8_SB(1, 0), pB1); PG8_STAGEA(PG8_SA(1, 0), 0, cur, 1, 0); PG8_STAGEB(PG8_SB(1, 1), pB1 + hstepB);
        PG8_WAIT_V(6); PG8_BAR;
    }
    for (;;) {
        const bool has_next = S.next(ui + 1, nxt);
        if (!has_next) nxt = cur;
        const int uin = has_next ? ui + 1 : ui;
#pragma unroll 1
        for (int t = 0; t < nt; t += 2) {
            const bool last = (t == nt - 2);
            const Unit& u2 = last ? nxt : cur; const int ui2 = last ? uin : ui; const int t2 = last ? 0 : t + 2;
            const char* b2 = S.b_ptr(u2, t2); const char* b3 = S.b_ptr(u2, t2 + 1);
            PG8_LDB(B0, 0, 0); PG8_LDB(B1, 0, 1); PG8_SCHED; PG8_LDA(At, 0, 0); PG8_STAGEA(PG8_SA(1, 1), ui, cur, t + 1, 1);
            PG8_WAIT_V(8); PG8_WAIT_L(0); PG8_BAR; PG8_MMA(0, 0, At, B0); PG8_MMA(0, 1, At, B1); PG8_BAR; PG8_SCHED;
            PG8_LDA(At, 0, 1); PG8_STAGEB(PG8_SB(0, 0), b2); PG8_STAGEB(PG8_SB(0, 1), b2 + hstepB); PG8_STAGEA(PG8_SA(0, 0), ui2, u2, t2, 0);
            PG8_WAIT_V(8); PG8_WAIT_L(0); PG8_BAR; PG8_MMA(1, 0, At, B0); PG8_MMA(1, 1, At, B1); PG8_BAR; PG8_SCHED;
            PG8_LDB(B0, 1, 0); PG8_LDB(B1, 1, 1); PG8_SCHED; PG8_LDA(At, 1, 0); PG8_STAGEA(PG8_SA(0, 1), ui2, u2, t2, 1);
            PG8_WAIT_V(8); PG8_WAIT_L(0); PG8_BAR; PG8_MMA(0, 0, At, B0); PG8_MMA(0, 1, At, B1); PG8_BAR; PG8_SCHED;
            PG8_LDA(At, 1, 1); PG8_STAGEB(PG8_SB(1, 0), b3); PG8_STAGEB(PG8_SB(1, 1), b3 + hstepB); PG8_STAGEA(PG8_SA(1, 0), ui2, u2, t2 + 1, 0);
            PG8_WAIT_V(8); PG8_WAIT_L(0); PG8_BAR; PG8_MMA(1, 0, At, B0); PG8_MMA(1, 1, At, B1); PG8_BAR; PG8_SCHED;
        }
        if (wr == 0) PG8_BAR;
        S.epi(acc, cur, wr, wc, fr, fq, ui);
        PG8_SCHED;
        if (!has_next) break;
#pragma unroll
        for (int a = 0; a < 2; ++a)
#pragma unroll
            for (int b = 0; b < 2; ++b)
#pragma unroll
                for (int m = 0; m < 4; ++m)
#pragma unroll
                    for (int n = 0; n < 2; ++n) acc[a][b][m][n] = (f32x4){0.f, 0.f, 0.f, 0.f};
        cur = nxt; ++ui;
        if (wr == 1) PG8_BAR;
    }
    PG8_WAIT_V(0);
    PG8_BAR;
#undef PG8_SA
#undef PG8_SB
#undef PG8_STAGE1
#undef PG8_STAGEB
#undef PG8_STAGEA
#undef PG8_LDA
#undef PG8_LDB
#undef PG8_MMA
#undef PG8_WAIT_V
#undef PG8_WAIT_L
#undef PG8_BAR
#undef PG8_SCHED
}
}
typedef f32x4 AccT[2][2][4][2];

struct Args { const float* in[30]; float* out; unsigned char* ws; int ph_lo, ph_hi; };

struct Frame {
    LAS unsigned char* lds;
    int tid, lane, wave, G, wg;
    const float* const* in;
    unsigned char* ws; unsigned char* os;
};
#define IN_X 0
#define IN_META 1
#define IN_NMG 2
#define IN_WIN 3
#define IN_LRE 4
#define IN_LIM 5
#define IN_LDT 6
#define IN_BRE 7
#define IN_BIM 8
#define IN_CRE 9
#define IN_CIM 10
#define IN_S5D 11
#define IN_WGLU 12
#define IN_HLB 13
#define IN_HNG 14
#define IN_LQ1 15
#define IN_LK1 16
#define IN_LQ2 17
#define IN_LK2 18
#define IN_SUBLN 19
#define IN_WOUT 20
#define IN_NFG 21
#define IN_WGRP 22
#define IN_BGRP 23
#define IN_WEXP 24
#define IN_BEXP 25
#define IN_WGATE 26
#define IN_WUP 27
#define IN_WDOWN 28
#define IN_FNG 29

template <class ColMap>
__device__ __forceinline__ void conv_item(const float* W, int ldw, const float* kscale, bf16* WT, int ldt, int k0, int n0, LAS float* scr, int lane, ColMap cm) {
    const int sc = cm(n0 + (lane & 31));
#pragma unroll
    for (int i = 0; i < 32; ++i) { const int kk = 2 * i + (lane >> 5); float v = W[(size_t)(k0 + kk) * ldw + sc]; if (kscale) v *= kscale[k0 + kk]; scr[kk * 33 + (lane & 31)] = v; }
    LDS_WAIT(); asm volatile("" ::: "memory");
    const int c = lane & 7;
#pragma unroll
    for (int j = 0; j < 4; ++j) { const int n = (lane >> 3) + 8 * j; const LAS float* s = scr + (8 * c) * 33 + n;
        u32x4 o; o.x = pk2(s[0 * 33], s[1 * 33]); o.y = pk2(s[2 * 33], s[3 * 33]); o.z = pk2(s[4 * 33], s[5 * 33]); o.w = pk2(s[6 * 33], s[7 * 33]);
        *(GAS u32x4*)(WT + (size_t)(n0 + n) * ldt + k0 + 8 * c) = o; }
    LDS_WAIT(); asm volatile("" ::: "memory");
}

__device__ __forceinline__ void p0_prologue(const Frame& F0) {
    Frame F = F0; LAUNDER(F.tid); F.lane = F.tid & 63;
    LAS float* scr = (LAS float*)(F.lds + F.wave * 16384);
    const int gw = F.wg * 8 + F.wave, NGW = F.G * 8, lane = F.lane;
    constexpr int I_IN = 16 * (NI / 32), I_OUT = 16 * 32, I_GLU = 4 * 16, I_GU = 16 * 16 * 32, I_DN = 16 * 8 * 32;
    constexpr int I_L = I_IN + I_OUT + I_GLU + I_GU + I_DN;
    for (int it = gw; it < 2 * I_L; it += NGW) {
        const int l = it / I_L; int r = it % I_L;
        if (r < I_IN) {
            const int kb = r / (NI / 32), nb = r % (NI / 32);
            conv_item(F.in[IN_WIN] + (size_t)l * D * NI, NI, F.in[IN_NMG] + l * D, (bf16*)(F.ws + WS_WIN) + (size_t)l * NI * D, D, kb * 64, nb * 32, scr, lane,
                      [](int n) { if (n >= C_AQ && n < C_AV) { const int p = n & 63, j = p >> 3, e = p & 7; return (n & ~63) + 4 * j + (e & 3) + 32 * (e >> 2); } return n; });
            continue; }
        r -= I_IN;
        if (r < I_OUT) {
            const int kb = r / 32, nb = r % 32;
            conv_item(F.in[IN_WOUT] + (size_t)l * D * D, D, nullptr, (bf16*)(F.ws + WS_WOUT) + (size_t)l * D * D, D, kb * 64, nb * 32, scr, lane, [](int n) { return n; });
            continue; }
        r -= I_OUT;
        if (r < I_GLU) {
            const int kb = r / 16, nb = r % 16;
            conv_item(F.in[IN_WGLU] + (size_t)l * 256 * 512, 512, nullptr, (bf16*)(F.ws + WS_WGLU) + (size_t)l * 512 * 256, 256, kb * 64, nb * 32, scr, lane,
                      [](int n) { const int pn = n >> 8, bj = (n >> 7) & 1, c = n & 127; return bj * 256 + pn * 128 + c; });
            continue; }
        r -= I_GLU;
        if (r < I_GU) {
            const int e = r / (16 * 32), q = r % (16 * 32), kb = q / 32, nb = q % 32, n0 = nb * 32, bj = (n0 >> 7) & 1;
            const float* src = (bj ? F.in[IN_WUP] : F.in[IN_WGATE]) + ((size_t)l * 16 + e) * 1024 * 512;
            conv_item(src, 512, F.in[IN_NFG] + l * D, (bf16*)(F.ws + WS_WGU) + ((size_t)l * 16 + e) * 1024 * 1024, 1024, kb * 64, n0, scr, lane,
                      [](int n) { const int pn = n >> 8, c = n & 127; return pn * 128 + c; });
            continue; }
        r -= I_GU;
        {
            const int e = r / (8 * 32), q = r % (8 * 32), kb = q / 32, nb = q % 32;
            conv_item(F.in[IN_WDOWN] + ((size_t)l * 16 + e) * 512 * 1024, 1024, nullptr, (bf16*)(F.ws + WS_WDN) + ((size_t)l * 16 + e) * 1024 * 512, 512, kb * 64, nb * 32, scr, lane, [](int n) { return n; });
        }
    }
    for (int idx = gw * 64 + lane; idx < 2 * 32 * 1024; idx += NGW * 64) {
        const int l = idx / (32 * 1024), j = (idx / 1024) % 32, k = idx % 1024;
        float w = 0.f;
        if (j < 4) w = F.in[IN_WGRP][((size_t)l * D + k) * 4 + j]; else if (j < 20) w = F.in[IN_WEXP][((size_t)l * D + k) * 16 + (j - 4)];
        w *= F.in[IN_NFG][l * D + k];
        const unsigned hi = f2bf(w); const float lo = w - bf2f(hi);
        bf16* wr = (bf16*)(F.ws + WS_WR) + (size_t)l * 2 * 32 * 1024;
        wr[j * 1024 + k] = (bf16)hi; wr[32 * 1024 + j * 1024 + k] = (bf16)f2bf(lo);
    }
    for (int idx = gw * 64 + lane; idx < LT * 32; idx += NGW * 64) {
        const int pos = idx / 32, i = idx % 32;
        const double inv = pow(10000.0, -(double)(2 * i) / 64.0); const double a = (double)pos * inv;
        ((float*)(F.ws + WS_ROPE))[idx] = (float)cos(a); ((float*)(F.ws + WS_ROPE))[LT * 32 + idx] = (float)sin(a);
    }
    for (int m = gw; m < T; m += NGW) {
        const int b = m / LT, t = m % LT;
        const float* src = (t < NMETA) ? F.in[IN_META] + (size_t)t * D : F.in[IN_X] + ((size_t)b * SEQ + (t - NMETA)) * D;
        const GAS f32x4* xr = (const GAS f32x4*)src + lane;
        GAS f32x4* hr = (GAS f32x4*)((float*)(F.ws + WS_H) + (size_t)m * D) + lane;
        GAS u32x2* hb = (GAS u32x2*)((bf16*)(F.ws + WS_HB) + (size_t)m * D) + lane;
        float s = 0.f;
#pragma unroll
        for (int j = 0; j < 4; ++j) { const f32x4 v = xr[64 * j]; hr[64 * j] = v; s += (v.x * v.x + v.y * v.y) + (v.z * v.z + v.w * v.w);
            u32x2 o; o.x = pk2(v.x, v.y); o.y = pk2(v.z, v.w); hb[64 * j] = o; }
        s = wave_sum(s);
        if (lane < 16) ((float*)(F.ws + WS_SS16))[(size_t)m * 16 + lane] = (lane == 0) ? s : 0.f;
    }
    for (int it = F.wg; it < 32; it += F.G) {
        const int l = it / 16, g = it % 16;
        LAS f32x2* Ap = (LAS f32x2*)(F.lds);
        LAS f32x2* Bb = Ap + 17 * 64;
        LAS f32x2* Cc = Bb + 64 * 16;
        LAS float* Kj = (LAS float*)(Cc + 16 * 64);
        __syncthreads();
        const double dt = exp((double)F.in[IN_LDT][l * 16 + g]);
        for (int idx = F.tid; idx < 17 * 64; idx += 512) { const int j = idx / 64, n = idx % 64;
            const double lr = F.in[IN_LRE][(l * 16 + g) * 64 + n], li = F.in[IN_LIM][(l * 16 + g) * 64 + n];
            const double mg = exp(j * lr * dt), an = j * li * dt; Ap[idx] = (f32x2){(float)(mg * cos(an)), (float)(mg * sin(an))}; }
        for (int idx = F.tid; idx < 64 * 16; idx += 512) { const int n = idx / 16, c = idx % 16;
            const double lr = F.in[IN_LRE][(l * 16 + g) * 64 + n], li = F.in[IN_LIM][(l * 16 + g) * 64 + n];
            const double mg = exp(lr * dt), ar = mg * cos(li * dt), ai = mg * sin(li * dt), den = lr * lr + li * li, zr = ar - 1.0, zi = ai;
            const double fr = (zr * lr + zi * li) / den, fi = (zi * lr - zr * li) / den;
            const double br = F.in[IN_BRE][((size_t)(l * 16 + g) * 64 + n) * 16 + c], bi = F.in[IN_BIM][((size_t)(l * 16 + g) * 64 + n) * 16 + c];
            Bb[idx] = (f32x2){(float)(fr * br - fi * bi), (float)(fr * bi + fi * br)}; }
        for (int idx = F.tid; idx < 16 * 64; idx += 512) { const int c = idx / 64, n = idx % 64;
            Cc[idx] = (f32x2){F.in[IN_CRE][((size_t)(l * 16 + g) * 16 + c) * 64 + n], F.in[IN_CIM][((size_t)(l * 16 + g) * 16 + c) * 64 + n]}; }
        __syncthreads();
        for (int idx = F.tid; idx < 4096; idx += 512) { const int j = idx >> 8, co = (idx >> 4) & 15, ci = idx & 15; float s = 0.f;
            for (int n = 0; n < 64; ++n) { const f32x2 a = Ap[j * 64 + n], b = Bb[n * 16 + ci], c = Cc[co * 64 + n];
                const float abr = a.x * b.x - a.y * b.y, abi = a.x * b.y + a.y * b.x; s += c.x * abr - c.y * abi; }
            Kj[idx] = s; }
        if (F.tid < 64) ((f32x2*)(F.ws + WS_S5A))[(l * 16 + g) * 64 + F.tid] = Ap[16 * 64 + F.tid];
        __syncthreads();
        bf16* TQ = (bf16*)(F.ws + WS_S5TQ) + (size_t)(l * 16 + g) * 256 * 384;
        for (int idx = F.tid; idx < 256 * 384; idx += 512) { const int nn = idx / 384, k = idx % 384, t = nn >> 4, co = nn & 15; float v;
            if (k < 256) { const int s = k >> 4, ci = k & 15; v = (s <= t) ? Kj[((t - s) << 8) + (co << 4) + ci] : 0.f; }
            else { const int kk = k - 256, n = kk >> 1; const f32x2 a = Ap[(t + 1) * 64 + n], c = Cc[co * 64 + n];
                const float zr = c.x * a.x - c.y * a.y, zi = c.x * a.y + c.y * a.x; v = (kk & 1) ? -zi : zr; }
            TQ[idx] = (bf16)f2bf(v); }
        bf16* PM = (bf16*)(F.ws + WS_S5P) + (size_t)(l * 16 + g) * 256 * 256;
        for (int idx = F.tid; idx < 256 * 256; idx += 512) { const int nn = idx >> 8, k = idx & 255; float v = 0.f;
            if (nn < 128) { const int n = nn >> 1, s = k >> 4, ci = k & 15; const f32x2 a = Ap[(15 - s) * 64 + n], b = Bb[n * 16 + ci];
                v = (nn & 1) ? (a.x * b.y + a.y * b.x) : (a.x * b.x - a.y * b.y); }
            PM[idx] = (bf16)f2bf(v); }
        __syncthreads();
    }
}

template <class V> __device__ __forceinline__ V ldg(const void* sbase, unsigned voff) { return *(const GAS V*)((const char*)sbase + voff); }
template <class V> __device__ __forceinline__ void stg(void* sbase, unsigned voff, V v) { *(GAS V*)((char*)sbase + voff) = v; }
#define GLDS2(p0, p1, dst) do { __builtin_amdgcn_global_load_lds((const unsigned*)(p0), (LAS unsigned*)(dst), 16, 0, 0); __builtin_amdgcn_global_load_lds((const unsigned*)(p1), (LAS unsigned*)((dst) + 8192), 16, 0, 0); } while (0)
#define EPI_FENCE() __builtin_amdgcn_sched_barrier(0)
struct UnitT { int pm, pn; };

struct PolIn {
    typedef UnitT Unit; static constexpr int NT = 16, LDB = 1024;
    pg8::TileOrder ord; const bf16* A; const bf16* B; bf16* proj; const float* ss16; const float* rope;
    __device__ __forceinline__ bool next(int i, Unit& u) const { return ord.get(i, u.pm, u.pn); }
    __device__ __forceinline__ void stage_a(LAS unsigned char* dst, int, const Unit& u, int t, int h, const int (&R)[2], const int (&C)[2]) const {
        const char* bp = (const char*)(A + (size_t)(u.pm * 256 + h * 128) * 1024) + t * 128;
        GLDS2(bp + (unsigned)((R[0] * 1024 + C[0]) * 2), bp + (unsigned)((R[1] * 1024 + C[1]) * 2), dst); }
    __device__ __forceinline__ const char* b_ptr(const Unit& u, int t) const { return (const char*)(B + (size_t)u.pn * 256 * 1024) + t * 128; }
    __device__ __forceinline__ void epi(const AccT& acc, const Unit& u, int wr, int wc, int fr, int fq, int) const {
        const bool isrope = (u.pn >= 5 && u.pn <= 8); const float qs = (u.pn == 5 || u.pn == 6) ? QSCALE : 1.f;
        const unsigned fi = 4u * (4u * (wc & 1) + fq);
        const unsigned vo_p = (unsigned)((fr * NI + u.pn * 256 + wc * 32 + 8 * fq) * 2), vo_s = (unsigned)(fr * 64);
#pragma unroll
        for (int ai = 0; ai < 2; ++ai)
#pragma unroll
            for (int m = 0; m < 4; ++m) {
                const int rowu = u.pm * 256 + ai * 128 + wr * 64 + m * 16;
                const float* sp = ss16 + (size_t)rowu * 16;
                const f32x4 s0 = ldg<f32x4>(sp, vo_s), s1 = ldg<f32x4>(sp, vo_s + 16), s2 = ldg<f32x4>(sp, vo_s + 32), s3 = ldg<f32x4>(sp, vo_s + 48);
                const float ss = ((s0.x + s0.y) + (s0.z + s0.w)) + ((s1.x + s1.y) + (s1.z + s1.w)) + ((s2.x + s2.y) + (s2.z + s2.w)) + ((s3.x + s3.y) + (s3.z + s3.w));
                const float rstd = rsqrtf(ss * (1.f / 1024.f) + RMS_EPS);
                f32x4 cs = (f32x4){1.f, 1.f, 1.f, 1.f}, sn = (f32x4){0.f, 0.f, 0.f, 0.f};
                if (isrope) { const unsigned pos = (unsigned)(rowu + fr) % (unsigned)LT; cs = ldg<f32x4>(rope, (pos * 32 + fi) * 4); sn = ldg<f32x4>(rope, (LT * 32 + pos * 32 + fi) * 4); }
                bf16* rowp = proj + (size_t)rowu * NI;
#pragma unroll
                for (int bj = 0; bj < 2; ++bj) {
                    f32x4 v0 = acc[ai][bj][m][0] * rstd, v1 = acc[ai][bj][m][1] * rstd;
                    if (isrope) { const f32x4 o0 = (v0 * cs - v1 * sn) * qs, o1 = (v1 * cs + v0 * sn) * qs; v0 = o0; v1 = o1; }
                    u32x4 w; w.x = cvt_pk_bf16(v0[0], v0[1]); w.y = cvt_pk_bf16(v0[2], v0[3]); w.z = cvt_pk_bf16(v1[0], v1[1]); w.w = cvt_pk_bf16(v1[2], v1[3]);
                    stg<u32x4>(rowp, vo_p + bj * 256, w);
                }
                EPI_FENCE();
            }
    }
};

struct UnitS5 { int g, mt; };
struct PolS5E {
    typedef UnitS5 Unit; static constexpr int NT = 4, LDB = 256;
    int G, c; const bf16* proj; const bf16* B; float* E;
    __device__ __forceinline__ bool next(int i, Unit& u) const { const int Lx = i * G + c; if (Lx >= 16 * 17) return false; u.g = Lx / 17; u.mt = Lx % 17; return true; }
    __device__ __forceinline__ void stage_a(LAS unsigned char* dst, int, const Unit& u, int t, int h, const int (&R)[2], const int (&C)[2]) const {
        const char* bp = (const char*)(proj + ((size_t)(16 * (256 * u.mt + 128 * h) + 4 * t)) * NI + C_U + u.g * 16);
        GLDS2(bp + (unsigned)(((16 * R[0] + (C[0] >> 4)) * NI + (C[0] & 15)) * 2), bp + (unsigned)(((16 * R[1] + (C[1] >> 4)) * NI + (C[1] & 15)) * 2), dst); }
    __device__ __forceinline__ const char* b_ptr(const Unit& u, int t) const { return (const char*)(B + (size_t)u.g * 256 * 256) + t * 128; }
    __device__ __forceinline__ void epi(const AccT& acc, const Unit& u, int wr, int wc, int fr, int fq, int) const {
        const unsigned vo = (unsigned)((fr * 128 + wc * 32 + 8 * fq) * 4);
#pragma unroll
        for (int ai = 0; ai < 2; ++ai)
#pragma unroll
            for (int m = 0; m < 4; ++m) { float* ep = E + ((size_t)u.g * S5RP + u.mt * 256 + ai * 128 + wr * 64 + m * 16) * 128;
                stg<f32x4>(ep, vo, acc[ai][0][m][0]); stg<f32x4>(ep, vo + 16, acc[ai][0][m][1]); }
    }
};

struct PolS5Y {
    typedef UnitS5 Unit; static constexpr int NT = 6, LDB = 384;
    int G, c; const bf16* X; const bf16* B; const bf16* proj; const float* dsk; bf16* Gout;
    __device__ __forceinline__ bool next(int i, Unit& u) const { const int Lx = i * G + c; if (Lx >= 16 * 17) return false; u.g = Lx / 17; u.mt = Lx % 17; return true; }
    __device__ __forceinline__ void stage_a(LAS unsigned char* dst, int, const Unit& u, int t, int h, const int (&R)[2], const int (&C)[2]) const {
        const char* bp = (const char*)(X + ((size_t)u.g * S5RP + 256 * u.mt + 128 * h) * 384) + t * 128;
        GLDS2(bp + (unsigned)((R[0] * 384 + C[0]) * 2), bp + (unsigned)((R[1] * 384 + C[1]) * 2), dst); }
    __device__ __forceinline__ const char* b_ptr(const Unit& u, int t) const { return (const char*)(B + (size_t)u.g * 256 * 384) + t * 128; }
    __device__ __forceinline__ void epi(const AccT& acc, const Unit& u, int wr, int wc, int fr, int fq, int) const {
        const int ch = u.g * 16 + 8 * (fq & 1);
        const f32x4 d0 = ldg<f32x4>(dsk, (unsigned)ch * 4), d1 = ldg<f32x4>(dsk, (unsigned)ch * 4 + 16);
        const unsigned vo_u = (unsigned)(((16 * fr + (fq >> 1)) * NI + C_U + ch) * 2), vo_g = (unsigned)(((16 * fr + (fq >> 1)) * 256 + ch) * 2);
#pragma unroll
        for (int ai = 0; ai < 2; ++ai)
#pragma unroll
            for (int m = 0; m < 4; ++m) { const int Ru = u.mt * 256 + ai * 128 + wr * 64 + m * 16;
                if (Ru + fr < S5R) {
#pragma unroll
                    for (int bj = 0; bj < 2; ++bj) { const size_t toku = (size_t)16 * Ru + 8 * bj + 2 * wc;
                        const u32x4 uu = ldg<u32x4>(proj + toku * NI, vo_u);
                        f32x4 v0 = acc[ai][bj][m][0], v1 = acc[ai][bj][m][1];
                        v0[0] += d0[0] * bf2f(uu.x); v0[1] += d0[1] * bf2f(uu.x >> 16); v0[2] += d0[2] * bf2f(uu.y); v0[3] += d0[3] * bf2f(uu.y >> 16);
                        v1[0] += d1[0] * bf2f(uu.z); v1[1] += d1[1] * bf2f(uu.z >> 16); v1[2] += d1[2] * bf2f(uu.w); v1[3] += d1[3] * bf2f(uu.w >> 16);
                        u32x4 w; w.x = pk2(gelu_tanh(v0[0]), gelu_tanh(v0[1])); w.y = pk2(gelu_tanh(v0[2]), gelu_tanh(v0[3]));
                        w.z = pk2(gelu_tanh(v1[0]), gelu_tanh(v1[1])); w.w = pk2(gelu_tanh(v1[2]), gelu_tanh(v1[3]));
                        stg<u32x4>(Gout + toku * 256, vo_g, w); }
                }
                EPI_FENCE();
            }
    }
};

struct PolGlu {
    typedef UnitT Unit; static constexpr int NT = 4, LDB = 256;
    pg8::TileOrder ord; const bf16* A; const bf16* B; bf16* mixed;
    __device__ __forceinline__ bool next(int i, Unit& u) const { return ord.get(i, u.pm, u.pn); }
    __device__ __forceinline__ void stage_a(LAS unsigned char* dst, int, const Unit& u, int t, int h, const int (&R)[2], const int (&C)[2]) const {
        const char* bp = (const char*)(A + (size_t)(u.pm * 256 + h * 128) * 256) + t * 128;
        GLDS2(bp + (unsigned)((R[0] * 256 + C[0]) * 2), bp + (unsigned)((R[1] * 256 + C[1]) * 2), dst); }
    __device__ __forceinline__ const char* b_ptr(const Unit& u, int t) const { return (const char*)(B + (size_t)u.pn * 256 * 256) + t * 128; }
    __device__ __forceinline__ void epi(const AccT& acc, const Unit& u, int wr, int wc, int fr, int fq, int) const {
        const unsigned vo = (unsigned)((fr * D + u.pn * 128 + wc * 32 + 8 * fq) * 2);
#pragma unroll
        for (int ai = 0; ai < 2; ++ai)
#pragma unroll
            for (int m = 0; m < 4; ++m) { bf16* rp = mixed + (size_t)(u.pm * 256 + ai * 128 + wr * 64 + m * 16) * D;
                const f32x4 a0 = acc[ai][0][m][0], a1 = acc[ai][0][m][1], b0 = acc[ai][1][m][0], b1 = acc[ai][1][m][1];
                u32x4 w; w.x = pk2(a0[0] * sigmoidf_(b0[0]), a0[1] * sigmoidf_(b0[1])); w.y = pk2(a0[2] * sigmoidf_(b0[2]), a0[3] * sigmoidf_(b0[3]));
                w.z = pk2(a1[0] * sigmoidf_(b1[0]), a1[1] * sigmoidf_(b1[1])); w.w = pk2(a1[2] * sigmoidf_(b1[2]), a1[3] * sigmoidf_(b1[3]));
                stg<u32x4>(rp, vo, w);
                EPI_FENCE(); }
    }
};

__device__ __forceinline__ void residual_rows(const AccT& acc, int ai, int m, unsigned vrow, bool valid, int pn, int wc, int fq, float* hrow, bf16* brow, float* srow) {
    const unsigned colb = (unsigned)(pn * 256 + wc * 32 + 8 * fq);
    const unsigned vh = (vrow * D + colb) * 4, vb = (vrow * D + colb) * 2;
    float ssq = 0.f;
    if (valid) {
#pragma unroll
        for (int bj = 0; bj < 2; ++bj) {
            f32x4 h0 = ldg<f32x4>(hrow, vh + bj * 512), h1 = ldg<f32x4>(hrow, vh + bj * 512 + 16);
            h0 += acc[ai][bj][m][0]; h1 += acc[ai][bj][m][1];
            stg<f32x4>(hrow, vh + bj * 512, h0); stg<f32x4>(hrow, vh + bj * 512 + 16, h1);
            u32x4 w; w.x = cvt_pk_bf16(h0[0], h0[1]); w.y = cvt_pk_bf16(h0[2], h0[3]); w.z = cvt_pk_bf16(h1[0], h1[1]); w.w = cvt_pk_bf16(h1[2], h1[3]);
            stg<u32x4>(brow, vb + bj * 256, w);
            ssq += (h0[0] * h0[0] + h0[1] * h0[1]) + (h0[2] * h0[2] + h0[3] * h0[3]) + (h1[0] * h1[0] + h1[1] * h1[1]) + (h1[2] * h1[2] + h1[3] * h1[3]);
        }
    }
    ssq += __shfl_xor(ssq, 16); ssq += __shfl_xor(ssq, 32);
    if (valid && fq == 0) stg<float>(srow, (vrow * 16 + pn * 4 + wc) * 4, ssq);
}

struct PolOut {
    typedef UnitT Unit; static constexpr int NT = 16, LDB = 1024;
    pg8::TileOrder ord; const bf16* A; const bf16* B; float* H; bf16* HB; float* ss16;
    __device__ __forceinline__ bool next(int i, Unit& u) const { return ord.get(i, u.pm, u.pn); }
    __device__ __forceinline__ void stage_a(LAS unsigned char* dst, int, const Unit& u, int t, int h, const int (&R)[2], const int (&C)[2]) const {
        const char* bp = (const char*)(A + (size_t)(u.pm * 256 + h * 128) * 1024) + t * 128;
        GLDS2(bp + (unsigned)((R[0] * 1024 + C[0]) * 2), bp + (unsigned)((R[1] * 1024 + C[1]) * 2), dst); }
    __device__ __forceinline__ const char* b_ptr(const Unit& u, int t) const { return (const char*)(B + (size_t)u.pn * 256 * 1024) + t * 128; }
    __device__ __forceinline__ void epi(const AccT& acc, const Unit& u, int wr, int wc, int fr, int fq, int) const {
#pragma unroll
        for (int ai = 0; ai < 2; ++ai)
#pragma unroll
            for (int m = 0; m < 4; ++m) { const size_t rowu = (size_t)(u.pm * 256 + ai * 128 + wr * 64 + m * 16);
                residual_rows(acc, ai, m, (unsigned)fr, true, u.pn, wc, fq, H + rowu * D, HB + rowu * D, ss16 + rowu * 16);
                EPI_FENCE(); }
    }
};

struct MoeList {
    LAS const int* cnt;
    __device__ __forceinline__ int ntiles() const { int s = 0; for (int c = 0; c < NCLS; ++c) s += (cnt[c] + 255) >> 8; return __builtin_amdgcn_readfirstlane(s); }
    __device__ __forceinline__ void decode(int gt, int& c, int& ti, int& nvalid) const {
        int s = 0, cc = 0, tt = 0, nv = 0;
        for (int k = 0; k < NCLS; ++k) { const int n = (cnt[k] + 255) >> 8; if (gt >= s && gt < s + n) { cc = k; tt = gt - s; nv = cnt[k] - 256 * tt; } s += n; }
        c = __builtin_amdgcn_readfirstlane(cc); ti = __builtin_amdgcn_readfirstlane(tt); nvalid = __builtin_amdgcn_readfirstlane(nv > 256 ? 256 : nv);
    }
};
__device__ __forceinline__ void class_experts(int c, int& ea, int& eb) {
    const int g = c / 6, p = c % 6; const int a = (p < 3) ? 0 : (p < 5 ? 1 : 2); const int b = (p < 3) ? p + 1 : (p < 5 ? p - 1 : 3);
    ea = g * 4 + a; eb = g * 4 + b;
}
struct UnitM { int gt, pn, c; };

struct PolGU {
    typedef UnitM Unit; static constexpr int NT = 16, LDB = 1024;
    int G, c, ntl; MoeList ml; LAS const int* tab;
    const bf16* HB; const bf16* W; bf16* he; const float* rstd; const float* gate;
    __device__ __forceinline__ bool next(int i, Unit& u) const { const int Lx = i * G + c; if (Lx >= ntl * 8) return false; u.gt = Lx >> 3; u.pn = Lx & 7; int ti, nv; ml.decode(u.gt, u.c, ti, nv); return true; }
    __device__ __forceinline__ void stage_a(LAS unsigned char* dst, int ui, const Unit&, int t, int h, const int (&R)[2], const int (&C)[2]) const {
        const char* bp = (const char*)HB + t * 128;
        const int t0 = tab[ui * 256 + 128 * h + R[0]], t1 = tab[ui * 256 + 128 * h + R[1]];
        GLDS2(bp + (unsigned)((t0 < 0 ? 0 : t0) * 2048 + C[0] * 2), bp + (unsigned)((t1 < 0 ? 0 : t1) * 2048 + C[1] * 2), dst); }
    __device__ __forceinline__ const char* b_ptr(const Unit& u, int t) const { int ea, eb; class_experts(u.c, ea, eb); const int e = (u.pn >> 2) ? eb : ea;
        return (const char*)(W + ((size_t)e * 1024 + (u.pn & 3) * 256) * 1024) + t * 128; }
    __device__ __forceinline__ void epi(const AccT& acc, const Unit& u, int wr, int wc, int fr, int fq, int ui) const {
        const int sel = u.pn >> 2;
        const unsigned vo = (unsigned)((fr * 1024 + sel * 512 + (u.pn & 3) * 128 + wc * 32 + 8 * fq) * 2);
#pragma unroll
        for (int ai = 0; ai < 2; ++ai)
#pragma unroll
            for (int m = 0; m < 4; ++m) { const int ru = ai * 128 + wr * 64 + m * 16; const int tk = tab[ui * 256 + ru + fr];
                float rs = 0.f, gw = 0.f; if (tk >= 0) { rs = ldg<float>(rstd, (unsigned)tk * 4); gw = ldg<float>(gate, (unsigned)(2 * tk + sel) * 4); }
                const f32x4 g0 = acc[ai][0][m][0] * rs, g1 = acc[ai][0][m][1] * rs, u0 = acc[ai][1][m][0] * (rs * gw), u1 = acc[ai][1][m][1] * (rs * gw);
                u32x4 w; w.x = pk2(siluf_(g0[0]) * u0[0], siluf_(g0[1]) * u0[1]); w.y = pk2(siluf_(g0[2]) * u0[2], siluf_(g0[3]) * u0[3]);
                w.z = pk2(siluf_(g1[0]) * u1[0], siluf_(g1[1]) * u1[1]); w.w = pk2(siluf_(g1[2]) * u1[2], siluf_(g1[3]) * u1[3]);
                stg<u32x4>(he + ((size_t)u.gt * 256 + ru) * 1024, vo, w);
                EPI_FENCE(); }
    }
};

struct PolDN {
    typedef UnitM Unit; static constexpr int NT = 16, LDB = 512;
    int G, c, ntl; MoeList ml; LAS const int* tab;
    const bf16* he; const bf16* W; float* H; bf16* HB; float* ss16;
    __device__ __forceinline__ bool next(int i, Unit& u) const { const int Lx = i * G + c; if (Lx >= ntl * 4) return false; u.gt = Lx >> 2; u.pn = Lx & 3; int ti, nv; ml.decode(u.gt, u.c, ti, nv); return true; }
    __device__ __forceinline__ void stage_a(LAS unsigned char* dst, int, const Unit& u, int t, int h, const int (&R)[2], const int (&C)[2]) const {
        const char* bp = (const char*)(he + (size_t)(u.gt * 256 + h * 128) * 1024) + t * 128;
        GLDS2(bp + (unsigned)((R[0] * 1024 + C[0]) * 2), bp + (unsigned)((R[1] * 1024 + C[1]) * 2), dst); }
    __device__ __forceinline__ const char* b_ptr(const Unit& u, int t) const { int ea, eb; class_experts(u.c, ea, eb); const int e = (t >= 8) ? eb : ea;
        return (const char*)(W + ((size_t)e * 1024 + u.pn * 256) * 512) + (t & 7) * 128; }
    __device__ __forceinline__ void epi(const AccT& acc, const Unit& u, int wr, int wc, int fr, int fq, int ui) const {
#pragma unroll
        for (int ai = 0; ai < 2; ++ai)
#pragma unroll
            for (int m = 0; m < 4; ++m) { const int tk = tab[ui * 256 + ai * 128 + wr * 64 + m * 16 + fr];
                residual_rows(acc, ai, m, (unsigned)(tk < 0 ? 0 : tk), tk >= 0, u.pn, wc, fq, H, HB, ss16);
                EPI_FENCE(); }
    }
};

#define MFMA16(a, b, c) __builtin_amdgcn_mfma_f32_16x16x32_bf16(a, b, c, 0, 0, 0)
#define MFMA32(a, b, c) __builtin_amdgcn_mfma_f32_32x32x16_bf16(a, b, c, 0, 0, 0)

__device__ __forceinline__ void s5_scan(const Frame& F0, int l) {
    Frame F = F0; LAUNDER(F.tid); F.lane = F.tid & 63;
    const bf16* proj = (const bf16*)(F.ws + WS_PROJ); const float* E = (const float*)(F.os + OS_E); bf16* X = (bf16*)(F.os + OS_X);
    const int lane = F.lane;
    for (int it = F.wg + F.G * F.wave; it < NB * 16; it += F.G * 8) {
        const int b = it >> 4, g = it & 15;
        const f32x2 A16 = ((const f32x2*)(F.ws + WS_S5A))[(l * 16 + g) * 64 + lane];
        float sr = 0.f, si = 0.f;
        for (int r0 = 0; r0 < NCH; r0 += 16) {
            f32x2 e[16]; u32x2 u4[16];
#pragma unroll
            for (int j = 0; j < 16; ++j) if (r0 + j < NCH) { const size_t R = (size_t)b * NCH + r0 + j;
                e[j] = *(const GAS f32x2*)(E + ((size_t)g * S5RP + R) * 128 + 2 * lane);
                u4[j] = *(const GAS u32x2*)(proj + (16 * R + (lane >> 2)) * NI + C_U + g * 16 + 4 * (lane & 3)); }
#pragma unroll
            for (int j = 0; j < 16; ++j) if (r0 + j < NCH) { const size_t R = (size_t)b * NCH + r0 + j;
                bf16* xr = X + ((size_t)g * S5RP + R) * 384;
                *(GAS unsigned*)(xr + 256 + 2 * lane) = pk2(sr, si);
                *(GAS u32x2*)(xr + 4 * lane) = u4[j];
                const float nr = A16.x * sr - A16.y * si + e[j].x, ni = A16.x * si + A16.y * sr + e[j].y; sr = nr; si = ni; }
        }
    }
}

__device__ __forceinline__ float hgrn_lb(const float* hlb, int l, int j) {
    if (l == 0) return 0.f;
    const float x0 = hlb[j], x1 = hlb[256 + j], mx = fmaxf(x0, x1), e0 = __expf(x0 - mx), e1 = __expf(x1 - mx);
    return e1 / (e0 + e1);
}
__device__ __forceinline__ void hgrn_gate(float z, float lbA, float onem, float& lf, float& k) {
    const float e = __expf(-fabsf(z)), r = __builtin_amdgcn_rcpf(1.f + e), er = e * r;
    const float s = (z >= 0.f) ? r : er, c = (z >= 0.f) ? er : r;
    lf = __logf(lbA + onem * s); k = onem * c;
}
constexpr int HG_HALF = 72960, HG_LF = 0, HG_SEG = 16640, HG_T0 = 17664, HG_TS = 9216;

__device__ __forceinline__ void hgrn_a(const Frame& F0, int l) {
    Frame F = F0; LAUNDER(F.tid); F.lane = F.tid & 63;
    const bf16* proj = (const bf16*)(F.ws + WS_PROJ); float* UT = (float*)(F.os + OS_UT); float* DEC = (float*)(F.os + OS_DEC);
    const int half = F.tid >> 8, ht = F.tid & 255, hw = F.wave & 3, lane = F.lane;
    LAS unsigned char* base = F.lds + half * HG_HALF;
    LAS float* LF = (LAS float*)(base + HG_LF); LAS float* SEG = (LAS float*)(base + HG_SEG);
    LAS bf16* vT = (LAS bf16*)(base + HG_T0); LAS bf16* KDT = (LAS bf16*)(base + HG_T0 + HG_TS);
    for (int p = F.wg; p < NB * 4 * HCH / 2; p += F.G) {
        const int item = 2 * p + half, c = item % HCH, bh = item / HCH, b = bh >> 2, h = bh & 3;
        const size_t tok0 = (size_t)b * LT + (c == 0 ? 0 : 16 + 64 * (c - 1)); const int nrows = (c == 0) ? 16 : 64;
        float lbA[8], onem[8];
#pragma unroll
        for (int jj = 0; jj < 8; ++jj) { const float lb = hgrn_lb(F.in[IN_HLB], l, h * 64 + 8 * (ht & 7) + jj); lbA[jj] = fmaxf(lb, 1e-30f); onem[jj] = 1.f - lb; }
#pragma unroll
        for (int e = 0; e < 2; ++e) { const int idx = ht + 256 * e, t = idx >> 3, c8 = idx & 7; const bool valid = t < nrows;
            u32x4 zf = (u32x4){0u, 0u, 0u, 0u}, zi = zf;
            if (valid) { zf = *(const GAS u32x4*)(proj + (tok0 + t) * NI + C_HF + h * 64 + 8 * c8); zi = *(const GAS u32x4*)(proj + (tok0 + t) * NI + C_HI + h * 64 + 8 * c8); }
#pragma unroll
            for (int jj = 0; jj < 8; ++jj) { const int d = 8 * c8 + jj; const unsigned wf = (jj & 1) ? (zf[jj >> 1] >> 16) : (zf[jj >> 1] & 0xffffu); const unsigned wi = (jj & 1) ? (zi[jj >> 1] >> 16) : (zi[jj >> 1] & 0xffffu);
                float lf, kk; hgrn_gate(bf2f(wf), lbA[jj], onem[jj], lf, kk); LF[t * 65 + d] = valid ? lf : 0.f;
                vT[d * 72 + t] = (bf16)wi; }
        }
        __syncthreads();
        const int d = ht & 63, seg = ht >> 6;
        { float run = 0.f;
#pragma unroll
          for (int i = 0; i < 16; ++i) { run += LF[(16 * seg + i) * 65 + d]; LF[(16 * seg + i) * 65 + d] = run; }
          SEG[seg * 64 + d] = run; }
        __syncthreads();
        { float offs = 0.f, last = 0.f;
#pragma unroll
          for (int s = 0; s < 4; ++s) { const float v = SEG[s * 64 + d]; if (s < seg) offs += v; last += v; }
          float prev = 0.f;
#pragma unroll
          for (int i = 0; i < 16; ++i) { const int t = 16 * seg + i; const float cl = LF[t * 65 + d], lf = cl - prev; prev = cl;
              const float k = 1.f - __expf(lf); KDT[d * 72 + t] = (bf16)f2bf(k * __expf(last - (cl + offs))); }
          if (seg == 0) DEC[(size_t)item * 64 + d] = __expf(last); }
        __syncthreads();
        f32x4 acc[4];
#pragma unroll
        for (int nt = 0; nt < 4; ++nt) acc[nt] = (f32x4){0.f, 0.f, 0.f, 0.f};
#pragma unroll
        for (int ks = 0; ks < 2; ++ks) { const bf16x8 a = *(const LAS bf16x8*)(vT + (16 * hw + (lane & 15)) * 72 + 32 * ks + 8 * (lane >> 4));
#pragma unroll
            for (int nt = 0; nt < 4; ++nt) { const bf16x8 bb = *(const LAS bf16x8*)(KDT + (16 * nt + (lane & 15)) * 72 + 32 * ks + 8 * (lane >> 4)); acc[nt] = MFMA16(a, bb, acc[nt]); } }
#pragma unroll
        for (int nt = 0; nt < 4; ++nt)
#pragma unroll
            for (int j = 0; j < 4; ++j) UT[(size_t)item * 4096 + (16 * hw + 4 * (lane >> 4) + j) * 64 + 16 * nt + (lane & 15)] = acc[nt][j];
        __syncthreads();
    }
}

__device__ __forceinline__ void hgrn_b(const Frame& F0) {
    Frame F = F0; LAUNDER(F.tid); F.lane = F.tid & 63;
    const float* UT = (const float*)(F.os + OS_UT); const float* DEC = (const float*)(F.os + OS_DEC); bf16* SP = (bf16*)(F.os + OS_SP);
    for (int blk = F.wg; blk < NB * 4 * 8; blk += F.G) {
        const int bh = blk >> 3, e = (blk & 7) * 512 + F.tid, d = e & 63;
        float S = 0.f;
        for (int c0 = 0; c0 < HCH; c0 += 11) {
            float ut[11], dc[11];
#pragma unroll
            for (int j = 0; j < 11; ++j) { const size_t item = (size_t)bh * HCH + c0 + j; ut[j] = UT[item * 4096 + e]; dc[j] = DEC[item * 64 + d]; }
#pragma unroll
            for (int j = 0; j < 11; ++j) { const size_t item = (size_t)bh * HCH + c0 + j; SP[item * 4096 + e] = (bf16)f2bf(S); S = dc[j] * S + ut[j]; }
        }
    }
}

__device__ __forceinline__ void hgrn_c(const Frame& F0, int l) {
    Frame F = F0; LAUNDER(F.tid); F.lane = F.tid & 63;
    const bf16* proj = (const bf16*)(F.ws + WS_PROJ); const bf16* SPg = (const bf16*)(F.os + OS_SP); bf16* mixed = (bf16*)(F.ws + WS_MIXED);
    const int half = F.tid >> 8, ht = F.tid & 255, hw = F.wave & 3, lane = F.lane;
    LAS unsigned char* base = F.lds + half * HG_HALF;
    LAS float* LF = (LAS float*)(base + HG_LF); LAS float* SEG = (LAS float*)(base + HG_SEG);
    LAS bf16* vT = (LAS bf16*)(base + HG_T0); LAS bf16* QT = vT + HG_TS / 2; LAS bf16* KT = QT + HG_TS / 2; LAS bf16* QS = KT + HG_TS / 2; LAS bf16* SPt = QS + HG_TS / 2; LAS bf16* P = SPt + HG_TS / 2;
    const float* ng = F.in[IN_HNG] + l * 64;
    for (int p = F.wg; p < NB * 4 * HCH / 2; p += F.G) {
        const int item = 2 * p + half, c = item % HCH, bh = item / HCH, b = bh >> 2, h = bh & 3;
        const size_t tok0 = (size_t)b * LT + (c == 0 ? 0 : 16 + 64 * (c - 1)); const int nrows = (c == 0) ? 16 : 64;
        float qv[16], kv[16], lbA[8], onem[8];
#pragma unroll
        for (int jj = 0; jj < 8; ++jj) { const float lb = hgrn_lb(F.in[IN_HLB], l, h * 64 + 8 * (ht & 7) + jj); lbA[jj] = fmaxf(lb, 1e-30f); onem[jj] = 1.f - lb; }
#pragma unroll
        for (int e = 0; e < 2; ++e) { const int idx = ht + 256 * e, t = idx >> 3, c8 = idx & 7; const bool valid = t < nrows;
            u32x4 zq = (u32x4){0u, 0u, 0u, 0u}, zf = zq, zi = zq;
            if (valid) { const bf16* rp = proj + (tok0 + t) * NI + h * 64 + 8 * c8; zq = *(const GAS u32x4*)(rp + C_HQ); zf = *(const GAS u32x4*)(rp + C_HF); zi = *(const GAS u32x4*)(rp + C_HI); }
            const u32x4 sp = *(const GAS u32x4*)(SPg + (size_t)item * 4096 + t * 64 + 8 * c8);
            *(LAS u32x4*)(SPt + t * 72 + 8 * c8) = sp;
#pragma unroll
            for (int jj = 0; jj < 8; ++jj) { const int d = 8 * c8 + jj; const unsigned wq = (jj & 1) ? (zq[jj >> 1] >> 16) : (zq[jj >> 1] & 0xffffu);
                const unsigned wf = (jj & 1) ? (zf[jj >> 1] >> 16) : (zf[jj >> 1] & 0xffffu); const unsigned wi = (jj & 1) ? (zi[jj >> 1] >> 16) : (zi[jj >> 1] & 0xffffu);
                float lf, kk; hgrn_gate(bf2f(wf), lbA[jj], onem[jj], lf, kk);
                LF[t * 65 + d] = valid ? lf : 0.f; kv[8 * e + jj] = valid ? kk : 0.f; qv[8 * e + jj] = valid ? siluf_(bf2f(wq)) : 0.f;
                vT[d * 72 + t] = (bf16)wi; }
        }
        __syncthreads();
        { const int d = ht & 63, seg = ht >> 6; float run = 0.f;
#pragma unroll
          for (int i = 0; i < 16; ++i) { run += LF[(16 * seg + i) * 65 + d]; LF[(16 * seg + i) * 65 + d] = run; }
          SEG[seg * 64 + d] = run; }
        __syncthreads();
#pragma unroll
        for (int e = 0; e < 2; ++e) { const int idx = ht + 256 * e, t = idx >> 3, c8 = idx & 7, seg = t >> 4;
            unsigned wq[4], wk[4], ws[4];
#pragma unroll
            for (int jp = 0; jp < 4; ++jp) { float qt[2], kt[2], qs[2];
#pragma unroll
                for (int u = 0; u < 2; ++u) { const int jj = 2 * jp + u, d = 8 * c8 + jj;
                    float offs = 0.f;
#pragma unroll
                    for (int s = 0; s < 3; ++s) if (s < seg) offs += SEG[s * 64 + d];
                    const float cum = LF[t * 65 + d] + offs, mid = LF[31 * 65 + d] + SEG[d];
                    const float q = qv[8 * e + jj], k = kv[8 * e + jj];
                    qt[u] = q * __expf(cum - mid); kt[u] = k * __expf(mid - cum); qs[u] = q * __expf(cum); }
                wq[jp] = pk2(qt[0], qt[1]); wk[jp] = pk2(kt[0], kt[1]); ws[jp] = pk2(qs[0], qs[1]); }
            *(LAS u32x4*)(QT + t * 72 + 8 * c8) = (u32x4){wq[0], wq[1], wq[2], wq[3]};
            *(LAS u32x4*)(KT + t * 72 + 8 * c8) = (u32x4){wk[0], wk[1], wk[2], wk[3]};
            *(LAS u32x4*)(QS + t * 72 + 8 * c8) = (u32x4){ws[0], ws[1], ws[2], ws[3]};
        }
        __syncthreads();
        const int ar = (16 * hw + (lane & 15)) * 72 + 8 * (lane >> 4);
        {
            f32x4 sc[4];
#pragma unroll
            for (int nt = 0; nt < 4; ++nt) sc[nt] = (f32x4){0.f, 0.f, 0.f, 0.f};
#pragma unroll
            for (int ks = 0; ks < 2; ++ks) { const bf16x8 a = *(const LAS bf16x8*)(QT + ar + 32 * ks);
#pragma unroll
                for (int nt = 0; nt < 4; ++nt) { const bf16x8 bb = *(const LAS bf16x8*)(KT + (16 * nt + (lane & 15)) * 72 + 32 * ks + 8 * (lane >> 4)); sc[nt] = MFMA16(a, bb, sc[nt]); } }
#pragma unroll
            for (int nt = 0; nt < 4; ++nt)
#pragma unroll
                for (int j = 0; j < 4; ++j) { const int t = 16 * hw + 4 * (lane >> 4) + j, s = 16 * nt + (lane & 15); P[t * 72 + s] = (bf16)f2bf(s <= t ? sc[nt][j] : 0.f); }
        }
        __syncthreads();
        f32x4 o[4];
#pragma unroll
        for (int nt = 0; nt < 4; ++nt) o[nt] = (f32x4){0.f, 0.f, 0.f, 0.f};
#pragma unroll
        for (int ks = 0; ks < 2; ++ks) { const bf16x8 a = *(const LAS bf16x8*)(P + ar + 32 * ks), a2 = *(const LAS bf16x8*)(QS + ar + 32 * ks);
#pragma unroll
            for (int nt = 0; nt < 4; ++nt) { const int br = (16 * nt + (lane & 15)) * 72 + 32 * ks + 8 * (lane >> 4);
                o[nt] = MFMA16(a, *(const LAS bf16x8*)(vT + br), o[nt]); o[nt] = MFMA16(a2, *(const LAS bf16x8*)(SPt + br), o[nt]); } }
#pragma unroll
        for (int j = 0; j < 4; ++j) { const int t = 16 * hw + 4 * (lane >> 4) + j;
            float ssq = o[0][j] * o[0][j] + o[1][j] * o[1][j] + o[2][j] * o[2][j] + o[3][j] * o[3][j];
            ssq += __shfl_xor(ssq, 1); ssq += __shfl_xor(ssq, 2); ssq += __shfl_xor(ssq, 4); ssq += __shfl_xor(ssq, 8);
            const float rn = rsqrtf(ssq * (1.f / 64.f) + RMS_EPS);
            if (t < nrows) {
#pragma unroll
                for (int nt = 0; nt < 4; ++nt) { const int v = 16 * nt + (lane & 15);
                    const float zg = bf2f(proj[(tok0 + t) * NI + C_HG + h * 64 + v]);
                    mixed[(tok0 + t) * D + 256 + h * 64 + v] = (bf16)f2bf(o[nt][j] * rn * ng[v] * siluf_(zg)); } } }
        __syncthreads();
    }
}

constexpr int AT_K = 0, AT_V = 2 * 9216, AT_KB = 9216, AT_VB = 16384;
typedef short v4i16_t __attribute__((ext_vector_type(4)));
__device__ __forceinline__ s16x4 vtr(const LAS unsigned char* p) { return __builtin_bit_cast(s16x4, __builtin_amdgcn_ds_read_tr16_b64_v4i16((LAS v4i16_t*)p)); }
__device__ __forceinline__ int crow(int r, int hi) { return (r & 3) + 8 * (r >> 2) + 4 * hi; }
__device__ __forceinline__ void attn_unit(const Frame& F, int b, int h, int j, float lam, float oscale, const float* subg) {
    const bf16* proj = (const bf16*)(F.ws + WS_PROJ); bf16* mixed = (bf16*)(F.ws + WS_MIXED);
    const int tid = F.tid, lane = F.lane, w = F.wave, r32 = lane & 31, hi = lane >> 5;
    const int qbase = (j == 0) ? 0 : 16 + 256 * (j - 1), ntile = (j == 0) ? 1 : 4 * j + 1;
    const int qrow = qbase + 32 * w + r32;
    const bf16* pb = proj + (size_t)b * LT * NI + h * 128;
    bf16* ob = mixed + ((size_t)b * LT + qbase + 32 * w) * D + 512 + h * 128;
    const unsigned vo_o = (unsigned)((r32 * D + 4 * hi) * 2);
    const bool rowok = (j > 0) || (32 * w + r32 < 16);
    LAS bf16* Kl = (LAS bf16*)(F.lds + AT_K); LAS unsigned char* Vc = F.lds + AT_V;
    const int kkey = tid >> 3, kc8 = tid & 7;
    const int vst = ((tid & 15) >> 2) * 4096 + (tid >> 4) * 64 + (tid & 3) * 16;
    const int vrd = (4 * hi + ((lane & 15) >> 2)) * 64 + ((lane >> 4) & 1) * 32 + (lane & 3) * 8;
    const unsigned vo_k = (unsigned)((kkey * NI + C_AK + 8 * kc8) * 2);
    const unsigned vo_v0 = (unsigned)(((tid >> 4) * NI + C_AV + 8 * (tid & 15)) * 2), vo_v1 = vo_v0 + (unsigned)(32 * NI * 2);
#pragma unroll 1
    for (int comp = 0; comp < 2; ++comp) {
        bf16x8 qf[4];
        { const unsigned vq = (unsigned)((qrow * NI + C_AQ + comp * 64 + 8 * hi) * 2);
#pragma unroll
          for (int ks = 0; ks < 4; ++ks) qf[ks] = ldg<bf16x8>(pb, vq + 32 * ks); }
        f32x16 O[4];
#pragma unroll
        for (int vb = 0; vb < 4; ++vb)
#pragma unroll
            for (int r = 0; r < 16; ++r) O[vb][r] = 0.f;
        float mrun = -1e30f, lrun = 0.f;
        u32x4 kreg, vreg0, vreg1;
#define AT_ISSUE(i_) do { const int kb_ = ((i_) == 0) ? 0 : 16 + 64 * ((i_) - 1); const bf16* tb_ = pb + (size_t)kb_ * NI; \
            kreg = ldg<u32x4>(tb_ + comp * 64, vo_k); vreg0 = ldg<u32x4>(tb_, vo_v0); vreg1 = ldg<u32x4>(tb_, vo_v1); } while (0)
#define AT_COMMIT(buf_) do { *(LAS u32x4*)(Kl + (buf_) * (AT_KB / 2) + kkey * 72 + 8 * kc8) = kreg; \
            *(LAS u32x4*)(Vc + (buf_) * AT_VB + vst) = vreg0; *(LAS u32x4*)(Vc + (buf_) * AT_VB + vst + 32 * 64) = vreg1; } while (0)
        __syncthreads();
        AT_ISSUE(0); AT_COMMIT(0);
        __syncthreads();
#pragma unroll 1
        for (int i = 0; i < ntile; ++i) {
            const int buf = i & 1, kb = (i == 0) ? 0 : 16 + 64 * (i - 1);
            if (i + 1 < ntile) AT_ISSUE(i + 1);
            const LAS bf16* Kb = Kl + buf * (AT_KB / 2); const LAS unsigned char* Vb = Vc + buf * AT_VB + vrd;
            f32x16 sT[2];
#pragma unroll
            for (int kblk = 0; kblk < 2; ++kblk) {
#pragma unroll
                for (int r = 0; r < 16; ++r) sT[kblk][r] = 0.f;
#pragma unroll
                for (int ks = 0; ks < 4; ++ks) { const bf16x8 kf = *(const LAS bf16x8*)(Kb + (32 * kblk + r32) * 72 + 16 * ks + 8 * hi); sT[kblk] = MFMA32(kf, qf[ks], sT[kblk]); }
            }
            if (i == 0 || i >= ntile - 4) {
#pragma unroll
                for (int kblk = 0; kblk < 2; ++kblk)
#pragma unroll
                    for (int r = 0; r < 16; ++r) { const int kl = 32 * kblk + crow(r, hi); const bool ok = (kb + kl <= qrow) && (i > 0 || kl < 16); if (!ok) sT[kblk][r] = -INFINITY; }
            }
            float mx = sT[0][0];
#pragma unroll
            for (int r = 1; r < 16; ++r) mx = fmaxf(mx, sT[0][r]);
#pragma unroll
            for (int r = 0; r < 16; ++r) mx = fmaxf(mx, sT[1][r]);
            mx = fmaxf(mx, __shfl_xor(mx, 32));
            const float mnew = fmaxf(mrun, mx), alpha = __builtin_amdgcn_exp2f(mrun - mnew);
            float psum = 0.f;
#pragma unroll
            for (int kblk = 0; kblk < 2; ++kblk)
#pragma unroll
                for (int r = 0; r < 16; ++r) { const float pv = __builtin_amdgcn_exp2f(sT[kblk][r] - mnew); sT[kblk][r] = pv; psum += pv; }
            psum += __shfl_xor(psum, 32);
            lrun = lrun * alpha + psum; mrun = mnew;
#pragma unroll
            for (int vb = 0; vb < 4; ++vb)
#pragma unroll
                for (int r = 0; r < 16; ++r) O[vb][r] *= alpha;
#pragma unroll
            for (int kblk = 0; kblk < 2; ++kblk)
#pragma unroll
                for (int s = 0; s < 2; ++s) {
                    u32x4 pw; pw.x = cvt_pk_bf16(sT[kblk][8 * s + 0], sT[kblk][8 * s + 1]); pw.y = cvt_pk_bf16(sT[kblk][8 * s + 2], sT[kblk][8 * s + 3]);
                    pw.z = cvt_pk_bf16(sT[kblk][8 * s + 4], sT[kblk][8 * s + 5]); pw.w = cvt_pk_bf16(sT[kblk][8 * s + 6], sT[kblk][8 * s + 7]);
                    const bf16x8 pf = __builtin_bit_cast(bf16x8, pw);
#pragma unroll
                    for (int vb = 0; vb < 4; ++vb) { const LAS unsigned char* vp = Vb + vb * 4096 + (32 * kblk + 16 * s) * 64;
                        const s16x4 lo = vtr(vp), hh = vtr(vp + 8 * 64);
                        const bf16x8 vf = (bf16x8){lo[0], lo[1], lo[2], lo[3], hh[0], hh[1], hh[2], hh[3]};
                        O[vb] = MFMA32(vf, pf, O[vb]); }
                }
            if (i + 1 < ntile) AT_COMMIT(buf ^ 1);
            __syncthreads();
        }
#undef AT_ISSUE
#undef AT_COMMIT
        const float linv = 1.f / lrun;
        if (comp == 0) {
#pragma unroll
            for (int vb = 0; vb < 4; ++vb)
#pragma unroll
                for (int g4 = 0; g4 < 4; ++g4) {
                    u32x2 wv; wv.x = pk2(O[vb][4 * g4 + 0] * linv, O[vb][4 * g4 + 1] * linv); wv.y = pk2(O[vb][4 * g4 + 2] * linv, O[vb][4 * g4 + 3] * linv);
                    if (rowok) stg<u32x2>(ob, vo_o + (unsigned)((32 * vb + 8 * g4) * 2), wv); }
        } else {
            float ssq = 0.f;
#pragma unroll
            for (int vb = 0; vb < 4; ++vb)
#pragma unroll
                for (int g4 = 0; g4 < 4; ++g4) {
                    u32x2 o0 = (u32x2){0u, 0u}; if (rowok) o0 = ldg<u32x2>(ob, vo_o + (unsigned)((32 * vb + 8 * g4) * 2));
                    const float a0 = bf2f(o0.x) - lam * (O[vb][4 * g4 + 0] * linv), a1 = bf2f(o0.x >> 16) - lam * (O[vb][4 * g4 + 1] * linv);
                    const float a2 = bf2f(o0.y) - lam * (O[vb][4 * g4 + 2] * linv), a3 = bf2f(o0.y >> 16) - lam * (O[vb][4 * g4 + 3] * linv);
                    O[vb][4 * g4 + 0] = a0; O[vb][4 * g4 + 1] = a1; O[vb][4 * g4 + 2] = a2; O[vb][4 * g4 + 3] = a3;
                    ssq += (a0 * a0 + a1 * a1) + (a2 * a2 + a3 * a3); }
            ssq += __shfl_xor(ssq, 32);
            const float rn = rsqrtf(ssq * (1.f / 128.f) + RMS_EPS) * oscale;
            if (rowok) {
#pragma unroll
                for (int vb = 0; vb < 4; ++vb)
#pragma unroll
                    for (int g4 = 0; g4 < 4; ++g4) { const f32x4 sg = ldg<f32x4>(subg, (unsigned)((32 * vb + 8 * g4 + 4 * hi) * 4));
                        u32x2 wv; wv.x = pk2(O[vb][4 * g4 + 0] * rn * sg[0], O[vb][4 * g4 + 1] * rn * sg[1]); wv.y = pk2(O[vb][4 * g4 + 2] * rn * sg[2], O[vb][4 * g4 + 3] * rn * sg[3]);
                        stg<u32x2>(ob, vo_o + (unsigned)((32 * vb + 8 * g4) * 2), wv); }
            }
        }
    }
}
__device__ __forceinline__ void attn_phase(const Frame& F0, int l) {
    Frame F = F0; LAUNDER(F.tid); F.lane = F.tid & 63;
    float s1 = 0.f, s2 = 0.f;
    for (int i = 0; i < 64; ++i) { s1 += F.in[IN_LQ1][l * 64 + i] * F.in[IN_LK1][l * 64 + i]; s2 += F.in[IN_LQ2][l * 64 + i] * F.in[IN_LK2][l * 64 + i]; }
    const float lam_init = 0.8f - 0.6f * expf(-0.3f * (float)l);
    const float lam = expf(s1) - expf(s2) + lam_init, oscale = 1.f - lam_init;
    const float* subg = F.in[IN_SUBLN] + l * 128;
    const int npair = (512 - F.wg + F.G - 1) / F.G, nmeta = (F.wg < NB * 4) ? (NB * 4 - F.wg + F.G - 1) / F.G : 0;
#pragma unroll 1
    for (int k = 0; k < 2 * npair + nmeta; ++k) {
        int bh, j;
        if (k < 2 * npair) { const int p = F.wg + (k >> 1) * F.G; bh = p >> 2; const int s = p & 3; j = (k & 1) ? s + 1 : 8 - s; }
        else { bh = F.wg + (k - 2 * npair) * F.G; j = 0; }
        attn_unit(F, bh >> 2, bh & 3, j, lam, oscale, subg);
    }
}

constexpr int RT_WP = 1032;
__device__ __forceinline__ void router_phase(const Frame& F0, int l) {
    Frame F = F0; LAUNDER(F.tid); F.lane = F.tid & 63;
    const float* H = (const float*)(F.ws + WS_H); const bf16* WR = (const bf16*)(F.ws + WS_WR) + (size_t)l * 2 * 32 * 1024;
    float* rstd = (float*)(F.ws + WS_RSTD); float* gate = (float*)(F.ws + WS_GATE); int* buck = (int*)(F.ws + WS_BUCK);
    unsigned* gcnt = (unsigned*)F.ws + CW_CNT + l * 64;
    LAS bf16* Wh = (LAS bf16*)F.lds;
    LAS bf16* Wl = Wh + 20 * RT_WP;
    LAS float* LG = (LAS float*)(F.lds + 2 * 20 * RT_WP * 2);
    LAS int* lcnt = (LAS int*)(LG + 8 * 16 * 33);
    LAS int* lbase = lcnt + 32;
    LAS int* tcls = lbase + 32;
    LAS int* tpos = tcls + 288;
    const int lane = F.lane, w = F.wave, fr = lane & 15, fq = lane >> 4;
    constexpr int NTASK = T / 16;
    const int ntl = (NTASK - F.wg + F.G - 1) / F.G;
    __syncthreads();
    for (int idx = F.tid; idx < 2 * 20 * 128; idx += 512) { const int hl = idx / (20 * 128), r = (idx / 128) % 20, c = idx % 128;
        *(LAS u32x4*)((hl ? Wl : Wh) + r * RT_WP + 8 * c) = *(const GAS u32x4*)(WR + (size_t)hl * 32 * 1024 + r * 1024 + 8 * c); }
    if (F.tid < 32) lcnt[F.tid] = 0;
    __syncthreads();
    const int n1 = (16 + fr < 20) ? 16 + fr : 19;
    for (int k = w; k < ntl; k += 8) {
        const int task = F.wg + k * F.G;
        const float* hrow = H + (size_t)task * 16 * D;
        const unsigned vo = (unsigned)((fr * D + 8 * fq) * 4);
        f32x4 acc[2]; acc[0] = (f32x4){0.f, 0.f, 0.f, 0.f}; acc[1] = acc[0];
        float ssq = 0.f;
#pragma unroll 8
        for (int ks = 0; ks < 32; ++ks) {
            const f32x4 x0 = ldg<f32x4>(hrow, vo + ks * 128), x1 = ldg<f32x4>(hrow, vo + ks * 128 + 16);
            ssq += (x0[0] * x0[0] + x0[1] * x0[1]) + (x0[2] * x0[2] + x0[3] * x0[3]) + (x1[0] * x1[0] + x1[1] * x1[1]) + (x1[2] * x1[2] + x1[3] * x1[3]);
            unsigned hw_[4], lw_[4];
#pragma unroll
            for (int q = 0; q < 4; ++q) { const float a = (q < 2) ? x0[2 * q] : x1[2 * q - 4], bq = (q < 2) ? x0[2 * q + 1] : x1[2 * q - 3];
                const unsigned ha = f2bf(a), hb = f2bf(bq); hw_[q] = ha | (hb << 16); lw_[q] = pk2(a - bf2f(ha), bq - bf2f(hb)); }
            const bf16x8 ahi = __builtin_bit_cast(bf16x8, (u32x4){hw_[0], hw_[1], hw_[2], hw_[3]}), alo = __builtin_bit_cast(bf16x8, (u32x4){lw_[0], lw_[1], lw_[2], lw_[3]});
            const bf16x8 bh0 = *(const LAS bf16x8*)(Wh + fr * RT_WP + 32 * ks + 8 * fq), bl0 = *(const LAS bf16x8*)(Wl + fr * RT_WP + 32 * ks + 8 * fq);
            const bf16x8 bh1 = *(const LAS bf16x8*)(Wh + n1 * RT_WP + 32 * ks + 8 * fq), bl1 = *(const LAS bf16x8*)(Wl + n1 * RT_WP + 32 * ks + 8 * fq);
            acc[0] = MFMA16(ahi, bh0, acc[0]); acc[0] = MFMA16(alo, bh0, acc[0]); acc[0] = MFMA16(ahi, bl0, acc[0]);
            acc[1] = MFMA16(ahi, bh1, acc[1]); acc[1] = MFMA16(alo, bh1, acc[1]); acc[1] = MFMA16(ahi, bl1, acc[1]);
        }
        ssq += __shfl_xor(ssq, 16); ssq += __shfl_xor(ssq, 32);
        const float rs = rsqrtf(ssq * (1.f / 1024.f) + RMS_EPS);
#pragma unroll
        for (int nt = 0; nt < 2; ++nt)
#pragma unroll
            for (int j = 0; j < 4; ++j) LG[w * 16 * 33 + (4 * fq + j) * 33 + 16 * nt + fr] = acc[nt][j];
        LDS_WAIT(); asm volatile("" ::: "memory");
        if (lane < 16) {
            const int tl = k * 16 + lane; const size_t m = (size_t)task * 16 + lane;
            const float rsm = rs;
            const LAS float* lg = LG + w * 16 * 33 + lane * 33;
            float gl[4]; float gm = -1e30f; int gi = 0;
#pragma unroll
            for (int q = 0; q < 4; ++q) { gl[q] = lg[q] * rsm + F.in[IN_BGRP][l * 4 + q]; if (gl[q] > gm) { gm = gl[q]; gi = q; } }
            float gs = 0.f;
#pragma unroll
            for (int q = 0; q < 4; ++q) gs += __expf(gl[q] - gm);
            const float gp = 1.f / gs;
            float el[4];
#pragma unroll
            for (int q = 0; q < 4; ++q) el[q] = lg[4 + 4 * gi + q] * rsm + F.in[IN_BEXP][l * 16 + 4 * gi + q];
            int i1 = 0; float v1 = el[0];
#pragma unroll
            for (int q = 1; q < 4; ++q) if (el[q] > v1) { v1 = el[q]; i1 = q; }
            int i2 = -1; float v2 = -1e30f;
#pragma unroll
            for (int q = 0; q < 4; ++q) if (q != i1 && el[q] > v2) { v2 = el[q]; i2 = q; }
            const float e2 = __expf(v2 - v1), w1 = gp / (1.f + e2), w2 = gp * e2 / (1.f + e2);
            const int a = i1 < i2 ? i1 : i2, bq = i1 < i2 ? i2 : i1;
            const int pidx = (a == 0) ? (bq - 1) : (a == 1 ? bq + 1 : 5);
            const int cls = gi * 6 + pidx;
            rstd[m] = rsm; gate[2 * m] = (a == i1) ? w1 : w2; gate[2 * m + 1] = (a == i1) ? w2 : w1;
            tcls[tl] = cls; tpos[tl] = atomicAdd((int*)&lcnt[cls], 1);
        }
    }
    __syncthreads();
    if (F.tid < NCLS) lbase[F.tid] = (int)atomicAdd(&gcnt[F.tid], (unsigned)lcnt[F.tid]);
    __syncthreads();
    if (F.tid < ntl * 16) { const int cls = tcls[F.tid]; buck[(size_t)cls * T + lbase[cls] + tpos[F.tid]] = (F.wg + (F.tid >> 4) * F.G) * 16 + (F.tid & 15); }
    __syncthreads();
}

__device__ __forceinline__ void final_phase(const Frame& F0, float* out) {
    Frame F = F0; LAUNDER(F.tid); F.lane = F.tid & 63;
    const float* H = (const float*)(F.ws + WS_H); const float* g = F.in[IN_FNG];
    const int gw = F.wg * 8 + F.wave, NGW = F.G * 8, lane = F.lane;
    for (int r = gw; r < NB * SEQ; r += NGW) {
        const int b = r / SEQ, t = r % SEQ; const size_t m = (size_t)b * LT + NMETA + t;
        const GAS f32x4* hr = (const GAS f32x4*)(H + m * D) + lane; GAS f32x4* orow = (GAS f32x4*)(out + (size_t)r * D) + lane;
        f32x4 v[4]; float s = 0.f;
#pragma unroll
        for (int j = 0; j < 4; ++j) { v[j] = hr[64 * j]; s += (v[j].x * v[j].x + v[j].y * v[j].y) + (v[j].z * v[j].z + v[j].w * v[j].w); }
        const float rs = rsqrtf(wave_sum(s) * (1.f / 1024.f) + RMS_EPS);
#pragma unroll
        for (int j = 0; j < 4; ++j) { const f32x4 gg = *((const GAS f32x4*)g + lane + 64 * j); orow[64 * j] = v[j] * rs * gg; }
    }
}

template <int NPN>
__device__ __forceinline__ int moe_prepare(const Frame& F0, int l, LAS int* cntl, LAS int* tab) {
    Frame F = F0; LAUNDER(F.tid); F.lane = F.tid & 63;
    const unsigned* gcnt = (const unsigned*)F.ws + CW_CNT + l * 64; const int* buck = (const int*)(F.ws + WS_BUCK);
    __syncthreads();
    if (F.tid < NCLS) cntl[F.tid] = (int)gcnt[F.tid];
    __syncthreads();
    MoeList ml{cntl}; const int ntl = ml.ntiles();
    for (int i = 0;; ++i) { const int Lx = i * F.G + F.wg; if (Lx >= ntl * NPN) break;
        int c, ti, nv; ml.decode(Lx / NPN, c, ti, nv);
        if (F.tid < 256) tab[i * 256 + F.tid] = (F.tid < nv) ? buck[(size_t)c * T + ti * 256 + F.tid] : -1; }
    __syncthreads();
    return ntl;
}

__global__ void __launch_bounds__(512, 2) hymba_fwd(Args args) {
    extern __shared__ __attribute__((aligned(16))) unsigned char lds_raw[];
    Frame F;
    F.lds = (LAS unsigned char*)lds_raw;
    F.tid = threadIdx.x; F.lane = F.tid & 63; F.wave = __builtin_amdgcn_readfirstlane(F.tid >> 6);
    F.G = gridDim.x; F.wg = blockIdx.x; F.in = args.in; F.ws = args.ws; F.os = (unsigned char*)args.out;
    volatile LAS unsigned* MISC = (volatile LAS unsigned*)(F.lds + MISC_OFF);
    if (F.tid < 256) MISC[F.tid] = 0u;
    __syncthreads();
    const int lo = args.ph_lo, hi = args.ph_hi;
    const bool one = (hi - lo) > 1;
    XcdBarrier bar; bar.bar = (unsigned*)F.ws + CW_BAR; bar.x = 0; bar.st = nullptr;
    if (one) bar = xcd_barrier_post((unsigned*)F.ws + CW_BAR, MISC + 8);
#ifndef ONLY_MASK
#define ONLY_MASK 0xFFFFFFFFu
#endif
#define IN(k) (lo <= (k) && (k) < hi)
#define EN(j) ((ONLY_MASK >> (j)) & 1u)
#ifndef SUBMASK
#define SUBMASK 3u
#endif
#define SEAM(k) do { if (IN(k) && IN((k) + 1)) xcd_barrier(bar); } while (0)
    bf16* proj = (bf16*)(F.ws + WS_PROJ); bf16* mixed = (bf16*)(F.ws + WS_MIXED); float* H = (float*)(F.ws + WS_H); bf16* HB = (bf16*)(F.ws + WS_HB);
    float* ss16 = (float*)(F.ws + WS_SS16);
    LAS int* tab = (LAS int*)(F.lds + TAB_OFF); LAS int* cntl = (LAS int*)(F.lds + TAB_OFF + 12 * 1024);

    if (EN(0) && IN(0)) { for (int rep = 0; rep < NREP(0); ++rep) p0_prologue(F); } SEAM(0);
#pragma unroll 1
    for (int l = 0; l < 2; ++l) {
        const int pb = 1 + 9 * l;
        if (EN(1) && IN(pb + 0)) {
            PolIn P; P.ord.init(MT, NI / 256, F.G, F.wg); P.A = HB; P.B = (const bf16*)(F.ws + WS_WIN) + (size_t)l * NI * D; P.proj = proj; P.ss16 = ss16; P.rope = (const float*)(F.ws + WS_ROPE);
            for (int rep = 0; rep < NREP(1); ++rep) pg8::gemm_phase(F.lds, P); }
        SEAM(pb + 0);
        if (EN(2) && IN(pb + 1)) {
            PolS5E P; P.G = F.G; P.c = F.wg; P.proj = proj; P.B = (const bf16*)(F.ws + WS_S5P) + (size_t)l * 16 * 256 * 256; P.E = (float*)(F.os + OS_E);
            for (int rep = 0; rep < NREP(2); ++rep) if (MIXSEL & 1u) pg8::gemm_phase(F.lds, P);
            __syncthreads();
            for (int rep = 0; rep < NREP(11); ++rep) if (MIXSEL & 2u) hgrn_a(F, l); }
        SEAM(pb + 1);
        if (EN(3) && IN(pb + 2)) { for (int rep = 0; rep < NREP(3); ++rep) { if (MIXSEL & 1u) s5_scan(F, l); if (MIXSEL & 2u) hgrn_b(F); } }
        SEAM(pb + 2);
        if (EN(4) && IN(pb + 3)) {
            PolS5Y P; P.G = F.G; P.c = F.wg; P.X = (const bf16*)(F.os + OS_X); P.B = (const bf16*)(F.ws + WS_S5TQ) + (size_t)l * 16 * 256 * 384; P.proj = proj; P.dsk = F.in[IN_S5D] + l * 256; P.Gout = (bf16*)(F.os + OS_G);
            for (int rep = 0; rep < NREP(4); ++rep) if ((SUBMASK & MIXSEL & 1u) != 0u) pg8::gemm_phase(F.lds, P);
            __syncthreads();
            for (int rep = 0; rep < NREP(12); ++rep) if ((SUBMASK & MIXSEL & 2u) != 0u) hgrn_c(F, l); }
        SEAM(pb + 3);
        if (EN(5) && IN(pb + 4)) {
            PolGlu P; P.ord.init(MT, 2, F.G, F.wg); P.A = (const bf16*)(F.os + OS_G); P.B = (const bf16*)(F.ws + WS_WGLU) + (size_t)l * 512 * 256; P.mixed = mixed;
            for (int rep = 0; rep < NREP(5); ++rep) if ((SUBMASK & MIXSEL & 1u) != 0u) pg8::gemm_phase(F.lds, P);
            __syncthreads();
            for (int rep = 0; rep < NREP(13); ++rep) if ((SUBMASK & 2u) != 0u && (MIXSEL & 4u) != 0u) attn_phase(F, l); }
        SEAM(pb + 4);
        if (EN(6) && IN(pb + 5)) {
            PolOut P; P.ord.init(MT, 4, F.G, F.wg); P.A = mixed; P.B = (const bf16*)(F.ws + WS_WOUT) + (size_t)l * D * D; P.H = H; P.HB = HB; P.ss16 = ss16;
            pg8::gemm_phase(F.lds, P); }
        SEAM(pb + 5);
        if (EN(7) && IN(pb + 6)) { router_phase(F, l); }
        SEAM(pb + 6);
        if (EN(8) && IN(pb + 7)) {
            PolGU P; P.G = F.G; P.c = F.wg; P.ntl = moe_prepare<8>(F, l, cntl, tab); P.ml = MoeList{cntl}; P.tab = tab;
            P.HB = HB; P.W = (const bf16*)(F.ws + WS_WGU) + (size_t)l * 16 * 1024 * 1024; P.he = proj; P.rstd = (const float*)(F.ws + WS_RSTD); P.gate = (const float*)(F.ws + WS_GATE);
            for (int rep = 0; rep < NREP(8); ++rep) pg8::gemm_phase(F.lds, P); }
        SEAM(pb + 7);
        if (EN(9) && IN(pb + 8)) {
            PolDN P; P.G = F.G; P.c = F.wg; P.ntl = moe_prepare<4>(F, l, cntl, tab); P.ml = MoeList{cntl}; P.tab = tab;
            P.he = proj; P.W = (const bf16*)(F.ws + WS_WDN) + (size_t)l * 16 * 1024 * 512; P.H = H; P.HB = HB; P.ss16 = ss16;
            pg8::gemm_phase(F.lds, P); }
        SEAM(pb + 8);
    }
    if (EN(10) && IN(19)) for (int rep = 0; rep < NREP(10); ++rep) final_phase(F, args.out);
#undef IN
#undef SEAM
}

extern "C" void kernel_launch(void* const* d_in, const int* in_sizes, int n_in, void* d_out, int out_size, void* d_ws, size_t ws_size, hipStream_t stream) {
    static int grid = 0;
    if (grid == 0) {
        if (n_in != 30 || ws_size < WS_END) { fprintf(stderr, "kernel_launch: unexpected inputs (n_in %d, ws %zu < %zu)\n", n_in, ws_size, (size_t)WS_END); grid = -1; return; }
        int dev = 0, cus = 0, per_cu = 0;
        (void)hipGetDevice(&dev); (void)hipDeviceGetAttribute(&cus, hipDeviceAttributeMultiprocessorCount, dev);
        (void)hipFuncSetAttribute((const void*)hymba_fwd, hipFuncAttributeMaxDynamicSharedMemorySize, LDS_BYTES);
        (void)hipOccupancyMaxActiveBlocksPerMultiprocessor(&per_cu, (const void*)hymba_fwd, 512, LDS_BYTES);
        (void)hipGetLastError();
        grid = cus > 0 ? cus : 256;
    }
    if (grid < 0) return;
    (void)hipMemsetAsync(d_ws, 0, CTL_BYTES, stream);
    Args a{};
    for (int i = 0; i < 30; ++i) a.in[i] = (const float*)d_in[i];
    a.out = (float*)d_out; a.ws = (unsigned char*)d_ws;
#if N_LAUNCH_MODE == 1
    a.ph_lo = 0; a.ph_hi = LAST_PHASE;
    hipLaunchKernelGGL(hymba_fwd, dim3(grid), dim3(512), LDS_BYTES, stream, a);
#else
    if (MIXSEL != 7u) (void)hipMemsetAsync((char*)d_ws + WS_MIXED, 0, (size_t)T * D * 2, stream);
    for (int p = 0; p < LAST_PHASE; ++p) { if (!((RUN_MASK >> p) & 1u)) continue; a.ph_lo = p; a.ph_hi = p + 1; hipLaunchKernelGGL(hymba_fwd, dim3(grid), dim3(512), LDS_BYTES, stream, a); }
#endif
}
```

```cpp
#include <hip/hip_runtime.h>
#include <stdint.h>
#include <stdio.h>

#ifndef N_LAUNCH_MODE
#define N_LAUNCH_MODE 1
#endif
#ifndef LAST_PHASE
#define LAST_PHASE 20
#endif
#ifndef RUN_MASK
#define RUN_MASK 0xFFFFFu
#endif
#ifndef REPMASK
#define REPMASK 0u
#endif
#define NREP(j) (((REPMASK >> (j)) & 1u) ? 2 : 1)
#ifndef MIXSEL
#define MIXSEL 7u
#endif

#define GAS __attribute__((address_space(1)))
#define LAS __attribute__((address_space(3)))
typedef unsigned short bf16;
typedef short bf16x8 __attribute__((ext_vector_type(8)));
typedef short s16x4 __attribute__((ext_vector_type(4)));
typedef float f32x2 __attribute__((ext_vector_type(2)));
typedef float f32x4 __attribute__((ext_vector_type(4)));
typedef float f32x16 __attribute__((ext_vector_type(16)));
typedef unsigned u32x2 __attribute__((ext_vector_type(2)));
typedef unsigned u32x4 __attribute__((ext_vector_type(4)));

constexpr int NB = 32, LT = 2064, NMETA = 16, SEQ = 2048, T = NB * LT;
constexpr int D = 1024, NI = 2816, MT = T / 256;
constexpr int C_U = 0, C_HQ = 256, C_HF = 512, C_HI = 768, C_HG = 1024, C_AQ = 1280, C_AK = 1792, C_AV = 2304;
constexpr int NCH = 129;
constexpr int S5R = NB * NCH;
constexpr int S5RP = 17 * 256;
constexpr int HCH = 33;
constexpr int NCLS = 24;
constexpr float RMS_EPS = 1e-6f;
constexpr float QSCALE = 0.125f * 1.4426950408889634f;

constexpr size_t al256(size_t x) { return (x + 255) & ~(size_t)255; }
constexpr size_t CTL_BYTES = 1u << 20;
constexpr size_t WS_WIN = CTL_BYTES;
constexpr size_t WS_WOUT = WS_WIN + al256((size_t)2 * NI * D * 2);
constexpr size_t WS_WGLU = WS_WOUT + al256((size_t)2 * D * D * 2);
constexpr size_t WS_WGU = WS_WGLU + al256((size_t)2 * 512 * 256 * 2);
constexpr size_t WS_WDN = WS_WGU + al256((size_t)2 * 16 * 1024 * 1024 * 2);
constexpr size_t WS_WR = WS_WDN + al256((size_t)2 * 16 * 1024 * 512 * 2);
constexpr size_t WS_S5TQ = WS_WR + al256((size_t)2 * 2 * 32 * 1024 * 2);
constexpr size_t WS_S5P = WS_S5TQ + al256((size_t)2 * 16 * 256 * 384 * 2);
constexpr size_t WS_S5A = WS_S5P + al256((size_t)2 * 16 * 256 * 256 * 2);
constexpr size_t WS_ROPE = WS_S5A + al256((size_t)2 * 16 * 64 * 8);
constexpr size_t WS_SS16 = WS_ROPE + al256((size_t)LT * 32 * 4 * 2);
constexpr size_t WS_RSTD = WS_SS16 + al256((size_t)T * 16 * 4);
constexpr size_t WS_GATE = WS_RSTD + al256((size_t)T * 4);
constexpr size_t WS_BUCK = WS_GATE + al256((size_t)T * 8);
constexpr size_t WS_H = WS_BUCK + al256((size_t)NCLS * T * 4);
constexpr size_t WS_HB = WS_H + al256((size_t)T * D * 4);
constexpr size_t WS_PROJ = WS_HB + al256((size_t)T * D * 2);
constexpr size_t WS_MIXED = WS_PROJ + al256((size_t)T * NI * 2);
constexpr size_t WS_END = WS_MIXED + al256((size_t)T * D * 2);
constexpr size_t OS_E = 0;
constexpr size_t OS_X = OS_E + al256((size_t)16 * S5RP * 128 * 4);
constexpr size_t OS_G = OS_X + al256((size_t)16 * S5RP * 384 * 2);
constexpr size_t OS_UT = OS_G + al256((size_t)T * 256 * 2);
constexpr size_t OS_DEC = OS_UT + al256((size_t)NB * 4 * HCH * 4096 * 4);
constexpr size_t OS_SP = OS_DEC + al256((size_t)NB * 4 * HCH * 64 * 4);
constexpr size_t OS_END = OS_SP + al256((size_t)NB * 4 * HCH * 4096 * 2);
static_assert(OS_END <= (size_t)NB * SEQ * D * 4, "mixer scratch must fit in d_out");
static_assert((size_t)(MT + NCLS) * 256 * 1024 * 2 <= (size_t)T * NI * 2, "he overlay fits in proj");

constexpr int CW_BAR = 4096, CW_CNT = 16384;

constexpr int LDS_BYTES = 147456;
constexpr int RING_BYTES = 131072;
constexpr int TAB_OFF = RING_BYTES;
constexpr int MISC_OFF = LDS_BYTES - 1024;

__device__ __forceinline__ unsigned f2bf(float f) { unsigned u = __builtin_bit_cast(unsigned, f); return (u + 0x7fffu + ((u >> 16) & 1u)) >> 16; }
__device__ __forceinline__ float bf2f(unsigned b) { return __builtin_bit_cast(float, (b & 0xffffu) << 16); }
__device__ __forceinline__ unsigned pk2(float lo, float hi) { return f2bf(lo) | (f2bf(hi) << 16); }
__device__ __forceinline__ unsigned cvt_pk_bf16(float lo, float hi) { unsigned r; asm volatile("v_cvt_pk_bf16_f32 %0, %1, %2" : "=v"(r) : "v"(lo), "v"(hi)); return r; }
__device__ __forceinline__ float wave_sum(float v) {
#pragma unroll
    for (int o = 1; o < 64; o <<= 1) v += __shfl_xor(v, o);
    return v;
}
__device__ __forceinline__ float sigmoidf_(float x) { return 1.f / (1.f + __expf(-x)); }
__device__ __forceinline__ float siluf_(float x) { return x / (1.f + __expf(-x)); }
__device__ __forceinline__ float gelu_tanh(float x) { const float u = 0.7978845608028654f * (x + 0.044715f * x * x * x); return x / (1.f + __expf(-2.f * u)); }
__device__ __forceinline__ int lane_id_() { int l; asm volatile("v_mbcnt_lo_u32_b32 %0, -1, 0\n\tv_mbcnt_hi_u32_b32 %0, -1, %0" : "=v"(l)); return l; }
#define LAUNDER(x) asm volatile("" : "+v"(x))
#define LAUNDER_S(x) asm volatile("" : "+s"(x))
#define LDS_WAIT() asm volatile("s_waitcnt lgkmcnt(0)" ::: "memory")
#define VM_WAIT() asm volatile("s_waitcnt vmcnt(0)" ::: "memory")

#define XB_TMO      128
#define XB_XCNT(j)  (256  + 64 * (j))
#define XB_XSUB(j)  (1280 + 64 * (j))
#define XB_XGEN(j)  (2304 + 64 * (j))
#define XB_TOP      3328
#define XB_TOPGEN   3392
#define XCD_BAR_WORDS 3456
#define XB_SPIN_CAP (1u << 18)
__device__ __forceinline__ unsigned xb_ld(unsigned* p)              { return __hip_atomic_load(p, __ATOMIC_RELAXED, __HIP_MEMORY_SCOPE_AGENT); }
__device__ __forceinline__ unsigned xb_add(unsigned* p, unsigned v) { return __hip_atomic_fetch_add(p, v, __ATOMIC_RELAXED, __HIP_MEMORY_SCOPE_AGENT); }
__device__ __forceinline__ unsigned xb_xcc_id() { return (unsigned)__builtin_amdgcn_s_getreg((3 << 11) | 20) & 0xFu; }
#define XB_SPIN(cond, bar) do { unsigned _sp = 0; while (cond) { __builtin_amdgcn_s_sleep(1); \
    if ((++_sp & 255u) == 0u) { if (xb_ld(&(bar)[XB_TMO])) break; if (_sp > XB_SPIN_CAP) { atomicAdd(&(bar)[XB_TMO], 1u); break; } } } } while (0)
struct XcdBarrier { unsigned* bar; unsigned x; volatile LAS unsigned* st; int wave; };
__device__ __forceinline__ XcdBarrier xcd_barrier_post(unsigned* bar, volatile LAS unsigned* st, int wave) {
    XcdBarrier b; b.bar = bar; b.x = xb_xcc_id(); b.st = st; b.wave = wave;
    if (wave == 0 && lane_id_() == 0) (void)xb_add(&bar[XB_XCNT(b.x)], 1u);
    return b;
}
__device__ __forceinline__ void xcd_barrier_complete(unsigned* bar, unsigned x, unsigned& nloc, unsigned& nx) {
    const unsigned G = gridDim.x * gridDim.y * gridDim.z;
    unsigned sum, cnt, mine, sp = 0u;
    for (;;) {
        sum = 0u; cnt = 0u; mine = 0u;
#pragma unroll 1
        for (unsigned j = 0; j < 16; ++j) { const unsigned c = xb_ld(&bar[XB_XCNT(j)]); sum += c; cnt += (c > 0u) ? 1u : 0u; mine = (j == x) ? c : mine; }
        if (sum == G) break;
        __builtin_amdgcn_s_sleep(1);
        if ((++sp & 255u) == 0u) { if (xb_ld(&bar[XB_TMO])) break; if (sp > XB_SPIN_CAP) { atomicAdd(&bar[XB_TMO], 1u); break; } }
    }
    nloc = mine > 0u ? mine : 1u; nx = cnt > 0u ? cnt : 1u;
}
__device__ __forceinline__ void xcd_barrier(const XcdBarrier& b) {
    asm volatile("s_waitcnt vmcnt(0)" ::: "memory");
    __syncthreads();
    if (b.wave == 0 && lane_id_() == 0) {
        unsigned* bar = b.bar;
        __builtin_amdgcn_s_waitcnt(0);
        unsigned nloc = b.st[0], nx = b.st[1];
        if (nloc == 0u) { xcd_barrier_complete(bar, b.x, nloc, nx); b.st[0] = nloc; b.st[1] = nx; }
        const unsigned old = xb_add(&bar[XB_XSUB(b.x)], 1u);
        const unsigned gen = old / nloc;
        if (old + 1u == (gen + 1u) * nloc) {
            __builtin_amdgcn_fence(__ATOMIC_RELEASE, "agent");
            asm volatile("s_waitcnt vmcnt(0)" ::: "memory");
            const unsigned og = xb_add(&bar[XB_TOP], 1u);
            const unsigned tg = og / nx;
            if (og + 1u == (tg + 1u) * nx) xb_add(&bar[XB_TOPGEN], 1u);
            else XB_SPIN(xb_ld(&bar[XB_TOPGEN]) == tg, bar);
            __builtin_amdgcn_fence(__ATOMIC_ACQUIRE, "agent");
            xb_add(&bar[XB_XGEN(b.x)], 1u);
            asm volatile("s_waitcnt vmcnt(0)" ::: "memory");
        } else {
            XB_SPIN(xb_ld(&bar[XB_XGEN(b.x)]) == gen, bar);
            __builtin_amdgcn_fence(__ATOMIC_ACQUIRE, "agent");
            asm volatile("s_waitcnt vmcnt(0)" ::: "memory");
        }
    }
    __syncthreads();
}

namespace pg8 {
constexpr int BM = 256, BK = 64, HALF = 128, HTB = HALF * BK * 2, NXCD = 8, WGM = 8;
__host__ __device__ __forceinline__ int lds_byte(int r, int c) { const int st = (r >> 4) * 2 + (c >> 5), rr = r & 15, cc = c & 31, ob = rr * 64 + cc * 2; return st * 1024 + (ob ^ (((ob >> 9) & 1) << 5)); }
__host__ __device__ __forceinline__ void stage_rc(int b, int& R, int& C) { const int st = b / 1024, sb = b % 1024, swz = sb ^ (((sb >> 9) & 1) << 5); R = (st >> 1) * 16 + swz / 64; C = (st & 1) * 32 + (swz % 64) / 2; }
__host__ __device__ __forceinline__ int perm32(int rho) { const int n = rho >> 4, i = rho & 15; return 8 * (i >> 2) + 4 * n + (i & 3); }

struct TileOrder {
    int nM, nN, nwg, G, c;
    __device__ __forceinline__ void init(int nM_, int nN_, int G_, int c_) { nM = nM_; nN = nN_; nwg = nM * nN; G = G_; c = c_; }
    __device__ __forceinline__ bool get(int i, int& pm, int& pn) const {
        const long Lx = (long)i * G + c; if (Lx >= nwg) return false;
        int wgid = (int)Lx; { const int q = nwg / NXCD, r = nwg % NXCD, xcd = wgid % NXCD, off = wgid / NXCD; wgid = (xcd < r ? xcd * (q + 1) : r * (q + 1) + (xcd - r) * q) + off; }
        const int nig = WGM * nN, gid = wgid / nig, fm = gid * WGM, gsz = (nM - fm) < WGM ? (nM - fm) : WGM;
        pm = fm + ((wgid % nig) % gsz); pn = (wgid % nig) / gsz; return true;
    }
};

template <class P>
__device__ __forceinline__ void gemm_phase(LAS unsigned char* lds, const P& S, int wave) {
    typedef typename P::Unit Unit;
    int tid_ = wave * 64 + lane_id_(); LAUNDER(tid_);
    const int tid = tid_, wid = wave, lane = tid & 63, wr = wid >> 2, wc = wid & 3, fr = lane & 15, fq = lane >> 4;
    constexpr int nt = P::NT; constexpr int LDB = P::LDB;
    int Rs[2], Cs[2]; unsigned voffB[2];
#pragma unroll
    for (int i = 0; i < 2; ++i) { int R, C; stage_rc(tid * 16 + i * 8192, R, C); Rs[i] = R; Cs[i] = C; const int Rb = (R & ~31) + perm32(R & 31); voffB[i] = (unsigned)(Rb * LDB + C) * 2u; }
    const size_t hstepB = (size_t)HALF * LDB * 2;
    const unsigned ldsw = (unsigned)wid * 1024u;
    const int aoff = lds_byte(wr * 64 + fr, fq * 8), boff = lds_byte(wc * 32 + fr, fq * 8);
#define PG8_SA(b, h) (((b) * 2 + (h)) * HTB)
#define PG8_SB(b, h) ((4 + (b) * 2 + (h)) * HTB)
#define PG8_STAGE1(bufoff, gptr, v0, v1) do { \
        __builtin_amdgcn_global_load_lds((const unsigned*)((const char*)(gptr) + (v0)), (LAS unsigned*)(lds + (bufoff) + ldsw), 16, 0, 0); \
        __builtin_amdgcn_global_load_lds((const unsigned*)((const char*)(gptr) + (v1)), (LAS unsigned*)(lds + (bufoff) + ldsw + 8192), 16, 0, 0); } while (0)
#define PG8_STAGEB(bufoff, gptr) PG8_STAGE1(bufoff, gptr, voffB[0], voffB[1])
#define PG8_LDA(dst, b, h) do { _Pragma("unroll") for (int m = 0; m < 4; ++m) _Pragma("unroll") for (int k = 0; k < 2; ++k) dst[m][k] = *(const LAS bf16x8*)(lds + PG8_SA(b, h) + aoff + m * 2048 + k * 1024); } while (0)
#define PG8_LDB(dst, b, h) do { _Pragma("unroll") for (int n = 0; n < 2; ++n) _Pragma("unroll") for (int k = 0; k < 2; ++k) dst[n][k] = *(const LAS bf16x8*)(lds + PG8_SB(b, h) + boff + n * 2048 + k * 1024); } while (0)
#define PG8_MMA(ai, bj, At, Bt) do { __builtin_amdgcn_s_setprio(1); _Pragma("unroll") for (int m = 0; m < 4; ++m) _Pragma("unroll") for (int n = 0; n < 2; ++n) _Pragma("unroll") for (int k = 0; k < 2; ++k) \
        acc[ai][bj][m][n] = __builtin_amdgcn_mfma_f32_16x16x32_bf16(Bt[n][k], At[m][k], acc[ai][bj][m][n], 0, 0, 0); __builtin_amdgcn_s_setprio(0); } while (0)
#define PG8_WAIT_V(n) asm volatile("s_waitcnt vmcnt(" #n ")" ::: "memory")
#define PG8_WAIT_L(n) asm volatile("s_waitcnt lgkmcnt(" #n ")" ::: "memory")
#define PG8_BAR __builtin_amdgcn_s_barrier()
#define PG8_SCHED __builtin_amdgcn_sched_barrier(0)
    Unit cur, nxt; int ui = 0;
    if (!S.next(0, cur)) return;
    f32x4 acc[2][2][4][2];
#pragma unroll
    for (int a = 0; a < 2; ++a)
#pragma unroll
        for (int b = 0; b < 2; ++b)
#pragma unroll
            for (int m = 0; m < 4; ++m)
#pragma unroll
                for (int n = 0; n < 2; ++n) acc[a][b][m][n] = (f32x4){0.f, 0.f, 0.f, 0.f};
    bf16x8 At[4][2], B0[2][2], B1[2][2];
#define PG8_STAGEA(bufoff, uidx, uu, tt, hh) S.stage_a(lds + (bufoff) + ldsw, uidx, uu, tt, hh, Rs, Cs)
    {
        const char* pB0 = S.b_ptr(cur, 0); const char* pB1 = S.b_ptr(cur, 1);
        PG8_STAGEB(PG8_SB(0, 0), pB0); PG8_STAGEB(PG8_SB(0, 1), pB0 + hstepB); PG8_STAGEA(PG8_SA(0, 0), 0, cur, 0, 0); PG8_STAGEA(PG8_SA(0, 1), 0, cur, 0, 1);
        if (wr == 1) PG8_BAR;
        PG8_WAIT_V(2); PG8_BAR;
        PG8_STAGEB(PG8_SB(1, 0), pB1); PG8_STAGEA(PG8_SA(1, 0), 0, cur, 1, 0); PG8_STAGEB(PG8_SB(1, 1), pB1 + hstepB);
        PG8_WAIT_V(6); PG8_BAR;
    }
    for (;;) {
        const bool has_next = S.next(ui + 1, nxt);
        if (!has_next) nxt = cur;
        const int uin = has_next ? ui + 1 : ui;
#pragma unroll 1
        for (int t = 0; t < nt; t += 2) {
            const bool last = (t == nt - 2);
            const Unit& u2 = last ? nxt : cur; const int ui2 = last ? uin : ui; const int t2 = last ? 0 : t + 2;
            const char* b2 = S.b_ptr(u2, t2); const char* b3 = S.b_ptr(u2, t2 + 1);
            PG8_LDB(B0, 0, 0); PG8_LDB(B1, 0, 1); PG8_SCHED; PG8_LDA(At, 0, 0); PG8_STAGEA(PG8_SA(1, 1), ui, cur, t + 1, 1);
            PG8_WAIT_V(8); PG8_WAIT_L(0); PG8_BAR; PG8_MMA(0, 0, At, B0); PG8_MMA(0, 1, At, B1); PG8_BAR; PG8_SCHED;
            PG8_LDA(At, 0, 1); PG8_STAGEB(PG8_SB(0, 0), b2); PG8_STAGEB(PG8_SB(0, 1), b2 + hstepB); PG8_STAGEA(PG8_SA(0, 0), ui2, u2, t2, 0);
            PG8_WAIT_V(8); PG8_WAIT_L(0); PG8_BAR; PG8_MMA(1, 0, At, B0); PG8_MMA(1, 1, At, B1); PG8_BAR; PG8_SCHED;
            PG8_LDB(B0, 1, 0); PG8_LDB(B1, 1, 1); PG8_SCHED; PG8_LDA(At, 1, 0); PG8_STAGEA(PG8_SA(0, 1), ui2, u2, t2, 1);
            PG8_WAIT_V(8); PG8_WAIT_L(0); PG8_BAR; PG8_MMA(0, 0, At, B0); PG8_MMA(0, 1, At, B1); PG8_BAR; PG8_SCHED;
            PG8_LDA(At, 1, 1); PG8_STAGEB(PG8_SB(1, 0), b3); PG8_STAGEB(PG8_SB(1, 1), b3 + hstepB); PG8_STAGEA(PG8_SA(1, 0), ui2, u2, t2 + 1, 0);
            PG8_WAIT_V(8); PG8_WAIT_L(0); PG8_BAR; PG8_MMA(1, 0, At, B0); PG8_MMA(1, 1, At, B1); PG8_BAR; PG8_SCHED;
        }
        if (wr == 0) PG8_BAR;
        S.epi(acc, cur, wr, wc, fr, fq, ui);
        PG8_SCHED;
        if (!has_next) break;
#pragma unroll
        for (int a = 0; a < 2; ++a)
#pragma unroll
            for (int b = 0; b < 2; ++b)
#pragma unroll
                for (int m = 0; m < 4; ++m)
#pragma unroll
                    for (int n = 0; n < 2; ++n) acc[a][b][m][n] = (f32x4){0.f, 0.f, 0.f, 0.f};
        cur = nxt; ++ui;
        if (wr == 1) PG8_BAR;
    }
    PG8_WAIT_V(0);
    PG8_BAR;
#undef PG8_SA
#undef PG8_SB
#undef PG8_STAGE1
#undef PG8_STAGEB
#undef PG8_STAGEA
#undef PG8_LDA
#undef PG8_LDB
#undef PG8_MMA
#undef PG8_WAIT_V
#undef PG8_WAIT_L
#undef PG8_BAR
#undef PG8_SCHED
}
}
typedef f32x4 AccT[2][2][4][2];

struct Args { const float* in[30]; float* out; unsigned char* ws; int ph_lo, ph_hi; };

struct Frame {
    LAS unsigned char* lds;
    int tid, lane, wave, G, wg;
    const float* const* in;
    unsigned char* ws; unsigned char* os;
};
#define IN_X 0
#define IN_META 1
#define IN_NMG 2
#define IN_WIN 3
#define IN_LRE 4
#define IN_LIM 5
#define IN_LDT 6
#define IN_BRE 7
#define IN_BIM 8
#define IN_CRE 9
#define IN_CIM 10
#define IN_S5D 11
#define IN_WGLU 12
#define IN_HLB 13
#define IN_HNG 14
#define IN_LQ1 15
#define IN_LK1 16
#define IN_LQ2 17
#define IN_LK2 18
#define IN_SUBLN 19
#define IN_WOUT 20
#define IN_NFG 21
#define IN_WGRP 22
#define IN_BGRP 23
#define IN_WEXP 24
#define IN_BEXP 25
#define IN_WGATE 26
#define IN_WUP 27
#define IN_WDOWN 28
#define IN_FNG 29

template <class ColMap>
__device__ __forceinline__ void conv_item(const float* W, int ldw, const float* kscale, bf16* WT, int ldt, int k0, int n0, LAS float* scr, int lane, ColMap cm) {
    const int sc = cm(n0 + (lane & 31));
#pragma unroll
    for (int i = 0; i < 32; ++i) { const int kk = 2 * i + (lane >> 5); float v = W[(size_t)(k0 + kk) * ldw + sc]; if (kscale) v *= kscale[k0 + kk]; scr[kk * 33 + (lane & 31)] = v; }
    LDS_WAIT(); asm volatile("" ::: "memory");
    const int c = lane & 7;
#pragma unroll
    for (int j = 0; j < 4; ++j) { const int n = (lane >> 3) + 8 * j; const LAS float* s = scr + (8 * c) * 33 + n;
        u32x4 o; o.x = pk2(s[0 * 33], s[1 * 33]); o.y = pk2(s[2 * 33], s[3 * 33]); o.z = pk2(s[4 * 33], s[5 * 33]); o.w = pk2(s[6 * 33], s[7 * 33]);
        *(GAS u32x4*)(WT + (size_t)(n0 + n) * ldt + k0 + 8 * c) = o; }
    LDS_WAIT(); asm volatile("" ::: "memory");
}

__device__ __forceinline__ void p0_prologue(const Frame& F0) {
    Frame F = F0; F.tid = F.wave * 64 + lane_id_(); LAUNDER(F.tid); F.lane = F.tid & 63;
    LAS float* scr = (LAS float*)(F.lds + F.wave * 16384);
    const int gw = F.wg * 8 + F.wave, NGW = F.G * 8, lane = F.lane;
    constexpr int I_IN = 16 * (NI / 32), I_OUT = 16 * 32, I_GLU = 4 * 16, I_GU = 16 * 16 * 32, I_DN = 16 * 8 * 32;
    constexpr int I_L = I_IN + I_OUT + I_GLU + I_GU + I_DN;
    for (int it = gw; it < 2 * I_L; it += NGW) {
        const int l = it / I_L; int r = it % I_L;
        if (r < I_IN) {
            const int kb = r / (NI / 32), nb = r % (NI / 32);
            conv_item(F.in[IN_WIN] + (size_t)l * D * NI, NI, F.in[IN_NMG] + l * D, (bf16*)(F.ws + WS_WIN) + (size_t)l * NI * D, D, kb * 64, nb * 32, scr, lane,
                      [](int n) { if (n >= C_AQ && n < C_AV) { const int p = n & 63, j = p >> 3, e = p & 7; return (n & ~63) + 4 * j + (e & 3) + 32 * (e >> 2); } return n; });
            continue; }
        r -= I_IN;
        if (r < I_OUT) {
            const int kb = r / 32, nb = r % 32;
            conv_item(F.in[IN_WOUT] + (size_t)l * D * D, D, nullptr, (bf16*)(F.ws + WS_WOUT) + (size_t)l * D * D, D, kb * 64, nb * 32, scr, lane, [](int n) { return n; });
            continue; }
        r -= I_OUT;
        if (r < I_GLU) {
            const int kb = r / 16, nb = r % 16;
            conv_item(F.in[IN_WGLU] + (size_t)l * 256 * 512, 512, nullptr, (bf16*)(F.ws + WS_WGLU) + (size_t)l * 512 * 256, 256, kb * 64, nb * 32, scr, lane,
                      [](int n) { const int pn = n >> 8, bj = (n >> 7) & 1, c = n & 127; return bj * 256 + pn * 128 + c; });
            continue; }
        r -= I_GLU;
        if (r < I_GU) {
            const int e = r / (16 * 32), q = r % (16 * 32), kb = q / 32, nb = q % 32, n0 = nb * 32, bj = (n0 >> 7) & 1;
            const float* src = (bj ? F.in[IN_WUP] : F.in[IN_WGATE]) + ((size_t)l * 16 + e) * 1024 * 512;
            conv_item(src, 512, F.in[IN_NFG] + l * D, (bf16*)(F.ws + WS_WGU) + ((size_t)l * 16 + e) * 1024 * 1024, 1024, kb * 64, n0, scr, lane,
                      [](int n) { const int pn = n >> 8, c = n & 127; return pn * 128 + c; });
            continue; }
        r -= I_GU;
        {
            const int e = r / (8 * 32), q = r % (8 * 32), kb = q / 32, nb = q % 32;
            conv_item(F.in[IN_WDOWN] + ((size_t)l * 16 + e) * 512 * 1024, 1024, nullptr, (bf16*)(F.ws + WS_WDN) + ((size_t)l * 16 + e) * 1024 * 512, 512, kb * 64, nb * 32, scr, lane, [](int n) { return n; });
        }
    }
    for (int idx = gw * 64 + lane; idx < 2 * 32 * 1024; idx += NGW * 64) {
        const int l = idx / (32 * 1024), j = (idx / 1024) % 32, k = idx % 1024;
        float w = 0.f;
        if (j < 4) w = F.in[IN_WGRP][((size_t)l * D + k) * 4 + j]; else if (j < 20) w = F.in[IN_WEXP][((size_t)l * D + k) * 16 + (j - 4)];
        w *= F.in[IN_NFG][l * D + k];
        const unsigned hi = f2bf(w); const float lo = w - bf2f(hi);
        bf16* wr = (bf16*)(F.ws + WS_WR) + (size_t)l * 2 * 32 * 1024;
        wr[j * 1024 + k] = (bf16)hi; wr[32 * 1024 + j * 1024 + k] = (bf16)f2bf(lo);
    }
    for (int idx = gw * 64 + lane; idx < LT * 32; idx += NGW * 64) {
        const int pos = idx / 32, i = idx % 32;
        const double inv = pow(10000.0, -(double)(2 * i) / 64.0); const double a = (double)pos * inv;
        ((float*)(F.ws + WS_ROPE))[idx] = (float)cos(a); ((float*)(F.ws + WS_ROPE))[LT * 32 + idx] = (float)sin(a);
    }
    for (int m = gw; m < T; m += NGW) {
        const int b = m / LT, t = m % LT;
        const float* src = (t < NMETA) ? F.in[IN_META] + (size_t)t * D : F.in[IN_X] + ((size_t)b * SEQ + (t - NMETA)) * D;
        const GAS f32x4* xr = (const GAS f32x4*)src + lane;
        GAS f32x4* hr = (GAS f32x4*)((float*)(F.ws + WS_H) + (size_t)m * D) + lane;
        GAS u32x2* hb = (GAS u32x2*)((bf16*)(F.ws + WS_HB) + (size_t)m * D) + lane;
        float s = 0.f;
#pragma unroll
        for (int j = 0; j < 4; ++j) { const f32x4 v = xr[64 * j]; hr[64 * j] = v; s += (v.x * v.x + v.y * v.y) + (v.z * v.z + v.w * v.w);
            u32x2 o; o.x = pk2(v.x, v.y); o.y = pk2(v.z, v.w); hb[64 * j] = o; }
        s = wave_sum(s);
        if (lane < 16) ((float*)(F.ws + WS_SS16))[(size_t)m * 16 + lane] = (lane == 0) ? s : 0.f;
    }
    for (int it = F.wg; it < 32; it += F.G) {
        const int l = it / 16, g = it % 16;
        LAS f32x2* Ap = (LAS f32x2*)(F.lds);
        LAS f32x2* Bb = Ap + 17 * 64;
        LAS f32x2* Cc = Bb + 64 * 16;
        LAS float* Kj = (LAS float*)(Cc + 16 * 64);
        __syncthreads();
        const double dt = exp((double)F.in[IN_LDT][l * 16 + g]);
        for (int idx = F.tid; idx < 17 * 64; idx += 512) { const int j = idx / 64, n = idx % 64;
            const double lr = F.in[IN_LRE][(l * 16 + g) * 64 + n], li = F.in[IN_LIM][(l * 16 + g) * 64 + n];
            const double mg = exp(j * lr * dt), an = j * li * dt; Ap[idx] = (f32x2){(float)(mg * cos(an)), (float)(mg * sin(an))}; }
        for (int idx = F.tid; idx < 64 * 16; idx += 512) { const int n = idx / 16, c = idx % 16;
            const double lr = F.in[IN_LRE][(l * 16 + g) * 64 + n], li = F.in[IN_LIM][(l * 16 + g) * 64 + n];
            const double mg = exp(lr * dt), ar = mg * cos(li * dt), ai = mg * sin(li * dt), den = lr * lr + li * li, zr = ar - 1.0, zi = ai;
            const double fr = (zr * lr + zi * li) / den, fi = (zi * lr - zr * li) / den;
            const double br = F.in[IN_BRE][((size_t)(l * 16 + g) * 64 + n) * 16 + c], bi = F.in[IN_BIM][((size_t)(l * 16 + g) * 64 + n) * 16 + c];
            Bb[idx] = (f32x2){(float)(fr * br - fi * bi), (float)(fr * bi + fi * br)}; }
        for (int idx = F.tid; idx < 16 * 64; idx += 512) { const int c = idx / 64, n = idx % 64;
            Cc[idx] = (f32x2){F.in[IN_CRE][((size_t)(l * 16 + g) * 16 + c) * 64 + n], F.in[IN_CIM][((size_t)(l * 16 + g) * 16 + c) * 64 + n]}; }
        __syncthreads();
        for (int idx = F.tid; idx < 4096; idx += 512) { const int j = idx >> 8, co = (idx >> 4) & 15, ci = idx & 15; float s = 0.f;
            for (int n = 0; n < 64; ++n) { const f32x2 a = Ap[j * 64 + n], b = Bb[n * 16 + ci], c = Cc[co * 64 + n];
                const float abr = a.x * b.x - a.y * b.y, abi = a.x * b.y + a.y * b.x; s += c.x * abr - c.y * abi; }
            Kj[idx] = s; }
        if (F.tid < 64) ((f32x2*)(F.ws + WS_S5A))[(l * 16 + g) * 64 + F.tid] = Ap[16 * 64 + F.tid];
        __syncthreads();
        bf16* TQ = (bf16*)(F.ws + WS_S5TQ) + (size_t)(l * 16 + g) * 256 * 384;
        for (int idx = F.tid; idx < 256 * 384; idx += 512) { const int nn = idx / 384, k = idx % 384, t = nn >> 4, co = nn & 15; float v;
            if (k < 256) { const int s = k >> 4, ci = k & 15; v = (s <= t) ? Kj[((t - s) << 8) + (co << 4) + ci] : 0.f; }
            else { const int kk = k - 256, n = kk >> 1; const f32x2 a = Ap[(t + 1) * 64 + n], c = Cc[co * 64 + n];
                const float zr = c.x * a.x - c.y * a.y, zi = c.x * a.y + c.y * a.x; v = (kk & 1) ? -zi : zr; }
            TQ[idx] = (bf16)f2bf(v); }
        bf16* PM = (bf16*)(F.ws + WS_S5P) + (size_t)(l * 16 + g) * 256 * 256;
        for (int idx = F.tid; idx < 256 * 256; idx += 512) { const int nn = idx >> 8, k = idx & 255; float v = 0.f;
            if (nn < 128) { const int n = nn >> 1, s = k >> 4, ci = k & 15; const f32x2 a = Ap[(15 - s) * 64 + n], b = Bb[n * 16 + ci];
                v = (nn & 1) ? (a.x * b.y + a.y * b.x) : (a.x * b.x - a.y * b.y); }
            PM[idx] = (bf16)f2bf(v); }
        __syncthreads();
    }
}

template <class V> __device__ __forceinline__ V ldg(const void* sbase, unsigned voff) { return *(const GAS V*)((const char*)sbase + voff); }
template <class V> __device__ __forceinline__ void stg(void* sbase, unsigned voff, V v) { *(GAS V*)((char*)sbase + voff) = v; }
__device__ __forceinline__ u32x4 bufld16(__amdgpu_buffer_rsrc_t r, unsigned voff, unsigned soff) { return __builtin_bit_cast(u32x4, __builtin_amdgcn_raw_buffer_load_b128(r, (int)voff, (int)soff, 0)); }
#define GLDS2(p0, p1, dst) do { __builtin_amdgcn_global_load_lds((const unsigned*)(p0), (LAS unsigned*)(dst), 16, 0, 0); __builtin_amdgcn_global_load_lds((const unsigned*)(p1), (LAS unsigned*)((dst) + 8192), 16, 0, 0); } while (0)
#define EPI_FENCE() __builtin_amdgcn_sched_barrier(0)
struct UnitT { int pm, pn; };

struct PolIn {
    typedef UnitT Unit; static constexpr int NT = 16, LDB = 1024;
    pg8::TileOrder ord; const bf16* A; const bf16* B; bf16* proj; const float* ss16; const float* rope;
    __device__ __forceinline__ bool next(int i, Unit& u) const { return ord.get(i, u.pm, u.pn); }
    __device__ __forceinline__ void stage_a(LAS unsigned char* dst, int, const Unit& u, int t, int h, const int (&R)[2], const int (&C)[2]) const {
        const char* bp = (const char*)(A + (size_t)(u.pm * 256 + h * 128) * 1024) + t * 128;
        GLDS2(bp + (unsigned)((R[0] * 1024 + C[0]) * 2), bp + (unsigned)((R[1] * 1024 + C[1]) * 2), dst); }
    __device__ __forceinline__ const char* b_ptr(const Unit& u, int t) const { return (const char*)(B + (size_t)u.pn * 256 * 1024) + t * 128; }
    __device__ __forceinline__ void epi(const AccT& acc, const Unit& u, int wr, int wc, int fr, int fq, int) const {
        const bool isrope = (u.pn >= 5 && u.pn <= 8); const float qs = (u.pn == 5 || u.pn == 6) ? QSCALE : 1.f;
        const unsigned fi = 4u * (4u * (wc & 1) + fq);
        const unsigned vo_p = (unsigned)((fr * NI + u.pn * 256 + wc * 32 + 8 * fq) * 2), vo_s = (unsigned)(fr * 64);
#pragma unroll
        for (int ai = 0; ai < 2; ++ai)
#pragma unroll
            for (int m = 0; m < 4; ++m) {
                const int rowu = u.pm * 256 + ai * 128 + wr * 64 + m * 16;
                const float* sp = ss16 + (size_t)rowu * 16;
                const f32x4 s0 = ldg<f32x4>(sp, vo_s), s1 = ldg<f32x4>(sp, vo_s + 16), s2 = ldg<f32x4>(sp, vo_s + 32), s3 = ldg<f32x4>(sp, vo_s + 48);
                const float ss = ((s0.x + s0.y) + (s0.z + s0.w)) + ((s1.x + s1.y) + (s1.z + s1.w)) + ((s2.x + s2.y) + (s2.z + s2.w)) + ((s3.x + s3.y) + (s3.z + s3.w));
                const float rstd = rsqrtf(ss * (1.f / 1024.f) + RMS_EPS);
                f32x4 cs = (f32x4){1.f, 1.f, 1.f, 1.f}, sn = (f32x4){0.f, 0.f, 0.f, 0.f};
                if (isrope) { const unsigned pos = (unsigned)(rowu + fr) % (unsigned)LT; cs = ldg<f32x4>(rope, (pos * 32 + fi) * 4); sn = ldg<f32x4>(rope, (LT * 32 + pos * 32 + fi) * 4); }
                bf16* rowp = proj + (size_t)rowu * NI;
#pragma unroll
                for (int bj = 0; bj < 2; ++bj) {
                    f32x4 v0 = acc[ai][bj][m][0] * rstd, v1 = acc[ai][bj][m][1] * rstd;
                    if (isrope) { const f32x4 o0 = (v0 * cs - v1 * sn) * qs, o1 = (v1 * cs + v0 * sn) * qs; v0 = o0; v1 = o1; }
                    u32x4 w; w.x = cvt_pk_bf16(v0[0], v0[1]); w.y = cvt_pk_bf16(v0[2], v0[3]); w.z = cvt_pk_bf16(v1[0], v1[1]); w.w = cvt_pk_bf16(v1[2], v1[3]);
                    stg<u32x4>(rowp, vo_p + bj * 256, w);
                }
                EPI_FENCE();
            }
    }
};

struct UnitS5 { int g, mt; };
struct PolS5E {
    typedef UnitS5 Unit; static constexpr int NT = 4, LDB = 256;
    int G, c; const bf16* proj; const bf16* B; float* E;
    __device__ __forceinline__ bool next(int i, Unit& u) const { const int Lx = i * G + c; if (Lx >= 16 * 17) return false; u.g = Lx / 17; u.mt = Lx % 17; return true; }
    __device__ __forceinline__ void stage_a(LAS unsigned char* dst, int, const Unit& u, int t, int h, const int (&R)[2], const int (&C)[2]) const {
        const char* bp = (const char*)(proj + ((size_t)(16 * (256 * u.mt + 128 * h) + 4 * t)) * NI + C_U + u.g * 16);
        GLDS2(bp + (unsigned)(((16 * R[0] + (C[0] >> 4)) * NI + (C[0] & 15)) * 2), bp + (unsigned)(((16 * R[1] + (C[1] >> 4)) * NI + (C[1] & 15)) * 2), dst); }
    __device__ __forceinline__ const char* b_ptr(const Unit& u, int t) const { return (const char*)(B + (size_t)u.g * 256 * 256) + t * 128; }
    __device__ __forceinline__ void epi(const AccT& acc, const Unit& u, int wr, int wc, int fr, int fq, int) const {
        const unsigned vo = (unsigned)((fr * 128 + wc * 32 + 8 * fq) * 4);
#pragma unroll
        for (int ai = 0; ai < 2; ++ai)
#pragma unroll
            for (int m = 0; m < 4; ++m) { float* ep = E + ((size_t)u.g * S5RP + u.mt * 256 + ai * 128 + wr * 64 + m * 16) * 128;
                stg<f32x4>(ep, vo, acc[ai][0][m][0]); stg<f32x4>(ep, vo + 16, acc[ai][0][m][1]); }
    }
};

struct PolS5Y {
    typedef UnitS5 Unit; static constexpr int NT = 6, LDB = 384;
    int G, c; const bf16* X; const bf16* B; const bf16* proj; const float* dsk; bf16* Gout;
    __device__ __forceinline__ bool next(int i, Unit& u) const { const int Lx = i * G + c; if (Lx >= 16 * 17) return false; u.g = Lx / 17; u.mt = Lx % 17; return true; }
    __device__ __forceinline__ void stage_a(LAS unsigned char* dst, int, const Unit& u, int t, int h, const int (&R)[2], const int (&C)[2]) const {
        const char* bp = (const char*)(X + ((size_t)u.g * S5RP + 256 * u.mt + 128 * h) * 384) + t * 128;
        GLDS2(bp + (unsigned)((R[0] * 384 + C[0]) * 2), bp + (unsigned)((R[1] * 384 + C[1]) * 2), dst); }
    __device__ __forceinline__ const char* b_ptr(const Unit& u, int t) const { return (const char*)(B + (size_t)u.g * 256 * 384) + t * 128; }
    __device__ __forceinline__ void epi(const AccT& acc, const Unit& u, int wr, int wc, int fr, int fq, int) const {
        const int ch = u.g * 16 + 8 * (fq & 1);
        const f32x4 d0 = ldg<f32x4>(dsk, (unsigned)ch * 4), d1 = ldg<f32x4>(dsk, (unsigned)ch * 4 + 16);
        const unsigned vo_u = (unsigned)(((16 * fr + (fq >> 1)) * NI + C_U + ch) * 2), vo_g = (unsigned)(((16 * fr + (fq >> 1)) * 256 + ch) * 2);
#pragma unroll
        for (int ai = 0; ai < 2; ++ai)
#pragma unroll
            for (int m = 0; m < 4; ++m) { const int Ru = u.mt * 256 + ai * 128 + wr * 64 + m * 16;
                if (Ru + fr < S5R) {
#pragma unroll
                    for (int bj = 0; bj < 2; ++bj) { const size_t toku = (size_t)16 * Ru + 8 * bj + 2 * wc;
                        const u32x4 uu = ldg<u32x4>(proj + toku * NI, vo_u);
                        f32x4 v0 = acc[ai][bj][m][0], v1 = acc[ai][bj][m][1];
                        v0[0] += d0[0] * bf2f(uu.x); v0[1] += d0[1] * bf2f(uu.x >> 16); v0[2] += d0[2] * bf2f(uu.y); v0[3] += d0[3] * bf2f(uu.y >> 16);
                        v1[0] += d1[0] * bf2f(uu.z); v1[1] += d1[1] * bf2f(uu.z >> 16); v1[2] += d1[2] * bf2f(uu.w); v1[3] += d1[3] * bf2f(uu.w >> 16);
                        u32x4 w; w.x = pk2(gelu_tanh(v0[0]), gelu_tanh(v0[1])); w.y = pk2(gelu_tanh(v0[2]), gelu_tanh(v0[3]));
                        w.z = pk2(gelu_tanh(v1[0]), gelu_tanh(v1[1])); w.w = pk2(gelu_tanh(v1[2]), gelu_tanh(v1[3]));
                        stg<u32x4>(Gout + toku * 256, vo_g, w); }
                }
                EPI_FENCE();
            }
    }
};

struct PolGlu {
    typedef UnitT Unit; static constexpr int NT = 4, LDB = 256;
    pg8::TileOrder ord; const bf16* A; const bf16* B; bf16* mixed;
    __device__ __forceinline__ bool next(int i, Unit& u) const { return ord.get(i, u.pm, u.pn); }
    __device__ __forceinline__ void stage_a(LAS unsigned char* dst, int, const Unit& u, int t, int h, const int (&R)[2], const int (&C)[2]) const {
        const char* bp = (const char*)(A + (size_t)(u.pm * 256 + h * 128) * 256) + t * 128;
        GLDS2(bp + (unsigned)((R[0] * 256 + C[0]) * 2), bp + (unsigned)((R[1] * 256 + C[1]) * 2), dst); }
    __device__ __forceinline__ const char* b_ptr(const Unit& u, int t) const { return (const char*)(B + (size_t)u.pn * 256 * 256) + t * 128; }
    __device__ __forceinline__ void epi(const AccT& acc, const Unit& u, int wr, int wc, int fr, int fq, int) const {
        const unsigned vo = (unsigned)((fr * D + u.pn * 128 + wc * 32 + 8 * fq) * 2);
#pragma unroll
        for (int ai = 0; ai < 2; ++ai)
#pragma unroll
            for (int m = 0; m < 4; ++m) { bf16* rp = mixed + (size_t)(u.pm * 256 + ai * 128 + wr * 64 + m * 16) * D;
                const f32x4 a0 = acc[ai][0][m][0], a1 = acc[ai][0][m][1], b0 = acc[ai][1][m][0], b1 = acc[ai][1][m][1];
                u32x4 w; w.x = pk2(a0[0] * sigmoidf_(b0[0]), a0[1] * sigmoidf_(b0[1])); w.y = pk2(a0[2] * sigmoidf_(b0[2]), a0[3] * sigmoidf_(b0[3]));
                w.z = pk2(a1[0] * sigmoidf_(b1[0]), a1[1] * sigmoidf_(b1[1])); w.w = pk2(a1[2] * sigmoidf_(b1[2]), a1[3] * sigmoidf_(b1[3]));
                stg<u32x4>(rp, vo, w);
                EPI_FENCE(); }
    }
};

__device__ __forceinline__ void residual_rows(const AccT& acc, int ai, int m, unsigned vrow, bool valid, int pn, int wc, int fq, float* hrow, bf16* brow, float* srow) {
    const unsigned colb = (unsigned)(pn * 256 + wc * 32 + 8 * fq);
    const unsigned vh = (vrow * D + colb) * 4, vb = (vrow * D + colb) * 2;
    float ssq = 0.f;
    if (valid) {
#pragma unroll
        for (int bj = 0; bj < 2; ++bj) {
            f32x4 h0 = ldg<f32x4>(hrow, vh + bj * 512), h1 = ldg<f32x4>(hrow, vh + bj * 512 + 16);
            h0 += acc[ai][bj][m][0]; h1 += acc[ai][bj][m][1];
            stg<f32x4>(hrow, vh + bj * 512, h0); stg<f32x4>(hrow, vh + bj * 512 + 16, h1);
            u32x4 w; w.x = cvt_pk_bf16(h0[0], h0[1]); w.y = cvt_pk_bf16(h0[2], h0[3]); w.z = cvt_pk_bf16(h1[0], h1[1]); w.w = cvt_pk_bf16(h1[2], h1[3]);
            stg<u32x4>(brow, vb + bj * 256, w);
            ssq += (h0[0] * h0[0] + h0[1] * h0[1]) + (h0[2] * h0[2] + h0[3] * h0[3]) + (h1[0] * h1[0] + h1[1] * h1[1]) + (h1[2] * h1[2] + h1[3] * h1[3]);
        }
    }
    ssq += __shfl_xor(ssq, 16); ssq += __shfl_xor(ssq, 32);
    if (valid && fq == 0) stg<float>(srow, (vrow * 16 + pn * 4 + wc) * 4, ssq);
}

struct PolOut {
    typedef UnitT Unit; static constexpr int NT = 16, LDB = 1024;
    pg8::TileOrder ord; const bf16* A; const bf16* B; float* H; bf16* HB; float* ss16;
    __device__ __forceinline__ bool next(int i, Unit& u) const { return ord.get(i, u.pm, u.pn); }
    __device__ __forceinline__ void stage_a(LAS unsigned char* dst, int, const Unit& u, int t, int h, const int (&R)[2], const int (&C)[2]) const {
        const char* bp = (const char*)(A + (size_t)(u.pm * 256 + h * 128) * 1024) + t * 128;
        GLDS2(bp + (unsigned)((R[0] * 1024 + C[0]) * 2), bp + (unsigned)((R[1] * 1024 + C[1]) * 2), dst); }
    __device__ __forceinline__ const char* b_ptr(const Unit& u, int t) const { return (const char*)(B + (size_t)u.pn * 256 * 1024) + t * 128; }
    __device__ __forceinline__ void epi(const AccT& acc, const Unit& u, int wr, int wc, int fr, int fq, int) const {
#pragma unroll
        for (int ai = 0; ai < 2; ++ai)
#pragma unroll
            for (int m = 0; m < 4; ++m) { const size_t rowu = (size_t)(u.pm * 256 + ai * 128 + wr * 64 + m * 16);
                residual_rows(acc, ai, m, (unsigned)fr, true, u.pn, wc, fq, H + rowu * D, HB + rowu * D, ss16 + rowu * 16);
                EPI_FENCE(); }
    }
};

struct MoeList {
    LAS const int* cnt;
    __device__ __forceinline__ int ntiles() const { int s = 0; for (int c = 0; c < NCLS; ++c) s += (cnt[c] + 255) >> 8; return __builtin_amdgcn_readfirstlane(s); }
    __device__ __forceinline__ void decode(int gt, int& c, int& ti, int& nvalid) const {
        int s = 0, cc = 0, tt = 0, nv = 0;
        for (int k = 0; k < NCLS; ++k) { const int n = (cnt[k] + 255) >> 8; if (gt >= s && gt < s + n) { cc = k; tt = gt - s; nv = cnt[k] - 256 * tt; } s += n; }
        c = __builtin_amdgcn_readfirstlane(cc); ti = __builtin_amdgcn_readfirstlane(tt); nvalid = __builtin_amdgcn_readfirstlane(nv > 256 ? 256 : nv);
    }
};
__device__ __forceinline__ void class_experts(int c, int& ea, int& eb) {
    const int g = c / 6, p = c % 6; const int a = (p < 3) ? 0 : (p < 5 ? 1 : 2); const int b = (p < 3) ? p + 1 : (p < 5 ? p - 1 : 3);
    ea = g * 4 + a; eb = g * 4 + b;
}
struct UnitM { int gt, pn, c; };

struct PolGU {
    typedef UnitM Unit; static constexpr int NT = 16, LDB = 1024;
    int G, c, ntl; MoeList ml; LAS const int* tab;
    const bf16* HB; const bf16* W; bf16* he; const float* rstd; const float* gate;
    __device__ __forceinline__ bool next(int i, Unit& u) const { const int Lx = i * G + c; if (Lx >= ntl * 8) return false; u.gt = Lx >> 3; u.pn = Lx & 7; int ti, nv; ml.decode(u.gt, u.c, ti, nv); return true; }
    __device__ __forceinline__ void stage_a(LAS unsigned char* dst, int ui, const Unit&, int t, int h, const int (&R)[2], const int (&C)[2]) const {
        const char* bp = (const char*)HB + t * 128;
        const int t0 = tab[ui * 256 + 128 * h + R[0]], t1 = tab[ui * 256 + 128 * h + R[1]];
        GLDS2(bp + (unsigned)((t0 < 0 ? 0 : t0) * 2048 + C[0] * 2), bp + (unsigned)((t1 < 0 ? 0 : t1) * 2048 + C[1] * 2), dst); }
    __device__ __forceinline__ const char* b_ptr(const Unit& u, int t) const { int ea, eb; class_experts(u.c, ea, eb); const int e = (u.pn >> 2) ? eb : ea;
        return (const char*)(W + ((size_t)e * 1024 + (u.pn & 3) * 256) * 1024) + t * 128; }
    __device__ __forceinline__ void epi(const AccT& acc, const Unit& u, int wr, int wc, int fr, int fq, int ui) const {
        const int sel = u.pn >> 2;
        const unsigned vo = (unsigned)((fr * 1024 + sel * 512 + (u.pn & 3) * 128 + wc * 32 + 8 * fq) * 2);
#pragma unroll
        for (int ai = 0; ai < 2; ++ai)
#pragma unroll
            for (int m = 0; m < 4; ++m) { const int ru = ai * 128 + wr * 64 + m * 16; const int tk = tab[ui * 256 + ru + fr];
                float rs = 0.f, gw = 0.f; if (tk >= 0) { rs = ldg<float>(rstd, (unsigned)tk * 4); gw = ldg<float>(gate, (unsigned)(2 * tk + sel) * 4); }
                const f32x4 g0 = acc[ai][0][m][0] * rs, g1 = acc[ai][0][m][1] * rs, u0 = acc[ai][1][m][0] * (rs * gw), u1 = acc[ai][1][m][1] * (rs * gw);
                u32x4 w; w.x = pk2(siluf_(g0[0]) * u0[0], siluf_(g0[1]) * u0[1]); w.y = pk2(siluf_(g0[2]) * u0[2], siluf_(g0[3]) * u0[3]);
                w.z = pk2(siluf_(g1[0]) * u1[0], siluf_(g1[1]) * u1[1]); w.w = pk2(siluf_(g1[2]) * u1[2], siluf_(g1[3]) * u1[3]);
                stg<u32x4>(he + ((size_t)u.gt * 256 + ru) * 1024, vo, w);
                EPI_FENCE(); }
    }
};

struct PolDN {
    typedef UnitM Unit; static constexpr int NT = 16, LDB = 512;
    int G, c, ntl; MoeList ml; LAS const int* tab;
    const bf16* he; const bf16* W; float* H; bf16* HB; float* ss16;
    __device__ __forceinline__ bool next(int i, Unit& u) const { const int Lx = i * G + c; if (Lx >= ntl * 4) return false; u.gt = Lx >> 2; u.pn = Lx & 3; int ti, nv; ml.decode(u.gt, u.c, ti, nv); return true; }
    __device__ __forceinline__ void stage_a(LAS unsigned char* dst, int, const Unit& u, int t, int h, const int (&R)[2], const int (&C)[2]) const {
        const char* bp = (const char*)(he + (size_t)(u.gt * 256 + h * 128) * 1024) + t * 128;
        GLDS2(bp + (unsigned)((R[0] * 1024 + C[0]) * 2), bp + (unsigned)((R[1] * 1024 + C[1]) * 2), dst); }
    __device__ __forceinline__ const char* b_ptr(const Unit& u, int t) const { int ea, eb; class_experts(u.c, ea, eb); const int e = (t >= 8) ? eb : ea;
        return (const char*)(W + ((size_t)e * 1024 + u.pn * 256) * 512) + (t & 7) * 128; }
    __device__ __forceinline__ void epi(const AccT& acc, const Unit& u, int wr, int wc, int fr, int fq, int ui) const {
#pragma unroll
        for (int ai = 0; ai < 2; ++ai)
#pragma unroll
            for (int m = 0; m < 4; ++m) { const int tk = tab[ui * 256 + ai * 128 + wr * 64 + m * 16 + fr];
                residual_rows(acc, ai, m, (unsigned)(tk < 0 ? 0 : tk), tk >= 0, u.pn, wc, fq, H, HB, ss16);
                EPI_FENCE(); }
    }
};

#define MFMA16(a, b, c) __builtin_amdgcn_mfma_f32_16x16x32_bf16(a, b, c, 0, 0, 0)
#define MFMA32(a, b, c) __builtin_amdgcn_mfma_f32_32x32x16_bf16(a, b, c, 0, 0, 0)

__device__ __forceinline__ void s5_scan(const Frame& F0, int l) {
    Frame F = F0; F.tid = F.wave * 64 + lane_id_(); LAUNDER(F.tid); F.lane = F.tid & 63;
    const bf16* proj = (const bf16*)(F.ws + WS_PROJ); const float* E = (const float*)(F.os + OS_E); bf16* X = (bf16*)(F.os + OS_X);
    const int lane = F.lane;
    for (int it = F.wg + F.G * F.wave; it < NB * 16; it += F.G * 8) {
        const int b = it >> 4, g = it & 15;
        const f32x2 A16 = ((const f32x2*)(F.ws + WS_S5A))[(l * 16 + g) * 64 + lane];
        float sr = 0.f, si = 0.f;
        for (int r0 = 0; r0 < NCH; r0 += 16) {
            f32x2 e[16]; u32x2 u4[16];
#pragma unroll
            for (int j = 0; j < 16; ++j) if (r0 + j < NCH) { const size_t R = (size_t)b * NCH + r0 + j;
                e[j] = *(const GAS f32x2*)(E + ((size_t)g * S5RP + R) * 128 + 2 * lane);
                u4[j] = *(const GAS u32x2*)(proj + (16 * R + (lane >> 2)) * NI + C_U + g * 16 + 4 * (lane & 3)); }
#pragma unroll
            for (int j = 0; j < 16; ++j) if (r0 + j < NCH) { const size_t R = (size_t)b * NCH + r0 + j;
                bf16* xr = X + ((size_t)g * S5RP + R) * 384;
                *(GAS unsigned*)(xr + 256 + 2 * lane) = pk2(sr, si);
                *(GAS u32x2*)(xr + 4 * lane) = u4[j];
                const float nr = A16.x * sr - A16.y * si + e[j].x, ni = A16.x * si + A16.y * sr + e[j].y; sr = nr; si = ni; }
        }
    }
}

__device__ __forceinline__ float hgrn_lb(const float* hlb, int l, int j) {
    if (l == 0) return 0.f;
    const float x0 = hlb[j], x1 = hlb[256 + j], mx = fmaxf(x0, x1), e0 = __expf(x0 - mx), e1 = __expf(x1 - mx);
    return e1 / (e0 + e1);
}
__device__ __forceinline__ void hgrn_gate(float z, float lbA, float onem, float& lf, float& k) {
    const float e = __expf(-fabsf(z)), r = __builtin_amdgcn_rcpf(1.f + e), er = e * r;
    const float s = (z >= 0.f) ? r : er, c = (z >= 0.f) ? er : r;
    lf = __logf(lbA + onem * s); k = onem * c;
}
constexpr int HG_HALF = 72960, HG_LF = 0, HG_SEG = 16640, HG_T0 = 17664, HG_TS = 9216;

__device__ __forceinline__ void hgrn_a(const Frame& F0, int l) {
    Frame F = F0; F.tid = F.wave * 64 + lane_id_(); LAUNDER(F.tid); F.lane = F.tid & 63;
    const bf16* proj = (const bf16*)(F.ws + WS_PROJ); float* UT = (float*)(F.os + OS_UT); float* DEC = (float*)(F.os + OS_DEC);
    const int half = F.tid >> 8, ht = F.tid & 255, hw = F.wave & 3, lane = F.lane;
    LAS unsigned char* base = F.lds + half * HG_HALF;
    LAS float* LF = (LAS float*)(base + HG_LF); LAS float* SEG = (LAS float*)(base + HG_SEG);
    LAS bf16* vT = (LAS bf16*)(base + HG_T0); LAS bf16* KDT = (LAS bf16*)(base + HG_T0 + HG_TS);
    for (int p = F.wg; p < NB * 4 * HCH / 2; p += F.G) {
        const int item = 2 * p + half, c = item % HCH, bh = item / HCH, b = bh >> 2, h = bh & 3;
        const size_t tok0 = (size_t)b * LT + (c == 0 ? 0 : 16 + 64 * (c - 1)); const int nrows = (c == 0) ? 16 : 64;
        float lbA[8], onem[8];
#pragma unroll
        for (int jj = 0; jj < 8; ++jj) { const float lb = hgrn_lb(F.in[IN_HLB], l, h * 64 + 8 * (ht & 7) + jj); lbA[jj] = fmaxf(lb, 1e-30f); onem[jj] = 1.f - lb; }
#pragma unroll
        for (int e = 0; e < 2; ++e) { const int idx = ht + 256 * e, t = idx >> 3, c8 = idx & 7; const bool valid = t < nrows;
            u32x4 zf = (u32x4){0u, 0u, 0u, 0u}, zi = zf;
            if (valid) { zf = *(const GAS u32x4*)(proj + (tok0 + t) * NI + C_HF + h * 64 + 8 * c8); zi = *(const GAS u32x4*)(proj + (tok0 + t) * NI + C_HI + h * 64 + 8 * c8); }
#pragma unroll
            for (int jj = 0; jj < 8; ++jj) { const int d = 8 * c8 + jj; const unsigned wf = (jj & 1) ? (zf[jj >> 1] >> 16) : (zf[jj >> 1] & 0xffffu); const unsigned wi = (jj & 1) ? (zi[jj >> 1] >> 16) : (zi[jj >> 1] & 0xffffu);
                float lf, kk; hgrn_gate(bf2f(wf), lbA[jj], onem[jj], lf, kk); LF[t * 65 + d] = valid ? lf : 0.f;
                vT[d * 72 + t] = (bf16)wi; }
        }
        __syncthreads();
        const int d = ht & 63, seg = ht >> 6;
        { float run = 0.f;
#pragma unroll
          for (int i = 0; i < 16; ++i) { run += LF[(16 * seg + i) * 65 + d]; LF[(16 * seg + i) * 65 + d] = run; }
          SEG[seg * 64 + d] = run; }
        __syncthreads();
        { float offs = 0.f, last = 0.f;
#pragma unroll
          for (int s = 0; s < 4; ++s) { const float v = SEG[s * 64 + d]; if (s < seg) offs += v; last += v; }
          float prev = 0.f;
#pragma unroll
          for (int i = 0; i < 16; ++i) { const int t = 16 * seg + i; const float cl = LF[t * 65 + d], lf = cl - prev; prev = cl;
              const float k = 1.f - __expf(lf); KDT[d * 72 + t] = (bf16)f2bf(k * __expf(last - (cl + offs))); }
          if (seg == 0) DEC[(size_t)item * 64 + d] = __expf(last); }
        __syncthreads();
        f32x4 acc[4];
#pragma unroll
        for (int nt = 0; nt < 4; ++nt) acc[nt] = (f32x4){0.f, 0.f, 0.f, 0.f};
#pragma unroll
        for (int ks = 0; ks < 2; ++ks) { const bf16x8 a = *(const LAS bf16x8*)(vT + (16 * hw + (lane & 15)) * 72 + 32 * ks + 8 * (lane >> 4));
#pragma unroll
            for (int nt = 0; nt < 4; ++nt) { const bf16x8 bb = *(const LAS bf16x8*)(KDT + (16 * nt + (lane & 15)) * 72 + 32 * ks + 8 * (lane >> 4)); acc[nt] = MFMA16(a, bb, acc[nt]); } }
#pragma unroll
        for (int nt = 0; nt < 4; ++nt)
#pragma unroll
            for (int j = 0; j < 4; ++j) UT[(size_t)item * 4096 + (16 * hw + 4 * (lane >> 4) + j) * 64 + 16 * nt + (lane & 15)] = acc[nt][j];
        __syncthreads();
    }
}

__device__ __forceinline__ void hgrn_b(const Frame& F0) {
    Frame F = F0; F.tid = F.wave * 64 + lane_id_(); LAUNDER(F.tid); F.lane = F.tid & 63;
    const float* UT = (const float*)(F.os + OS_UT); const float* DEC = (const float*)(F.os + OS_DEC); bf16* SP = (bf16*)(F.os + OS_SP);
    for (int blk = F.wg; blk < NB * 4 * 8; blk += F.G) {
        const int bh = blk >> 3, e = (blk & 7) * 512 + F.tid, d = e & 63;
        float S = 0.f;
        for (int c0 = 0; c0 < HCH; c0 += 11) {
            float ut[11], dc[11];
#pragma unroll
            for (int j = 0; j < 11; ++j) { const size_t item = (size_t)bh * HCH + c0 + j; ut[j] = UT[item * 4096 + e]; dc[j] = DEC[item * 64 + d]; }
#pragma unroll
            for (int j = 0; j < 11; ++j) { const size_t item = (size_t)bh * HCH + c0 + j; SP[item * 4096 + e] = (bf16)f2bf(S); S = dc[j] * S + ut[j]; }
        }
    }
}

__device__ __forceinline__ void hgrn_c(const Frame& F0, int l) {
    Frame F = F0; F.tid = F.wave * 64 + lane_id_(); LAUNDER(F.tid); F.lane = F.tid & 63;
    const bf16* proj = (const bf16*)(F.ws + WS_PROJ); const bf16* SPg = (const bf16*)(F.os + OS_SP); bf16* mixed = (bf16*)(F.ws + WS_MIXED);
    const int half = F.tid >> 8, ht = F.tid & 255, hw = F.wave & 3, lane = F.lane;
    LAS unsigned char* base = F.lds + half * HG_HALF;
    LAS float* LF = (LAS float*)(base + HG_LF); LAS float* SEG = (LAS float*)(base + HG_SEG);
    LAS bf16* vT = (LAS bf16*)(base + HG_T0); LAS bf16* QT = vT + HG_TS / 2; LAS bf16* KT = QT + HG_TS / 2; LAS bf16* QS = KT + HG_TS / 2; LAS bf16* SPt = QS + HG_TS / 2; LAS bf16* P = SPt + HG_TS / 2;
    const float* ng = F.in[IN_HNG] + l * 64;
    for (int p = F.wg; p < NB * 4 * HCH / 2; p += F.G) {
        const int item = 2 * p + half, c = item % HCH, bh = item / HCH, b = bh >> 2, h = bh & 3;
        const size_t tok0 = (size_t)b * LT + (c == 0 ? 0 : 16 + 64 * (c - 1)); const int nrows = (c == 0) ? 16 : 64;
        float qv[16], kv[16], lbA[8], onem[8];
#pragma unroll
        for (int jj = 0; jj < 8; ++jj) { const float lb = hgrn_lb(F.in[IN_HLB], l, h * 64 + 8 * (ht & 7) + jj); lbA[jj] = fmaxf(lb, 1e-30f); onem[jj] = 1.f - lb; }
#pragma unroll
        for (int e = 0; e < 2; ++e) { const int idx = ht + 256 * e, t = idx >> 3, c8 = idx & 7; const bool valid = t < nrows;
            u32x4 zq = (u32x4){0u, 0u, 0u, 0u}, zf = zq, zi = zq;
            if (valid) { const bf16* rp = proj + (tok0 + t) * NI + h * 64 + 8 * c8; zq = *(const GAS u32x4*)(rp + C_HQ); zf = *(const GAS u32x4*)(rp + C_HF); zi = *(const GAS u32x4*)(rp + C_HI); }
            const u32x4 sp = *(const GAS u32x4*)(SPg + (size_t)item * 4096 + t * 64 + 8 * c8);
            *(LAS u32x4*)(SPt + t * 72 + 8 * c8) = sp;
#pragma unroll
            for (int jj = 0; jj < 8; ++jj) { const int d = 8 * c8 + jj; const unsigned wq = (jj & 1) ? (zq[jj >> 1] >> 16) : (zq[jj >> 1] & 0xffffu);
                const unsigned wf = (jj & 1) ? (zf[jj >> 1] >> 16) : (zf[jj >> 1] & 0xffffu); const unsigned wi = (jj & 1) ? (zi[jj >> 1] >> 16) : (zi[jj >> 1] & 0xffffu);
                float lf, kk; hgrn_gate(bf2f(wf), lbA[jj], onem[jj], lf, kk);
                LF[t * 65 + d] = valid ? lf : 0.f; kv[8 * e + jj] = valid ? kk : 0.f; qv[8 * e + jj] = valid ? siluf_(bf2f(wq)) : 0.f;
                vT[d * 72 + t] = (bf16)wi; }
        }
        __syncthreads();
        { const int d = ht & 63, seg = ht >> 6; float run = 0.f;
#pragma unroll
          for (int i = 0; i < 16; ++i) { run += LF[(16 * seg + i) * 65 + d]; LF[(16 * seg + i) * 65 + d] = run; }
          SEG[seg * 64 + d] = run; }
        __syncthreads();
#pragma unroll
        for (int e = 0; e < 2; ++e) { const int idx = ht + 256 * e, t = idx >> 3, c8 = idx & 7, seg = t >> 4;
            unsigned wq[4], wk[4], ws[4];
#pragma unroll
            for (int jp = 0; jp < 4; ++jp) { float qt[2], kt[2], qs[2];
#pragma unroll
                for (int u = 0; u < 2; ++u) { const int jj = 2 * jp + u, d = 8 * c8 + jj;
                    float offs = 0.f;
#pragma unroll
                    for (int s = 0; s < 3; ++s) if (s < seg) offs += SEG[s * 64 + d];
                    const float cum = LF[t * 65 + d] + offs, mid = LF[31 * 65 + d] + SEG[d];
                    const float q = qv[8 * e + jj], k = kv[8 * e + jj];
                    qt[u] = q * __expf(cum - mid); kt[u] = k * __expf(mid - cum); qs[u] = q * __expf(cum); }
                wq[jp] = pk2(qt[0], qt[1]); wk[jp] = pk2(kt[0], kt[1]); ws[jp] = pk2(qs[0], qs[1]); }
            *(LAS u32x4*)(QT + t * 72 + 8 * c8) = (u32x4){wq[0], wq[1], wq[2], wq[3]};
            *(LAS u32x4*)(KT + t * 72 + 8 * c8) = (u32x4){wk[0], wk[1], wk[2], wk[3]};
            *(LAS u32x4*)(QS + t * 72 + 8 * c8) = (u32x4){ws[0], ws[1], ws[2], ws[3]};
        }
        __syncthreads();
        const int ar = (16 * hw + (lane & 15)) * 72 + 8 * (lane >> 4);
        {
            f32x4 sc[4];
#pragma unroll
            for (int nt = 0; nt < 4; ++nt) sc[nt] = (f32x4){0.f, 0.f, 0.f, 0.f};
#pragma unroll
            for (int ks = 0; ks < 2; ++ks) { const bf16x8 a = *(const LAS bf16x8*)(QT + ar + 32 * ks);
#pragma unroll
                for (int nt = 0; nt < 4; ++nt) { const bf16x8 bb = *(const LAS bf16x8*)(KT + (16 * nt + (lane & 15)) * 72 + 32 * ks + 8 * (lane >> 4)); sc[nt] = MFMA16(a, bb, sc[nt]); } }
#pragma unroll
            for (int nt = 0; nt < 4; ++nt)
#pragma unroll
                for (int j = 0; j < 4; ++j) { const int t = 16 * hw + 4 * (lane >> 4) + j, s = 16 * nt + (lane & 15); P[t * 72 + s] = (bf16)f2bf(s <= t ? sc[nt][j] : 0.f); }
        }
        __syncthreads();
        f32x4 o[4];
#pragma unroll
        for (int nt = 0; nt < 4; ++nt) o[nt] = (f32x4){0.f, 0.f, 0.f, 0.f};
#pragma unroll
        for (int ks = 0; ks < 2; ++ks) { const bf16x8 a = *(const LAS bf16x8*)(P + ar + 32 * ks), a2 = *(const LAS bf16x8*)(QS + ar + 32 * ks);
#pragma unroll
            for (int nt = 0; nt < 4; ++nt) { const int br = (16 * nt + (lane & 15)) * 72 + 32 * ks + 8 * (lane >> 4);
                o[nt] = MFMA16(a, *(const LAS bf16x8*)(vT + br), o[nt]); o[nt] = MFMA16(a2, *(const LAS bf16x8*)(SPt + br), o[nt]); } }
#pragma unroll
        for (int j = 0; j < 4; ++j) { const int t = 16 * hw + 4 * (lane >> 4) + j;
            float ssq = o[0][j] * o[0][j] + o[1][j] * o[1][j] + o[2][j] * o[2][j] + o[3][j] * o[3][j];
            ssq += __shfl_xor(ssq, 1); ssq += __shfl_xor(ssq, 2); ssq += __shfl_xor(ssq, 4); ssq += __shfl_xor(ssq, 8);
            const float rn = rsqrtf(ssq * (1.f / 64.f) + RMS_EPS);
            if (t < nrows) {
#pragma unroll
                for (int nt = 0; nt < 4; ++nt) { const int v = 16 * nt + (lane & 15);
                    const float zg = bf2f(proj[(tok0 + t) * NI + C_HG + h * 64 + v]);
                    mixed[(tok0 + t) * D + 256 + h * 64 + v] = (bf16)f2bf(o[nt][j] * rn * ng[v] * siluf_(zg)); } } }
        __syncthreads();
    }
}

constexpr int AT_KP = 272;
constexpr int AT_KB = 64 * AT_KP, AT_VB = 16384, AT_K = 0, AT_V = 2 * AT_KB, AT_Q = AT_V + 2 * AT_VB;
typedef short v4i16_t __attribute__((ext_vector_type(4)));
__device__ __forceinline__ s16x4 vtr(const LAS unsigned char* p) { return __builtin_bit_cast(s16x4, __builtin_amdgcn_ds_read_tr16_b64_v4i16((LAS v4i16_t*)p)); }
__device__ __forceinline__ float u2f_(unsigned u) { return __builtin_bit_cast(float, u); }
__device__ __forceinline__ float xhalf_max(float v) { const unsigned a = __builtin_bit_cast(unsigned, v); auto rr = __builtin_amdgcn_permlane32_swap(a, a, false, false); const unsigned r0 = rr[0], r1 = rr[1]; return fmaxf(u2f_(r0), u2f_(r1)); }
__device__ __forceinline__ float xhalf_sum(float v) { const unsigned a = __builtin_bit_cast(unsigned, v); auto rr = __builtin_amdgcn_permlane32_swap(a, a, false, false); const unsigned r0 = rr[0], r1 = rr[1]; return u2f_(r0) + u2f_(r1); }
__device__ __forceinline__ int crow(int r, int hi) { return (r & 3) + 8 * (r >> 2) + 4 * hi; }
__device__ __forceinline__ void attn_unit(const Frame& F, int b, int h, int j, const float* subg) {
    const bf16* proj = (const bf16*)(F.ws + WS_PROJ); bf16* mixed = (bf16*)(F.ws + WS_MIXED);
    int tid_ = F.wave * 64 + lane_id_(); LAUNDER(tid_);
    const int tid = tid_, lane = tid & 63, w = F.wave, r32 = lane & 31, hi = lane >> 5;
    const int qbase = (j == 0) ? 0 : 16 + 256 * (j - 1), ntile = (j == 0) ? 1 : 4 * j + 1;
    const int qrow = qbase + 32 * w + r32;
    const bf16* pb = proj + (size_t)b * LT * NI + h * 128;
    bf16* ob = mixed + ((size_t)b * LT + qbase + 32 * w) * D + 512 + h * 128;
    const __amdgpu_buffer_rsrc_t prs = __builtin_amdgcn_make_buffer_rsrc((void*)pb, 0, 0x7fffffff, 0x00020000);
    LAS unsigned char* Kc = F.lds + AT_K; LAS unsigned char* Vc = F.lds + AT_V;
    const unsigned vo_k0 = (unsigned)(((tid >> 4) * NI + C_AK + 8 * (tid & 15)) * 2), vo_k1 = vo_k0 + (unsigned)(32 * NI * 2);
    const unsigned vo_v0 = (unsigned)(((tid >> 4) * NI + C_AV + 8 * (tid & 15)) * 2), vo_v1 = vo_v0 + (unsigned)(32 * NI * 2);
    const int kst = (tid >> 4) * AT_KP + (tid & 15) * 16;
    const int vst = ((tid & 15) >> 2) * 4096 + (tid >> 4) * 64 + (tid & 3) * 16;
    const int krd = r32 * AT_KP + 16 * hi;
    const int vrd = (4 * hi + ((lane & 15) >> 2)) * 64 + ((lane >> 4) & 1) * 32 + (lane & 3) * 8;
    LAS unsigned char* Qw = F.lds + AT_Q + (tid >> 6) * (32 * AT_KP);
    __syncthreads();
    {
        const unsigned vq = (unsigned)(((qbase + 32 * w + (lane >> 1)) * NI + C_AQ + 64 * (lane & 1)) * 2);
#pragma unroll
        for (int c = 0; c < 8; ++c) *(LAS u32x4*)(Qw + (lane >> 1) * AT_KP + (lane & 1) * 128 + 16 * c) = bufld16(prs, vq + 16 * c, 0u);
    }
    const LAS unsigned char* Qr = Qw + r32 * AT_KP + 16 * hi;
    f32x16 O[2][4];
#pragma unroll
    for (int comp = 0; comp < 2; ++comp)
#pragma unroll
        for (int vb = 0; vb < 4; ++vb)
#pragma unroll
            for (int r = 0; r < 16; ++r) O[comp][vb][r] = 0.f;
    float mrun[2] = {-1e30f, -1e30f}, lrun[2] = {0.f, 0.f};
    u32x4 kreg0, kreg1, vreg0, vreg1;
#define AT_ISSUE(i_) do { const int kb_ = ((i_) == 0) ? 0 : 16 + 64 * ((i_) - 1); const unsigned so_ = (unsigned)(kb_ * NI * 2); \
        kreg0 = bufld16(prs, vo_k0, so_); kreg1 = bufld16(prs, vo_k1, so_); vreg0 = bufld16(prs, vo_v0, so_); vreg1 = bufld16(prs, vo_v1, so_); } while (0)
#define AT_COMMIT(buf_) do { *(LAS u32x4*)(Kc + (buf_) * AT_KB + kst) = kreg0; *(LAS u32x4*)(Kc + (buf_) * AT_KB + kst + 32 * AT_KP) = kreg1; \
        *(LAS u32x4*)(Vc + (buf_) * AT_VB + vst) = vreg0; *(LAS u32x4*)(Vc + (buf_) * AT_VB + vst + 32 * 64) = vreg1; } while (0)
    AT_ISSUE(0); AT_COMMIT(0);
    __syncthreads();
#pragma unroll 1
    for (int i = 0; i < ntile; ++i) {
        const int buf = i & 1, kb = (i == 0) ? 0 : 16 + 64 * (i - 1);
        const LAS unsigned char* Kb = Kc + buf * AT_KB + krd; const LAS unsigned char* Vb = Vc + buf * AT_VB + vrd;
        const bool domask = (i == 0 || i >= ntile - 4);
        if (i + 1 < ntile) AT_ISSUE(i + 1);
#pragma unroll
        for (int comp = 0; comp < 2; ++comp) {
            f32x16 sT[2]; bf16x8 pf[4];
#pragma unroll
            for (int kblk = 0; kblk < 2; ++kblk) {
#pragma unroll
                for (int r = 0; r < 16; ++r) sT[kblk][r] = 0.f;
#pragma unroll
                for (int ks = 0; ks < 4; ++ks) { const bf16x8 kf = *(const LAS bf16x8*)(Kb + (32 * kblk) * AT_KP + comp * 128 + 32 * ks); const bf16x8 qq = *(const LAS bf16x8*)(Qr + comp * 128 + 32 * ks); sT[kblk] = MFMA32(kf, qq, sT[kblk]); }
                __builtin_amdgcn_sched_barrier(0);
            }
            if (domask) {
#pragma unroll
                for (int kblk = 0; kblk < 2; ++kblk)
#pragma unroll
                    for (int r = 0; r < 16; ++r) { const int kl = 32 * kblk + crow(r, hi); const bool ok = (kb + kl <= qrow) && (i > 0 || kl < 16); if (!ok) sT[kblk][r] = -INFINITY; }
            }
            float mx = sT[0][0];
#pragma unroll
            for (int r = 1; r < 16; ++r) mx = fmaxf(mx, sT[0][r]);
#pragma unroll
            for (int r = 0; r < 16; ++r) mx = fmaxf(mx, sT[1][r]);
            mx = xhalf_max(mx);
            const float mnew = fmaxf(mrun[comp], mx), alpha = __builtin_amdgcn_exp2f(mrun[comp] - mnew);
            float psum = 0.f;
#pragma unroll
            for (int kblk = 0; kblk < 2; ++kblk)
#pragma unroll
                for (int r = 0; r < 16; ++r) { const float pv = __builtin_amdgcn_exp2f(sT[kblk][r] - mnew); sT[kblk][r] = pv; psum += pv; }
            psum = xhalf_sum(psum);
            lrun[comp] = lrun[comp] * alpha + psum; mrun[comp] = mnew;
#pragma unroll
            for (int vb = 0; vb < 4; ++vb)
#pragma unroll
                for (int r = 0; r < 16; ++r) O[comp][vb][r] *= alpha;
#pragma unroll
            for (int kblk = 0; kblk < 2; ++kblk)
#pragma unroll
                for (int s = 0; s < 2; ++s) {
                    u32x4 pw; pw.x = cvt_pk_bf16(sT[kblk][8 * s + 0], sT[kblk][8 * s + 1]); pw.y = cvt_pk_bf16(sT[kblk][8 * s + 2], sT[kblk][8 * s + 3]);
                    pw.z = cvt_pk_bf16(sT[kblk][8 * s + 4], sT[kblk][8 * s + 5]); pw.w = cvt_pk_bf16(sT[kblk][8 * s + 6], sT[kblk][8 * s + 7]);
                    pf[2 * kblk + s] = __builtin_bit_cast(bf16x8, pw); }
            __builtin_amdgcn_sched_barrier(0);
#pragma unroll
            for (int ks4 = 0; ks4 < 4; ++ks4)
#pragma unroll
                for (int vb = 0; vb < 4; ++vb) { const LAS unsigned char* vp = Vb + vb * 4096 + (16 * ks4) * 64;
                    const s16x4 lo = vtr(vp), hh = vtr(vp + 8 * 64);
                    const bf16x8 vf = (bf16x8){lo[0], lo[1], lo[2], lo[3], hh[0], hh[1], hh[2], hh[3]};
                    O[comp][vb] = MFMA32(vf, pf[ks4], O[comp][vb]);
                    if (vb & 1) __builtin_amdgcn_sched_barrier(0); }
            __builtin_amdgcn_sched_barrier(0);
        }
        if (i + 1 < ntile) AT_COMMIT(buf ^ 1);
        __syncthreads();
    }
#undef AT_ISSUE
#undef AT_COMMIT
    int tid2 = lane_id_(); LAUNDER(tid2);
    const int r32e = tid2 & 31, hie = (tid2 >> 5) & 1;
    const unsigned vo_o = (unsigned)((r32e * D + 4 * hie) * 2);
    const bool rowok = (j > 0) || (32 * w + r32e < 16);
    const float lam = ((const LAS float*)(F.lds + MISC_OFF))[16], oscale = ((const LAS float*)(F.lds + MISC_OFF))[17];
    const float l0inv = 1.f / lrun[0], l1s = lam / lrun[1];
    float ssq = 0.f;
#pragma unroll
    for (int vb = 0; vb < 4; ++vb)
#pragma unroll
        for (int r = 0; r < 16; ++r) { const float a = O[0][vb][r] * l0inv - O[1][vb][r] * l1s; O[0][vb][r] = a; ssq += a * a; }
    ssq = xhalf_sum(ssq);
    const float rn = rsqrtf(ssq * (1.f / 128.f) + RMS_EPS) * oscale;
    if (rowok) {
#pragma unroll
        for (int vb = 0; vb < 4; ++vb)
#pragma unroll
            for (int g4 = 0; g4 < 4; ++g4) { const f32x4 sg = ldg<f32x4>(subg, (unsigned)((32 * vb + 8 * g4 + 4 * hie) * 4));
                u32x2 wv; wv.x = pk2(O[0][vb][4 * g4 + 0] * rn * sg[0], O[0][vb][4 * g4 + 1] * rn * sg[1]); wv.y = pk2(O[0][vb][4 * g4 + 2] * rn * sg[2], O[0][vb][4 * g4 + 3] * rn * sg[3]);
                stg<u32x2>(ob, vo_o + (unsigned)((32 * vb + 8 * g4) * 2), wv); }
    }
}
__device__ __forceinline__ void attn_phase(const Frame& F0, int l) {
    Frame F = F0; F.tid = F.wave * 64 + lane_id_(); LAUNDER(F.tid); F.lane = F.tid & 63;
    float s1 = 0.f, s2 = 0.f;
    for (int i = 0; i < 64; ++i) { s1 += F.in[IN_LQ1][l * 64 + i] * F.in[IN_LK1][l * 64 + i]; s2 += F.in[IN_LQ2][l * 64 + i] * F.in[IN_LK2][l * 64 + i]; }
    const float lam_init = 0.8f - 0.6f * expf(-0.3f * (float)l);
    { const float lam = expf(s1) - expf(s2) + lam_init; if (F.tid == 0) { ((LAS float*)(F.lds + MISC_OFF))[16] = lam; ((LAS float*)(F.lds + MISC_OFF))[17] = 1.f - lam_init; } }
    __syncthreads();
    const float* subg = F.in[IN_SUBLN] + l * 128;
    const int npair = (512 - F.wg + F.G - 1) / F.G, nmeta = (F.wg < NB * 4) ? (NB * 4 - F.wg + F.G - 1) / F.G : 0;
#pragma unroll 1
    for (int k = 0; k < 2 * npair + nmeta; ++k) {
        int bh, j;
        if (k < 2 * npair) { const int p = F.wg + (k >> 1) * F.G; bh = p >> 2; const int s = p & 3; j = (k & 1) ? s + 1 : 8 - s; }
        else { bh = F.wg + (k - 2 * npair) * F.G; j = 0; }
        attn_unit(F, bh >> 2, bh & 3, j, subg);
    }
}

constexpr int RT_WP = 1032;
__device__ __forceinline__ void router_phase(const Frame& F0, int l) {
    Frame F = F0; F.tid = F.wave * 64 + lane_id_(); LAUNDER(F.tid); F.lane = F.tid & 63;
    const float* H = (const float*)(F.ws + WS_H); const bf16* WR = (const bf16*)(F.ws + WS_WR) + (size_t)l * 2 * 32 * 1024;
    float* rstd = (float*)(F.ws + WS_RSTD); float* gate = (float*)(F.ws + WS_GATE); int* buck = (int*)(F.ws + WS_BUCK);
    unsigned* gcnt = (unsigned*)F.ws + CW_CNT + l * 64;
    LAS bf16* Wh = (LAS bf16*)F.lds;
    LAS bf16* Wl = Wh + 20 * RT_WP;
    LAS float* LG = (LAS float*)(F.lds + 2 * 20 * RT_WP * 2);
    LAS int* lcnt = (LAS int*)(LG + 8 * 16 * 33);
    LAS int* lbase = lcnt + 32;
    LAS int* tcls = lbase + 32;
    LAS int* tpos = tcls + 288;
    const int lane = F.lane, w = F.wave, fr = lane & 15, fq = lane >> 4;
    constexpr int NTASK = T / 16;
    const int ntl = (NTASK - F.wg + F.G - 1) / F.G;
    __syncthreads();
    for (int idx = F.tid; idx < 2 * 20 * 128; idx += 512) { const int hl = idx / (20 * 128), r = (idx / 128) % 20, c = idx % 128;
        *(LAS u32x4*)((hl ? Wl : Wh) + r * RT_WP + 8 * c) = *(const GAS u32x4*)(WR + (size_t)hl * 32 * 1024 + r * 1024 + 8 * c); }
    if (F.tid < 32) lcnt[F.tid] = 0;
    __syncthreads();
    const int n1 = (16 + fr < 20) ? 16 + fr : 19;
    for (int k = w; k < ntl; k += 8) {
        const int task = F.wg + k * F.G;
        const float* hrow = H + (size_t)task * 16 * D;
        const unsigned vo = (unsigned)((fr * D + 8 * fq) * 4);
        f32x4 acc[2]; acc[0] = (f32x4){0.f, 0.f, 0.f, 0.f}; acc[1] = acc[0];
        float ssq = 0.f;
#pragma unroll 8
        for (int ks = 0; ks < 32; ++ks) {
            const f32x4 x0 = ldg<f32x4>(hrow, vo + ks * 128), x1 = ldg<f32x4>(hrow, vo + ks * 128 + 16);
            ssq += (x0[0] * x0[0] + x0[1] * x0[1]) + (x0[2] * x0[2] + x0[3] * x0[3]) + (x1[0] * x1[0] + x1[1] * x1[1]) + (x1[2] * x1[2] + x1[3] * x1[3]);
            unsigned hw_[4], lw_[4];
#pragma unroll
            for (int q = 0; q < 4; ++q) { const float a = (q < 2) ? x0[2 * q] : x1[2 * q - 4], bq = (q < 2) ? x0[2 * q + 1] : x1[2 * q - 3];
                const unsigned ha = f2bf(a), hb = f2bf(bq); hw_[q] = ha | (hb << 16); lw_[q] = pk2(a - bf2f(ha), bq - bf2f(hb)); }
            const bf16x8 ahi = __builtin_bit_cast(bf16x8, (u32x4){hw_[0], hw_[1], hw_[2], hw_[3]}), alo = __builtin_bit_cast(bf16x8, (u32x4){lw_[0], lw_[1], lw_[2], lw_[3]});
            const bf16x8 bh0 = *(const LAS bf16x8*)(Wh + fr * RT_WP + 32 * ks + 8 * fq), bl0 = *(const LAS bf16x8*)(Wl + fr * RT_WP + 32 * ks + 8 * fq);
            const bf16x8 bh1 = *(const LAS bf16x8*)(Wh + n1 * RT_WP + 32 * ks + 8 * fq), bl1 = *(const LAS bf16x8*)(Wl + n1 * RT_WP + 32 * ks + 8 * fq);
            acc[0] = MFMA16(ahi, bh0, acc[0]); acc[0] = MFMA16(alo, bh0, acc[0]); acc[0] = MFMA16(ahi, bl0, acc[0]);
            acc[1] = MFMA16(ahi, bh1, acc[1]); acc[1] = MFMA16(alo, bh1, acc[1]); acc[1] = MFMA16(ahi, bl1, acc[1]);
        }
        ssq += __shfl_xor(ssq, 16); ssq += __shfl_xor(ssq, 32);
        const float rs = rsqrtf(ssq * (1.f / 1024.f) + RMS_EPS);
#pragma unroll
        for (int nt = 0; nt < 2; ++nt)
#pragma unroll
            for (int j = 0; j < 4; ++j) LG[w * 16 * 33 + (4 * fq + j) * 33 + 16 * nt + fr] = acc[nt][j];
        LDS_WAIT(); asm volatile("" ::: "memory");
        if (lane < 16) {
            const int tl = k * 16 + lane; const size_t m = (size_t)task * 16 + lane;
            const float rsm = rs;
            const LAS float* lg = LG + w * 16 * 33 + lane * 33;
            float gl[4]; float gm = -1e30f; int gi = 0;
#pragma unroll
            for (int q = 0; q < 4; ++q) { gl[q] = lg[q] * rsm + F.in[IN_BGRP][l * 4 + q]; if (gl[q] > gm) { gm = gl[q]; gi = q; } }
            float gs = 0.f;
#pragma unroll
            for (int q = 0; q < 4; ++q) gs += __expf(gl[q] - gm);
            const float gp = 1.f / gs;
            float el[4];
#pragma unroll
            for (int q = 0; q < 4; ++q) el[q] = lg[4 + 4 * gi + q] * rsm + F.in[IN_BEXP][l * 16 + 4 * gi + q];
            int i1 = 0; float v1 = el[0];
#pragma unroll
            for (int q = 1; q < 4; ++q) if (el[q] > v1) { v1 = el[q]; i1 = q; }
            int i2 = -1; float v2 = -1e30f;
#pragma unroll
            for (int q = 0; q < 4; ++q) if (q != i1 && el[q] > v2) { v2 = el[q]; i2 = q; }
            const float e2 = __expf(v2 - v1), w1 = gp / (1.f + e2), w2 = gp * e2 / (1.f + e2);
            const int a = i1 < i2 ? i1 : i2, bq = i1 < i2 ? i2 : i1;
            const int pidx = (a == 0) ? (bq - 1) : (a == 1 ? bq + 1 : 5);
            const int cls = gi * 6 + pidx;
            rstd[m] = rsm; gate[2 * m] = (a == i1) ? w1 : w2; gate[2 * m + 1] = (a == i1) ? w2 : w1;
            tcls[tl] = cls; tpos[tl] = atomicAdd((int*)&lcnt[cls], 1);
        }
    }
    __syncthreads();
    if (F.tid < NCLS) lbase[F.tid] = (int)atomicAdd(&gcnt[F.tid], (unsigned)lcnt[F.tid]);
    __syncthreads();
    if (F.tid < ntl * 16) { const int cls = tcls[F.tid]; buck[(size_t)cls * T + lbase[cls] + tpos[F.tid]] = (F.wg + (F.tid >> 4) * F.G) * 16 + (F.tid & 15); }
    __syncthreads();
}

__device__ __forceinline__ void final_phase(const Frame& F0, float* out) {
    Frame F = F0; F.tid = F.wave * 64 + lane_id_(); LAUNDER(F.tid); F.lane = F.tid & 63;
    const float* H = (const float*)(F.ws + WS_H); const float* g = F.in[IN_FNG];
    const int gw = F.wg * 8 + F.wave, NGW = F.G * 8, lane = F.lane;
    for (int r = gw; r < NB * SEQ; r += NGW) {
        const int b = r / SEQ, t = r % SEQ; const size_t m = (size_t)b * LT + NMETA + t;
        const GAS f32x4* hr = (const GAS f32x4*)(H + m * D) + lane; GAS f32x4* orow = (GAS f32x4*)(out + (size_t)r * D) + lane;
        f32x4 v[4]; float s = 0.f;
#pragma unroll
        for (int j = 0; j < 4; ++j) { v[j] = hr[64 * j]; s += (v[j].x * v[j].x + v[j].y * v[j].y) + (v[j].z * v[j].z + v[j].w * v[j].w); }
        const float rs = rsqrtf(wave_sum(s) * (1.f / 1024.f) + RMS_EPS);
#pragma unroll
        for (int j = 0; j < 4; ++j) { const f32x4 gg = *((const GAS f32x4*)g + lane + 64 * j); orow[64 * j] = v[j] * rs * gg; }
    }
}

template <int NPN>
__device__ __forceinline__ int moe_prepare(const Frame& F0, int l, LAS int* cntl, LAS int* tab) {
    Frame F = F0; F.tid = F.wave * 64 + lane_id_(); LAUNDER(F.tid); F.lane = F.tid & 63;
    const unsigned* gcnt = (const unsigned*)F.ws + CW_CNT + l * 64; const int* buck = (const int*)(F.ws + WS_BUCK);
    __syncthreads();
    if (F.tid < NCLS) cntl[F.tid] = (int)gcnt[F.tid];
    __syncthreads();
    MoeList ml{cntl}; const int ntl = ml.ntiles();
    for (int i = 0;; ++i) { const int Lx = i * F.G + F.wg; if (Lx >= ntl * NPN) break;
        int c, ti, nv; ml.decode(Lx / NPN, c, ti, nv);
        if (F.tid < 256) tab[i * 256 + F.tid] = (F.tid < nv) ? buck[(size_t)c * T + ti * 256 + F.tid] : -1; }
    __syncthreads();
    return ntl;
}

#ifndef ONLY_MASK
#define ONLY_MASK 0xFFFFFFFFu
#endif
#define IN(k) (lo <= (k) && (k) < hi)
#define EN(j) ((ONLY_MASK >> (j)) & 1u)
#ifndef SUBMASK
#define SUBMASK 3u
#endif
#define SEAM(k) do { if (IN(k) && IN((k) + 1)) xcd_barrier(bar); } while (0)
template <int L>
__device__ __forceinline__ void layer_phases(const Frame& F, const XcdBarrier& bar, int lo, int hi) {
    bf16* proj = (bf16*)(F.ws + WS_PROJ); bf16* mixed = (bf16*)(F.ws + WS_MIXED); float* H = (float*)(F.ws + WS_H); bf16* HB = (bf16*)(F.ws + WS_HB);
    float* ss16 = (float*)(F.ws + WS_SS16);
    LAS int* tab = (LAS int*)(F.lds + TAB_OFF); LAS int* cntl = (LAS int*)(F.lds + TAB_OFF + 12 * 1024);
    constexpr int l = L; constexpr int pb = 1 + 9 * L;
        if (EN(1) && IN(pb + 0)) {
            PolIn P; P.ord.init(MT, NI / 256, F.G, F.wg); P.A = HB; P.B = (const bf16*)(F.ws + WS_WIN) + (size_t)l * NI * D; P.proj = proj; P.ss16 = ss16; P.rope = (const float*)(F.ws + WS_ROPE);
            for (int rep = 0; rep < NREP(1); ++rep) pg8::gemm_phase(F.lds, P, F.wave); }
        SEAM(pb + 0);
        if (EN(2) && IN(pb + 1)) {
            PolS5E P; P.G = F.G; P.c = F.wg; P.proj = proj; P.B = (const bf16*)(F.ws + WS_S5P) + (size_t)l * 16 * 256 * 256; P.E = (float*)(F.os + OS_E);
            for (int rep = 0; rep < NREP(2); ++rep) if (MIXSEL & 1u) pg8::gemm_phase(F.lds, P, F.wave);
            __syncthreads();
            for (int rep = 0; rep < NREP(11); ++rep) if (MIXSEL & 2u) hgrn_a(F, l); }
        SEAM(pb + 1);
        if (EN(3) && IN(pb + 2)) { for (int rep = 0; rep < NREP(3); ++rep) { if (MIXSEL & 1u) s5_scan(F, l); if (MIXSEL & 2u) hgrn_b(F); } }
        SEAM(pb + 2);
        if (EN(4) && IN(pb + 3)) {
            PolS5Y P; P.G = F.G; P.c = F.wg; P.X = (const bf16*)(F.os + OS_X); P.B = (const bf16*)(F.ws + WS_S5TQ) + (size_t)l * 16 * 256 * 384; P.proj = proj; P.dsk = F.in[IN_S5D] + l * 256; P.Gout = (bf16*)(F.os + OS_G);
            for (int rep = 0; rep < NREP(4); ++rep) if ((SUBMASK & MIXSEL & 1u) != 0u) pg8::gemm_phase(F.lds, P, F.wave);
            __syncthreads();
            for (int rep = 0; rep < NREP(12); ++rep) if ((SUBMASK & MIXSEL & 2u) != 0u) hgrn_c(F, l); }
        SEAM(pb + 3);
        if (EN(5) && IN(pb + 4)) {
            PolGlu P; P.ord.init(MT, 2, F.G, F.wg); P.A = (const bf16*)(F.os + OS_G); P.B = (const bf16*)(F.ws + WS_WGLU) + (size_t)l * 512 * 256; P.mixed = mixed;
            for (int rep = 0; rep < NREP(5); ++rep) if ((SUBMASK & MIXSEL & 1u) != 0u) pg8::gemm_phase(F.lds, P, F.wave);
            __syncthreads();
            for (int rep = 0; rep < NREP(13); ++rep) if ((SUBMASK & 2u) != 0u && (MIXSEL & 4u) != 0u) attn_phase(F, l); }
        SEAM(pb + 4);
        if (EN(6) && IN(pb + 5)) {
            PolOut P; P.ord.init(MT, 4, F.G, F.wg); P.A = mixed; P.B = (const bf16*)(F.ws + WS_WOUT) + (size_t)l * D * D; P.H = H; P.HB = HB; P.ss16 = ss16;
            pg8::gemm_phase(F.lds, P, F.wave); }
        SEAM(pb + 5);
        if (EN(7) && IN(pb + 6)) { router_phase(F, l); }
        SEAM(pb + 6);
        if (EN(8) && IN(pb + 7)) {
            PolGU P; P.G = F.G; P.c = F.wg; P.ntl = moe_prepare<8>(F, l, cntl, tab); P.ml = MoeList{cntl}; P.tab = tab;
            P.HB = HB; P.W = (const bf16*)(F.ws + WS_WGU) + (size_t)l * 16 * 1024 * 1024; P.he = proj; P.rstd = (const float*)(F.ws + WS_RSTD); P.gate = (const float*)(F.ws + WS_GATE);
            for (int rep = 0; rep < NREP(8); ++rep) pg8::gemm_phase(F.lds, P, F.wave); }
        SEAM(pb + 7);
        if (EN(9) && IN(pb + 8)) {
            PolDN P; P.G = F.G; P.c = F.wg; P.ntl = moe_prepare<4>(F, l, cntl, tab); P.ml = MoeList{cntl}; P.tab = tab;
            P.he = proj; P.W = (const bf16*)(F.ws + WS_WDN) + (size_t)l * 16 * 1024 * 512; P.H = H; P.HB = HB; P.ss16 = ss16;
            pg8::gemm_phase(F.lds, P, F.wave); }
        SEAM(pb + 8);
}

__global__ void __launch_bounds__(512, 2) hymba_fwd(Args args) {
    extern __shared__ __attribute__((aligned(16))) unsigned char lds_raw[];
    Frame F;
    F.lds = (LAS unsigned char*)lds_raw;
    F.tid = threadIdx.x; F.lane = F.tid & 63; F.wave = __builtin_amdgcn_readfirstlane(F.tid >> 6);
    F.G = gridDim.x; F.wg = blockIdx.x; F.in = args.in; F.ws = args.ws; F.os = (unsigned char*)args.out;
    volatile LAS unsigned* MISC = (volatile LAS unsigned*)(F.lds + MISC_OFF);
    if (F.tid < 256) MISC[F.tid] = 0u;
    __syncthreads();
    const int lo = args.ph_lo, hi = args.ph_hi;
    const bool one = (hi - lo) > 1;
    XcdBarrier bar; bar.bar = (unsigned*)F.ws + CW_BAR; bar.x = 0; bar.st = nullptr;
    bar.wave = F.wave;
    if (one) bar = xcd_barrier_post((unsigned*)F.ws + CW_BAR, MISC + 8, F.wave);
    if (EN(0) && IN(0)) { for (int rep = 0; rep < NREP(0); ++rep) p0_prologue(F); } SEAM(0);
    layer_phases<0>(F, bar, lo, hi);
    layer_phases<1>(F, bar, lo, hi);
    if (EN(10) && IN(19)) for (int rep = 0; rep < NREP(10); ++rep) final_phase(F, args.out);
#undef IN
#undef SEAM
}

extern "C" void kernel_launch(void* const* d_in, const int* in_sizes, int n_in, void* d_out, int out_size, void* d_ws, size_t ws_size, hipStream_t stream) {
    static int grid = 0;
    if (grid == 0) {
        if (n_in != 30 || ws_size < WS_END) { fprintf(stderr, "kernel_launch: unexpected inputs (n_in %d, ws %zu < %zu)\n", n_in, ws_size, (size_t)WS_END); grid = -1; return; }
        int dev = 0, cus = 0, per_cu = 0;
        (void)hipGetDevice(&dev); (void)hipDeviceGetAttribute(&cus, hipDeviceAttributeMultiprocessorCount, dev);
        (void)hipFuncSetAttribute((const void*)hymba_fwd, hipFuncAttributeMaxDynamicSharedMemorySize, LDS_BYTES);
        (void)hipOccupancyMaxActiveBlocksPerMultiprocessor(&per_cu, (const void*)hymba_fwd, 512, LDS_BYTES);
        (void)hipGetLastError();
        grid = cus > 0 ? cus : 256;
    }
    if (grid < 0) return;
    (void)hipMemsetAsync(d_ws, 0, CTL_BYTES, stream);
    Args a{};
    for (int i = 0; i < 30; ++i) a.in[i] = (const float*)d_in[i];
    a.out = (float*)d_out; a.ws = (unsigned char*)d_ws;
#if N_LAUNCH_MODE == 1
    a.ph_lo = 0; a.ph_hi = LAST_PHASE;
    hipLaunchKernelGGL(hymba_fwd, dim3(grid), dim3(512), LDS_BYTES, stream, a);
#else
    if (MIXSEL != 7u) (void)hipMemsetAsync((char*)d_ws + WS_MIXED, 0, (size_t)T * D * 2, stream);
    for (int p = 0; p < LAST_PHASE; ++p) { if (!((RUN_MASK >> p) & 1u)) continue; a.ph_lo = p; a.ph_hi = p + 1; hipLaunchKernelGGL(hymba_fwd, dim3(grid), dim3(512), LDS_BYTES, stream, a); }
#endif
}
```

```cpp
#include <hip/hip_runtime.h>
#include <stdint.h>
#include <stdio.h>

#ifndef N_LAUNCH_MODE
#define N_LAUNCH_MODE 1
#endif
#ifndef LAST_PHASE
#define LAST_PHASE 20
#endif
#ifndef RUN_MASK
#define RUN_MASK 0xFFFFFu
#endif
#ifndef REPMASK
#define REPMASK 0u
#endif
#define NREP(j) (((REPMASK >> (j)) & 1u) ? 2 : 1)
#ifndef MIXSEL
#define MIXSEL 7u
#endif

#define GAS __attribute__((address_space(1)))
#define LAS __attribute__((address_space(3)))
typedef unsigned short bf16;
typedef short bf16x8 __attribute__((ext_vector_type(8)));
typedef short s16x4 __attribute__((ext_vector_type(4)));
typedef float f32x2 __attribute__((ext_vector_type(2)));
typedef float f32x4 __attribute__((ext_vector_type(4)));
typedef float f32x16 __attribute__((ext_vector_type(16)));
typedef unsigned u32x2 __attribute__((ext_vector_type(2)));
typedef unsigned u32x4 __attribute__((ext_vector_type(4)));

constexpr int NB = 32, LT = 2064, NMETA = 16, SEQ = 2048, T = NB * LT;
constexpr int D = 1024, NI = 2816, MT = T / 256;
constexpr int C_U = 0, C_HQ = 256, C_HF = 512, C_HI = 768, C_HG = 1024, C_AQ = 1280, C_AK = 1792, C_AV = 2304;
constexpr int NCH = 129;
constexpr int S5R = NB * NCH;
constexpr int S5RP = 17 * 256;
constexpr int HCH = 33;
constexpr int NCLS = 24;
constexpr float RMS_EPS = 1e-6f;
constexpr float QSCALE = 0.125f * 1.4426950408889634f;

constexpr size_t al256(size_t x) { return (x + 255) & ~(size_t)255; }
constexpr size_t CTL_BYTES = 1u << 20;
constexpr size_t WS_WIN = CTL_BYTES;
constexpr size_t WS_WOUT = WS_WIN + al256((size_t)2 * NI * D * 2);
constexpr size_t WS_WGLU = WS_WOUT + al256((size_t)2 * D * D * 2);
constexpr size_t WS_WGU = WS_WGLU + al256((size_t)2 * 512 * 256 * 2);
constexpr size_t WS_WDN = WS_WGU + al256((size_t)2 * 16 * 1024 * 1024 * 2);
constexpr size_t WS_WR = WS_WDN + al256((size_t)2 * 16 * 1024 * 512 * 2);
constexpr size_t WS_S5TQ = WS_WR + al256((size_t)2 * 2 * 32 * 1024 * 2);
constexpr size_t WS_S5P = WS_S5TQ + al256((size_t)2 * 16 * 256 * 384 * 2);
constexpr size_t WS_S5A = WS_S5P + al256((size_t)2 * 16 * 256 * 256 * 2);
constexpr size_t WS_ROPE = WS_S5A + al256((size_t)2 * 16 * 64 * 8);
constexpr size_t WS_SS16 = WS_ROPE + al256((size_t)LT * 32 * 4 * 2);
constexpr size_t WS_RSTD = WS_SS16 + al256((size_t)T * 16 * 4);
constexpr size_t WS_GATE = WS_RSTD + al256((size_t)T * 4);
constexpr size_t WS_BUCK = WS_GATE + al256((size_t)T * 8);
constexpr size_t WS_HB = WS_BUCK + al256((size_t)NCLS * T * 4);
constexpr size_t WS_PROJ = WS_HB + al256((size_t)T * D * 2);
constexpr size_t WS_MIXED = WS_PROJ + al256((size_t)T * NI * 2);
constexpr size_t WS_END = WS_MIXED + al256((size_t)T * D * 2);
constexpr size_t OS_E = 0;
constexpr size_t OS_X = OS_E + al256((size_t)16 * S5RP * 128 * 4);
constexpr size_t OS_G = OS_X + al256((size_t)16 * S5RP * 384 * 2);
constexpr size_t OS_UT = OS_G + al256((size_t)T * 256 * 2);
constexpr size_t OS_DEC = OS_UT + al256((size_t)NB * 4 * HCH * 4096 * 4);
constexpr size_t OS_SP = OS_DEC + al256((size_t)NB * 4 * HCH * 64 * 4);
constexpr size_t OS_END = OS_SP + al256((size_t)NB * 4 * HCH * 4096 * 2);
static_assert(OS_END <= (size_t)NB * SEQ * D * 4, "mixer scratch must fit in d_out");
static_assert((size_t)(MT + NCLS) * 256 * 1024 * 2 <= (size_t)T * NI * 2, "he overlay fits in proj");

constexpr int CW_BAR = 4096, CW_CNT = 16384;

constexpr int LDS_BYTES = 147456;
constexpr int RING_BYTES = 131072;
constexpr int TAB_OFF = RING_BYTES;
constexpr int MISC_OFF = LDS_BYTES - 1024;

__device__ __forceinline__ unsigned f2bf(float f) { unsigned u = __builtin_bit_cast(unsigned, f); return (u + 0x7fffu + ((u >> 16) & 1u)) >> 16; }
__device__ __forceinline__ float bf2f(unsigned b) { return __builtin_bit_cast(float, (b & 0xffffu) << 16); }
__device__ __forceinline__ unsigned pk2(float lo, float hi) { return f2bf(lo) | (f2bf(hi) << 16); }
__device__ __forceinline__ unsigned cvt_pk_bf16(float lo, float hi) { unsigned r; asm volatile("v_cvt_pk_bf16_f32 %0, %1, %2" : "=v"(r) : "v"(lo), "v"(hi)); return r; }
__device__ __forceinline__ float wave_sum(float v) {
#pragma unroll
    for (int o = 1; o < 64; o <<= 1) v += __shfl_xor(v, o);
    return v;
}
__device__ __forceinline__ float sigmoidf_(float x) { return 1.f / (1.f + __expf(-x)); }
__device__ __forceinline__ float siluf_(float x) { return x / (1.f + __expf(-x)); }
__device__ __forceinline__ float gelu_tanh(float x) { const float u = 0.7978845608028654f * (x + 0.044715f * x * x * x); return x / (1.f + __expf(-2.f * u)); }
__device__ __forceinline__ int lane_id_() { int l; asm volatile("v_mbcnt_lo_u32_b32 %0, -1, 0\n\tv_mbcnt_hi_u32_b32 %0, -1, %0" : "=v"(l)); return l; }
#define LAUNDER(x) asm volatile("" : "+v"(x))
#define LAUNDER_S(x) asm volatile("" : "+s"(x))
#define LDS_WAIT() asm volatile("s_waitcnt lgkmcnt(0)" ::: "memory")
#define VM_WAIT() asm volatile("s_waitcnt vmcnt(0)" ::: "memory")

#define XB_TMO      128
#define XB_XCNT(j)  (256  + 64 * (j))
#define XB_XSUB(j)  (1280 + 64 * (j))
#define XB_XGEN(j)  (2304 + 64 * (j))
#define XB_TOP      3328
#define XB_TOPGEN   3392
#define XCD_BAR_WORDS 3456
#define XB_SPIN_CAP (1u << 18)
__device__ __forceinline__ unsigned xb_ld(unsigned* p)              { return __hip_atomic_load(p, __ATOMIC_RELAXED, __HIP_MEMORY_SCOPE_AGENT); }
__device__ __forceinline__ unsigned xb_add(unsigned* p, unsigned v) { return __hip_atomic_fetch_add(p, v, __ATOMIC_RELAXED, __HIP_MEMORY_SCOPE_AGENT); }
__device__ __forceinline__ unsigned xb_xcc_id() { return (unsigned)__builtin_amdgcn_s_getreg((3 << 11) | 20) & 0xFu; }
#define XB_SPIN(cond, bar) do { unsigned _sp = 0; while (cond) { __builtin_amdgcn_s_sleep(1); \
    if ((++_sp & 255u) == 0u) { if (xb_ld(&(bar)[XB_TMO])) break; if (_sp > XB_SPIN_CAP) { atomicAdd(&(bar)[XB_TMO], 1u); break; } } } } while (0)
struct XcdBarrier { unsigned* bar; unsigned x; volatile LAS unsigned* st; int wave; };
__device__ __forceinline__ XcdBarrier xcd_barrier_post(unsigned* bar, volatile LAS unsigned* st, int wave) {
    XcdBarrier b; b.bar = bar; b.x = xb_xcc_id(); b.st = st; b.wave = wave;
    if (wave == 0 && lane_id_() == 0) (void)xb_add(&bar[XB_XCNT(b.x)], 1u);
    return b;
}
__device__ __forceinline__ void xcd_barrier_complete(unsigned* bar, unsigned x, unsigned& nloc, unsigned& nx) {
    const unsigned G = gridDim.x * gridDim.y * gridDim.z;
    unsigned sum, cnt, mine, sp = 0u;
    for (;;) {
        sum = 0u; cnt = 0u; mine = 0u;
#pragma unroll 1
        for (unsigned j = 0; j < 16; ++j) { const unsigned c = xb_ld(&bar[XB_XCNT(j)]); sum += c; cnt += (c > 0u) ? 1u : 0u; mine = (j == x) ? c : mine; }
        if (sum == G) break;
        __builtin_amdgcn_s_sleep(1);
        if ((++sp & 255u) == 0u) { if (xb_ld(&bar[XB_TMO])) break; if (sp > XB_SPIN_CAP) { atomicAdd(&bar[XB_TMO], 1u); break; } }
    }
    nloc = mine > 0u ? mine : 1u; nx = cnt > 0u ? cnt : 1u;
}
__device__ __forceinline__ void xcd_barrier(const XcdBarrier& b) {
    asm volatile("s_waitcnt vmcnt(0)" ::: "memory");
    __syncthreads();
    if (b.wave == 0 && lane_id_() == 0) {
        unsigned* bar = b.bar;
        __builtin_amdgcn_s_waitcnt(0);
        unsigned nloc = b.st[0], nx = b.st[1];
        if (nloc == 0u) { xcd_barrier_complete(bar, b.x, nloc, nx); b.st[0] = nloc; b.st[1] = nx; }
        const unsigned old = xb_add(&bar[XB_XSUB(b.x)], 1u);
        const unsigned gen = old / nloc;
        if (old + 1u == (gen + 1u) * nloc) {
            __builtin_amdgcn_fence(__ATOMIC_RELEASE, "agent");
            asm volatile("s_waitcnt vmcnt(0)" ::: "memory");
            const unsigned og = xb_add(&bar[XB_TOP], 1u);
            const unsigned tg = og / nx;
            if (og + 1u == (tg + 1u) * nx) xb_add(&bar[XB_TOPGEN], 1u);
            else XB_SPIN(xb_ld(&bar[XB_TOPGEN]) == tg, bar);
            __builtin_amdgcn_fence(__ATOMIC_ACQUIRE, "agent");
            xb_add(&bar[XB_XGEN(b.x)], 1u);
            asm volatile("s_waitcnt vmcnt(0)" ::: "memory");
        } else {
            XB_SPIN(xb_ld(&bar[XB_XGEN(b.x)]) == gen, bar);
            __builtin_amdgcn_fence(__ATOMIC_ACQUIRE, "agent");
            asm volatile("s_waitcnt vmcnt(0)" ::: "memory");
        }
    }
    __syncthreads();
}

namespace pg8 {
constexpr int BM = 256, BK = 64, HALF = 128, HTB = HALF * BK * 2, NXCD = 8, WGM = 8;
__host__ __device__ __forceinline__ int lds_byte(int r, int c) { const int st = (r >> 4) * 2 + (c >> 5), rr = r & 15, cc = c & 31, ob = rr * 64 + cc * 2; return st * 1024 + (ob ^ (((ob >> 9) & 1) << 5)); }
__host__ __device__ __forceinline__ void stage_rc(int b, int& R, int& C) { const int st = b / 1024, sb = b % 1024, swz = sb ^ (((sb >> 9) & 1) << 5); R = (st >> 1) * 16 + swz / 64; C = (st & 1) * 32 + (swz % 64) / 2; }
__host__ __device__ __forceinline__ int perm32(int rho) { const int n = rho >> 4, i = rho & 15; return 8 * (i >> 2) + 4 * n + (i & 3); }

struct TileOrder {
    int nM, nN, nwg, G, c;
    __device__ __forceinline__ void init(int nM_, int nN_, int G_, int c_) { nM = nM_; nN = nN_; nwg = nM * nN; G = G_; c = c_; }
    __device__ __forceinline__ bool get(int i, int& pm, int& pn) const {
        const long Lx = (long)i * G + c; if (Lx >= nwg) return false;
        int wgid = (int)Lx; { const int q = nwg / NXCD, r = nwg % NXCD, xcd = wgid % NXCD, off = wgid / NXCD; wgid = (xcd < r ? xcd * (q + 1) : r * (q + 1) + (xcd - r) * q) + off; }
        const int nig = WGM * nN, gid = wgid / nig, fm = gid * WGM, gsz = (nM - fm) < WGM ? (nM - fm) : WGM;
        pm = fm + ((wgid % nig) % gsz); pn = (wgid % nig) / gsz; return true;
    }
};

template <class P>
__device__ __forceinline__ void gemm_phase(LAS unsigned char* lds, const P& S, int wave) {
    typedef typename P::Unit Unit;
    int tid_ = wave * 64 + lane_id_(); LAUNDER(tid_);
    const int tid = tid_, wid = wave, lane = tid & 63, wr = wid >> 2, wc = wid & 3, fr = lane & 15, fq = lane >> 4;
    constexpr int nt = P::NT; constexpr int LDB = P::LDB;
    int Rs[2], Cs[2]; unsigned voffB[2];
#pragma unroll
    for (int i = 0; i < 2; ++i) { int R, C; stage_rc(tid * 16 + i * 8192, R, C); Rs[i] = R; Cs[i] = C; const int Rb = (R & ~31) + perm32(R & 31); voffB[i] = (unsigned)(Rb * LDB + C) * 2u; }
    const size_t hstepB = (size_t)HALF * LDB * 2;
    const unsigned ldsw = (unsigned)wid * 1024u;
    const int aoff = lds_byte(wr * 64 + fr, fq * 8), boff = lds_byte(wc * 32 + fr, fq * 8);
#define PG8_SA(b, h) (((b) * 2 + (h)) * HTB)
#define PG8_SB(b, h) ((4 + (b) * 2 + (h)) * HTB)
#define PG8_STAGE1(bufoff, gptr, v0, v1) do { \
        __builtin_amdgcn_global_load_lds((const unsigned*)((const char*)(gptr) + (v0)), (LAS unsigned*)(lds + (bufoff) + ldsw), 16, 0, 0); \
        __builtin_amdgcn_global_load_lds((const unsigned*)((const char*)(gptr) + (v1)), (LAS unsigned*)(lds + (bufoff) + ldsw + 8192), 16, 0, 0); } while (0)
#define PG8_STAGEB(bufoff, gptr) PG8_STAGE1(bufoff, gptr, voffB[0], voffB[1])
#define PG8_LDA(dst, b, h) do { _Pragma("unroll") for (int m = 0; m < 4; ++m) _Pragma("unroll") for (int k = 0; k < 2; ++k) dst[m][k] = *(const LAS bf16x8*)(lds + PG8_SA(b, h) + aoff + m * 2048 + k * 1024); } while (0)
#define PG8_LDB(dst, b, h) do { _Pragma("unroll") for (int n = 0; n < 2; ++n) _Pragma("unroll") for (int k = 0; k < 2; ++k) dst[n][k] = *(const LAS bf16x8*)(lds + PG8_SB(b, h) + boff + n * 2048 + k * 1024); } while (0)
#define PG8_MMA(ai, bj, At, Bt) do { __builtin_amdgcn_s_setprio(1); _Pragma("unroll") for (int m = 0; m < 4; ++m) _Pragma("unroll") for (int n = 0; n < 2; ++n) _Pragma("unroll") for (int k = 0; k < 2; ++k) \
        acc[ai][bj][m][n] = __builtin_amdgcn_mfma_f32_16x16x32_bf16(Bt[n][k], At[m][k], acc[ai][bj][m][n], 0, 0, 0); __builtin_amdgcn_s_setprio(0); } while (0)
#define PG8_WAIT_V(n) asm volatile("s_waitcnt vmcnt(" #n ")" ::: "memory")
#define PG8_WAIT_L(n) asm volatile("s_waitcnt lgkmcnt(" #n ")" ::: "memory")
#define PG8_BAR __builtin_amdgcn_s_barrier()
#define PG8_SCHED __builtin_amdgcn_sched_barrier(0)
    Unit cur, nxt; int ui = 0;
    if (!S.next(0, cur)) return;
    f32x4 acc[2][2][4][2];
#pragma unroll
    for (int a = 0; a < 2; ++a)
#pragma unroll
        for (int b = 0; b < 2; ++b)
#pragma unroll
            for (int m = 0; m < 4; ++m)
#pragma unroll
                for (int n = 0; n < 2; ++n) acc[a][b][m][n] = (f32x4){0.f, 0.f, 0.f, 0.f};
    bf16x8 At[4][2], B0[2][2], B1[2][2];
#define PG8_STAGEA(bufoff, uidx, uu, tt, hh) S.stage_a(lds + (bufoff) + ldsw, uidx, uu, tt, hh, Rs, Cs)
    {
        const char* pB0 = S.b_ptr(cur, 0); const char* pB1 = S.b_ptr(cur, 1);
        PG8_STAGEB(PG8_SB(0, 0), pB0); PG8_STAGEB(PG8_SB(0, 1), pB0 + hstepB); PG8_STAGEA(PG8_SA(0, 0), 0, cur, 0, 0); PG8_STAGEA(PG8_SA(0, 1), 0, cur, 0, 1);
        if (wr == 1) PG8_BAR;
        PG8_WAIT_V(2); PG8_BAR;
        PG8_STAGEB(PG8_SB(1, 0), pB1); PG8_STAGEA(PG8_SA(1, 0), 0, cur, 1, 0); PG8_STAGEB(PG8_SB(1, 1), pB1 + hstepB);
        PG8_WAIT_V(6); PG8_BAR;
    }
    for (;;) {
        const bool has_next = S.next(ui + 1, nxt);
        if (!has_next) nxt = cur;
        const int uin = has_next ? ui + 1 : ui;
#pragma unroll 1
        for (int t = 0; t < nt; t += 2) {
            const bool last = (t == nt - 2);
            const Unit& u2 = last ? nxt : cur; const int ui2 = last ? uin : ui; const int t2 = last ? 0 : t + 2;
            const char* b2 = S.b_ptr(u2, t2); const char* b3 = S.b_ptr(u2, t2 + 1);
            PG8_LDB(B0, 0, 0); PG8_LDB(B1, 0, 1); PG8_SCHED; PG8_LDA(At, 0, 0); PG8_STAGEA(PG8_SA(1, 1), ui, cur, t + 1, 1);
            PG8_WAIT_V(8); PG8_WAIT_L(0); PG8_BAR; PG8_MMA(0, 0, At, B0); PG8_MMA(0, 1, At, B1); PG8_BAR; PG8_SCHED;
            PG8_LDA(At, 0, 1); PG8_STAGEB(PG8_SB(0, 0), b2); PG8_STAGEB(PG8_SB(0, 1), b2 + hstepB); PG8_STAGEA(PG8_SA(0, 0), ui2, u2, t2, 0);
            PG8_WAIT_V(8); PG8_WAIT_L(0); PG8_BAR; PG8_MMA(1, 0, At, B0); PG8_MMA(1, 1, At, B1); PG8_BAR; PG8_SCHED;
            PG8_LDB(B0, 1, 0); PG8_LDB(B1, 1, 1); PG8_SCHED; PG8_LDA(At, 1, 0); PG8_STAGEA(PG8_SA(0, 1), ui2, u2, t2, 1);
            PG8_WAIT_V(8); PG8_WAIT_L(0); PG8_BAR; PG8_MMA(0, 0, At, B0); PG8_MMA(0, 1, At, B1); PG8_BAR; PG8_SCHED;
            PG8_LDA(At, 1, 1); PG8_STAGEB(PG8_SB(1, 0), b3); PG8_STAGEB(PG8_SB(1, 1), b3 + hstepB); PG8_STAGEA(PG8_SA(1, 0), ui2, u2, t2 + 1, 0);
            PG8_WAIT_V(8); PG8_WAIT_L(0); PG8_BAR; PG8_MMA(1, 0, At, B0); PG8_MMA(1, 1, At, B1); PG8_BAR; PG8_SCHED;
        }
        if (wr == 0) PG8_BAR;
        S.epi(acc, cur, wr, wc, fr, fq, ui);
        PG8_SCHED;
        if (!has_next) break;
#pragma unroll
        for (int a = 0; a < 2; ++a)
#pragma unroll
            for (int b = 0; b < 2; ++b)
#pragma unroll
                for (int m = 0; m < 4; ++m)
#pragma unroll
                    for (int n = 0; n < 2; ++n) acc[a][b][m][n] = (f32x4){0.f, 0.f, 0.f, 0.f};
        cur = nxt; ++ui;
        if (wr == 1) PG8_BAR;
    }
    PG8_WAIT_V(0);
    PG8_BAR;
#undef PG8_SA
#undef PG8_SB
#undef PG8_STAGE1
#undef PG8_STAGEB
#undef PG8_STAGEA
#undef PG8_LDA
#undef PG8_LDB
#undef PG8_MMA
#undef PG8_WAIT_V
#undef PG8_WAIT_L
#undef PG8_BAR
#undef PG8_SCHED
}
}
typedef f32x4 AccT[2][2][4][2];

struct Args { const float* in[30]; float* out; unsigned char* ws; int ph_lo, ph_hi; };

struct Frame {
    LAS unsigned char* lds;
    int tid, lane, wave, G, wg;
    const float* const* in;
    unsigned char* ws; unsigned char* os;
};
#define IN_X 0
#define IN_META 1
#define IN_NMG 2
#define IN_WIN 3
#define IN_LRE 4
#define IN_LIM 5
#define IN_LDT 6
#define IN_BRE 7
#define IN_BIM 8
#define IN_CRE 9
#define IN_CIM 10
#define IN_S5D 11
#define IN_WGLU 12
#define IN_HLB 13
#define IN_HNG 14
#define IN_LQ1 15
#define IN_LK1 16
#define IN_LQ2 17
#define IN_LK2 18
#define IN_SUBLN 19
#define IN_WOUT 20
#define IN_NFG 21
#define IN_WGRP 22
#define IN_BGRP 23
#define IN_WEXP 24
#define IN_BEXP 25
#define IN_WGATE 26
#define IN_WUP 27
#define IN_WDOWN 28
#define IN_FNG 29

template <class ColMap>
__device__ __forceinline__ void conv_item(const float* W, int ldw, const float* kscale, bf16* WT, int ldt, int k0, int n0, LAS float* scr, int lane, ColMap cm) {
    const int sc = cm(n0 + (lane & 31));
#pragma unroll
    for (int i = 0; i < 32; ++i) { const int kk = 2 * i + (lane >> 5); float v = W[(size_t)(k0 + kk) * ldw + sc]; if (kscale) v *= kscale[k0 + kk]; scr[kk * 33 + (lane & 31)] = v; }
    LDS_WAIT(); asm volatile("" ::: "memory");
    const int c = lane & 7;
#pragma unroll
    for (int j = 0; j < 4; ++j) { const int n = (lane >> 3) + 8 * j; const LAS float* s = scr + (8 * c) * 33 + n;
        u32x4 o; o.x = pk2(s[0 * 33], s[1 * 33]); o.y = pk2(s[2 * 33], s[3 * 33]); o.z = pk2(s[4 * 33], s[5 * 33]); o.w = pk2(s[6 * 33], s[7 * 33]);
        *(GAS u32x4*)(WT + (size_t)(n0 + n) * ldt + k0 + 8 * c) = o; }
    LDS_WAIT(); asm volatile("" ::: "memory");
}

__device__ __forceinline__ void p0_prologue(const Frame& F0) {
    Frame F = F0; F.tid = F.wave * 64 + lane_id_(); LAUNDER(F.tid); F.lane = F.tid & 63;
    LAS float* scr = (LAS float*)(F.lds + F.wave * 16384);
    const int gw = F.wg * 8 + F.wave, NGW = F.G * 8, lane = F.lane;
    constexpr int I_IN = 16 * (NI / 32), I_OUT = 16 * 32, I_GLU = 4 * 16, I_GU = 16 * 16 * 32, I_DN = 16 * 8 * 32;
    constexpr int I_L = I_IN + I_OUT + I_GLU + I_GU + I_DN;
    for (int it = gw; it < 2 * I_L; it += NGW) {
        const int l = it / I_L; int r = it % I_L;
        if (r < I_IN) {
            const int kb = r / (NI / 32), nb = r % (NI / 32);
            conv_item(F.in[IN_WIN] + (size_t)l * D * NI, NI, F.in[IN_NMG] + l * D, (bf16*)(F.ws + WS_WIN) + (size_t)l * NI * D, D, kb * 64, nb * 32, scr, lane,
                      [](int n) { if (n >= C_AQ && n < C_AV) { const int p = n & 63, j = p >> 3, e = p & 7; return (n & ~63) + 4 * j + (e & 3) + 32 * (e >> 2); } return n; });
            continue; }
        r -= I_IN;
        if (r < I_OUT) {
            const int kb = r / 32, nb = r % 32;
            conv_item(F.in[IN_WOUT] + (size_t)l * D * D, D, nullptr, (bf16*)(F.ws + WS_WOUT) + (size_t)l * D * D, D, kb * 64, nb * 32, scr, lane, [](int n) { return n; });
            continue; }
        r -= I_OUT;
        if (r < I_GLU) {
            const int kb = r / 16, nb = r % 16;
            conv_item(F.in[IN_WGLU] + (size_t)l * 256 * 512, 512, nullptr, (bf16*)(F.ws + WS_WGLU) + (size_t)l * 512 * 256, 256, kb * 64, nb * 32, scr, lane,
                      [](int n) { const int pn = n >> 8, bj = (n >> 7) & 1, c = n & 127; return bj * 256 + pn * 128 + c; });
            continue; }
        r -= I_GLU;
        if (r < I_GU) {
            const int e = r / (16 * 32), q = r % (16 * 32), kb = q / 32, nb = q % 32, n0 = nb * 32, bj = (n0 >> 7) & 1;
            const float* src = (bj ? F.in[IN_WUP] : F.in[IN_WGATE]) + ((size_t)l * 16 + e) * 1024 * 512;
            conv_item(src, 512, F.in[IN_NFG] + l * D, (bf16*)(F.ws + WS_WGU) + ((size_t)l * 16 + e) * 1024 * 1024, 1024, kb * 64, n0, scr, lane,
                      [](int n) { const int pn = n >> 8, c = n & 127; return pn * 128 + c; });
            continue; }
        r -= I_GU;
        {
            const int e = r / (8 * 32), q = r % (8 * 32), kb = q / 32, nb = q % 32;
            conv_item(F.in[IN_WDOWN] + ((size_t)l * 16 + e) * 512 * 1024, 1024, nullptr, (bf16*)(F.ws + WS_WDN) + ((size_t)l * 16 + e) * 1024 * 512, 512, kb * 64, nb * 32, scr, lane, [](int n) { return n; });
        }
    }
    for (int idx = gw * 64 + lane; idx < 2 * 32 * 1024; idx += NGW * 64) {
        const int l = idx / (32 * 1024), j = (idx / 1024) % 32, k = idx % 1024;
        float w = 0.f;
        if (j < 4) w = F.in[IN_WGRP][((size_t)l * D + k) * 4 + j]; else if (j < 20) w = F.in[IN_WEXP][((size_t)l * D + k) * 16 + (j - 4)];
        w *= F.in[IN_NFG][l * D + k];
        const unsigned hi = f2bf(w); const float lo = w - bf2f(hi);
        bf16* wr = (bf16*)(F.ws + WS_WR) + (size_t)l * 2 * 32 * 1024;
        wr[j * 1024 + k] = (bf16)hi; wr[32 * 1024 + j * 1024 + k] = (bf16)f2bf(lo);
    }
    for (int idx = gw * 64 + lane; idx < LT * 32; idx += NGW * 64) {
        const int pos = idx / 32, i = idx % 32;
        const double inv = pow(10000.0, -(double)(2 * i) / 64.0); const double a = (double)pos * inv;
        ((float*)(F.ws + WS_ROPE))[idx] = (float)cos(a); ((float*)(F.ws + WS_ROPE))[LT * 32 + idx] = (float)sin(a);
    }
    for (int m = gw; m < T; m += NGW) {
        const int b = m / LT, t = m % LT;
        const float* src = (t < NMETA) ? F.in[IN_META] + (size_t)t * D : F.in[IN_X] + ((size_t)b * SEQ + (t - NMETA)) * D;
        const GAS f32x4* xr = (const GAS f32x4*)src + lane;
        GAS u32x2* hb = (GAS u32x2*)((bf16*)(F.ws + WS_HB) + (size_t)m * D) + lane;
        float s = 0.f;
#pragma unroll
        for (int j = 0; j < 4; ++j) { const f32x4 v = xr[64 * j]; s += (v.x * v.x + v.y * v.y) + (v.z * v.z + v.w * v.w);
            u32x2 o; o.x = pk2(v.x, v.y); o.y = pk2(v.z, v.w); hb[64 * j] = o; }
        s = wave_sum(s);
        if (lane < 16) ((float*)(F.ws + WS_SS16))[(size_t)m * 16 + lane] = (lane == 0) ? s : 0.f;
    }
    for (int it = F.wg; it < 32; it += F.G) {
        const int l = it / 16, g = it % 16;
        LAS f32x2* Ap = (LAS f32x2*)(F.lds);
        LAS f32x2* Bb = Ap + 17 * 64;
        LAS f32x2* Cc = Bb + 64 * 16;
        LAS float* Kj = (LAS float*)(Cc + 16 * 64);
        __syncthreads();
        const double dt = exp((double)F.in[IN_LDT][l * 16 + g]);
        for (int idx = F.tid; idx < 17 * 64; idx += 512) { const int j = idx / 64, n = idx % 64;
            const double lr = F.in[IN_LRE][(l * 16 + g) * 64 + n], li = F.in[IN_LIM][(l * 16 + g) * 64 + n];
            const double mg = exp(j * lr * dt), an = j * li * dt; Ap[idx] = (f32x2){(float)(mg * cos(an)), (float)(mg * sin(an))}; }
        for (int idx = F.tid; idx < 64 * 16; idx += 512) { const int n = idx / 16, c = idx % 16;
            const double lr = F.in[IN_LRE][(l * 16 + g) * 64 + n], li = F.in[IN_LIM][(l * 16 + g) * 64 + n];
            const double mg = exp(lr * dt), ar = mg * cos(li * dt), ai = mg * sin(li * dt), den = lr * lr + li * li, zr = ar - 1.0, zi = ai;
            const double fr = (zr * lr + zi * li) / den, fi = (zi * lr - zr * li) / den;
            const double br = F.in[IN_BRE][((size_t)(l * 16 + g) * 64 + n) * 16 + c], bi = F.in[IN_BIM][((size_t)(l * 16 + g) * 64 + n) * 16 + c];
            Bb[idx] = (f32x2){(float)(fr * br - fi * bi), (float)(fr * bi + fi * br)}; }
        for (int idx = F.tid; idx < 16 * 64; idx += 512) { const int c = idx / 64, n = idx % 64;
            Cc[idx] = (f32x2){F.in[IN_CRE][((size_t)(l * 16 + g) * 16 + c) * 64 + n], F.in[IN_CIM][((size_t)(l * 16 + g) * 16 + c) * 64 + n]}; }
        __syncthreads();
        for (int idx = F.tid; idx < 4096; idx += 512) { const int j = idx >> 8, co = (idx >> 4) & 15, ci = idx & 15; float s = 0.f;
            for (int n = 0; n < 64; ++n) { const f32x2 a = Ap[j * 64 + n], b = Bb[n * 16 + ci], c = Cc[co * 64 + n];
                const float abr = a.x * b.x - a.y * b.y, abi = a.x * b.y + a.y * b.x; s += c.x * abr - c.y * abi; }
            Kj[idx] = s; }
        if (F.tid < 64) ((f32x2*)(F.ws + WS_S5A))[(l * 16 + g) * 64 + F.tid] = Ap[16 * 64 + F.tid];
        __syncthreads();
        bf16* TQ = (bf16*)(F.ws + WS_S5TQ) + (size_t)(l * 16 + g) * 256 * 384;
        for (int idx = F.tid; idx < 256 * 384; idx += 512) { const int nn = idx / 384, k = idx % 384, t = nn >> 4, co = nn & 15; float v;
            if (k < 256) { const int s = k >> 4, ci = k & 15; v = (s <= t) ? Kj[((t - s) << 8) + (co << 4) + ci] : 0.f; }
            else { const int kk = k - 256, n = kk >> 1; const f32x2 a = Ap[(t + 1) * 64 + n], c = Cc[co * 64 + n];
                const float zr = c.x * a.x - c.y * a.y, zi = c.x * a.y + c.y * a.x; v = (kk & 1) ? -zi : zr; }
            TQ[idx] = (bf16)f2bf(v); }
        bf16* PM = (bf16*)(F.ws + WS_S5P) + (size_t)(l * 16 + g) * 256 * 256;
        for (int idx = F.tid; idx < 256 * 256; idx += 512) { const int nn = idx >> 8, k = idx & 255; float v = 0.f;
            if (nn < 128) { const int n = nn >> 1, s = k >> 4, ci = k & 15; const f32x2 a = Ap[(15 - s) * 64 + n], b = Bb[n * 16 + ci];
                v = (nn & 1) ? (a.x * b.y + a.y * b.x) : (a.x * b.x - a.y * b.y); }
            PM[idx] = (bf16)f2bf(v); }
        __syncthreads();
    }
}

template <class V> __device__ __forceinline__ V ldg(const void* sbase, unsigned voff) { return *(const GAS V*)((const char*)sbase + voff); }
template <class V> __device__ __forceinline__ void stg(void* sbase, unsigned voff, V v) { *(GAS V*)((char*)sbase + voff) = v; }
__device__ __forceinline__ u32x4 bufld16(__amdgpu_buffer_rsrc_t r, unsigned voff, unsigned soff) { return __builtin_bit_cast(u32x4, __builtin_amdgcn_raw_buffer_load_b128(r, (int)voff, (int)soff, 0)); }
#define GLDS2(p0, p1, dst) do { __builtin_amdgcn_global_load_lds((const unsigned*)(p0), (LAS unsigned*)(dst), 16, 0, 0); __builtin_amdgcn_global_load_lds((const unsigned*)(p1), (LAS unsigned*)((dst) + 8192), 16, 0, 0); } while (0)
#define EPI_FENCE() __builtin_amdgcn_sched_barrier(0)
struct UnitT { int pm, pn; };

struct PolIn {
    typedef UnitT Unit; static constexpr int NT = 16, LDB = 1024;
    pg8::TileOrder ord; const bf16* A; const bf16* B; bf16* proj; const float* ss16; const float* rope;
    __device__ __forceinline__ bool next(int i, Unit& u) const { return ord.get(i, u.pm, u.pn); }
    __device__ __forceinline__ void stage_a(LAS unsigned char* dst, int, const Unit& u, int t, int h, const int (&R)[2], const int (&C)[2]) const {
        const char* bp = (const char*)(A + (size_t)(u.pm * 256 + h * 128) * 1024) + t * 128;
        GLDS2(bp + (unsigned)((R[0] * 1024 + C[0]) * 2), bp + (unsigned)((R[1] * 1024 + C[1]) * 2), dst); }
    __device__ __forceinline__ const char* b_ptr(const Unit& u, int t) const { return (const char*)(B + (size_t)u.pn * 256 * 1024) + t * 128; }
    __device__ __forceinline__ void epi(const AccT& acc, const Unit& u, int wr, int wc, int fr, int fq, int) const {
        const bool isrope = (u.pn >= 5 && u.pn <= 8); const float qs = (u.pn == 5 || u.pn == 6) ? QSCALE : 1.f;
        const unsigned fi = 4u * (4u * (wc & 1) + fq);
        const unsigned vo_p = (unsigned)((fr * NI + u.pn * 256 + wc * 32 + 8 * fq) * 2), vo_s = (unsigned)(fr * 64);
#pragma unroll
        for (int ai = 0; ai < 2; ++ai)
#pragma unroll
            for (int m = 0; m < 4; ++m) {
                const int rowu = u.pm * 256 + ai * 128 + wr * 64 + m * 16;
                const float* sp = ss16 + (size_t)rowu * 16;
                const f32x4 s0 = ldg<f32x4>(sp, vo_s), s1 = ldg<f32x4>(sp, vo_s + 16), s2 = ldg<f32x4>(sp, vo_s + 32), s3 = ldg<f32x4>(sp, vo_s + 48);
                const float ss = ((s0.x + s0.y) + (s0.z + s0.w)) + ((s1.x + s1.y) + (s1.z + s1.w)) + ((s2.x + s2.y) + (s2.z + s2.w)) + ((s3.x + s3.y) + (s3.z + s3.w));
                const float rstd = rsqrtf(ss * (1.f / 1024.f) + RMS_EPS);
                f32x4 cs = (f32x4){1.f, 1.f, 1.f, 1.f}, sn = (f32x4){0.f, 0.f, 0.f, 0.f};
                if (isrope) { const unsigned pos = (unsigned)(rowu + fr) % (unsigned)LT; cs = ldg<f32x4>(rope, (pos * 32 + fi) * 4); sn = ldg<f32x4>(rope, (LT * 32 + pos * 32 + fi) * 4); }
                bf16* rowp = proj + (size_t)rowu * NI;
#pragma unroll
                for (int bj = 0; bj < 2; ++bj) {
                    f32x4 v0 = acc[ai][bj][m][0] * rstd, v1 = acc[ai][bj][m][1] * rstd;
                    if (isrope) { const f32x4 o0 = (v0 * cs - v1 * sn) * qs, o1 = (v1 * cs + v0 * sn) * qs; v0 = o0; v1 = o1; }
                    u32x4 w; w.x = cvt_pk_bf16(v0[0], v0[1]); w.y = cvt_pk_bf16(v0[2], v0[3]); w.z = cvt_pk_bf16(v1[0], v1[1]); w.w = cvt_pk_bf16(v1[2], v1[3]);
                    stg<u32x4>(rowp, vo_p + bj * 256, w);
                }
                EPI_FENCE();
            }
    }
};

struct UnitS5 { int g, mt; };
struct PolS5E {
    typedef UnitS5 Unit; static constexpr int NT = 4, LDB = 256;
    int G, c; const bf16* proj; const bf16* B; float* E;
    __device__ __forceinline__ bool next(int i, Unit& u) const { const int Lx = i * G + c; if (Lx >= 16 * 17) return false; u.g = Lx / 17; u.mt = Lx % 17; return true; }
    __device__ __forceinline__ void stage_a(LAS unsigned char* dst, int, const Unit& u, int t, int h, const int (&R)[2], const int (&C)[2]) const {
        const char* bp = (const char*)(proj + ((size_t)(16 * (256 * u.mt + 128 * h) + 4 * t)) * NI + C_U + u.g * 16);
        GLDS2(bp + (unsigned)(((16 * R[0] + (C[0] >> 4)) * NI + (C[0] & 15)) * 2), bp + (unsigned)(((16 * R[1] + (C[1] >> 4)) * NI + (C[1] & 15)) * 2), dst); }
    __device__ __forceinline__ const char* b_ptr(const Unit& u, int t) const { return (const char*)(B + (size_t)u.g * 256 * 256) + t * 128; }
    __device__ __forceinline__ void epi(const AccT& acc, const Unit& u, int wr, int wc, int fr, int fq, int) const {
        const unsigned vo = (unsigned)((fr * 128 + wc * 32 + 8 * fq) * 4);
#pragma unroll
        for (int ai = 0; ai < 2; ++ai)
#pragma unroll
            for (int m = 0; m < 4; ++m) { float* ep = E + ((size_t)u.g * S5RP + u.mt * 256 + ai * 128 + wr * 64 + m * 16) * 128;
                stg<f32x4>(ep, vo, acc[ai][0][m][0]); stg<f32x4>(ep, vo + 16, acc[ai][0][m][1]); }
    }
};

struct PolS5Y {
    typedef UnitS5 Unit; static constexpr int NT = 6, LDB = 384;
    int G, c; const bf16* X; const bf16* B; const bf16* proj; const float* dsk; bf16* Gout;
    __device__ __forceinline__ bool next(int i, Unit& u) const { const int Lx = i * G + c; if (Lx >= 16 * 17) return false; u.g = Lx / 17; u.mt = Lx % 17; return true; }
    __device__ __forceinline__ void stage_a(LAS unsigned char* dst, int, const Unit& u, int t, int h, const int (&R)[2], const int (&C)[2]) const {
        const char* bp = (const char*)(X + ((size_t)u.g * S5RP + 256 * u.mt + 128 * h) * 384) + t * 128;
        GLDS2(bp + (unsigned)((R[0] * 384 + C[0]) * 2), bp + (unsigned)((R[1] * 384 + C[1]) * 2), dst); }
    __device__ __forceinline__ const char* b_ptr(const Unit& u, int t) const { return (const char*)(B + (size_t)u.g * 256 * 384) + t * 128; }
    __device__ __forceinline__ void epi(const AccT& acc, const Unit& u, int wr, int wc, int fr, int fq, int) const {
        const int ch = u.g * 16 + 8 * (fq & 1);
        const f32x4 d0 = ldg<f32x4>(dsk, (unsigned)ch * 4), d1 = ldg<f32x4>(dsk, (unsigned)ch * 4 + 16);
        const unsigned vo_u = (unsigned)(((16 * fr + (fq >> 1)) * NI + C_U + ch) * 2), vo_g = (unsigned)(((16 * fr + (fq >> 1)) * 256 + ch) * 2);
#pragma unroll
        for (int ai = 0; ai < 2; ++ai)
#pragma unroll
            for (int m = 0; m < 4; ++m) { const int Ru = u.mt * 256 + ai * 128 + wr * 64 + m * 16;
                if (Ru + fr < S5R) {
#pragma unroll
                    for (int bj = 0; bj < 2; ++bj) { const size_t toku = (size_t)16 * Ru + 8 * bj + 2 * wc;
                        const u32x4 uu = ldg<u32x4>(proj + toku * NI, vo_u);
                        f32x4 v0 = acc[ai][bj][m][0], v1 = acc[ai][bj][m][1];
                        v0[0] += d0[0] * bf2f(uu.x); v0[1] += d0[1] * bf2f(uu.x >> 16); v0[2] += d0[2] * bf2f(uu.y); v0[3] += d0[3] * bf2f(uu.y >> 16);
                        v1[0] += d1[0] * bf2f(uu.z); v1[1] += d1[1] * bf2f(uu.z >> 16); v1[2] += d1[2] * bf2f(uu.w); v1[3] += d1[3] * bf2f(uu.w >> 16);
                        u32x4 w; w.x = pk2(gelu_tanh(v0[0]), gelu_tanh(v0[1])); w.y = pk2(gelu_tanh(v0[2]), gelu_tanh(v0[3]));
                        w.z = pk2(gelu_tanh(v1[0]), gelu_tanh(v1[1])); w.w = pk2(gelu_tanh(v1[2]), gelu_tanh(v1[3]));
                        stg<u32x4>(Gout + toku * 256, vo_g, w); }
                }
                EPI_FENCE();
            }
    }
};

struct PolGlu {
    typedef UnitT Unit; static constexpr int NT = 4, LDB = 256;
    pg8::TileOrder ord; const bf16* A; const bf16* B; bf16* mixed;
    __device__ __forceinline__ bool next(int i, Unit& u) const { return ord.get(i, u.pm, u.pn); }
    __device__ __forceinline__ void stage_a(LAS unsigned char* dst, int, const Unit& u, int t, int h, const int (&R)[2], const int (&C)[2]) const {
        const char* bp = (const char*)(A + (size_t)(u.pm * 256 + h * 128) * 256) + t * 128;
        GLDS2(bp + (unsigned)((R[0] * 256 + C[0]) * 2), bp + (unsigned)((R[1] * 256 + C[1]) * 2), dst); }
    __device__ __forceinline__ const char* b_ptr(const Unit& u, int t) const { return (const char*)(B + (size_t)u.pn * 256 * 256) + t * 128; }
    __device__ __forceinline__ void epi(const AccT& acc, const Unit& u, int wr, int wc, int fr, int fq, int) const {
        const unsigned vo = (unsigned)((fr * D + u.pn * 128 + wc * 32 + 8 * fq) * 2);
#pragma unroll
        for (int ai = 0; ai < 2; ++ai)
#pragma unroll
            for (int m = 0; m < 4; ++m) { bf16* rp = mixed + (size_t)(u.pm * 256 + ai * 128 + wr * 64 + m * 16) * D;
                const f32x4 a0 = acc[ai][0][m][0], a1 = acc[ai][0][m][1], b0 = acc[ai][1][m][0], b1 = acc[ai][1][m][1];
                u32x4 w; w.x = pk2(a0[0] * sigmoidf_(b0[0]), a0[1] * sigmoidf_(b0[1])); w.y = pk2(a0[2] * sigmoidf_(b0[2]), a0[3] * sigmoidf_(b0[3]));
                w.z = pk2(a1[0] * sigmoidf_(b1[0]), a1[1] * sigmoidf_(b1[1])); w.w = pk2(a1[2] * sigmoidf_(b1[2]), a1[3] * sigmoidf_(b1[3]));
                stg<u32x4>(rp, vo, w);
                EPI_FENCE(); }
    }
};

__device__ __forceinline__ void residual_rows(const AccT& acc, int ai, int m, unsigned vrow, bool valid, int pn, int wc, int fq, bf16* brow, float* srow) {
    const unsigned vb = (vrow * D + (unsigned)(pn * 256 + wc * 32 + 8 * fq)) * 2;
    float ssq = 0.f;
    if (valid) {
#pragma unroll
        for (int bj = 0; bj < 2; ++bj) {
            const u32x4 hb = ldg<u32x4>(brow, vb + bj * 256);
            f32x4 h0 = (f32x4){bf2f(hb.x), bf2f(hb.x >> 16), bf2f(hb.y), bf2f(hb.y >> 16)}, h1 = (f32x4){bf2f(hb.z), bf2f(hb.z >> 16), bf2f(hb.w), bf2f(hb.w >> 16)};
            h0 += acc[ai][bj][m][0]; h1 += acc[ai][bj][m][1];
            u32x4 w; w.x = cvt_pk_bf16(h0[0], h0[1]); w.y = cvt_pk_bf16(h0[2], h0[3]); w.z = cvt_pk_bf16(h1[0], h1[1]); w.w = cvt_pk_bf16(h1[2], h1[3]);
            stg<u32x4>(brow, vb + bj * 256, w);
            ssq += (h0[0] * h0[0] + h0[1] * h0[1]) + (h0[2] * h0[2] + h0[3] * h0[3]) + (h1[0] * h1[0] + h1[1] * h1[1]) + (h1[2] * h1[2] + h1[3] * h1[3]);
        }
    }
    ssq += __shfl_xor(ssq, 16); ssq += __shfl_xor(ssq, 32);
    if (valid && fq == 0) stg<float>(srow, (vrow * 16 + pn * 4 + wc) * 4, ssq);
}

struct PolOut {
    typedef UnitT Unit; static constexpr int NT = 16, LDB = 1024;
    pg8::TileOrder ord; const bf16* A; const bf16* B; bf16* HB; float* ss16;
    __device__ __forceinline__ bool next(int i, Unit& u) const { return ord.get(i, u.pm, u.pn); }
    __device__ __forceinline__ void stage_a(LAS unsigned char* dst, int, const Unit& u, int t, int h, const int (&R)[2], const int (&C)[2]) const {
        const char* bp = (const char*)(A + (size_t)(u.pm * 256 + h * 128) * 1024) + t * 128;
        GLDS2(bp + (unsigned)((R[0] * 1024 + C[0]) * 2), bp + (unsigned)((R[1] * 1024 + C[1]) * 2), dst); }
    __device__ __forceinline__ const char* b_ptr(const Unit& u, int t) const { return (const char*)(B + (size_t)u.pn * 256 * 1024) + t * 128; }
    __device__ __forceinline__ void epi(const AccT& acc, const Unit& u, int wr, int wc, int fr, int fq, int) const {
#pragma unroll
        for (int ai = 0; ai < 2; ++ai)
#pragma unroll
            for (int m = 0; m < 4; ++m) { const size_t rowu = (size_t)(u.pm * 256 + ai * 128 + wr * 64 + m * 16);
                residual_rows(acc, ai, m, (unsigned)fr, true, u.pn, wc, fq, HB + rowu * D, ss16 + rowu * 16);
                EPI_FENCE(); }
    }
};

struct MoeList {
    LAS const int* cnt;
    __device__ __forceinline__ int ntiles() const { int s = 0; for (int c = 0; c < NCLS; ++c) s += (cnt[c] + 255) >> 8; return __builtin_amdgcn_readfirstlane(s); }
    __device__ __forceinline__ void decode(int gt, int& c, int& ti, int& nvalid) const {
        int s = 0, cc = 0, tt = 0, nv = 0;
        for (int k = 0; k < NCLS; ++k) { const int n = (cnt[k] + 255) >> 8; if (gt >= s && gt < s + n) { cc = k; tt = gt - s; nv = cnt[k] - 256 * tt; } s += n; }
        c = __builtin_amdgcn_readfirstlane(cc); ti = __builtin_amdgcn_readfirstlane(tt); nvalid = __builtin_amdgcn_readfirstlane(nv > 256 ? 256 : nv);
    }
};
__device__ __forceinline__ void class_experts(int c, int& ea, int& eb) {
    const int g = c / 6, p = c % 6; const int a = (p < 3) ? 0 : (p < 5 ? 1 : 2); const int b = (p < 3) ? p + 1 : (p < 5 ? p - 1 : 3);
    ea = g * 4 + a; eb = g * 4 + b;
}
struct UnitM { int gt, pn, c; };

struct PolGU {
    typedef UnitM Unit; static constexpr int NT = 16, LDB = 1024;
    int G, c, ntl; MoeList ml; LAS const int* tab;
    const bf16* HB; const bf16* W; bf16* he; const float* rstd; const float* gate;
    __device__ __forceinline__ bool next(int i, Unit& u) const { const int Lx = i * G + c; if (Lx >= ntl * 8) return false; u.gt = Lx >> 3; u.pn = Lx & 7; int ti, nv; ml.decode(u.gt, u.c, ti, nv); return true; }
    __device__ __forceinline__ void stage_a(LAS unsigned char* dst, int ui, const Unit&, int t, int h, const int (&R)[2], const int (&C)[2]) const {
        const char* bp = (const char*)HB + t * 128;
        const int t0 = tab[ui * 256 + 128 * h + R[0]], t1 = tab[ui * 256 + 128 * h + R[1]];
        GLDS2(bp + (unsigned)((t0 < 0 ? 0 : t0) * 2048 + C[0] * 2), bp + (unsigned)((t1 < 0 ? 0 : t1) * 2048 + C[1] * 2), dst); }
    __device__ __forceinline__ const char* b_ptr(const Unit& u, int t) const { int ea, eb; class_experts(u.c, ea, eb); const int e = (u.pn >> 2) ? eb : ea;
        return (const char*)(W + ((size_t)e * 1024 + (u.pn & 3) * 256) * 1024) + t * 128; }
    __device__ __forceinline__ void epi(const AccT& acc, const Unit& u, int wr, int wc, int fr, int fq, int ui) const {
        const int sel = u.pn >> 2;
        const unsigned vo = (unsigned)((fr * 1024 + sel * 512 + (u.pn & 3) * 128 + wc * 32 + 8 * fq) * 2);
#pragma unroll
        for (int ai = 0; ai < 2; ++ai)
#pragma unroll
            for (int m = 0; m < 4; ++m) { const int ru = ai * 128 + wr * 64 + m * 16; const int tk = tab[ui * 256 + ru + fr];
                float rs = 0.f, gw = 0.f; if (tk >= 0) { rs = ldg<float>(rstd, (unsigned)tk * 4); gw = ldg<float>(gate, (unsigned)(2 * tk + sel) * 4); }
                const f32x4 g0 = acc[ai][0][m][0] * rs, g1 = acc[ai][0][m][1] * rs, u0 = acc[ai][1][m][0] * (rs * gw), u1 = acc[ai][1][m][1] * (rs * gw);
                u32x4 w; w.x = pk2(siluf_(g0[0]) * u0[0], siluf_(g0[1]) * u0[1]); w.y = pk2(siluf_(g0[2]) * u0[2], siluf_(g0[3]) * u0[3]);
                w.z = pk2(siluf_(g1[0]) * u1[0], siluf_(g1[1]) * u1[1]); w.w = pk2(siluf_(g1[2]) * u1[2], siluf_(g1[3]) * u1[3]);
                stg<u32x4>(he + ((size_t)u.gt * 256 + ru) * 1024, vo, w);
                EPI_FENCE(); }
    }
};

struct PolDN {
    typedef UnitM Unit; static constexpr int NT = 16, LDB = 512;
    int G, c, ntl; MoeList ml; LAS const int* tab;
    const bf16* he; const bf16* W; bf16* HB; float* ss16;
    __device__ __forceinline__ bool next(int i, Unit& u) const { const int Lx = i * G + c; if (Lx >= ntl * 4) return false; u.gt = Lx >> 2; u.pn = Lx & 3; int ti, nv; ml.decode(u.gt, u.c, ti, nv); return true; }
    __device__ __forceinline__ void stage_a(LAS unsigned char* dst, int, const Unit& u, int t, int h, const int (&R)[2], const int (&C)[2]) const {
        const char* bp = (const char*)(he + (size_t)(u.gt * 256 + h * 128) * 1024) + t * 128;
        GLDS2(bp + (unsigned)((R[0] * 1024 + C[0]) * 2), bp + (unsigned)((R[1] * 1024 + C[1]) * 2), dst); }
    __device__ __forceinline__ const char* b_ptr(const Unit& u, int t) const { int ea, eb; class_experts(u.c, ea, eb); const int e = (t >= 8) ? eb : ea;
        return (const char*)(W + ((size_t)e * 1024 + u.pn * 256) * 512) + (t & 7) * 128; }
    __device__ __forceinline__ void epi(const AccT& acc, const Unit& u, int wr, int wc, int fr, int fq, int ui) const {
#pragma unroll
        for (int ai = 0; ai < 2; ++ai)
#pragma unroll
            for (int m = 0; m < 4; ++m) { const int tk = tab[ui * 256 + ai * 128 + wr * 64 + m * 16 + fr];
                residual_rows(acc, ai, m, (unsigned)(tk < 0 ? 0 : tk), tk >= 0, u.pn, wc, fq, HB, ss16);
                EPI_FENCE(); }
    }
};

#define MFMA16(a, b, c) __builtin_amdgcn_mfma_f32_16x16x32_bf16(a, b, c, 0, 0, 0)
#define MFMA32(a, b, c) __builtin_amdgcn_mfma_f32_32x32x16_bf16(a, b, c, 0, 0, 0)

__device__ __forceinline__ void s5_scan(const Frame& F0, int l) {
    Frame F = F0; F.tid = F.wave * 64 + lane_id_(); LAUNDER(F.tid); F.lane = F.tid & 63;
    const bf16* proj = (const bf16*)(F.ws + WS_PROJ); const float* E = (const float*)(F.os + OS_E); bf16* X = (bf16*)(F.os + OS_X);
    const int lane = F.lane;
    for (int it = F.wg + F.G * F.wave; it < NB * 16; it += F.G * 8) {
        const int b = it >> 4, g = it & 15;
        const f32x2 A16 = ((const f32x2*)(F.ws + WS_S5A))[(l * 16 + g) * 64 + lane];
        float sr = 0.f, si = 0.f;
        for (int r0 = 0; r0 < NCH; r0 += 16) {
            f32x2 e[16]; u32x2 u4[16];
#pragma unroll
            for (int j = 0; j < 16; ++j) if (r0 + j < NCH) { const size_t R = (size_t)b * NCH + r0 + j;
                e[j] = *(const GAS f32x2*)(E + ((size_t)g * S5RP + R) * 128 + 2 * lane);
                u4[j] = *(const GAS u32x2*)(proj + (16 * R + (lane >> 2)) * NI + C_U + g * 16 + 4 * (lane & 3)); }
#pragma unroll
            for (int j = 0; j < 16; ++j) if (r0 + j < NCH) { const size_t R = (size_t)b * NCH + r0 + j;
                bf16* xr = X + ((size_t)g * S5RP + R) * 384;
                *(GAS unsigned*)(xr + 256 + 2 * lane) = pk2(sr, si);
                *(GAS u32x2*)(xr + 4 * lane) = u4[j];
                const float nr = A16.x * sr - A16.y * si + e[j].x, ni = A16.x * si + A16.y * sr + e[j].y; sr = nr; si = ni; }
        }
    }
}

__device__ __forceinline__ float hgrn_lb(const float* hlb, int l, int j) {
    if (l == 0) return 0.f;
    const float x0 = hlb[j], x1 = hlb[256 + j], mx = fmaxf(x0, x1), e0 = __expf(x0 - mx), e1 = __expf(x1 - mx);
    return e1 / (e0 + e1);
}
__device__ __forceinline__ void hgrn_gate(float z, float lbA, float onem, float& lf, float& k) {
    const float e = __expf(-fabsf(z)), r = __builtin_amdgcn_rcpf(1.f + e), er = e * r;
    const float s = (z >= 0.f) ? r : er, c = (z >= 0.f) ? er : r;
    lf = __logf(lbA + onem * s); k = onem * c;
}
constexpr int HG_HALF = 72960, HG_LF = 0, HG_SEG = 16640, HG_T0 = 17664, HG_TS = 9216;

__device__ __forceinline__ void hgrn_a(const Frame& F0, int l) {
    Frame F = F0; F.tid = F.wave * 64 + lane_id_(); LAUNDER(F.tid); F.lane = F.tid & 63;
    const bf16* proj = (const bf16*)(F.ws + WS_PROJ); float* UT = (float*)(F.os + OS_UT); float* DEC = (float*)(F.os + OS_DEC);
    const int half = F.tid >> 8, ht = F.tid & 255, hw = F.wave & 3, lane = F.lane;
    LAS unsigned char* base = F.lds + half * HG_HALF;
    LAS float* LF = (LAS float*)(base + HG_LF); LAS float* SEG = (LAS float*)(base + HG_SEG);
    LAS bf16* vT = (LAS bf16*)(base + HG_T0); LAS bf16* KDT = (LAS bf16*)(base + HG_T0 + HG_TS);
    for (int p = F.wg; p < NB * 4 * HCH / 2; p += F.G) {
        const int item = 2 * p + half, c = item % HCH, bh = item / HCH, b = bh >> 2, h = bh & 3;
        const size_t tok0 = (size_t)b * LT + (c == 0 ? 0 : 16 + 64 * (c - 1)); const int nrows = (c == 0) ? 16 : 64;
        float lbA[8], onem[8];
#pragma unroll
        for (int jj = 0; jj < 8; ++jj) { const float lb = hgrn_lb(F.in[IN_HLB], l, h * 64 + 8 * (ht & 7) + jj); lbA[jj] = fmaxf(lb, 1e-30f); onem[jj] = 1.f - lb; }
#pragma unroll
        for (int e = 0; e < 2; ++e) { const int idx = ht + 256 * e, t = idx >> 3, c8 = idx & 7; const bool valid = t < nrows;
            u32x4 zf = (u32x4){0u, 0u, 0u, 0u}, zi = zf;
            if (valid) { zf = *(const GAS u32x4*)(proj + (tok0 + t) * NI + C_HF + h * 64 + 8 * c8); zi = *(const GAS u32x4*)(proj + (tok0 + t) * NI + C_HI + h * 64 + 8 * c8); }
#pragma unroll
            for (int jj = 0; jj < 8; ++jj) { const int d = 8 * c8 + jj; const unsigned wf = (jj & 1) ? (zf[jj >> 1] >> 16) : (zf[jj >> 1] & 0xffffu); const unsigned wi = (jj & 1) ? (zi[jj >> 1] >> 16) : (zi[jj >> 1] & 0xffffu);
                float lf, kk; hgrn_gate(bf2f(wf), lbA[jj], onem[jj], lf, kk); LF[t * 65 + d] = valid ? lf : 0.f;
                vT[d * 72 + t] = (bf16)wi; }
        }
        __syncthreads();
        const int d = ht & 63, seg = ht >> 6;
        { float run = 0.f;
#pragma unroll
          for (int i = 0; i < 16; ++i) { run += LF[(16 * seg + i) * 65 + d]; LF[(16 * seg + i) * 65 + d] = run; }
          SEG[seg * 64 + d] = run; }
        __syncthreads();
        { float offs = 0.f, last = 0.f;
#pragma unroll
          for (int s = 0; s < 4; ++s) { const float v = SEG[s * 64 + d]; if (s < seg) offs += v; last += v; }
          float prev = 0.f;
#pragma unroll
          for (int i = 0; i < 16; ++i) { const int t = 16 * seg + i; const float cl = LF[t * 65 + d], lf = cl - prev; prev = cl;
              const float k = 1.f - __expf(lf); KDT[d * 72 + t] = (bf16)f2bf(k * __expf(last - (cl + offs))); }
          if (seg == 0) DEC[(size_t)item * 64 + d] = __expf(last); }
        __syncthreads();
        f32x4 acc[4];
#pragma unroll
        for (int nt = 0; nt < 4; ++nt) acc[nt] = (f32x4){0.f, 0.f, 0.f, 0.f};
#pragma unroll
        for (int ks = 0; ks < 2; ++ks) { const bf16x8 a = *(const LAS bf16x8*)(vT + (16 * hw + (lane & 15)) * 72 + 32 * ks + 8 * (lane >> 4));
#pragma unroll
            for (int nt = 0; nt < 4; ++nt) { const bf16x8 bb = *(const LAS bf16x8*)(KDT + (16 * nt + (lane & 15)) * 72 + 32 * ks + 8 * (lane >> 4)); acc[nt] = MFMA16(a, bb, acc[nt]); } }
#pragma unroll
        for (int nt = 0; nt < 4; ++nt)
#pragma unroll
            for (int j = 0; j < 4; ++j) UT[(size_t)item * 4096 + (16 * hw + 4 * (lane >> 4) + j) * 64 + 16 * nt + (lane & 15)] = acc[nt][j];
        __syncthreads();
    }
}

__device__ __forceinline__ void hgrn_b(const Frame& F0) {
    Frame F = F0; F.tid = F.wave * 64 + lane_id_(); LAUNDER(F.tid); F.lane = F.tid & 63;
    const float* UT = (const float*)(F.os + OS_UT); const float* DEC = (const float*)(F.os + OS_DEC); bf16* SP = (bf16*)(F.os + OS_SP);
    for (int blk = F.wg; blk < NB * 4 * 8; blk += F.G) {
        const int bh = blk >> 3, e = (blk & 7) * 512 + F.tid, d = e & 63;
        float S = 0.f;
        for (int c0 = 0; c0 < HCH; c0 += 11) {
            float ut[11], dc[11];
#pragma unroll
            for (int j = 0; j < 11; ++j) { const size_t item = (size_t)bh * HCH + c0 + j; ut[j] = UT[item * 4096 + e]; dc[j] = DEC[item * 64 + d]; }
#pragma unroll
            for (int j = 0; j < 11; ++j) { const size_t item = (size_t)bh * HCH + c0 + j; SP[item * 4096 + e] = (bf16)f2bf(S); S = dc[j] * S + ut[j]; }
        }
    }
}

__device__ __forceinline__ void hgrn_c(const Frame& F0, int l) {
    Frame F = F0; F.tid = F.wave * 64 + lane_id_(); LAUNDER(F.tid); F.lane = F.tid & 63;
    const bf16* proj = (const bf16*)(F.ws + WS_PROJ); const bf16* SPg = (const bf16*)(F.os + OS_SP); bf16* mixed = (bf16*)(F.ws + WS_MIXED);
    const int half = F.tid >> 8, ht = F.tid & 255, hw = F.wave & 3, lane = F.lane;
    LAS unsigned char* base = F.lds + half * HG_HALF;
    LAS float* LF = (LAS float*)(base + HG_LF); LAS float* SEG = (LAS float*)(base + HG_SEG);
    LAS bf16* vT = (LAS bf16*)(base + HG_T0); LAS bf16* QT = vT + HG_TS / 2; LAS bf16* KT = QT + HG_TS / 2; LAS bf16* QS = KT + HG_TS / 2; LAS bf16* SPt = QS + HG_TS / 2; LAS bf16* P = SPt + HG_TS / 2;
    const float* ng = F.in[IN_HNG] + l * 64;
    for (int p = F.wg; p < NB * 4 * HCH / 2; p += F.G) {
        const int item = 2 * p + half, c = item % HCH, bh = item / HCH, b = bh >> 2, h = bh & 3;
        const size_t tok0 = (size_t)b * LT + (c == 0 ? 0 : 16 + 64 * (c - 1)); const int nrows = (c == 0) ? 16 : 64;
        float qv[16], kv[16], lbA[8], onem[8];
#pragma unroll
        for (int jj = 0; jj < 8; ++jj) { const float lb = hgrn_lb(F.in[IN_HLB], l, h * 64 + 8 * (ht & 7) + jj); lbA[jj] = fmaxf(lb, 1e-30f); onem[jj] = 1.f - lb; }
#pragma unroll
        for (int e = 0; e < 2; ++e) { const int idx = ht + 256 * e, t = idx >> 3, c8 = idx & 7; const bool valid = t < nrows;
            u32x4 zq = (u32x4){0u, 0u, 0u, 0u}, zf = zq, zi = zq;
            if (valid) { const bf16* rp = proj + (tok0 + t) * NI + h * 64 + 8 * c8; zq = *(const GAS u32x4*)(rp + C_HQ); zf = *(const GAS u32x4*)(rp + C_HF); zi = *(const GAS u32x4*)(rp + C_HI); }
            const u32x4 sp = *(const GAS u32x4*)(SPg + (size_t)item * 4096 + t * 64 + 8 * c8);
            *(LAS u32x4*)(SPt + t * 72 + 8 * c8) = sp;
#pragma unroll
            for (int jj = 0; jj < 8; ++jj) { const int d = 8 * c8 + jj; const unsigned wq = (jj & 1) ? (zq[jj >> 1] >> 16) : (zq[jj >> 1] & 0xffffu);
                const unsigned wf = (jj & 1) ? (zf[jj >> 1] >> 16) : (zf[jj >> 1] & 0xffffu); const unsigned wi = (jj & 1) ? (zi[jj >> 1] >> 16) : (zi[jj >> 1] & 0xffffu);
                float lf, kk; hgrn_gate(bf2f(wf), lbA[jj], onem[jj], lf, kk);
                LF[t * 65 + d] = valid ? lf : 0.f; kv[8 * e + jj] = valid ? kk : 0.f; qv[8 * e + jj] = valid ? siluf_(bf2f(wq)) : 0.f;
                vT[d * 72 + t] = (bf16)wi; }
        }
        __syncthreads();
        { const int d = ht & 63, seg = ht >> 6; float run = 0.f;
#pragma unroll
          for (int i = 0; i < 16; ++i) { run += LF[(16 * seg + i) * 65 + d]; LF[(16 * seg + i) * 65 + d] = run; }
          SEG[seg * 64 + d] = run; }
        __syncthreads();
#pragma unroll
        for (int e = 0; e < 2; ++e) { const int idx = ht + 256 * e, t = idx >> 3, c8 = idx & 7, seg = t >> 4;
            unsigned wq[4], wk[4], ws[4];
#pragma unroll
            for (int jp = 0; jp < 4; ++jp) { float qt[2], kt[2], qs[2];
#pragma unroll
                for (int u = 0; u < 2; ++u) { const int jj = 2 * jp + u, d = 8 * c8 + jj;
                    float offs = 0.f;
#pragma unroll
                    for (int s = 0; s < 3; ++s) if (s < seg) offs += SEG[s * 64 + d];
                    const float cum = LF[t * 65 + d] + offs, mid = LF[31 * 65 + d] + SEG[d];
                    const float q = qv[8 * e + jj], k = kv[8 * e + jj];
                    qt[u] = q * __expf(cum - mid); kt[u] = k * __expf(mid - cum); qs[u] = q * __expf(cum); }
                wq[jp] = pk2(qt[0], qt[1]); wk[jp] = pk2(kt[0], kt[1]); ws[jp] = pk2(qs[0], qs[1]); }
            *(LAS u32x4*)(QT + t * 72 + 8 * c8) = (u32x4){wq[0], wq[1], wq[2], wq[3]};
            *(LAS u32x4*)(KT + t * 72 + 8 * c8) = (u32x4){wk[0], wk[1], wk[2], wk[3]};
            *(LAS u32x4*)(QS + t * 72 + 8 * c8) = (u32x4){ws[0], ws[1], ws[2], ws[3]};
        }
        __syncthreads();
        const int ar = (16 * hw + (lane & 15)) * 72 + 8 * (lane >> 4);
        {
            f32x4 sc[4];
#pragma unroll
            for (int nt = 0; nt < 4; ++nt) sc[nt] = (f32x4){0.f, 0.f, 0.f, 0.f};
#pragma unroll
            for (int ks = 0; ks < 2; ++ks) { const bf16x8 a = *(const LAS bf16x8*)(QT + ar + 32 * ks);
#pragma unroll
                for (int nt = 0; nt < 4; ++nt) { const bf16x8 bb = *(const LAS bf16x8*)(KT + (16 * nt + (lane & 15)) * 72 + 32 * ks + 8 * (lane >> 4)); sc[nt] = MFMA16(a, bb, sc[nt]); } }
#pragma unroll
            for (int nt = 0; nt < 4; ++nt)
#pragma unroll
                for (int j = 0; j < 4; ++j) { const int t = 16 * hw + 4 * (lane >> 4) + j, s = 16 * nt + (lane & 15); P[t * 72 + s] = (bf16)f2bf(s <= t ? sc[nt][j] : 0.f); }
        }
        __syncthreads();
        f32x4 o[4];
#pragma unroll
        for (int nt = 0; nt < 4; ++nt) o[nt] = (f32x4){0.f, 0.f, 0.f, 0.f};
#pragma unroll
        for (int ks = 0; ks < 2; ++ks) { const bf16x8 a = *(const LAS bf16x8*)(P + ar + 32 * ks), a2 = *(const LAS bf16x8*)(QS + ar + 32 * ks);
#pragma unroll
            for (int nt = 0; nt < 4; ++nt) { const int br = (16 * nt + (lane & 15)) * 72 + 32 * ks + 8 * (lane >> 4);
                o[nt] = MFMA16(a, *(const LAS bf16x8*)(vT + br), o[nt]); o[nt] = MFMA16(a2, *(const LAS bf16x8*)(SPt + br), o[nt]); } }
#pragma unroll
        for (int j = 0; j < 4; ++j) { const int t = 16 * hw + 4 * (lane >> 4) + j;
            float ssq = o[0][j] * o[0][j] + o[1][j] * o[1][j] + o[2][j] * o[2][j] + o[3][j] * o[3][j];
            ssq += __shfl_xor(ssq, 1); ssq += __shfl_xor(ssq, 2); ssq += __shfl_xor(ssq, 4); ssq += __shfl_xor(ssq, 8);
            const float rn = rsqrtf(ssq * (1.f / 64.f) + RMS_EPS);
            if (t < nrows) {
#pragma unroll
                for (int nt = 0; nt < 4; ++nt) { const int v = 16 * nt + (lane & 15);
                    const float zg = bf2f(proj[(tok0 + t) * NI + C_HG + h * 64 + v]);
                    mixed[(tok0 + t) * D + 256 + h * 64 + v] = (bf16)f2bf(o[nt][j] * rn * ng[v] * siluf_(zg)); } } }
        __syncthreads();
    }
}

constexpr int AT_KP = 272;
constexpr int AT_KB = 64 * AT_KP, AT_VB = 16384, AT_K = 0, AT_V = 2 * AT_KB, AT_Q = AT_V + 2 * AT_VB;
typedef short v4i16_t __attribute__((ext_vector_type(4)));
__device__ __forceinline__ s16x4 vtr(const LAS unsigned char* p) { return __builtin_bit_cast(s16x4, __builtin_amdgcn_ds_read_tr16_b64_v4i16((LAS v4i16_t*)p)); }
__device__ __forceinline__ float u2f_(unsigned u) { return __builtin_bit_cast(float, u); }
__device__ __forceinline__ float xhalf_max(float v) { const unsigned a = __builtin_bit_cast(unsigned, v); auto rr = __builtin_amdgcn_permlane32_swap(a, a, false, false); const unsigned r0 = rr[0], r1 = rr[1]; return fmaxf(u2f_(r0), u2f_(r1)); }
__device__ __forceinline__ float xhalf_sum(float v) { const unsigned a = __builtin_bit_cast(unsigned, v); auto rr = __builtin_amdgcn_permlane32_swap(a, a, false, false); const unsigned r0 = rr[0], r1 = rr[1]; return u2f_(r0) + u2f_(r1); }
__device__ __forceinline__ int crow(int r, int hi) { return (r & 3) + 8 * (r >> 2) + 4 * hi; }
__device__ __forceinline__ void attn_unit(const Frame& F, int b, int h, int j, const float* subg) {
    const bf16* proj = (const bf16*)(F.ws + WS_PROJ); bf16* mixed = (bf16*)(F.ws + WS_MIXED);
    int tid_ = F.wave * 64 + lane_id_(); LAUNDER(tid_);
    const int tid = tid_, lane = tid & 63, w = F.wave, r32 = lane & 31, hi = lane >> 5;
    const int qbase = (j == 0) ? 0 : 16 + 256 * (j - 1), ntile = (j == 0) ? 1 : 4 * j + 1;
    const int qrow = qbase + 32 * w + r32;
    const bf16* pb = proj + (size_t)b * LT * NI + h * 128;
    bf16* ob = mixed + ((size_t)b * LT + qbase + 32 * w) * D + 512 + h * 128;
    const __amdgpu_buffer_rsrc_t prs = __builtin_amdgcn_make_buffer_rsrc((void*)pb, 0, 0x7fffffff, 0x00020000);
    LAS unsigned char* Kc = F.lds + AT_K; LAS unsigned char* Vc = F.lds + AT_V;
    const unsigned vo_k0 = (unsigned)(((tid >> 4) * NI + C_AK + 8 * (tid & 15)) * 2), vo_k1 = vo_k0 + (unsigned)(32 * NI * 2);
    const unsigned vo_v0 = (unsigned)(((tid >> 4) * NI + C_AV + 8 * (tid & 15)) * 2), vo_v1 = vo_v0 + (unsigned)(32 * NI * 2);
    const int kst = (tid >> 4) * AT_KP + (tid & 15) * 16;
    const int vst = ((tid & 15) >> 2) * 4096 + (tid >> 4) * 64 + (tid & 3) * 16;
    const int krd = r32 * AT_KP + 16 * hi;
    const int vrd = (4 * hi + ((lane & 15) >> 2)) * 64 + ((lane >> 4) & 1) * 32 + (lane & 3) * 8;
    LAS unsigned char* Qw = F.lds + AT_Q + (tid >> 6) * (32 * AT_KP);
    __syncthreads();
    {
        const unsigned vq = (unsigned)(((qbase + 32 * w + (lane >> 1)) * NI + C_AQ + 64 * (lane & 1)) * 2);
#pragma unroll
        for (int c = 0; c < 8; ++c) *(LAS u32x4*)(Qw + (lane >> 1) * AT_KP + (lane & 1) * 128 + 16 * c) = bufld16(prs, vq + 16 * c, 0u);
    }
    const LAS unsigned char* Qr = Qw + r32 * AT_KP + 16 * hi;
    f32x16 O[2][4];
#pragma unroll
    for (int comp = 0; comp < 2; ++comp)
#pragma unroll
        for (int vb = 0; vb < 4; ++vb)
#pragma unroll
            for (int r = 0; r < 16; ++r) O[comp][vb][r] = 0.f;
    float mrun[2] = {-1e30f, -1e30f}, lrun[2] = {0.f, 0.f};
    u32x4 kreg0, kreg1, vreg0, vreg1;
#define AT_ISSUE(i_) do { const int kb_ = ((i_) == 0) ? 0 : 16 + 64 * ((i_) - 1); const unsigned so_ = (unsigned)(kb_ * NI * 2); \
        kreg0 = bufld16(prs, vo_k0, so_); kreg1 = bufld16(prs, vo_k1, so_); vreg0 = bufld16(prs, vo_v0, so_); vreg1 = bufld16(prs, vo_v1, so_); } while (0)
#define AT_COMMIT(buf_) do { *(LAS u32x4*)(Kc + (buf_) * AT_KB + kst) = kreg0; *(LAS u32x4*)(Kc + (buf_) * AT_KB + kst + 32 * AT_KP) = kreg1; \
        *(LAS u32x4*)(Vc + (buf_) * AT_VB + vst) = vreg0; *(LAS u32x4*)(Vc + (buf_) * AT_VB + vst + 32 * 64) = vreg1; } while (0)
    AT_ISSUE(0); AT_COMMIT(0);
    __syncthreads();
#pragma unroll 1
    for (int i = 0; i < ntile; ++i) {
        const int buf = i & 1, kb = (i == 0) ? 0 : 16 + 64 * (i - 1);
        const LAS unsigned char* Kb = Kc + buf * AT_KB + krd; const LAS unsigned char* Vb = Vc + buf * AT_VB + vrd;
        const bool domask = (i == 0 || i >= ntile - 4);
        if (i + 1 < ntile) AT_ISSUE(i + 1);
#pragma unroll
        for (int comp = 0; comp < 2; ++comp) {
            f32x16 sT[2]; bf16x8 pf[4];
#pragma unroll
            for (int kblk = 0; kblk < 2; ++kblk) {
#pragma unroll
                for (int r = 0; r < 16; ++r) sT[kblk][r] = 0.f;
#pragma unroll
                for (int ks = 0; ks < 4; ++ks) { const bf16x8 kf = *(const LAS bf16x8*)(Kb + (32 * kblk) * AT_KP + comp * 128 + 32 * ks); const bf16x8 qq = *(const LAS bf16x8*)(Qr + comp * 128 + 32 * ks); sT[kblk] = MFMA32(kf, qq, sT[kblk]); }
                __builtin_amdgcn_sched_barrier(0);
            }
            if (domask) {
#pragma unroll
                for (int kblk = 0; kblk < 2; ++kblk)
#pragma unroll
                    for (int r = 0; r < 16; ++r) { const int kl = 32 * kblk + crow(r, hi); const bool ok = (kb + kl <= qrow) && (i > 0 || kl < 16); if (!ok) sT[kblk][r] = -INFINITY; }
            }
            float mx = sT[0][0];
#pragma unroll
            for (int r = 1; r < 16; ++r) mx = fmaxf(mx, sT[0][r]);
#pragma unroll
            for (int r = 0; r < 16; ++r) mx = fmaxf(mx, sT[1][r]);
            mx = xhalf_max(mx);
            const float mnew = fmaxf(mrun[comp], mx), alpha = __builtin_amdgcn_exp2f(mrun[comp] - mnew);
            float psum = 0.f;
#pragma unroll
            for (int kblk = 0; kblk < 2; ++kblk)
#pragma unroll
                for (int r = 0; r < 16; ++r) { const float pv = __builtin_amdgcn_exp2f(sT[kblk][r] - mnew); sT[kblk][r] = pv; psum += pv; }
            psum = xhalf_sum(psum);
            lrun[comp] = lrun[comp] * alpha + psum; mrun[comp] = mnew;
#pragma unroll
            for (int vb = 0; vb < 4; ++vb)
#pragma unroll
                for (int r = 0; r < 16; ++r) O[comp][vb][r] *= alpha;
#pragma unroll
            for (int kblk = 0; kblk < 2; ++kblk)
#pragma unroll
                for (int s = 0; s < 2; ++s) {
                    u32x4 pw; pw.x = cvt_pk_bf16(sT[kblk][8 * s + 0], sT[kblk][8 * s + 1]); pw.y = cvt_pk_bf16(sT[kblk][8 * s + 2], sT[kblk][8 * s + 3]);
                    pw.z = cvt_pk_bf16(sT[kblk][8 * s + 4], sT[kblk][8 * s + 5]); pw.w = cvt_pk_bf16(sT[kblk][8 * s + 6], sT[kblk][8 * s + 7]);
                    pf[2 * kblk + s] = __builtin_bit_cast(bf16x8, pw); }
            __builtin_amdgcn_sched_barrier(0);
#pragma unroll
            for (int ks4 = 0; ks4 < 4; ++ks4)
#pragma unroll
                for (int vb = 0; vb < 4; ++vb) { const LAS unsigned char* vp = Vb + vb * 4096 + (16 * ks4) * 64;
                    const s16x4 lo = vtr(vp), hh = vtr(vp + 8 * 64);
                    const bf16x8 vf = (bf16x8){lo[0], lo[1], lo[2], lo[3], hh[0], hh[1], hh[2], hh[3]};
                    O[comp][vb] = MFMA32(vf, pf[ks4], O[comp][vb]);
                    if (vb & 1) __builtin_amdgcn_sched_barrier(0); }
            __builtin_amdgcn_sched_barrier(0);
        }
        if (i + 1 < ntile) AT_COMMIT(buf ^ 1);
        __syncthreads();
    }
#undef AT_ISSUE
#undef AT_COMMIT
    int tid2 = lane_id_(); LAUNDER(tid2);
    const int r32e = tid2 & 31, hie = (tid2 >> 5) & 1;
    const unsigned vo_o = (unsigned)((r32e * D + 4 * hie) * 2);
    const bool rowok = (j > 0) || (32 * w + r32e < 16);
    const float lam = ((const LAS float*)(F.lds + MISC_OFF))[16], oscale = ((const LAS float*)(F.lds + MISC_OFF))[17];
    const float l0inv = 1.f / lrun[0], l1s = lam / lrun[1];
    float ssq = 0.f;
#pragma unroll
    for (int vb = 0; vb < 4; ++vb)
#pragma unroll
        for (int r = 0; r < 16; ++r) { const float a = O[0][vb][r] * l0inv - O[1][vb][r] * l1s; O[0][vb][r] = a; ssq += a * a; }
    ssq = xhalf_sum(ssq);
    const float rn = rsqrtf(ssq * (1.f / 128.f) + RMS_EPS) * oscale;
    if (rowok) {
#pragma unroll
        for (int vb = 0; vb < 4; ++vb)
#pragma unroll
            for (int g4 = 0; g4 < 4; ++g4) { const f32x4 sg = ldg<f32x4>(subg, (unsigned)((32 * vb + 8 * g4 + 4 * hie) * 4));
                u32x2 wv; wv.x = pk2(O[0][vb][4 * g4 + 0] * rn * sg[0], O[0][vb][4 * g4 + 1] * rn * sg[1]); wv.y = pk2(O[0][vb][4 * g4 + 2] * rn * sg[2], O[0][vb][4 * g4 + 3] * rn * sg[3]);
                stg<u32x2>(ob, vo_o + (unsigned)((32 * vb + 8 * g4) * 2), wv); }
    }
}
__device__ __forceinline__ void attn_phase(const Frame& F0, int l) {
    Frame F = F0; F.tid = F.wave * 64 + lane_id_(); LAUNDER(F.tid); F.lane = F.tid & 63;
    float s1 = 0.f, s2 = 0.f;
    for (int i = 0; i < 64; ++i) { s1 += F.in[IN_LQ1][l * 64 + i] * F.in[IN_LK1][l * 64 + i]; s2 += F.in[IN_LQ2][l * 64 + i] * F.in[IN_LK2][l * 64 + i]; }
    const float lam_init = 0.8f - 0.6f * expf(-0.3f * (float)l);
    { const float lam = expf(s1) - expf(s2) + lam_init; if (F.tid == 0) { ((LAS float*)(F.lds + MISC_OFF))[16] = lam; ((LAS float*)(F.lds + MISC_OFF))[17] = 1.f - lam_init; } }
    __syncthreads();
    const float* subg = F.in[IN_SUBLN] + l * 128;
    const int npair = (512 - F.wg + F.G - 1) / F.G, nmeta = (F.wg < NB * 4) ? (NB * 4 - F.wg + F.G - 1) / F.G : 0;
#ifndef ATT_REP
#define ATT_REP 1
#endif
#pragma unroll 1
    for (int k0 = 0; k0 < ATT_REP * (2 * npair + nmeta); ++k0) {
        const int k = (ATT_REP == 1) ? k0 : k0 % (2 * npair + nmeta);
        int bh, j;
        if (k < 2 * npair) { const int p = F.wg + (k >> 1) * F.G; bh = p >> 2; const int s = p & 3; j = (k & 1) ? s + 1 : 8 - s; }
        else { bh = F.wg + (k - 2 * npair) * F.G; j = 0; }
        attn_unit(F, bh >> 2, bh & 3, j, subg);
    }
}

constexpr int RT_WP = 1032;
__device__ __forceinline__ void router_phase(const Frame& F0, int l) {
    Frame F = F0; F.tid = F.wave * 64 + lane_id_(); LAUNDER(F.tid); F.lane = F.tid & 63;
    const bf16* HBr = (const bf16*)(F.ws + WS_HB); const bf16* WR = (const bf16*)(F.ws + WS_WR) + (size_t)l * 2 * 32 * 1024;
    float* rstd = (float*)(F.ws + WS_RSTD); float* gate = (float*)(F.ws + WS_GATE); int* buck = (int*)(F.ws + WS_BUCK);
    unsigned* gcnt = (unsigned*)F.ws + CW_CNT + l * 64;
    LAS bf16* Wh = (LAS bf16*)F.lds;
    LAS bf16* Wl = Wh + 20 * RT_WP;
    LAS float* LG = (LAS float*)(F.lds + 2 * 20 * RT_WP * 2);
    LAS int* lcnt = (LAS int*)(LG + 8 * 16 * 33);
    LAS int* lbase = lcnt + 32;
    LAS int* tcls = lbase + 32;
    LAS int* tpos = tcls + 288;
    const int lane = F.lane, w = F.wave, fr = lane & 15, fq = lane >> 4;
    constexpr int NTASK = T / 16;
    const int ntl = (NTASK - F.wg + F.G - 1) / F.G;
    __syncthreads();
    for (int idx = F.tid; idx < 2 * 20 * 128; idx += 512) { const int hl = idx / (20 * 128), r = (idx / 128) % 20, c = idx % 128;
        *(LAS u32x4*)((hl ? Wl : Wh) + r * RT_WP + 8 * c) = *(const GAS u32x4*)(WR + (size_t)hl * 32 * 1024 + r * 1024 + 8 * c); }
    if (F.tid < 32) lcnt[F.tid] = 0;
    __syncthreads();
    const int n1 = (16 + fr < 20) ? 16 + fr : 19;
    for (int k = w; k < ntl; k += 8) {
        const int task = F.wg + k * F.G;
        const bf16* hrow = HBr + (size_t)task * 16 * D;
        const unsigned vo = (unsigned)((fr * D + 8 * fq) * 2);
        f32x4 acc[2]; acc[0] = (f32x4){0.f, 0.f, 0.f, 0.f}; acc[1] = acc[0];
        float ssq = 0.f;
#pragma unroll 8
        for (int ks = 0; ks < 32; ++ks) {
            const u32x4 xa = ldg<u32x4>(hrow, vo + ks * 64);
            const float x0 = bf2f(xa.x), x1 = bf2f(xa.x >> 16), x2 = bf2f(xa.y), x3 = bf2f(xa.y >> 16), x4 = bf2f(xa.z), x5 = bf2f(xa.z >> 16), x6 = bf2f(xa.w), x7 = bf2f(xa.w >> 16);
            ssq += (x0 * x0 + x1 * x1) + (x2 * x2 + x3 * x3) + (x4 * x4 + x5 * x5) + (x6 * x6 + x7 * x7);
            const bf16x8 ahi = __builtin_bit_cast(bf16x8, xa);
            const bf16x8 bh0 = *(const LAS bf16x8*)(Wh + fr * RT_WP + 32 * ks + 8 * fq), bl0 = *(const LAS bf16x8*)(Wl + fr * RT_WP + 32 * ks + 8 * fq);
            const bf16x8 bh1 = *(const LAS bf16x8*)(Wh + n1 * RT_WP + 32 * ks + 8 * fq), bl1 = *(const LAS bf16x8*)(Wl + n1 * RT_WP + 32 * ks + 8 * fq);
            acc[0] = MFMA16(ahi, bh0, acc[0]); acc[0] = MFMA16(ahi, bl0, acc[0]);
            acc[1] = MFMA16(ahi, bh1, acc[1]); acc[1] = MFMA16(ahi, bl1, acc[1]);
        }
        ssq += __shfl_xor(ssq, 16); ssq += __shfl_xor(ssq, 32);
        const float rs = rsqrtf(ssq * (1.f / 1024.f) + RMS_EPS);
#pragma unroll
        for (int nt = 0; nt < 2; ++nt)
#pragma unroll
            for (int j = 0; j < 4; ++j) LG[w * 16 * 33 + (4 * fq + j) * 33 + 16 * nt + fr] = acc[nt][j];
        LDS_WAIT(); asm volatile("" ::: "memory");
        if (lane < 16) {
            const int tl = k * 16 + lane; const size_t m = (size_t)task * 16 + lane;
            const float rsm = rs;
            const LAS float* lg = LG + w * 16 * 33 + lane * 33;
            float gl[4]; float gm = -1e30f; int gi = 0;
#pragma unroll
            for (int q = 0; q < 4; ++q) { gl[q] = lg[q] * rsm + F.in[IN_BGRP][l * 4 + q]; if (gl[q] > gm) { gm = gl[q]; gi = q; } }
            float gs = 0.f;
#pragma unroll
            for (int q = 0; q < 4; ++q) gs += __expf(gl[q] - gm);
            const float gp = 1.f / gs;
            float el[4];
#pragma unroll
            for (int q = 0; q < 4; ++q) el[q] = lg[4 + 4 * gi + q] * rsm + F.in[IN_BEXP][l * 16 + 4 * gi + q];
            int i1 = 0; float v1 = el[0];
#pragma unroll
            for (int q = 1; q < 4; ++q) if (el[q] > v1) { v1 = el[q]; i1 = q; }
            int i2 = -1; float v2 = -1e30f;
#pragma unroll
            for (int q = 0; q < 4; ++q) if (q != i1 && el[q] > v2) { v2 = el[q]; i2 = q; }
            const float e2 = __expf(v2 - v1), w1 = gp / (1.f + e2), w2 = gp * e2 / (1.f + e2);
            const int a = i1 < i2 ? i1 : i2, bq = i1 < i2 ? i2 : i1;
            const int pidx = (a == 0) ? (bq - 1) : (a == 1 ? bq + 1 : 5);
            const int cls = gi * 6 + pidx;
            rstd[m] = rsm; gate[2 * m] = (a == i1) ? w1 : w2; gate[2 * m + 1] = (a == i1) ? w2 : w1;
            tcls[tl] = cls; tpos[tl] = atomicAdd((int*)&lcnt[cls], 1);
        }
    }
    __syncthreads();
    if (F.tid < NCLS) lbase[F.tid] = (int)atomicAdd(&gcnt[F.tid], (unsigned)lcnt[F.tid]);
    __syncthreads();
    if (F.tid < ntl * 16) { const int cls = tcls[F.tid]; buck[(size_t)cls * T + lbase[cls] + tpos[F.tid]] = (F.wg + (F.tid >> 4) * F.G) * 16 + (F.tid & 15); }
    __syncthreads();
}

__device__ __forceinline__ void final_phase(const Frame& F0, float* out) {
    Frame F = F0; F.tid = F.wave * 64 + lane_id_(); LAUNDER(F.tid); F.lane = F.tid & 63;
    const bf16* HBf = (const bf16*)(F.ws + WS_HB); const float* g = F.in[IN_FNG];
    const int gw = F.wg * 8 + F.wave, NGW = F.G * 8, lane = F.lane;
    for (int r = gw; r < NB * SEQ; r += NGW) {
        const int b = r / SEQ, t = r % SEQ; const size_t m = (size_t)b * LT + NMETA + t;
        const GAS u32x2* hr = (const GAS u32x2*)(HBf + m * D) + lane; GAS f32x4* orow = (GAS f32x4*)(out + (size_t)r * D) + lane;
        f32x4 v[4]; float s = 0.f;
#pragma unroll
        for (int j = 0; j < 4; ++j) { const u32x2 q = hr[64 * j]; v[j] = (f32x4){bf2f(q.x), bf2f(q.x >> 16), bf2f(q.y), bf2f(q.y >> 16)}; s += (v[j].x * v[j].x + v[j].y * v[j].y) + (v[j].z * v[j].z + v[j].w * v[j].w); }
        const float rs = rsqrtf(wave_sum(s) * (1.f / 1024.f) + RMS_EPS);
#pragma unroll
        for (int j = 0; j < 4; ++j) { const f32x4 gg = *((const GAS f32x4*)g + lane + 64 * j); orow[64 * j] = v[j] * rs * gg; }
    }
}

template <int NPN>
__device__ __forceinline__ int moe_prepare(const Frame& F0, int l, LAS int* cntl, LAS int* tab) {
    Frame F = F0; F.tid = F.wave * 64 + lane_id_(); LAUNDER(F.tid); F.lane = F.tid & 63;
    const unsigned* gcnt = (const unsigned*)F.ws + CW_CNT + l * 64; const int* buck = (const int*)(F.ws + WS_BUCK);
    __syncthreads();
    if (F.tid < NCLS) cntl[F.tid] = (int)gcnt[F.tid];
    __syncthreads();
    MoeList ml{cntl}; const int ntl = ml.ntiles();
    for (int i = 0;; ++i) { const int Lx = i * F.G + F.wg; if (Lx >= ntl * NPN) break;
        int c, ti, nv; ml.decode(Lx / NPN, c, ti, nv);
        if (F.tid < 256) tab[i * 256 + F.tid] = (F.tid < nv) ? buck[(size_t)c * T + ti * 256 + F.tid] : -1; }
    __syncthreads();
    return ntl;
}

#ifndef ONLY_MASK
#define ONLY_MASK 0xFFFFFFFFu
#endif
#define IN(k) (lo <= (k) && (k) < hi)
#define EN(j) ((ONLY_MASK >> (j)) & 1u)
#ifndef SUBMASK
#define SUBMASK 3u
#endif
#define SEAM(k) do { if (IN(k) && IN((k) + 1)) xcd_barrier(bar); } while (0)
template <int L>
__device__ __forceinline__ void layer_phases(const Frame& F, const XcdBarrier& bar, int lo, int hi) {
    bf16* proj = (bf16*)(F.ws + WS_PROJ); bf16* mixed = (bf16*)(F.ws + WS_MIXED); bf16* HB = (bf16*)(F.ws + WS_HB);
    float* ss16 = (float*)(F.ws + WS_SS16);
    LAS int* tab = (LAS int*)(F.lds + TAB_OFF); LAS int* cntl = (LAS int*)(F.lds + TAB_OFF + 12 * 1024);
    constexpr int l = L; constexpr int pb = 1 + 9 * L;
        if (EN(1) && IN(pb + 0)) {
            PolIn P; P.ord.init(MT, NI / 256, F.G, F.wg); P.A = HB; P.B = (const bf16*)(F.ws + WS_WIN) + (size_t)l * NI * D; P.proj = proj; P.ss16 = ss16; P.rope = (const float*)(F.ws + WS_ROPE);
            for (int rep = 0; rep < NREP(1); ++rep) pg8::gemm_phase(F.lds, P, F.wave); }
        SEAM(pb + 0);
        if (EN(2) && IN(pb + 1)) {
            PolS5E P; P.G = F.G; P.c = F.wg; P.proj = proj; P.B = (const bf16*)(F.ws + WS_S5P) + (size_t)l * 16 * 256 * 256; P.E = (float*)(F.os + OS_E);
            for (int rep = 0; rep < NREP(2); ++rep) if (MIXSEL & 1u) pg8::gemm_phase(F.lds, P, F.wave);
            __syncthreads();
            for (int rep = 0; rep < NREP(11); ++rep) if (MIXSEL & 2u) hgrn_a(F, l); }
        SEAM(pb + 1);
        if (EN(3) && IN(pb + 2)) { for (int rep = 0; rep < NREP(3); ++rep) { if (MIXSEL & 1u) s5_scan(F, l); if (MIXSEL & 2u) hgrn_b(F); } }
        SEAM(pb + 2);
        if (EN(4) && IN(pb + 3)) {
            PolS5Y P; P.G = F.G; P.c = F.wg; P.X = (const bf16*)(F.os + OS_X); P.B = (const bf16*)(F.ws + WS_S5TQ) + (size_t)l * 16 * 256 * 384; P.proj = proj; P.dsk = F.in[IN_S5D] + l * 256; P.Gout = (bf16*)(F.os + OS_G);
            for (int rep = 0; rep < NREP(4); ++rep) if ((SUBMASK & MIXSEL & 1u) != 0u) pg8::gemm_phase(F.lds, P, F.wave);
            __syncthreads();
            for (int rep = 0; rep < NREP(12); ++rep) if ((SUBMASK & MIXSEL & 2u) != 0u) hgrn_c(F, l); }
        SEAM(pb + 3);
        if (EN(5) && IN(pb + 4)) {
            PolGlu P; P.ord.init(MT, 2, F.G, F.wg); P.A = (const bf16*)(F.os + OS_G); P.B = (const bf16*)(F.ws + WS_WGLU) + (size_t)l * 512 * 256; P.mixed = mixed;
            for (int rep = 0; rep < NREP(5); ++rep) if ((SUBMASK & MIXSEL & 1u) != 0u) pg8::gemm_phase(F.lds, P, F.wave);
            __syncthreads();
            for (int rep = 0; rep < NREP(13); ++rep) if ((SUBMASK & 2u) != 0u && (MIXSEL & 4u) != 0u) attn_phase(F, l); }
        SEAM(pb + 4);
        if (EN(6) && IN(pb + 5)) {
            PolOut P; P.ord.init(MT, 4, F.G, F.wg); P.A = mixed; P.B = (const bf16*)(F.ws + WS_WOUT) + (size_t)l * D * D; P.HB = HB; P.ss16 = ss16;
            pg8::gemm_phase(F.lds, P, F.wave); }
        SEAM(pb + 5);
        if (EN(7) && IN(pb + 6)) { router_phase(F, l); }
        SEAM(pb + 6);
        if (EN(8) && IN(pb + 7)) {
            PolGU P; P.G = F.G; P.c = F.wg; P.ntl = moe_prepare<8>(F, l, cntl, tab); P.ml = MoeList{cntl}; P.tab = tab;
            P.HB = HB; P.W = (const bf16*)(F.ws + WS_WGU) + (size_t)l * 16 * 1024 * 1024; P.he = proj; P.rstd = (const float*)(F.ws + WS_RSTD); P.gate = (const float*)(F.ws + WS_GATE);
            for (int rep = 0; rep < NREP(8); ++rep) pg8::gemm_phase(F.lds, P, F.wave); }
        SEAM(pb + 7);
        if (EN(9) && IN(pb + 8)) {
            PolDN P; P.G = F.G; P.c = F.wg; P.ntl = moe_prepare<4>(F, l, cntl, tab); P.ml = MoeList{cntl}; P.tab = tab;
            P.he = proj; P.W = (const bf16*)(F.ws + WS_WDN) + (size_t)l * 16 * 1024 * 512; P.HB = HB; P.ss16 = ss16;
            pg8::gemm_phase(F.lds, P, F.wave); }
        SEAM(pb + 8);
}

__global__ void __launch_bounds__(512, 2) hymba_fwd(Args args) {
    extern __shared__ __attribute__((aligned(16))) unsigned char lds_raw[];
    Frame F;
    F.lds = (LAS unsigned char*)lds_raw;
    F.tid = threadIdx.x; F.lane = F.tid & 63; F.wave = __builtin_amdgcn_readfirstlane(F.tid >> 6);
    F.G = gridDim.x; F.wg = blockIdx.x; F.in = args.in; F.ws = args.ws; F.os = (unsigned char*)args.out;
    volatile LAS unsigned* MISC = (volatile LAS unsigned*)(F.lds + MISC_OFF);
    if (F.tid < 256) MISC[F.tid] = 0u;
    __syncthreads();
    const int lo = args.ph_lo, hi = args.ph_hi;
    const bool one = (hi - lo) > 1;
    XcdBarrier bar; bar.bar = (unsigned*)F.ws + CW_BAR; bar.x = 0; bar.st = nullptr;
    bar.wave = F.wave;
    if (one) bar = xcd_barrier_post((unsigned*)F.ws + CW_BAR, MISC + 8, F.wave);
    if (EN(0) && IN(0)) { for (int rep = 0; rep < NREP(0); ++rep) p0_prologue(F); } SEAM(0);
    layer_phases<0>(F, bar, lo, hi);
    layer_phases<1>(F, bar, lo, hi);
    if (EN(10) && IN(19)) for (int rep = 0; rep < NREP(10); ++rep) final_phase(F, args.out);
#undef IN
#undef SEAM
}

extern "C" void kernel_launch(void* const* d_in, const int* in_sizes, int n_in, void* d_out, int out_size, void* d_ws, size_t ws_size, hipStream_t stream) {
    static int grid = 0;
    if (grid == 0) {
        if (n_in != 30 || ws_size < WS_END) { fprintf(stderr, "kernel_launch: unexpected inputs (n_in %d, ws %zu < %zu)\n", n_in, ws_size, (size_t)WS_END); grid = -1; return; }
        int dev = 0, cus = 0, per_cu = 0;
        (void)hipGetDevice(&dev); (void)hipDeviceGetAttribute(&cus, hipDeviceAttributeMultiprocessorCount, dev);
        (void)hipFuncSetAttribute((const void*)hymba_fwd, hipFuncAttributeMaxDynamicSharedMemorySize, LDS_BYTES);
        (void)hipOccupancyMaxActiveBlocksPerMultiprocessor(&per_cu, (const void*)hymba_fwd, 512, LDS_BYTES);
        (void)hipGetLastError();
        grid = cus > 0 ? cus : 256;
    }
    if (grid < 0) return;
    (void)hipMemsetAsync(d_ws, 0, CTL_BYTES, stream);
    Args a{};
    for (int i = 0; i < 30; ++i) a.in[i] = (const float*)d_in[i];
    a.out = (float*)d_out; a.ws = (unsigned char*)d_ws;
#if N_LAUNCH_MODE == 1
    a.ph_lo = 0; a.ph_hi = LAST_PHASE;
    hipLaunchKernelGGL(hymba_fwd, dim3(grid), dim3(512), LDS_BYTES, stream, a);
#else
    if (MIXSEL != 7u) (void)hipMemsetAsync((char*)d_ws + WS_MIXED, 0, (size_t)T * D * 2, stream);
    for (int p = 0; p < LAST_PHASE; ++p) { if (!((RUN_MASK >> p) & 1u)) continue; a.ph_lo = p; a.ph_hi = p + 1; hipLaunchKernelGGL(hymba_fwd, dim3(grid), dim3(512), LDS_BYTES, stream, a); }
#endif
}
```

```cpp
#include <hip/hip_runtime.h>
#include <stdint.h>
#include <stdio.h>

#ifndef N_LAUNCH_MODE
#define N_LAUNCH_MODE 1
#endif
#ifndef LAST_PHASE
#define LAST_PHASE 20
#endif
#ifndef RUN_MASK
#define RUN_MASK 0xFFFFFu
#endif
#ifndef REPMASK
#define REPMASK 0u
#endif
#define NREP(j) (((REPMASK >> (j)) & 1u) ? 2 : 1)
#ifndef MIXSEL
#define MIXSEL 7u
#endif

#define GAS __attribute__((address_space(1)))
#define LAS __attribute__((address_space(3)))
typedef unsigned short bf16;
typedef short bf16x8 __attribute__((ext_vector_type(8)));
typedef short s16x4 __attribute__((ext_vector_type(4)));
typedef float f32x2 __attribute__((ext_vector_type(2)));
typedef float f32x4 __attribute__((ext_vector_type(4)));
typedef float f32x16 __attribute__((ext_vector_type(16)));
typedef unsigned u32x2 __attribute__((ext_vector_type(2)));
typedef unsigned u32x4 __attribute__((ext_vector_type(4)));

constexpr int NB = 32, LT = 2064, NMETA = 16, SEQ = 2048, T = NB * LT;
constexpr int D = 1024, NI = 2816, MT = T / 256;
constexpr int C_U = 0, C_HQ = 256, C_HF = 512, C_HI = 768, C_HG = 1024, C_AQ = 1280, C_AK = 1792, C_AV = 2304;
constexpr int NCH = 129;
constexpr int S5R = NB * NCH;
constexpr int S5RP = 17 * 256;
constexpr int HCH = 33;
constexpr int NCLS = 24;
constexpr float RMS_EPS = 1e-6f;
constexpr float QSCALE = 0.125f * 1.4426950408889634f;

constexpr size_t al256(size_t x) { return (x + 255) & ~(size_t)255; }
constexpr size_t CTL_BYTES = 1u << 20;
constexpr size_t WS_WIN = CTL_BYTES;
constexpr size_t WS_WOUT = WS_WIN + al256((size_t)2 * NI * D * 2);
constexpr size_t WS_WGLU = WS_WOUT + al256((size_t)2 * D * D * 2);
constexpr size_t WS_WGU = WS_WGLU + al256((size_t)2 * 512 * 256 * 2);
constexpr size_t WS_WDN = WS_WGU + al256((size_t)2 * 16 * 1024 * 1024 * 2);
constexpr size_t WS_WR = WS_WDN + al256((size_t)2 * 16 * 1024 * 512 * 2);
constexpr size_t WS_S5TQ = WS_WR + al256((size_t)2 * 2 * 32 * 1024 * 2);
constexpr size_t WS_S5P = WS_S5TQ + al256((size_t)2 * 16 * 256 * 384 * 2);
constexpr size_t WS_S5A = WS_S5P + al256((size_t)2 * 16 * 256 * 256 * 2);
constexpr size_t WS_ROPE = WS_S5A + al256((size_t)2 * 16 * 64 * 8);
constexpr size_t WS_SS16 = WS_ROPE + al256((size_t)LT * 32 * 4 * 2);
constexpr size_t WS_RSTD = WS_SS16 + al256((size_t)T * 16 * 4);
constexpr size_t WS_GATE = WS_RSTD + al256((size_t)T * 4);
constexpr size_t WS_BUCK = WS_GATE + al256((size_t)T * 8);
constexpr size_t WS_HB = WS_BUCK + al256((size_t)NCLS * T * 4);
constexpr size_t WS_PROJ = WS_HB + al256((size_t)T * D * 2);
constexpr size_t WS_MIXED = WS_PROJ + al256((size_t)T * NI * 2);
constexpr size_t WS_END = WS_MIXED + al256((size_t)T * D * 2);
constexpr size_t OS_E = 0;
constexpr size_t OS_X = OS_E + al256((size_t)16 * S5RP * 128 * 4);
constexpr size_t OS_G = OS_X + al256((size_t)16 * S5RP * 384 * 2);
constexpr size_t OS_UT = OS_G + al256((size_t)T * 256 * 2);
constexpr size_t OS_DEC = OS_UT + al256((size_t)NB * 4 * HCH * 4096 * 4);
constexpr size_t OS_SP = OS_DEC + al256((size_t)NB * 4 * HCH * 64 * 4);
constexpr size_t OS_END = OS_SP + al256((size_t)NB * 4 * HCH * 4096 * 2);
static_assert(OS_END <= (size_t)NB * SEQ * D * 4, "mixer scratch must fit in d_out");
static_assert((size_t)(MT + NCLS) * 256 * 1024 * 2 <= (size_t)T * NI * 2, "he overlay fits in proj");

constexpr int CW_BAR = 4096, CW_CNT = 16384, CW_Q = 20480;

constexpr int LDS_BYTES = 147456;
constexpr int RING_BYTES = 131072;
constexpr int TAB_OFF = RING_BYTES;
constexpr int MISC_OFF = LDS_BYTES - 1024;

__device__ __forceinline__ unsigned f2bf(float f) { unsigned u = __builtin_bit_cast(unsigned, f); return (u + 0x7fffu + ((u >> 16) & 1u)) >> 16; }
__device__ __forceinline__ float bf2f(unsigned b) { return __builtin_bit_cast(float, (b & 0xffffu) << 16); }
__device__ __forceinline__ unsigned pk2(float lo, float hi) { return f2bf(lo) | (f2bf(hi) << 16); }
__device__ __forceinline__ unsigned cvt_pk_bf16(float lo, float hi) { unsigned r; asm volatile("v_cvt_pk_bf16_f32 %0, %1, %2" : "=v"(r) : "v"(lo), "v"(hi)); return r; }
__device__ __forceinline__ float wave_sum(float v) {
#pragma unroll
    for (int o = 1; o < 64; o <<= 1) v += __shfl_xor(v, o);
    return v;
}
__device__ __forceinline__ float sigmoidf_(float x) { return __builtin_amdgcn_rcpf(1.f + __expf(-x)); }
__device__ __forceinline__ float siluf_(float x) { return x * __builtin_amdgcn_rcpf(1.f + __expf(-x)); }
__device__ __forceinline__ float gelu_tanh(float x) { const float u = 0.7978845608028654f * (x + 0.044715f * x * x * x); return x * __builtin_amdgcn_rcpf(1.f + __expf(-2.f * u)); }
__device__ __forceinline__ int lane_id_() { int l; asm volatile("v_mbcnt_lo_u32_b32 %0, -1, 0\n\tv_mbcnt_hi_u32_b32 %0, -1, %0" : "=v"(l)); return l; }
#define LAUNDER(x) asm volatile("" : "+v"(x))
#define LAUNDER_S(x) asm volatile("" : "+s"(x))
#define LDS_WAIT() asm volatile("s_waitcnt lgkmcnt(0)" ::: "memory")
#define VM_WAIT() asm volatile("s_waitcnt vmcnt(0)" ::: "memory")

#define XB_TMO      128
#define XB_XCNT(j)  (256  + 64 * (j))
#define XB_XSUB(j)  (1280 + 64 * (j))
#define XB_XGEN(j)  (2304 + 64 * (j))
#define XB_TOP      3328
#define XB_TOPGEN   3392
#define XCD_BAR_WORDS 3456
#define XB_SPIN_CAP (1u << 18)
__device__ __forceinline__ unsigned xb_ld(unsigned* p)              { return __hip_atomic_load(p, __ATOMIC_RELAXED, __HIP_MEMORY_SCOPE_AGENT); }
__device__ __forceinline__ unsigned xb_add(unsigned* p, unsigned v) { return __hip_atomic_fetch_add(p, v, __ATOMIC_RELAXED, __HIP_MEMORY_SCOPE_AGENT); }
__device__ __forceinline__ unsigned xb_xcc_id() { return (unsigned)__builtin_amdgcn_s_getreg((3 << 11) | 20) & 0xFu; }
#define XB_SPIN(cond, bar) do { unsigned _sp = 0; while (cond) { __builtin_amdgcn_s_sleep(1); \
    if ((++_sp & 255u) == 0u) { if (xb_ld(&(bar)[XB_TMO])) break; if (_sp > XB_SPIN_CAP) { atomicAdd(&(bar)[XB_TMO], 1u); break; } } } } while (0)
struct XcdBarrier { unsigned* bar; unsigned x; volatile LAS unsigned* st; int wave; };
__device__ __forceinline__ XcdBarrier xcd_barrier_post(unsigned* bar, volatile LAS unsigned* st, int wave) {
    XcdBarrier b; b.bar = bar; b.x = xb_xcc_id(); b.st = st; b.wave = wave;
    if (wave == 0 && lane_id_() == 0) (void)xb_add(&bar[XB_XCNT(b.x)], 1u);
    return b;
}
__device__ __forceinline__ void xcd_barrier_complete(unsigned* bar, unsigned x, unsigned& nloc, unsigned& nx) {
    const unsigned G = gridDim.x * gridDim.y * gridDim.z;
    unsigned sum, cnt, mine, sp = 0u;
    for (;;) {
        sum = 0u; cnt = 0u; mine = 0u;
#pragma unroll 1
        for (unsigned j = 0; j < 16; ++j) { const unsigned c = xb_ld(&bar[XB_XCNT(j)]); sum += c; cnt += (c > 0u) ? 1u : 0u; mine = (j == x) ? c : mine; }
        if (sum == G) break;
        __builtin_amdgcn_s_sleep(1);
        if ((++sp & 255u) == 0u) { if (xb_ld(&bar[XB_TMO])) break; if (sp > XB_SPIN_CAP) { atomicAdd(&bar[XB_TMO], 1u); break; } }
    }
    nloc = mine > 0u ? mine : 1u; nx = cnt > 0u ? cnt : 1u;
}
__device__ __forceinline__ void xcd_barrier(const XcdBarrier& b) {
    asm volatile("s_waitcnt vmcnt(0)" ::: "memory");
    __syncthreads();
    if (b.wave == 0 && lane_id_() == 0) {
        unsigned* bar = b.bar;
        __builtin_amdgcn_s_waitcnt(0);
        unsigned nloc = b.st[0], nx = b.st[1];
        if (nloc == 0u) { xcd_barrier_complete(bar, b.x, nloc, nx); b.st[0] = nloc; b.st[1] = nx; }
        const unsigned old = xb_add(&bar[XB_XSUB(b.x)], 1u);
        const unsigned gen = old / nloc;
        if (old + 1u == (gen + 1u) * nloc) {
            __builtin_amdgcn_fence(__ATOMIC_RELEASE, "agent");
            asm volatile("s_waitcnt vmcnt(0)" ::: "memory");
            const unsigned og = xb_add(&bar[XB_TOP], 1u);
            const unsigned tg = og / nx;
            if (og + 1u == (tg + 1u) * nx) xb_add(&bar[XB_TOPGEN], 1u);
            else XB_SPIN(xb_ld(&bar[XB_TOPGEN]) == tg, bar);
            __builtin_amdgcn_fence(__ATOMIC_ACQUIRE, "agent");
            xb_add(&bar[XB_XGEN(b.x)], 1u);
            asm volatile("s_waitcnt vmcnt(0)" ::: "memory");
        } else {
            XB_SPIN(xb_ld(&bar[XB_XGEN(b.x)]) == gen, bar);
            __builtin_amdgcn_fence(__ATOMIC_ACQUIRE, "agent");
            asm volatile("s_waitcnt vmcnt(0)" ::: "memory");
        }
    }
    __syncthreads();
}

namespace pg8 {
constexpr int BM = 256, BK = 64, HALF = 128, HTB = HALF * BK * 2, NXCD = 8, WGM = 8;
__host__ __device__ __forceinline__ int lds_byte(int r, int c) { const int st = (r >> 4) * 2 + (c >> 5), rr = r & 15, cc = c & 31, ob = rr * 64 + cc * 2; return st * 1024 + (ob ^ (((ob >> 9) & 1) << 5)); }
__host__ __device__ __forceinline__ void stage_rc(int b, int& R, int& C) { const int st = b / 1024, sb = b % 1024, swz = sb ^ (((sb >> 9) & 1) << 5); R = (st >> 1) * 16 + swz / 64; C = (st & 1) * 32 + (swz % 64) / 2; }
__host__ __device__ __forceinline__ int perm32(int rho) { const int n = rho >> 4, i = rho & 15; return 8 * (i >> 2) + 4 * n + (i & 3); }

struct TileOrder {
    int nM, nN, nwg, G, c;
    __device__ __forceinline__ void init(int nM_, int nN_, int G_, int c_) { nM = nM_; nN = nN_; nwg = nM * nN; G = G_; c = c_; }
    __device__ __forceinline__ bool get(int i, int& pm, int& pn) const {
        const long Lx = (long)i * G + c; if (Lx >= nwg) return false;
        int wgid = (int)Lx; { const int q = nwg / NXCD, r = nwg % NXCD, xcd = wgid % NXCD, off = wgid / NXCD; wgid = (xcd < r ? xcd * (q + 1) : r * (q + 1) + (xcd - r) * q) + off; }
        const int nig = WGM * nN, gid = wgid / nig, fm = gid * WGM, gsz = (nM - fm) < WGM ? (nM - fm) : WGM;
        pm = fm + ((wgid % nig) % gsz); pn = (wgid % nig) / gsz; return true;
    }
};

template <class P>
__device__ __forceinline__ void gemm_phase(LAS unsigned char* lds, const P& S, int wave) {
    typedef typename P::Unit Unit;
    int tid_ = wave * 64 + lane_id_(); LAUNDER(tid_);
    const int tid = tid_, wid = wave, lane = tid & 63, wr = wid >> 2, wc = wid & 3, fr = lane & 15, fq = lane >> 4;
    constexpr int nt = P::NT; constexpr int LDB = P::LDB;
    int Rs[2], Cs[2]; unsigned voffB[2];
#pragma unroll
    for (int i = 0; i < 2; ++i) { int R, C; stage_rc(tid * 16 + i * 8192, R, C); Rs[i] = R; Cs[i] = C; const int Rb = (R & ~31) + perm32(R & 31); voffB[i] = (unsigned)(Rb * LDB + C) * 2u; }
    const size_t hstepB = (size_t)HALF * LDB * 2;
    const unsigned ldsw = (unsigned)wid * 1024u;
    const int aoff = lds_byte(wr * 64 + fr, fq * 8), boff = lds_byte(wc * 32 + fr, fq * 8);
#define PG8_SA(b, h) (((b) * 2 + (h)) * HTB)
#define PG8_SB(b, h) ((4 + (b) * 2 + (h)) * HTB)
#define PG8_STAGE1(bufoff, gptr, v0, v1) do { \
        __builtin_amdgcn_global_load_lds((const unsigned*)((const char*)(gptr) + (v0)), (LAS unsigned*)(lds + (bufoff) + ldsw), 16, 0, 0); \
        __builtin_amdgcn_global_load_lds((const unsigned*)((const char*)(gptr) + (v1)), (LAS unsigned*)(lds + (bufoff) + ldsw + 8192), 16, 0, 0); } while (0)
#define PG8_STAGEB(bufoff, gptr) PG8_STAGE1(bufoff, gptr, voffB[0], voffB[1])
#define PG8_LDA(dst, b, h) do { _Pragma("unroll") for (int m = 0; m < 4; ++m) _Pragma("unroll") for (int k = 0; k < 2; ++k) dst[m][k] = *(const LAS bf16x8*)(lds + PG8_SA(b, h) + aoff + m * 2048 + k * 1024); } while (0)
#define PG8_LDB(dst, b, h) do { _Pragma("unroll") for (int n = 0; n < 2; ++n) _Pragma("unroll") for (int k = 0; k < 2; ++k) dst[n][k] = *(const LAS bf16x8*)(lds + PG8_SB(b, h) + boff + n * 2048 + k * 1024); } while (0)
#define PG8_MMA(ai, bj, At, Bt) do { __builtin_amdgcn_s_setprio(1); _Pragma("unroll") for (int m = 0; m < 4; ++m) _Pragma("unroll") for (int n = 0; n < 2; ++n) _Pragma("unroll") for (int k = 0; k < 2; ++k) \
        acc[ai][bj][m][n] = __builtin_amdgcn_mfma_f32_16x16x32_bf16(Bt[n][k], At[m][k], acc[ai][bj][m][n], 0, 0, 0); __builtin_amdgcn_s_setprio(0); } while (0)
#define PG8_WAIT_V(n) asm volatile("s_waitcnt vmcnt(" #n ")" ::: "memory")
#define PG8_WAIT_L(n) asm volatile("s_waitcnt lgkmcnt(" #n ")" ::: "memory")
#define PG8_BAR __builtin_amdgcn_s_barrier()
#define PG8_SCHED __builtin_amdgcn_sched_barrier(0)
    Unit cur, nxt; int ui = 0;
    if (!S.next(0, cur)) return;
    f32x4 acc[2][2][4][2];
#pragma unroll
    for (int a = 0; a < 2; ++a)
#pragma unroll
        for (int b = 0; b < 2; ++b)
#pragma unroll
            for (int m = 0; m < 4; ++m)
#pragma unroll
                for (int n = 0; n < 2; ++n) acc[a][b][m][n] = (f32x4){0.f, 0.f, 0.f, 0.f};
    bf16x8 At[4][2], B0[2][2], B1[2][2];
#define PG8_STAGEA(bufoff, uidx, uu, tt, hh) S.stage_a(lds + (bufoff) + ldsw, uidx, uu, tt, hh, Rs, Cs)
    {
        const char* pB0 = S.b_ptr(cur, 0); const char* pB1 = S.b_ptr(cur, 1);
        PG8_STAGEB(PG8_SB(0, 0), pB0); PG8_STAGEB(PG8_SB(0, 1), pB0 + hstepB); PG8_STAGEA(PG8_SA(0, 0), 0, cur, 0, 0); PG8_STAGEA(PG8_SA(0, 1), 0, cur, 0, 1);
        if (wr == 1) PG8_BAR;
        PG8_WAIT_V(2); PG8_BAR;
        PG8_STAGEB(PG8_SB(1, 0), pB1); PG8_STAGEA(PG8_SA(1, 0), 0, cur, 1, 0); PG8_STAGEB(PG8_SB(1, 1), pB1 + hstepB);
        PG8_WAIT_V(6); PG8_BAR;
    }
    for (;;) {
        const bool has_next = S.next(ui + 1, nxt);
        if (!has_next) nxt = cur;
        const int uin = has_next ? ui + 1 : ui;
#pragma unroll 1
        for (int t = 0; t < nt; t += 2) {
            const bool last = (t == nt - 2);
            const Unit& u2 = last ? nxt : cur; const int ui2 = last ? uin : ui; const int t2 = last ? 0 : t + 2;
            const char* b2 = S.b_ptr(u2, t2); const char* b3 = S.b_ptr(u2, t2 + 1);
            PG8_LDB(B0, 0, 0); PG8_LDB(B1, 0, 1); PG8_SCHED; PG8_LDA(At, 0, 0); PG8_STAGEA(PG8_SA(1, 1), ui, cur, t + 1, 1);
            PG8_WAIT_V(8); PG8_WAIT_L(0); PG8_BAR; PG8_MMA(0, 0, At, B0); PG8_MMA(0, 1, At, B1); PG8_BAR; PG8_SCHED;
            PG8_LDA(At, 0, 1); PG8_STAGEB(PG8_SB(0, 0), b2); PG8_STAGEB(PG8_SB(0, 1), b2 + hstepB); PG8_STAGEA(PG8_SA(0, 0), ui2, u2, t2, 0);
            PG8_WAIT_V(8); PG8_WAIT_L(0); PG8_BAR; PG8_MMA(1, 0, At, B0); PG8_MMA(1, 1, At, B1); PG8_BAR; PG8_SCHED;
            PG8_LDB(B0, 1, 0); PG8_LDB(B1, 1, 1); PG8_SCHED; PG8_LDA(At, 1, 0); PG8_STAGEA(PG8_SA(0, 1), ui2, u2, t2, 1);
            PG8_WAIT_V(8); PG8_WAIT_L(0); PG8_BAR; PG8_MMA(0, 0, At, B0); PG8_MMA(0, 1, At, B1); PG8_BAR; PG8_SCHED;
            PG8_LDA(At, 1, 1); PG8_STAGEB(PG8_SB(1, 0), b3); PG8_STAGEB(PG8_SB(1, 1), b3 + hstepB); PG8_STAGEA(PG8_SA(1, 0), ui2, u2, t2 + 1, 0);
            PG8_WAIT_V(8); PG8_WAIT_L(0); PG8_BAR; PG8_MMA(1, 0, At, B0); PG8_MMA(1, 1, At, B1); PG8_BAR; PG8_SCHED;
        }
        if (wr == 0) PG8_BAR;
        S.epi(acc, cur, wr, wc, fr, fq, ui);
        PG8_SCHED;
        if (!has_next) break;
#pragma unroll
        for (int a = 0; a < 2; ++a)
#pragma unroll
            for (int b = 0; b < 2; ++b)
#pragma unroll
                for (int m = 0; m < 4; ++m)
#pragma unroll
                    for (int n = 0; n < 2; ++n) acc[a][b][m][n] = (f32x4){0.f, 0.f, 0.f, 0.f};
        cur = nxt; ++ui;
        if (wr == 1) PG8_BAR;
    }
    PG8_WAIT_V(0);
    PG8_BAR;
#undef PG8_SA
#undef PG8_SB
#undef PG8_STAGE1
#undef PG8_STAGEB
#undef PG8_STAGEA
#undef PG8_LDA
#undef PG8_LDB
#undef PG8_MMA
#undef PG8_WAIT_V
#undef PG8_WAIT_L
#undef PG8_BAR
#undef PG8_SCHED
}
}
typedef f32x4 AccT[2][2][4][2];

struct Args { const float* in[30]; float* out; unsigned char* ws; int ph_lo, ph_hi; };

struct Frame {
    LAS unsigned char* lds;
    int tid, lane, wave, G, wg;
    const float* const* in;
    unsigned char* ws; unsigned char* os;
};
#define IN_X 0
#define IN_META 1
#define IN_NMG 2
#define IN_WIN 3
#define IN_LRE 4
#define IN_LIM 5
#define IN_LDT 6
#define IN_BRE 7
#define IN_BIM 8
#define IN_CRE 9
#define IN_CIM 10
#define IN_S5D 11
#define IN_WGLU 12
#define IN_HLB 13
#define IN_HNG 14
#define IN_LQ1 15
#define IN_LK1 16
#define IN_LQ2 17
#define IN_LK2 18
#define IN_SUBLN 19
#define IN_WOUT 20
#define IN_NFG 21
#define IN_WGRP 22
#define IN_BGRP 23
#define IN_WEXP 24
#define IN_BEXP 25
#define IN_WGATE 26
#define IN_WUP 27
#define IN_WDOWN 28
#define IN_FNG 29

template <class ColMap>
__device__ __forceinline__ void conv_item(const float* W, int ldw, const float* kscale, bf16* WT, int ldt, int k0, int n0, LAS float* scr, int lane, ColMap cm) {
    const int sc = cm(n0 + (lane & 31));
#pragma unroll
    for (int i = 0; i < 32; ++i) { const int kk = 2 * i + (lane >> 5); float v = W[(size_t)(k0 + kk) * ldw + sc]; if (kscale) v *= kscale[k0 + kk]; scr[kk * 33 + (lane & 31)] = v; }
    LDS_WAIT(); asm volatile("" ::: "memory");
    const int c = lane & 7;
#pragma unroll
    for (int j = 0; j < 4; ++j) { const int n = (lane >> 3) + 8 * j; const LAS float* s = scr + (8 * c) * 33 + n;
        u32x4 o; o.x = pk2(s[0 * 33], s[1 * 33]); o.y = pk2(s[2 * 33], s[3 * 33]); o.z = pk2(s[4 * 33], s[5 * 33]); o.w = pk2(s[6 * 33], s[7 * 33]);
        *(GAS u32x4*)(WT + (size_t)(n0 + n) * ldt + k0 + 8 * c) = o; }
    LDS_WAIT(); asm volatile("" ::: "memory");
}

__device__ __forceinline__ void p0_prologue(const Frame& F0) {
    Frame F = F0; F.tid = F.wave * 64 + lane_id_(); LAUNDER(F.tid); F.lane = F.tid & 63;
    LAS float* scr = (LAS float*)(F.lds + F.wave * 16384);
    const int gw = F.wg * 8 + F.wave, NGW = F.G * 8, lane = F.lane;
    constexpr int I_IN = 16 * (NI / 32), I_OUT = 16 * 32, I_GLU = 4 * 16, I_GU = 16 * 16 * 32, I_DN = 16 * 8 * 32;
    constexpr int I_L = I_IN + I_OUT + I_GLU + I_GU + I_DN;
    for (int it = gw; it < 2 * I_L; it += NGW) {
        const int l = it / I_L; int r = it % I_L;
        if (r < I_IN) {
            const int kb = r / (NI / 32), nb = r % (NI / 32);
            conv_item(F.in[IN_WIN] + (size_t)l * D * NI, NI, F.in[IN_NMG] + l * D, (bf16*)(F.ws + WS_WIN) + (size_t)l * NI * D, D, kb * 64, nb * 32, scr, lane,
                      [](int n) { if (n >= C_AQ && n < C_AV) { const int p = n & 63, j = p >> 3, e = p & 7; return (n & ~63) + 4 * j + (e & 3) + 32 * (e >> 2); } return n; });
            continue; }
        r -= I_IN;
        if (r < I_OUT) {
            const int kb = r / 32, nb = r % 32;
            conv_item(F.in[IN_WOUT] + (size_t)l * D * D, D, nullptr, (bf16*)(F.ws + WS_WOUT) + (size_t)l * D * D, D, kb * 64, nb * 32, scr, lane, [](int n) { return n; });
            continue; }
        r -= I_OUT;
        if (r < I_GLU) {
            const int kb = r / 16, nb = r % 16;
            conv_item(F.in[IN_WGLU] + (size_t)l * 256 * 512, 512, nullptr, (bf16*)(F.ws + WS_WGLU) + (size_t)l * 512 * 256, 256, kb * 64, nb * 32, scr, lane,
                      [](int n) { const int pn = n >> 8, bj = (n >> 7) & 1, c = n & 127; return bj * 256 + pn * 128 + c; });
            continue; }
        r -= I_GLU;
        if (r < I_GU) {
            const int e = r / (16 * 32), q = r % (16 * 32), kb = q / 32, nb = q % 32, n0 = nb * 32, bj = (n0 >> 7) & 1;
            const float* src = (bj ? F.in[IN_WUP] : F.in[IN_WGATE]) + ((size_t)l * 16 + e) * 1024 * 512;
            conv_item(src, 512, F.in[IN_NFG] + l * D, (bf16*)(F.ws + WS_WGU) + ((size_t)l * 16 + e) * 1024 * 1024, 1024, kb * 64, n0, scr, lane,
                      [](int n) { const int pn = n >> 8, c = n & 127; return pn * 128 + c; });
            continue; }
        r -= I_GU;
        {
            const int e = r / (8 * 32), q = r % (8 * 32), kb = q / 32, nb = q % 32;
            conv_item(F.in[IN_WDOWN] + ((size_t)l * 16 + e) * 512 * 1024, 1024, nullptr, (bf16*)(F.ws + WS_WDN) + ((size_t)l * 16 + e) * 1024 * 512, 512, kb * 64, nb * 32, scr, lane, [](int n) { return n; });
        }
    }
    for (int idx = gw * 64 + lane; idx < 2 * 32 * 1024; idx += NGW * 64) {
        const int l = idx / (32 * 1024), j = (idx / 1024) % 32, k = idx % 1024;
        float w = 0.f;
        if (j < 4) w = F.in[IN_WGRP][((size_t)l * D + k) * 4 + j]; else if (j < 20) w = F.in[IN_WEXP][((size_t)l * D + k) * 16 + (j - 4)];
        w *= F.in[IN_NFG][l * D + k];
        const unsigned hi = f2bf(w); const float lo = w - bf2f(hi);
        bf16* wr = (bf16*)(F.ws + WS_WR) + (size_t)l * 2 * 32 * 1024;
        wr[j * 1024 + k] = (bf16)hi; wr[32 * 1024 + j * 1024 + k] = (bf16)f2bf(lo);
    }
    for (int idx = gw * 64 + lane; idx < LT * 32; idx += NGW * 64) {
        const int pos = idx / 32, i = idx % 32;
        const double inv = pow(10000.0, -(double)(2 * i) / 64.0); const double a = (double)pos * inv;
        ((float*)(F.ws + WS_ROPE))[idx] = (float)cos(a); ((float*)(F.ws + WS_ROPE))[LT * 32 + idx] = (float)sin(a);
    }
    for (int m = gw; m < T; m += NGW) {
        const int b = m / LT, t = m % LT;
        const float* src = (t < NMETA) ? F.in[IN_META] + (size_t)t * D : F.in[IN_X] + ((size_t)b * SEQ + (t - NMETA)) * D;
        const GAS f32x4* xr = (const GAS f32x4*)src + lane;
        GAS u32x2* hb = (GAS u32x2*)((bf16*)(F.ws + WS_HB) + (size_t)m * D) + lane;
        float s = 0.f;
#pragma unroll
        for (int j = 0; j < 4; ++j) { const f32x4 v = xr[64 * j]; s += (v.x * v.x + v.y * v.y) + (v.z * v.z + v.w * v.w);
            u32x2 o; o.x = pk2(v.x, v.y); o.y = pk2(v.z, v.w); hb[64 * j] = o; }
        s = wave_sum(s);
        if (lane < 16) ((float*)(F.ws + WS_SS16))[(size_t)m * 16 + lane] = (lane == 0) ? s : 0.f;
    }
    for (int it = F.wg; it < 32; it += F.G) {
        const int l = it / 16, g = it % 16;
        LAS f32x2* Ap = (LAS f32x2*)(F.lds);
        LAS f32x2* Bb = Ap + 17 * 64;
        LAS f32x2* Cc = Bb + 64 * 16;
        LAS float* Kj = (LAS float*)(Cc + 16 * 64);
        __syncthreads();
        const double dt = exp((double)F.in[IN_LDT][l * 16 + g]);
        for (int idx = F.tid; idx < 17 * 64; idx += 512) { const int j = idx / 64, n = idx % 64;
            const double lr = F.in[IN_LRE][(l * 16 + g) * 64 + n], li = F.in[IN_LIM][(l * 16 + g) * 64 + n];
            const double mg = exp(j * lr * dt), an = j * li * dt; Ap[idx] = (f32x2){(float)(mg * cos(an)), (float)(mg * sin(an))}; }
        for (int idx = F.tid; idx < 64 * 16; idx += 512) { const int n = idx / 16, c = idx % 16;
            const double lr = F.in[IN_LRE][(l * 16 + g) * 64 + n], li = F.in[IN_LIM][(l * 16 + g) * 64 + n];
            const double mg = exp(lr * dt), ar = mg * cos(li * dt), ai = mg * sin(li * dt), den = lr * lr + li * li, zr = ar - 1.0, zi = ai;
            const double fr = (zr * lr + zi * li) / den, fi = (zi * lr - zr * li) / den;
            const double br = F.in[IN_BRE][((size_t)(l * 16 + g) * 64 + n) * 16 + c], bi = F.in[IN_BIM][((size_t)(l * 16 + g) * 64 + n) * 16 + c];
            Bb[idx] = (f32x2){(float)(fr * br - fi * bi), (float)(fr * bi + fi * br)}; }
        for (int idx = F.tid; idx < 16 * 64; idx += 512) { const int c = idx / 64, n = idx % 64;
            Cc[idx] = (f32x2){F.in[IN_CRE][((size_t)(l * 16 + g) * 16 + c) * 64 + n], F.in[IN_CIM][((size_t)(l * 16 + g) * 16 + c) * 64 + n]}; }
        __syncthreads();
        for (int idx = F.tid; idx < 4096; idx += 512) { const int j = idx >> 8, co = (idx >> 4) & 15, ci = idx & 15; float s = 0.f;
            for (int n = 0; n < 64; ++n) { const f32x2 a = Ap[j * 64 + n], b = Bb[n * 16 + ci], c = Cc[co * 64 + n];
                const float abr = a.x * b.x - a.y * b.y, abi = a.x * b.y + a.y * b.x; s += c.x * abr - c.y * abi; }
            Kj[idx] = s; }
        if (F.tid < 64) ((f32x2*)(F.ws + WS_S5A))[(l * 16 + g) * 64 + F.tid] = Ap[16 * 64 + F.tid];
        __syncthreads();
        bf16* TQ = (bf16*)(F.ws + WS_S5TQ) + (size_t)(l * 16 + g) * 256 * 384;
        for (int idx = F.tid; idx < 256 * 384; idx += 512) { const int nn = idx / 384, k = idx % 384, t = nn >> 4, co = nn & 15; float v;
            if (k < 256) { const int s = k >> 4, ci = k & 15; v = (s <= t) ? Kj[((t - s) << 8) + (co << 4) + ci] : 0.f; }
            else { const int kk = k - 256, n = kk >> 1; const f32x2 a = Ap[(t + 1) * 64 + n], c = Cc[co * 64 + n];
                const float zr = c.x * a.x - c.y * a.y, zi = c.x * a.y + c.y * a.x; v = (kk & 1) ? -zi : zr; }
            TQ[idx] = (bf16)f2bf(v); }
        bf16* PM = (bf16*)(F.ws + WS_S5P) + (size_t)(l * 16 + g) * 256 * 256;
        for (int idx = F.tid; idx < 256 * 256; idx += 512) { const int nn = idx >> 8, k = idx & 255; float v = 0.f;
            if (nn < 128) { const int n = nn >> 1, s = k >> 4, ci = k & 15; const f32x2 a = Ap[(15 - s) * 64 + n], b = Bb[n * 16 + ci];
                v = (nn & 1) ? (a.x * b.y + a.y * b.x) : (a.x * b.x - a.y * b.y); }
            PM[idx] = (bf16)f2bf(v); }
        __syncthreads();
    }
}

template <class V> __device__ __forceinline__ V ldg(const void* sbase, unsigned voff) { return *(const GAS V*)((const char*)sbase + voff); }
template <class V> __device__ __forceinline__ void stg(void* sbase, unsigned voff, V v) { *(GAS V*)((char*)sbase + voff) = v; }
__device__ __forceinline__ u32x4 bufld16(__amdgpu_buffer_rsrc_t r, unsigned voff, unsigned soff) { return __builtin_bit_cast(u32x4, __builtin_amdgcn_raw_buffer_load_b128(r, (int)voff, (int)soff, 0)); }
#define GLDS2(p0, p1, dst) do { __builtin_amdgcn_global_load_lds((const unsigned*)(p0), (LAS unsigned*)(dst), 16, 0, 0); __builtin_amdgcn_global_load_lds((const unsigned*)(p1), (LAS unsigned*)((dst) + 8192), 16, 0, 0); } while (0)
#define EPI_FENCE() __builtin_amdgcn_sched_barrier(0)
struct UnitT { int pm, pn; };

struct PolIn {
    typedef UnitT Unit; static constexpr int NT = 16, LDB = 1024;
    pg8::TileOrder ord; const bf16* A; const bf16* B; bf16* proj; const float* ss16; const float* rope; bf16* X;
    __device__ __forceinline__ bool next(int i, Unit& u) const { return ord.get(i, u.pm, u.pn); }
    __device__ __forceinline__ void stage_a(LAS unsigned char* dst, int, const Unit& u, int t, int h, const int (&R)[2], const int (&C)[2]) const {
        const char* bp = (const char*)(A + (size_t)(u.pm * 256 + h * 128) * 1024) + t * 128;
        GLDS2(bp + (unsigned)((R[0] * 1024 + C[0]) * 2), bp + (unsigned)((R[1] * 1024 + C[1]) * 2), dst); }
    __device__ __forceinline__ const char* b_ptr(const Unit& u, int t) const { return (const char*)(B + (size_t)u.pn * 256 * 1024) + t * 128; }
    __device__ __forceinline__ void epi(const AccT& acc, const Unit& u, int wr, int wc, int fr, int fq, int) const {
        const bool isrope = (u.pn >= 5 && u.pn <= 8); const float qs = (u.pn == 5 || u.pn == 6) ? QSCALE : 1.f;
        const unsigned fi = 4u * (4u * (wc & 1) + fq);
        const unsigned vo_p = (unsigned)((fr * NI + u.pn * 256 + wc * 32 + 8 * fq) * 2), vo_s = (unsigned)(fr * 64);
        const int row00 = u.pm * 256 + wr * 64;
        f32x4 sA[4], csA = (f32x4){1.f, 1.f, 1.f, 1.f}, snA = (f32x4){0.f, 0.f, 0.f, 0.f};
#define IN_LOAD(g_, s_, c_, n_) do { const int ru_ = row00 + ((g_) >> 2) * 128 + ((g_) & 3) * 16; const unsigned so_ = (unsigned)ru_ * 64u + vo_s; \
            s_[0] = ldg<f32x4>(ss16, so_); s_[1] = ldg<f32x4>(ss16, so_ + 16); s_[2] = ldg<f32x4>(ss16, so_ + 32); s_[3] = ldg<f32x4>(ss16, so_ + 48); \
            if (isrope) { const unsigned pos_ = (unsigned)(ru_ + fr) % (unsigned)LT; c_ = ldg<f32x4>(rope, (pos_ * 32 + fi) * 4); n_ = ldg<f32x4>(rope, (LT * 32 + pos_ * 32 + fi) * 4); } } while (0)
        IN_LOAD(0, sA, csA, snA);
#pragma unroll
        for (int g = 0; g < 8; ++g) {
            const int ai = g >> 2, m = g & 3;
            f32x4 sB[4], csB = csA, snB = snA;
#pragma unroll
            for (int q = 0; q < 4; ++q) sB[q] = sA[q];
            if (g < 7) IN_LOAD(g + 1, sA, csA, snA);
            const float ss = ((sB[0].x + sB[0].y) + (sB[0].z + sB[0].w)) + ((sB[1].x + sB[1].y) + (sB[1].z + sB[1].w)) + ((sB[2].x + sB[2].y) + (sB[2].z + sB[2].w)) + ((sB[3].x + sB[3].y) + (sB[3].z + sB[3].w));
            const float rstd = rsqrtf(ss * (1.f / 1024.f) + RMS_EPS);
            bf16* rowp = proj + (size_t)(row00 + ai * 128 + m * 16) * NI;
            bf16* xrow = X + (size_t)((row00 + ai * 128 + m * 16) >> 4) * 384;
#pragma unroll
            for (int bj = 0; bj < 2; ++bj) {
                f32x4 v0 = acc[ai][bj][m][0] * rstd, v1 = acc[ai][bj][m][1] * rstd;
                if (isrope) { const f32x4 o0 = (v0 * csB - v1 * snB) * qs, o1 = (v1 * csB + v0 * snB) * qs; v0 = o0; v1 = o1; }
                u32x4 w; w.x = cvt_pk_bf16(v0[0], v0[1]); w.y = cvt_pk_bf16(v0[2], v0[3]); w.z = cvt_pk_bf16(v1[0], v1[1]); w.w = cvt_pk_bf16(v1[2], v1[3]);
                if (u.pn == 0) stg<u32x4>(xrow, (unsigned)((((2 * wc + 8 * bj + (fq >> 1)) * S5RP) * 384 + fr * 16 + 8 * (fq & 1)) * 2), w);
                else stg<u32x4>(rowp, vo_p + bj * 256, w);
            }
            EPI_FENCE();
        }
#undef IN_LOAD
    }
};

struct UnitS5 { int g, mt; };
struct PolS5E {
    typedef UnitS5 Unit; static constexpr int NT = 4, LDB = 256;
    int G, c; const bf16* X; const bf16* B; float* E;
    __device__ __forceinline__ bool next(int i, Unit& u) const { const int Lx = i * G + c; if (Lx >= 16 * 17) return false; u.g = Lx / 17; u.mt = Lx % 17; return true; }
    __device__ __forceinline__ void stage_a(LAS unsigned char* dst, int, const Unit& u, int t, int h, const int (&R)[2], const int (&C)[2]) const {
        const char* bp = (const char*)(X + ((size_t)u.g * S5RP + 256 * u.mt + 128 * h) * 384) + t * 128;
        GLDS2(bp + (unsigned)((R[0] * 384 + C[0]) * 2), bp + (unsigned)((R[1] * 384 + C[1]) * 2), dst); }
    __device__ __forceinline__ const char* b_ptr(const Unit& u, int t) const { return (const char*)(B + (size_t)u.g * 256 * 256) + t * 128; }
    __device__ __forceinline__ void epi(const AccT& acc, const Unit& u, int wr, int wc, int fr, int fq, int) const {
        const unsigned vo = (unsigned)((fr * 128 + wc * 32 + 8 * fq) * 4);
#pragma unroll
        for (int ai = 0; ai < 2; ++ai)
#pragma unroll
            for (int m = 0; m < 4; ++m) { float* ep = E + ((size_t)u.g * S5RP + u.mt * 256 + ai * 128 + wr * 64 + m * 16) * 128;
                stg<f32x4>(ep, vo, acc[ai][0][m][0]); stg<f32x4>(ep, vo + 16, acc[ai][0][m][1]); }
    }
};

struct PolS5Y {
    typedef UnitS5 Unit; static constexpr int NT = 6, LDB = 384;
    int G, c; const bf16* X; const bf16* B; const bf16* proj; const float* dsk; bf16* Gout;
    __device__ __forceinline__ bool next(int i, Unit& u) const { const int Lx = i * G + c; if (Lx >= 16 * 17) return false; u.g = Lx / 17; u.mt = Lx % 17; return true; }
    __device__ __forceinline__ void stage_a(LAS unsigned char* dst, int, const Unit& u, int t, int h, const int (&R)[2], const int (&C)[2]) const {
        const char* bp = (const char*)(X + ((size_t)u.g * S5RP + 256 * u.mt + 128 * h) * 384) + t * 128;
        GLDS2(bp + (unsigned)((R[0] * 384 + C[0]) * 2), bp + (unsigned)((R[1] * 384 + C[1]) * 2), dst); }
    __device__ __forceinline__ const char* b_ptr(const Unit& u, int t) const { return (const char*)(B + (size_t)u.g * 256 * 384) + t * 128; }
    __device__ __forceinline__ void epi(const AccT& acc, const Unit& u, int wr, int wc, int fr, int fq, int) const {
        const int ch = u.g * 16 + 8 * (fq & 1);
        const f32x4 d0 = ldg<f32x4>(dsk, (unsigned)ch * 4), d1 = ldg<f32x4>(dsk, (unsigned)ch * 4 + 16);
        const unsigned vo_u = (unsigned)((fr * 384 + (fq >> 1) * 16 + 8 * (fq & 1)) * 2), vo_g = (unsigned)(((16 * fr + (fq >> 1)) * 256 + ch) * 2);
        const int R0 = u.mt * 256 + wr * 64;
        u32x4 pre[8][2];
#pragma unroll
        for (int g = 0; g < 8; ++g)
#pragma unroll
            for (int bj = 0; bj < 2; ++bj) { const int Ru = R0 + (g >> 2) * 128 + (g & 3) * 16; pre[g][bj] = (u32x4){0u, 0u, 0u, 0u};
                if (Ru + fr < S5R) pre[g][bj] = ldg<u32x4>(X + ((size_t)u.g * S5RP + Ru) * 384 + (8 * bj + 2 * wc) * 16, vo_u); }
#pragma unroll
        for (int g = 0; g < 8; ++g) { const int ai = g >> 2, m = g & 3, Ru = R0 + ai * 128 + m * 16;
            if (Ru + fr < S5R) {
#pragma unroll
                for (int bj = 0; bj < 2; ++bj) { const size_t toku = (size_t)16 * Ru + 8 * bj + 2 * wc; const u32x4 uu = pre[g][bj];
                    f32x4 v0 = acc[ai][bj][m][0], v1 = acc[ai][bj][m][1];
                    v0[0] += d0[0] * bf2f(uu.x); v0[1] += d0[1] * bf2f(uu.x >> 16); v0[2] += d0[2] * bf2f(uu.y); v0[3] += d0[3] * bf2f(uu.y >> 16);
                    v1[0] += d1[0] * bf2f(uu.z); v1[1] += d1[1] * bf2f(uu.z >> 16); v1[2] += d1[2] * bf2f(uu.w); v1[3] += d1[3] * bf2f(uu.w >> 16);
                    u32x4 w; w.x = pk2(gelu_tanh(v0[0]), gelu_tanh(v0[1])); w.y = pk2(gelu_tanh(v0[2]), gelu_tanh(v0[3]));
                    w.z = pk2(gelu_tanh(v1[0]), gelu_tanh(v1[1])); w.w = pk2(gelu_tanh(v1[2]), gelu_tanh(v1[3]));
                    stg<u32x4>(Gout + toku * 256, vo_g, w); }
            }
            EPI_FENCE();
        }
    }
};

struct PolGlu {
    typedef UnitT Unit; static constexpr int NT = 4, LDB = 256;
    pg8::TileOrder ord; const bf16* A; const bf16* B; bf16* mixed;
    __device__ __forceinline__ bool next(int i, Unit& u) const { return ord.get(i, u.pm, u.pn); }
    __device__ __forceinline__ void stage_a(LAS unsigned char* dst, int, const Unit& u, int t, int h, const int (&R)[2], const int (&C)[2]) const {
        const char* bp = (const char*)(A + (size_t)(u.pm * 256 + h * 128) * 256) + t * 128;
        GLDS2(bp + (unsigned)((R[0] * 256 + C[0]) * 2), bp + (unsigned)((R[1] * 256 + C[1]) * 2), dst); }
    __device__ __forceinline__ const char* b_ptr(const Unit& u, int t) const { return (const char*)(B + (size_t)u.pn * 256 * 256) + t * 128; }
    __device__ __forceinline__ void epi(const AccT& acc, const Unit& u, int wr, int wc, int fr, int fq, int) const {
        const unsigned vo = (unsigned)((fr * D + u.pn * 128 + wc * 32 + 8 * fq) * 2);
#pragma unroll
        for (int ai = 0; ai < 2; ++ai)
#pragma unroll
            for (int m = 0; m < 4; ++m) { bf16* rp = mixed + (size_t)(u.pm * 256 + ai * 128 + wr * 64 + m * 16) * D;
                const f32x4 a0 = acc[ai][0][m][0], a1 = acc[ai][0][m][1], b0 = acc[ai][1][m][0], b1 = acc[ai][1][m][1];
                u32x4 w; w.x = pk2(a0[0] * sigmoidf_(b0[0]), a0[1] * sigmoidf_(b0[1])); w.y = pk2(a0[2] * sigmoidf_(b0[2]), a0[3] * sigmoidf_(b0[3]));
                w.z = pk2(a1[0] * sigmoidf_(b1[0]), a1[1] * sigmoidf_(b1[1])); w.w = pk2(a1[2] * sigmoidf_(b1[2]), a1[3] * sigmoidf_(b1[3]));
                stg<u32x4>(rp, vo, w);
                EPI_FENCE(); }
    }
};

__device__ __forceinline__ void residual_epi(const AccT& acc, const int (&vrow)[8], int pn, int wc, int fq, bf16* HB, float* ss16) {
    const unsigned colb = (unsigned)(pn * 256 + wc * 32 + 8 * fq);
    u32x4 pre[8][2];
#pragma unroll
    for (int g = 0; g < 8; ++g)
#pragma unroll
        for (int bj = 0; bj < 2; ++bj) { pre[g][bj] = (u32x4){0u, 0u, 0u, 0u}; if (vrow[g] >= 0) pre[g][bj] = ldg<u32x4>(HB, ((unsigned)vrow[g] * D + colb) * 2 + bj * 256); }
#pragma unroll
    for (int g = 0; g < 8; ++g) { const int ai = g >> 2, m = g & 3; const bool valid = vrow[g] >= 0; const unsigned vb = ((unsigned)(valid ? vrow[g] : 0) * D + colb) * 2;
        float ssq = 0.f;
#pragma unroll
        for (int bj = 0; bj < 2; ++bj) { const u32x4 hb = pre[g][bj];
            f32x4 h0 = (f32x4){bf2f(hb.x), bf2f(hb.x >> 16), bf2f(hb.y), bf2f(hb.y >> 16)}, h1 = (f32x4){bf2f(hb.z), bf2f(hb.z >> 16), bf2f(hb.w), bf2f(hb.w >> 16)};
            h0 += acc[ai][bj][m][0]; h1 += acc[ai][bj][m][1];
            u32x4 w; w.x = cvt_pk_bf16(h0[0], h0[1]); w.y = cvt_pk_bf16(h0[2], h0[3]); w.z = cvt_pk_bf16(h1[0], h1[1]); w.w = cvt_pk_bf16(h1[2], h1[3]);
            if (valid) stg<u32x4>(HB, vb + bj * 256, w);
            ssq += (h0[0] * h0[0] + h0[1] * h0[1]) + (h0[2] * h0[2] + h0[3] * h0[3]) + (h1[0] * h1[0] + h1[1] * h1[1]) + (h1[2] * h1[2] + h1[3] * h1[3]);
        }
        ssq += __shfl_xor(ssq, 16); ssq += __shfl_xor(ssq, 32);
        if (valid && fq == 0) stg<float>(ss16, ((unsigned)vrow[g] * 16 + pn * 4 + wc) * 4, ssq);
    }
}

struct PolOut {
    typedef UnitT Unit; static constexpr int NT = 16, LDB = 1024;
    pg8::TileOrder ord; const bf16* A; const bf16* B; bf16* HB; float* ss16;
    __device__ __forceinline__ bool next(int i, Unit& u) const { return ord.get(i, u.pm, u.pn); }
    __device__ __forceinline__ void stage_a(LAS unsigned char* dst, int, const Unit& u, int t, int h, const int (&R)[2], const int (&C)[2]) const {
        const char* bp = (const char*)(A + (size_t)(u.pm * 256 + h * 128) * 1024) + t * 128;
        GLDS2(bp + (unsigned)((R[0] * 1024 + C[0]) * 2), bp + (unsigned)((R[1] * 1024 + C[1]) * 2), dst); }
    __device__ __forceinline__ const char* b_ptr(const Unit& u, int t) const { return (const char*)(B + (size_t)u.pn * 256 * 1024) + t * 128; }
    __device__ __forceinline__ void epi(const AccT& acc, const Unit& u, int wr, int wc, int fr, int fq, int) const {
        int vrow[8];
#pragma unroll
        for (int g = 0; g < 8; ++g) vrow[g] = u.pm * 256 + (g >> 2) * 128 + wr * 64 + (g & 3) * 16 + fr;
        residual_epi(acc, vrow, u.pn, wc, fq, HB, ss16);
    }
};

struct MoeList {
    LAS const int* cnt;
    __device__ __forceinline__ int ntiles() const { int s = 0; for (int c = 0; c < NCLS; ++c) s += (cnt[c] + 255) >> 8; return __builtin_amdgcn_readfirstlane(s); }
    __device__ __forceinline__ void decode(int gt, int& c, int& ti, int& nvalid) const {
        int s = 0, cc = 0, tt = 0, nv = 0;
        for (int k = 0; k < NCLS; ++k) { const int n = (cnt[k] + 255) >> 8; if (gt >= s && gt < s + n) { cc = k; tt = gt - s; nv = cnt[k] - 256 * tt; } s += n; }
        c = __builtin_amdgcn_readfirstlane(cc); ti = __builtin_amdgcn_readfirstlane(tt); nvalid = __builtin_amdgcn_readfirstlane(nv > 256 ? 256 : nv);
    }
};
__device__ __forceinline__ void class_experts(int c, int& ea, int& eb) {
    const int g = c / 6, p = c % 6; const int a = (p < 3) ? 0 : (p < 5 ? 1 : 2); const int b = (p < 3) ? p + 1 : (p < 5 ? p - 1 : 3);
    ea = g * 4 + a; eb = g * 4 + b;
}
struct UnitM { int gt, pn, c; };

struct PolGU {
    typedef UnitM Unit; static constexpr int NT = 16, LDB = 1024;
    int G, c, ntl; MoeList ml; LAS const int* tab;
    const bf16* HB; const bf16* W; bf16* he; const float* rstd; const float* gate;
    __device__ __forceinline__ bool next(int i, Unit& u) const { const int Lx = i * G + c; if (Lx >= ntl * 8) return false; u.gt = Lx >> 3; u.pn = Lx & 7; int ti, nv; ml.decode(u.gt, u.c, ti, nv); return true; }
    __device__ __forceinline__ void stage_a(LAS unsigned char* dst, int ui, const Unit&, int t, int h, const int (&R)[2], const int (&C)[2]) const {
        const char* bp = (const char*)HB + t * 128;
        const int t0 = tab[ui * 256 + 128 * h + R[0]], t1 = tab[ui * 256 + 128 * h + R[1]];
        GLDS2(bp + (unsigned)((t0 < 0 ? 0 : t0) * 2048 + C[0] * 2), bp + (unsigned)((t1 < 0 ? 0 : t1) * 2048 + C[1] * 2), dst); }
    __device__ __forceinline__ const char* b_ptr(const Unit& u, int t) const { int ea, eb; class_experts(u.c, ea, eb); const int e = (u.pn >> 2) ? eb : ea;
        return (const char*)(W + ((size_t)e * 1024 + (u.pn & 3) * 256) * 1024) + t * 128; }
    __device__ __forceinline__ void epi(const AccT& acc, const Unit& u, int wr, int wc, int fr, int fq, int ui) const {
        const int sel = u.pn >> 2;
        const unsigned vo = (unsigned)((fr * 1024 + sel * 512 + (u.pn & 3) * 128 + wc * 32 + 8 * fq) * 2);
        float rsv[8], gwv[8];
#pragma unroll
        for (int g = 0; g < 8; ++g) { const int tk = tab[ui * 256 + (g >> 2) * 128 + wr * 64 + (g & 3) * 16 + fr]; rsv[g] = 0.f; gwv[g] = 0.f;
            if (tk >= 0) { rsv[g] = ldg<float>(rstd, (unsigned)tk * 4); gwv[g] = ldg<float>(gate, (unsigned)(2 * tk + sel) * 4); } }
#pragma unroll
        for (int g = 0; g < 8; ++g) { const int ai = g >> 2, m = g & 3, ru = ai * 128 + wr * 64 + m * 16; const float rs = rsv[g], gw = gwv[g];
            const f32x4 g0 = acc[ai][0][m][0] * rs, g1 = acc[ai][0][m][1] * rs, u0 = acc[ai][1][m][0] * (rs * gw), u1 = acc[ai][1][m][1] * (rs * gw);
            u32x4 w; w.x = pk2(siluf_(g0[0]) * u0[0], siluf_(g0[1]) * u0[1]); w.y = pk2(siluf_(g0[2]) * u0[2], siluf_(g0[3]) * u0[3]);
            w.z = pk2(siluf_(g1[0]) * u1[0], siluf_(g1[1]) * u1[1]); w.w = pk2(siluf_(g1[2]) * u1[2], siluf_(g1[3]) * u1[3]);
            stg<u32x4>(he + ((size_t)u.gt * 256 + ru) * 1024, vo, w);
            EPI_FENCE(); }
    }
};

struct PolDN {
    typedef UnitM Unit; static constexpr int NT = 16, LDB = 512;
    int G, c, ntl; MoeList ml; LAS const int* tab;
    const bf16* he; const bf16* W; bf16* HB; float* ss16;
    __device__ __forceinline__ bool next(int i, Unit& u) const { const int Lx = i * G + c; if (Lx >= ntl * 4) return false; u.gt = Lx >> 2; u.pn = Lx & 3; int ti, nv; ml.decode(u.gt, u.c, ti, nv); return true; }
    __device__ __forceinline__ void stage_a(LAS unsigned char* dst, int, const Unit& u, int t, int h, const int (&R)[2], const int (&C)[2]) const {
        const char* bp = (const char*)(he + (size_t)(u.gt * 256 + h * 128) * 1024) + t * 128;
        GLDS2(bp + (unsigned)((R[0] * 1024 + C[0]) * 2), bp + (unsigned)((R[1] * 1024 + C[1]) * 2), dst); }
    __device__ __forceinline__ const char* b_ptr(const Unit& u, int t) const { int ea, eb; class_experts(u.c, ea, eb); const int e = (t >= 8) ? eb : ea;
        return (const char*)(W + ((size_t)e * 1024 + u.pn * 256) * 512) + (t & 7) * 128; }
    __device__ __forceinline__ void epi(const AccT& acc, const Unit& u, int wr, int wc, int fr, int fq, int ui) const {
        int vrow[8];
#pragma unroll
        for (int g = 0; g < 8; ++g) vrow[g] = tab[ui * 256 + (g >> 2) * 128 + wr * 64 + (g & 3) * 16 + fr];
        residual_epi(acc, vrow, u.pn, wc, fq, HB, ss16);
    }
};

#define MFMA16(a, b, c) __builtin_amdgcn_mfma_f32_16x16x32_bf16(a, b, c, 0, 0, 0)
#define MFMA32(a, b, c) __builtin_amdgcn_mfma_f32_32x32x16_bf16(a, b, c, 0, 0, 0)

__device__ __forceinline__ int wq_fetch(unsigned* ctr, const Frame& F) {
    volatile LAS int* slot = (volatile LAS int*)(F.lds + MISC_OFF) + 20;
    __syncthreads();
    if (F.tid == 0) *slot = (int)__hip_atomic_fetch_add(ctr, 1u, __ATOMIC_RELAXED, __HIP_MEMORY_SCOPE_AGENT);
    __syncthreads();
    return __builtin_amdgcn_readfirstlane(*slot);
}

__device__ __forceinline__ void s5_scan(const Frame& F0, int l) {
    Frame F = F0; F.tid = F.wave * 64 + lane_id_(); LAUNDER(F.tid); F.lane = F.tid & 63;
    const float* E = (const float*)(F.os + OS_E); bf16* X = (bf16*)(F.os + OS_X);
    const int lane = F.lane;
    for (int it = F.wg + F.G * F.wave; it < NB * 16; it += F.G * 8) {
        const int b = it >> 4, g = it & 15;
        const f32x2 A16 = ((const f32x2*)(F.ws + WS_S5A))[(l * 16 + g) * 64 + lane];
        float sr = 0.f, si = 0.f;
        for (int r0 = 0; r0 < NCH; r0 += 16) {
            f32x2 e[16];
#pragma unroll
            for (int j = 0; j < 16; ++j) if (r0 + j < NCH) { const size_t R = (size_t)b * NCH + r0 + j;
                e[j] = *(const GAS f32x2*)(E + ((size_t)g * S5RP + R) * 128 + 2 * lane); }
#pragma unroll
            for (int j = 0; j < 16; ++j) if (r0 + j < NCH) { const size_t R = (size_t)b * NCH + r0 + j;
                bf16* xr = X + ((size_t)g * S5RP + R) * 384;
                *(GAS unsigned*)(xr + 256 + 2 * lane) = pk2(sr, si);
                const float nr = A16.x * sr - A16.y * si + e[j].x, ni = A16.x * si + A16.y * sr + e[j].y; sr = nr; si = ni; }
        }
    }
}

__device__ __forceinline__ float hgrn_lb(const float* hlb, int l, int j) {
    if (l == 0) return 0.f;
    const float x0 = hlb[j], x1 = hlb[256 + j], mx = fmaxf(x0, x1), e0 = __expf(x0 - mx), e1 = __expf(x1 - mx);
    return e1 / (e0 + e1);
}
__device__ __forceinline__ void hgrn_gate(float z, float lbA, float onem, float& lf, float& k) {
    const float e = __expf(-fabsf(z)), r = __builtin_amdgcn_rcpf(1.f + e), er = e * r;
    const float s = (z >= 0.f) ? r : er, c = (z >= 0.f) ? er : r;
    lf = __logf(lbA + onem * s); k = onem * c;
}
constexpr int HG_LP = 68, HG_LF = 0, HG_SEG = 64 * HG_LP * 4, HG_T0 = HG_SEG + 1024, HG_TS = 9216, HG_HALF = HG_T0 + 5 * HG_TS;
static_assert(2 * HG_HALF <= MISC_OFF, "HGRN LDS map");

__device__ __forceinline__ void hgrn_a(const Frame& F0, int l) {
    Frame F = F0; F.tid = F.wave * 64 + lane_id_(); LAUNDER(F.tid); F.lane = F.tid & 63;
    const bf16* proj = (const bf16*)(F.ws + WS_PROJ); float* UT = (float*)(F.os + OS_UT); float* DEC = (float*)(F.os + OS_DEC);
    const int half = F.tid >> 8, ht = F.tid & 255, hw = F.wave & 3, lane = F.lane;
    LAS unsigned char* base = F.lds + half * HG_HALF;
    LAS float* LF = (LAS float*)(base + HG_LF); LAS float* SEG = (LAS float*)(base + HG_SEG);
    LAS bf16* vT = (LAS bf16*)(base + HG_T0); LAS bf16* KDT = (LAS bf16*)(base + HG_T0 + HG_TS);
    unsigned* qh = (unsigned*)F.ws + CW_Q + (l * 4 + 1) * 64;
    constexpr int NP = NB * 4 * HCH / 2, NSTAT = 7;
    int kq = 0;
#pragma unroll 1
    for (int p = F.wg; p < NP; p = (++kq < NSTAT) ? F.wg + kq * F.G : NSTAT * F.G + wq_fetch(qh, F)) {
        const int item = 2 * p + half, c = item % HCH, bh = item / HCH, b = bh >> 2, h = bh & 3;
        const size_t tok0 = (size_t)b * LT + (c == 0 ? 0 : 16 + 64 * (c - 1)); const int nrows = (c == 0) ? 16 : 64;
        float lbA[8], onem[8];
#pragma unroll
        for (int jj = 0; jj < 8; ++jj) { const float lb = hgrn_lb(F.in[IN_HLB], l, h * 64 + 8 * (ht & 7) + jj); lbA[jj] = fmaxf(lb, 1e-30f); onem[jj] = 1.f - lb; }
#pragma unroll
        for (int e = 0; e < 2; ++e) { const int idx = ht + 256 * e, t = idx >> 3, c8 = idx & 7; const bool valid = t < nrows;
            u32x4 zf = (u32x4){0u, 0u, 0u, 0u}, zi = zf;
            if (valid) { zf = *(const GAS u32x4*)(proj + (tok0 + t) * NI + C_HF + h * 64 + 8 * c8); zi = *(const GAS u32x4*)(proj + (tok0 + t) * NI + C_HI + h * 64 + 8 * c8); }
#pragma unroll
            for (int jj = 0; jj < 8; ++jj) { const int d = 8 * c8 + jj; const unsigned wf = (jj & 1) ? (zf[jj >> 1] >> 16) : (zf[jj >> 1] & 0xffffu); const unsigned wi = (jj & 1) ? (zi[jj >> 1] >> 16) : (zi[jj >> 1] & 0xffffu);
                float lf, kk; hgrn_gate(bf2f(wf), lbA[jj], onem[jj], lf, kk); LF[t * HG_LP + d] = valid ? lf : 0.f;
                vT[d * 72 + t] = (bf16)wi; }
        }
        __syncthreads();
        const int d = ht & 63, seg = ht >> 6;
        { float run = 0.f;
#pragma unroll
          for (int i = 0; i < 16; ++i) { run += LF[(16 * seg + i) * HG_LP + d]; LF[(16 * seg + i) * HG_LP + d] = run; }
          SEG[seg * 64 + d] = run; }
        __syncthreads();
        { float offs = 0.f, last = 0.f;
#pragma unroll
          for (int s = 0; s < 4; ++s) { const float v = SEG[s * 64 + d]; if (s < seg) offs += v; last += v; }
          float prev = 0.f;
#pragma unroll
          for (int i = 0; i < 16; ++i) { const int t = 16 * seg + i; const float cl = LF[t * HG_LP + d], lf = cl - prev; prev = cl;
              const float k = 1.f - __expf(lf); KDT[d * 72 + t] = (bf16)f2bf(k * __expf(last - (cl + offs))); }
          if (seg == 0) DEC[(size_t)item * 64 + d] = __expf(last); }
        __syncthreads();
        f32x4 acc[4];
#pragma unroll
        for (int nt = 0; nt < 4; ++nt) acc[nt] = (f32x4){0.f, 0.f, 0.f, 0.f};
#pragma unroll
        for (int ks = 0; ks < 2; ++ks) { const bf16x8 a = *(const LAS bf16x8*)(vT + (16 * hw + (lane & 15)) * 72 + 32 * ks + 8 * (lane >> 4));
#pragma unroll
            for (int nt = 0; nt < 4; ++nt) { const bf16x8 bb = *(const LAS bf16x8*)(KDT + (16 * nt + (lane & 15)) * 72 + 32 * ks + 8 * (lane >> 4)); acc[nt] = MFMA16(a, bb, acc[nt]); } }
#pragma unroll
        for (int nt = 0; nt < 4; ++nt)
#pragma unroll
            for (int j = 0; j < 4; ++j) UT[(size_t)item * 4096 + (16 * hw + 4 * (lane >> 4) + j) * 64 + 16 * nt + (lane & 15)] = acc[nt][j];
        __syncthreads();
    }
}

__device__ __forceinline__ void hgrn_b(const Frame& F0) {
    Frame F = F0; F.tid = F.wave * 64 + lane_id_(); LAUNDER(F.tid); F.lane = F.tid & 63;
    const float* UT = (const float*)(F.os + OS_UT); const float* DEC = (const float*)(F.os + OS_DEC); bf16* SP = (bf16*)(F.os + OS_SP);
    for (int blk = F.wg; blk < NB * 4 * 8; blk += F.G) {
        const int bh = blk >> 3, e = (blk & 7) * 512 + F.tid, d = e & 63;
        float S = 0.f;
        for (int c0 = 0; c0 < HCH; c0 += 11) {
            float ut[11], dc[11];
#pragma unroll
            for (int j = 0; j < 11; ++j) { const size_t item = (size_t)bh * HCH + c0 + j; ut[j] = UT[item * 4096 + e]; dc[j] = DEC[item * 64 + d]; }
#pragma unroll
            for (int j = 0; j < 11; ++j) { const size_t item = (size_t)bh * HCH + c0 + j; SP[item * 4096 + e] = (bf16)f2bf(S); S = dc[j] * S + ut[j]; }
        }
    }
}

__device__ __forceinline__ void hgrn_c(const Frame& F0, int l) {
    Frame F = F0; F.tid = F.wave * 64 + lane_id_(); LAUNDER(F.tid); F.lane = F.tid & 63;
    const bf16* proj = (const bf16*)(F.ws + WS_PROJ); const bf16* SPg = (const bf16*)(F.os + OS_SP); bf16* mixed = (bf16*)(F.ws + WS_MIXED);
    const int half = F.tid >> 8, ht = F.tid & 255, hw = F.wave & 3, lane = F.lane;
    LAS unsigned char* base = F.lds + half * HG_HALF;
    LAS float* LF = (LAS float*)(base + HG_LF); LAS float* SEG = (LAS float*)(base + HG_SEG);
    LAS bf16* vT = (LAS bf16*)(base + HG_T0); LAS bf16* QT = vT + HG_TS / 2; LAS bf16* KT = QT + HG_TS / 2; LAS bf16* QS = KT + HG_TS / 2; LAS bf16* SPt = QS + HG_TS / 2;
    LAS bf16* P = QT;
    LAS bf16* OT = QS;
    float ngv[4];
#pragma unroll
    for (int nt = 0; nt < 4; ++nt) ngv[nt] = F.in[IN_HNG][l * 64 + 16 * nt + (lane & 15)];
    unsigned* qh = (unsigned*)F.ws + CW_Q + (l * 4 + 2) * 64;
    constexpr int NP = NB * 4 * HCH / 2, NSTAT = 7;
    int kk = 0;
#pragma unroll 1
    for (int p = F.wg; p < NP; p = (++kk < NSTAT) ? F.wg + kk * F.G : NSTAT * F.G + wq_fetch(qh, F)) {
        const int item = 2 * p + half, c = item % HCH, bh = item / HCH, b = bh >> 2, h = bh & 3;
        const size_t tok0 = (size_t)b * LT + (c == 0 ? 0 : 16 + 64 * (c - 1)); const int nrows = (c == 0) ? 16 : 64;
        float qv[16], kv[16], lbA[8], onem[8]; u32x4 zgv[2];
#pragma unroll
        for (int jj = 0; jj < 8; ++jj) { const float lb = hgrn_lb(F.in[IN_HLB], l, h * 64 + 8 * (ht & 7) + jj); lbA[jj] = fmaxf(lb, 1e-30f); onem[jj] = 1.f - lb; }
#pragma unroll
        for (int e = 0; e < 2; ++e) { const int idx = ht + 256 * e, t = idx >> 3, c8 = idx & 7; const bool valid = t < nrows;
            u32x4 zq = (u32x4){0u, 0u, 0u, 0u}, zf = zq, zi = zq; zgv[e] = zq;
            if (valid) { const bf16* rp = proj + (tok0 + t) * NI + h * 64 + 8 * c8; zq = *(const GAS u32x4*)(rp + C_HQ); zf = *(const GAS u32x4*)(rp + C_HF); zi = *(const GAS u32x4*)(rp + C_HI); zgv[e] = *(const GAS u32x4*)(rp + C_HG); }
            const u32x4 sp = *(const GAS u32x4*)(SPg + (size_t)item * 4096 + t * 64 + 8 * c8);
            *(LAS u32x4*)(SPt + t * 72 + 8 * c8) = sp;
            float lfr[8];
#pragma unroll
            for (int jj = 0; jj < 8; ++jj) { const int d = 8 * c8 + jj; const unsigned wq = (jj & 1) ? (zq[jj >> 1] >> 16) : (zq[jj >> 1] & 0xffffu);
                const unsigned wf = (jj & 1) ? (zf[jj >> 1] >> 16) : (zf[jj >> 1] & 0xffffu); const unsigned wi = (jj & 1) ? (zi[jj >> 1] >> 16) : (zi[jj >> 1] & 0xffffu);
                float lf, kx; hgrn_gate(bf2f(wf), lbA[jj], onem[jj], lf, kx);
                lfr[jj] = valid ? lf : 0.f; kv[8 * e + jj] = valid ? kx : 0.f; qv[8 * e + jj] = valid ? siluf_(bf2f(wq)) : 0.f;
                vT[d * 72 + t] = (bf16)wi; }
            *(LAS f32x4*)(LF + t * HG_LP + 8 * c8) = (f32x4){lfr[0], lfr[1], lfr[2], lfr[3]}; *(LAS f32x4*)(LF + t * HG_LP + 8 * c8 + 4) = (f32x4){lfr[4], lfr[5], lfr[6], lfr[7]};
        }
        __syncthreads();
        { const int d = ht & 63, seg = ht >> 6; float run = 0.f;
#pragma unroll
          for (int i = 0; i < 16; ++i) { run += LF[(16 * seg + i) * HG_LP + d]; LF[(16 * seg + i) * HG_LP + d] = run; }
          SEG[seg * 64 + d] = run; }
        __syncthreads();
#pragma unroll
        for (int e = 0; e < 2; ++e) { const int idx = ht + 256 * e, t = idx >> 3, c8 = idx & 7, seg = t >> 4;
            float cum[8], mid[8];
            { const f32x4 a0 = *(const LAS f32x4*)(LF + t * HG_LP + 8 * c8), a1 = *(const LAS f32x4*)(LF + t * HG_LP + 8 * c8 + 4);
              const f32x4 m0 = *(const LAS f32x4*)(LF + 31 * HG_LP + 8 * c8), m1 = *(const LAS f32x4*)(LF + 31 * HG_LP + 8 * c8 + 4);
              const f32x4 s0 = *(const LAS f32x4*)(SEG + 8 * c8), s1 = *(const LAS f32x4*)(SEG + 8 * c8 + 4);
#pragma unroll
              for (int q = 0; q < 4; ++q) { cum[q] = a0[q]; cum[4 + q] = a1[q]; mid[q] = m0[q] + s0[q]; mid[4 + q] = m1[q] + s1[q]; }
#pragma unroll
              for (int s = 0; s < 3; ++s) if (s < seg) { const f32x4 o0 = *(const LAS f32x4*)(SEG + s * 64 + 8 * c8), o1 = *(const LAS f32x4*)(SEG + s * 64 + 8 * c8 + 4);
#pragma unroll
                  for (int q = 0; q < 4; ++q) { cum[q] += o0[q]; cum[4 + q] += o1[q]; } } }
            unsigned wq[4], wk[4], ws[4];
#pragma unroll
            for (int jp = 0; jp < 4; ++jp) { float qt[2], kt[2], qs[2];
#pragma unroll
                for (int u = 0; u < 2; ++u) { const int jj = 2 * jp + u; const float q = qv[8 * e + jj], k = kv[8 * e + jj];
                    qt[u] = q * __expf(cum[jj] - mid[jj]); kt[u] = k * __expf(mid[jj] - cum[jj]); qs[u] = q * __expf(cum[jj]); }
                wq[jp] = pk2(qt[0], qt[1]); wk[jp] = pk2(kt[0], kt[1]); ws[jp] = pk2(qs[0], qs[1]); }
            *(LAS u32x4*)(QT + t * 72 + 8 * c8) = (u32x4){wq[0], wq[1], wq[2], wq[3]};
            *(LAS u32x4*)(KT + t * 72 + 8 * c8) = (u32x4){wk[0], wk[1], wk[2], wk[3]};
            *(LAS u32x4*)(QS + t * 72 + 8 * c8) = (u32x4){ws[0], ws[1], ws[2], ws[3]};
        }
        __syncthreads();
        const int ar = (16 * hw + (lane & 15)) * 72 + 8 * (lane >> 4);
        {
            f32x4 sc[4];
#pragma unroll
            for (int nt = 0; nt < 4; ++nt) sc[nt] = (f32x4){0.f, 0.f, 0.f, 0.f};
#pragma unroll
            for (int ks = 0; ks < 2; ++ks) { const bf16x8 a = *(const LAS bf16x8*)(QT + ar + 32 * ks);
#pragma unroll
                for (int nt = 0; nt < 4; ++nt) { const bf16x8 bb = *(const LAS bf16x8*)(KT + (16 * nt + (lane & 15)) * 72 + 32 * ks + 8 * (lane >> 4)); sc[nt] = MFMA16(a, bb, sc[nt]); } }
#pragma unroll
            for (int nt = 0; nt < 4; ++nt)
#pragma unroll
                for (int j = 0; j < 4; ++j) { const int t = 16 * hw + 4 * (lane >> 4) + j, s = 16 * nt + (lane & 15); P[t * 72 + s] = (bf16)f2bf(s <= t ? sc[nt][j] : 0.f); }
        }
        __syncthreads();
        f32x4 o[4];
#pragma unroll
        for (int nt = 0; nt < 4; ++nt) o[nt] = (f32x4){0.f, 0.f, 0.f, 0.f};
#pragma unroll
        for (int ks = 0; ks < 2; ++ks) { const bf16x8 a = *(const LAS bf16x8*)(P + ar + 32 * ks), a2 = *(const LAS bf16x8*)(QS + ar + 32 * ks);
#pragma unroll
            for (int nt = 0; nt < 4; ++nt) { const int br = (16 * nt + (lane & 15)) * 72 + 32 * ks + 8 * (lane >> 4);
                o[nt] = MFMA16(a, *(const LAS bf16x8*)(vT + br), o[nt]); o[nt] = MFMA16(a2, *(const LAS bf16x8*)(SPt + br), o[nt]); } }
#pragma unroll
        for (int j = 0; j < 4; ++j) { const int t = 16 * hw + 4 * (lane >> 4) + j;
            float ssq = o[0][j] * o[0][j] + o[1][j] * o[1][j] + o[2][j] * o[2][j] + o[3][j] * o[3][j];
            ssq += __shfl_xor(ssq, 1); ssq += __shfl_xor(ssq, 2); ssq += __shfl_xor(ssq, 4); ssq += __shfl_xor(ssq, 8);
            const float rn = rsqrtf(ssq * (1.f / 64.f) + RMS_EPS);
#pragma unroll
            for (int nt = 0; nt < 4; ++nt) OT[t * 72 + 16 * nt + (lane & 15)] = (bf16)f2bf(o[nt][j] * rn * ngv[nt]); }
        __syncthreads();
#pragma unroll
        for (int e = 0; e < 2; ++e) { const int idx = ht + 256 * e, t = idx >> 3, c8 = idx & 7;
            if (t < nrows) { const u32x4 ov = *(const LAS u32x4*)(OT + t * 72 + 8 * c8); const u32x4 zg = zgv[e]; u32x4 w;
#pragma unroll
                for (int q = 0; q < 4; ++q) { const float g0 = bf2f(zg[q]), g1 = bf2f(zg[q] >> 16); w[q] = pk2(bf2f(ov[q]) * siluf_(g0), bf2f(ov[q] >> 16) * siluf_(g1)); }
                *(GAS u32x4*)(mixed + (tok0 + t) * D + 256 + h * 64 + 8 * c8) = w; } }
        __syncthreads();
    }
}

constexpr int AT_KP = 272;
constexpr int AT_KB = 64 * AT_KP, AT_VB = 16384, AT_K = 0, AT_V = 2 * AT_KB, AT_Q = AT_V + 2 * AT_VB;
typedef short v4i16_t __attribute__((ext_vector_type(4)));
__device__ __forceinline__ s16x4 vtr(const LAS unsigned char* p) { return __builtin_bit_cast(s16x4, __builtin_amdgcn_ds_read_tr16_b64_v4i16((LAS v4i16_t*)p)); }
__device__ __forceinline__ float u2f_(unsigned u) { return __builtin_bit_cast(float, u); }
__device__ __forceinline__ float xhalf_max(float v) { const unsigned a = __builtin_bit_cast(unsigned, v); auto rr = __builtin_amdgcn_permlane32_swap(a, a, false, false); const unsigned r0 = rr[0], r1 = rr[1]; return fmaxf(u2f_(r0), u2f_(r1)); }
__device__ __forceinline__ float xhalf_sum(float v) { const unsigned a = __builtin_bit_cast(unsigned, v); auto rr = __builtin_amdgcn_permlane32_swap(a, a, false, false); const unsigned r0 = rr[0], r1 = rr[1]; return u2f_(r0) + u2f_(r1); }
__device__ __forceinline__ int crow(int r, int hi) { return (r & 3) + 8 * (r >> 2) + 4 * hi; }
__device__ __forceinline__ void attn_unit(const Frame& F, int b, int h, int j, const float* subg) {
    const bf16* proj = (const bf16*)(F.ws + WS_PROJ); bf16* mixed = (bf16*)(F.ws + WS_MIXED);
    int tid_ = F.wave * 64 + lane_id_(); LAUNDER(tid_);
    const int tid = tid_, lane = tid & 63, w = F.wave, r32 = lane & 31, hi = lane >> 5;
    const int qbase = (j == 0) ? 0 : 16 + 256 * (j - 1), ntile = (j == 0) ? 1 : 4 * j + 1;
    const int qrow = qbase + 32 * w + r32;
    const bf16* pb = proj + (size_t)b * LT * NI + h * 128;
    bf16* ob = mixed + ((size_t)b * LT + qbase + 32 * w) * D + 512 + h * 128;
    const __amdgpu_buffer_rsrc_t prs = __builtin_amdgcn_make_buffer_rsrc((void*)pb, 0, 0x7fffffff, 0x00020000);
    LAS unsigned char* Kc = F.lds + AT_K; LAS unsigned char* Vc = F.lds + AT_V;
    const unsigned vo_k0 = (unsigned)(((tid >> 4) * NI + C_AK + 8 * (tid & 15)) * 2), vo_k1 = vo_k0 + (unsigned)(32 * NI * 2);
    const unsigned vo_v0 = (unsigned)(((tid >> 4) * NI + C_AV + 8 * (tid & 15)) * 2), vo_v1 = vo_v0 + (unsigned)(32 * NI * 2);
    const int kst = (tid >> 4) * AT_KP + (tid & 15) * 16;
    const int vst = ((tid & 15) >> 2) * 4096 + (tid >> 4) * 64 + (tid & 3) * 16;
    const int krd = r32 * AT_KP + 16 * hi;
    const int vrd = (4 * hi + ((lane & 15) >> 2)) * 64 + ((lane >> 4) & 1) * 32 + (lane & 3) * 8;
    LAS unsigned char* Qw = F.lds + AT_Q + (tid >> 6) * (32 * AT_KP);
    __syncthreads();
    {
        const unsigned vq = (unsigned)(((qbase + 32 * w + (lane >> 1)) * NI + C_AQ + 64 * (lane & 1)) * 2);
#pragma unroll
        for (int c = 0; c < 8; ++c) *(LAS u32x4*)(Qw + (lane >> 1) * AT_KP + (lane & 1) * 128 + 16 * c) = bufld16(prs, vq + 16 * c, 0u);
    }
    const LAS unsigned char* Qr = Qw + r32 * AT_KP + 16 * hi;
    f32x16 O[2][4];
#pragma unroll
    for (int comp = 0; comp < 2; ++comp)
#pragma unroll
        for (int vb = 0; vb < 4; ++vb)
#pragma unroll
            for (int r = 0; r < 16; ++r) O[comp][vb][r] = 0.f;
    float mrun[2] = {-1e30f, -1e30f}, lrun[2] = {0.f, 0.f};
    u32x4 kreg0, kreg1, vreg0, vreg1;
#define AT_ISSUE(i_) do { const int kb_ = ((i_) == 0) ? 0 : 16 + 64 * ((i_) - 1); const unsigned so_ = (unsigned)(kb_ * NI * 2); \
        kreg0 = bufld16(prs, vo_k0, so_); kreg1 = bufld16(prs, vo_k1, so_); vreg0 = bufld16(prs, vo_v0, so_); vreg1 = bufld16(prs, vo_v1, so_); } while (0)
#define AT_COMMIT(buf_) do { *(LAS u32x4*)(Kc + (buf_) * AT_KB + kst) = kreg0; *(LAS u32x4*)(Kc + (buf_) * AT_KB + kst + 32 * AT_KP) = kreg1; \
        *(LAS u32x4*)(Vc + (buf_) * AT_VB + vst) = vreg0; *(LAS u32x4*)(Vc + (buf_) * AT_VB + vst + 32 * 64) = vreg1; } while (0)
    AT_ISSUE(0); AT_COMMIT(0);
    __syncthreads();
#pragma unroll 1
    for (int i = 0; i < ntile; ++i) {
        const int buf = i & 1, kb = (i == 0) ? 0 : 16 + 64 * (i - 1);
        const LAS unsigned char* Kb = Kc + buf * AT_KB + krd; const LAS unsigned char* Vb = Vc + buf * AT_VB + vrd;
        const bool domask = (i == 0 || i >= ntile - 4);
        if (i + 1 < ntile) AT_ISSUE(i + 1);
#pragma unroll
        for (int comp = 0; comp < 2; ++comp) {
            f32x16 sT[2]; bf16x8 pf[4];
#pragma unroll
            for (int kblk = 0; kblk < 2; ++kblk) {
#pragma unroll
                for (int r = 0; r < 16; ++r) sT[kblk][r] = 0.f;
#pragma unroll
                for (int ks = 0; ks < 4; ++ks) { const bf16x8 kf = *(const LAS bf16x8*)(Kb + (32 * kblk) * AT_KP + comp * 128 + 32 * ks); const bf16x8 qq = *(const LAS bf16x8*)(Qr + comp * 128 + 32 * ks); sT[kblk] = MFMA32(kf, qq, sT[kblk]); }
                __builtin_amdgcn_sched_barrier(0);
            }
            if (domask) {
#pragma unroll
                for (int kblk = 0; kblk < 2; ++kblk)
#pragma unroll
                    for (int r = 0; r < 16; ++r) { const int kl = 32 * kblk + crow(r, hi); const bool ok = (kb + kl <= qrow) && (i > 0 || kl < 16); if (!ok) sT[kblk][r] = -INFINITY; }
            }
            float mx = sT[0][0];
#pragma unroll
            for (int r = 1; r < 16; ++r) mx = fmaxf(mx, sT[0][r]);
#pragma unroll
            for (int r = 0; r < 16; ++r) mx = fmaxf(mx, sT[1][r]);
            mx = xhalf_max(mx);
            const float mnew = fmaxf(mrun[comp], mx), alpha = __builtin_amdgcn_exp2f(mrun[comp] - mnew);
            float psum = 0.f;
#pragma unroll
            for (int kblk = 0; kblk < 2; ++kblk)
#pragma unroll
                for (int r = 0; r < 16; ++r) { const float pv = __builtin_amdgcn_exp2f(sT[kblk][r] - mnew); sT[kblk][r] = pv; psum += pv; }
            psum = xhalf_sum(psum);
            lrun[comp] = lrun[comp] * alpha + psum; mrun[comp] = mnew;
#pragma unroll
            for (int vb = 0; vb < 4; ++vb)
#pragma unroll
                for (int r = 0; r < 16; ++r) O[comp][vb][r] *= alpha;
#pragma unroll
            for (int kblk = 0; kblk < 2; ++kblk)
#pragma unroll
                for (int s = 0; s < 2; ++s) {
                    u32x4 pw; pw.x = cvt_pk_bf16(sT[kblk][8 * s + 0], sT[kblk][8 * s + 1]); pw.y = cvt_pk_bf16(sT[kblk][8 * s + 2], sT[kblk][8 * s + 3]);
                    pw.z = cvt_pk_bf16(sT[kblk][8 * s + 4], sT[kblk][8 * s + 5]); pw.w = cvt_pk_bf16(sT[kblk][8 * s + 6], sT[kblk][8 * s + 7]);
                    pf[2 * kblk + s] = __builtin_bit_cast(bf16x8, pw); }
            __builtin_amdgcn_sched_barrier(0);
#pragma unroll
            for (int ks4 = 0; ks4 < 4; ++ks4)
#pragma unroll
                for (int vb = 0; vb < 4; ++vb) { const LAS unsigned char* vp = Vb + vb * 4096 + (16 * ks4) * 64;
                    const s16x4 lo = vtr(vp), hh = vtr(vp + 8 * 64);
                    const bf16x8 vf = (bf16x8){lo[0], lo[1], lo[2], lo[3], hh[0], hh[1], hh[2], hh[3]};
                    O[comp][vb] = MFMA32(vf, pf[ks4], O[comp][vb]);
                    if (vb & 1) __builtin_amdgcn_sched_barrier(0); }
            __builtin_amdgcn_sched_barrier(0);
        }
        if (i + 1 < ntile) AT_COMMIT(buf ^ 1);
        __syncthreads();
    }
#undef AT_ISSUE
#undef AT_COMMIT
    int tid2 = lane_id_(); LAUNDER(tid2);
    const int r32e = tid2 & 31, hie = (tid2 >> 5) & 1;
    const unsigned vo_o = (unsigned)((r32e * D + 4 * hie) * 2);
    const bool rowok = (j > 0) || (32 * w + r32e < 16);
    const float lam = ((const LAS float*)(F.lds + MISC_OFF))[16], oscale = ((const LAS float*)(F.lds + MISC_OFF))[17];
    const float l0inv = 1.f / lrun[0], l1s = lam / lrun[1];
    float ssq = 0.f;
#pragma unroll
    for (int vb = 0; vb < 4; ++vb)
#pragma unroll
        for (int r = 0; r < 16; ++r) { const float a = O[0][vb][r] * l0inv - O[1][vb][r] * l1s; O[0][vb][r] = a; ssq += a * a; }
    ssq = xhalf_sum(ssq);
    const float rn = rsqrtf(ssq * (1.f / 128.f) + RMS_EPS) * oscale;
    if (rowok) {
#pragma unroll
        for (int vb = 0; vb < 4; ++vb)
#pragma unroll
            for (int g4 = 0; g4 < 4; ++g4) { const f32x4 sg = ldg<f32x4>(subg, (unsigned)((32 * vb + 8 * g4 + 4 * hie) * 4));
                u32x2 wv; wv.x = pk2(O[0][vb][4 * g4 + 0] * rn * sg[0], O[0][vb][4 * g4 + 1] * rn * sg[1]); wv.y = pk2(O[0][vb][4 * g4 + 2] * rn * sg[2], O[0][vb][4 * g4 + 3] * rn * sg[3]);
                stg<u32x2>(ob, vo_o + (unsigned)((32 * vb + 8 * g4) * 2), wv); }
    }
}
__device__ __forceinline__ void attn_phase(const Frame& F0, int l) {
    Frame F = F0; F.tid = F.wave * 64 + lane_id_(); LAUNDER(F.tid); F.lane = F.tid & 63;
    float s1 = 0.f, s2 = 0.f;
    for (int i = 0; i < 64; ++i) { s1 += F.in[IN_LQ1][l * 64 + i] * F.in[IN_LK1][l * 64 + i]; s2 += F.in[IN_LQ2][l * 64 + i] * F.in[IN_LK2][l * 64 + i]; }
    const float lam_init = 0.8f - 0.6f * expf(-0.3f * (float)l);
    { const float lam = expf(s1) - expf(s2) + lam_init; if (F.tid == 0) { ((LAS float*)(F.lds + MISC_OFF))[16] = lam; ((LAS float*)(F.lds + MISC_OFF))[17] = 1.f - lam_init; } }
    __syncthreads();
    const float* subg = F.in[IN_SUBLN] + l * 128;
    unsigned* qh = (unsigned*)F.ws + CW_Q + (l * 4 + 0) * 64;
#ifndef ATT_REP
#define ATT_REP 1
#endif
    constexpr int NQ = ATT_REP * (1024 + NB * 4);
#pragma unroll 1
    for (int q0 = F.wg; q0 < NQ; q0 = F.G + wq_fetch(qh, F)) {
        const int q = q0 % (1024 + NB * 4);
        const int bh = q & 127, j = (q < 1024) ? 8 - (q >> 7) : 0;
        attn_unit(F, bh >> 2, bh & 3, j, subg);
    }
}

constexpr int RT_WP = 1032;
__device__ __forceinline__ void router_phase(const Frame& F0, int l) {
    Frame F = F0; F.tid = F.wave * 64 + lane_id_(); LAUNDER(F.tid); F.lane = F.tid & 63;
    const bf16* HBr = (const bf16*)(F.ws + WS_HB); const bf16* WR = (const bf16*)(F.ws + WS_WR) + (size_t)l * 2 * 32 * 1024;
    float* rstd = (float*)(F.ws + WS_RSTD); float* gate = (float*)(F.ws + WS_GATE); int* buck = (int*)(F.ws + WS_BUCK);
    unsigned* gcnt = (unsigned*)F.ws + CW_CNT + l * 64;
    LAS bf16* Wh = (LAS bf16*)F.lds;
    LAS bf16* Wl = Wh + 20 * RT_WP;
    LAS float* LG = (LAS float*)(F.lds + 2 * 20 * RT_WP * 2);
    LAS int* lcnt = (LAS int*)(LG + 8 * 16 * 33);
    LAS int* lbase = lcnt + 32;
    LAS int* tcls = lbase + 32;
    LAS int* tpos = tcls + 288;
    const int lane = F.lane, w = F.wave, fr = lane & 15, fq = lane >> 4;
    constexpr int NTASK = T / 16;
    const int ntl = (NTASK - F.wg + F.G - 1) / F.G;
    __syncthreads();
    for (int idx = F.tid; idx < 2 * 20 * 128; idx += 512) { const int hl = idx / (20 * 128), r = (idx / 128) % 20, c = idx % 128;
        *(LAS u32x4*)((hl ? Wl : Wh) + r * RT_WP + 8 * c) = *(const GAS u32x4*)(WR + (size_t)hl * 32 * 1024 + r * 1024 + 8 * c); }
    if (F.tid < 32) lcnt[F.tid] = 0;
    __syncthreads();
    const int n1 = (16 + fr < 20) ? 16 + fr : 19;
    for (int k = w; k < ntl; k += 8) {
        const int task = F.wg + k * F.G;
        const bf16* hrow = HBr + (size_t)task * 16 * D;
        const unsigned vo = (unsigned)((fr * D + 8 * fq) * 2);
        f32x4 acc[2]; acc[0] = (f32x4){0.f, 0.f, 0.f, 0.f}; acc[1] = acc[0];
        float ssq = 0.f;
#pragma unroll 8
        for (int ks = 0; ks < 32; ++ks) {
            const u32x4 xa = ldg<u32x4>(hrow, vo + ks * 64);
            const float x0 = bf2f(xa.x), x1 = bf2f(xa.x >> 16), x2 = bf2f(xa.y), x3 = bf2f(xa.y >> 16), x4 = bf2f(xa.z), x5 = bf2f(xa.z >> 16), x6 = bf2f(xa.w), x7 = bf2f(xa.w >> 16);
            ssq += (x0 * x0 + x1 * x1) + (x2 * x2 + x3 * x3) + (x4 * x4 + x5 * x5) + (x6 * x6 + x7 * x7);
            const bf16x8 ahi = __builtin_bit_cast(bf16x8, xa);
            const bf16x8 bh0 = *(const LAS bf16x8*)(Wh + fr * RT_WP + 32 * ks + 8 * fq), bl0 = *(const LAS bf16x8*)(Wl + fr * RT_WP + 32 * ks + 8 * fq);
            const bf16x8 bh1 = *(const LAS bf16x8*)(Wh + n1 * RT_WP + 32 * ks + 8 * fq), bl1 = *(const LAS bf16x8*)(Wl + n1 * RT_WP + 32 * ks + 8 * fq);
            acc[0] = MFMA16(ahi, bh0, acc[0]); acc[0] = MFMA16(ahi, bl0, acc[0]);
            acc[1] = MFMA16(ahi, bh1, acc[1]); acc[1] = MFMA16(ahi, bl1, acc[1]);
        }
        ssq += __shfl_xor(ssq, 16); ssq += __shfl_xor(ssq, 32);
        const float rs = rsqrtf(ssq * (1.f / 1024.f) + RMS_EPS);
#pragma unroll
        for (int nt = 0; nt < 2; ++nt)
#pragma unroll
            for (int j = 0; j < 4; ++j) LG[w * 16 * 33 + (4 * fq + j) * 33 + 16 * nt + fr] = acc[nt][j];
        LDS_WAIT(); asm volatile("" ::: "memory");
        if (lane < 16) {
            const int tl = k * 16 + lane; const size_t m = (size_t)task * 16 + lane;
            const float rsm = rs;
            const LAS float* lg = LG + w * 16 * 33 + lane * 33;
            float gl[4]; float gm = -1e30f; int gi = 0;
#pragma unroll
            for (int q = 0; q < 4; ++q) { gl[q] = lg[q] * rsm + F.in[IN_BGRP][l * 4 + q]; if (gl[q] > gm) { gm = gl[q]; gi = q; } }
            float gs = 0.f;
#pragma unroll
            for (int q = 0; q < 4; ++q) gs += __expf(gl[q] - gm);
            const float gp = 1.f / gs;
            float el[4];
#pragma unroll
            for (int q = 0; q < 4; ++q) el[q] = lg[4 + 4 * gi + q] * rsm + F.in[IN_BEXP][l * 16 + 4 * gi + q];
            int i1 = 0; float v1 = el[0];
#pragma unroll
            for (int q = 1; q < 4; ++q) if (el[q] > v1) { v1 = el[q]; i1 = q; }
            int i2 = -1; float v2 = -1e30f;
#pragma unroll
            for (int q = 0; q < 4; ++q) if (q != i1 && el[q] > v2) { v2 = el[q]; i2 = q; }
            const float e2 = __expf(v2 - v1), w1 = gp / (1.f + e2), w2 = gp * e2 / (1.f + e2);
            const int a = i1 < i2 ? i1 : i2, bq = i1 < i2 ? i2 : i1;
            const int pidx = (a == 0) ? (bq - 1) : (a == 1 ? bq + 1 : 5);
            const int cls = gi * 6 + pidx;
            rstd[m] = rsm; gate[2 * m] = (a == i1) ? w1 : w2; gate[2 * m + 1] = (a == i1) ? w2 : w1;
            tcls[tl] = cls; tpos[tl] = atomicAdd((int*)&lcnt[cls], 1);
        }
    }
    __syncthreads();
    if (F.tid < NCLS) lbase[F.tid] = (int)atomicAdd(&gcnt[F.tid], (unsigned)lcnt[F.tid]);
    __syncthreads();
    if (F.tid < ntl * 16) { const int cls = tcls[F.tid]; buck[(size_t)cls * T + lbase[cls] + tpos[F.tid]] = (F.wg + (F.tid >> 4) * F.G) * 16 + (F.tid & 15); }
    __syncthreads();
}

__device__ __forceinline__ void final_phase(const Frame& F0, float* out) {
    Frame F = F0; F.tid = F.wave * 64 + lane_id_(); LAUNDER(F.tid); F.lane = F.tid & 63;
    const bf16* HBf = (const bf16*)(F.ws + WS_HB); const float* g = F.in[IN_FNG];
    const int gw = F.wg * 8 + F.wave, NGW = F.G * 8, lane = F.lane;
    for (int r = gw; r < NB * SEQ; r += NGW) {
        const int b = r / SEQ, t = r % SEQ; const size_t m = (size_t)b * LT + NMETA + t;
        const GAS u32x2* hr = (const GAS u32x2*)(HBf + m * D) + lane; GAS f32x4* orow = (GAS f32x4*)(out + (size_t)r * D) + lane;
        f32x4 v[4]; float s = 0.f;
#pragma unroll
        for (int j = 0; j < 4; ++j) { const u32x2 q = hr[64 * j]; v[j] = (f32x4){bf2f(q.x), bf2f(q.x >> 16), bf2f(q.y), bf2f(q.y >> 16)}; s += (v[j].x * v[j].x + v[j].y * v[j].y) + (v[j].z * v[j].z + v[j].w * v[j].w); }
        const float rs = rsqrtf(wave_sum(s) * (1.f / 1024.f) + RMS_EPS);
#pragma unroll
        for (int j = 0; j < 4; ++j) { const f32x4 gg = *((const GAS f32x4*)g + lane + 64 * j); orow[64 * j] = v[j] * rs * gg; }
    }
}

template <int NPN>
__device__ __forceinline__ int moe_prepare(const Frame& F0, int l, LAS int* cntl, LAS int* tab) {
    Frame F = F0; F.tid = F.wave * 64 + lane_id_(); LAUNDER(F.tid); F.lane = F.tid & 63;
    const unsigned* gcnt = (const unsigned*)F.ws + CW_CNT + l * 64; const int* buck = (const int*)(F.ws + WS_BUCK);
    __syncthreads();
    if (F.tid < NCLS) cntl[F.tid] = (int)gcnt[F.tid];
    __syncthreads();
    MoeList ml{cntl}; const int ntl = ml.ntiles();
    for (int i = 0;; ++i) { const int Lx = i * F.G + F.wg; if (Lx >= ntl * NPN) break;
        int c, ti, nv; ml.decode(Lx / NPN, c, ti, nv);
        if (F.tid < 256) tab[i * 256 + F.tid] = (F.tid < nv) ? buck[(size_t)c * T + ti * 256 + F.tid] : -1; }
    __syncthreads();
    return ntl;
}

#ifndef ONLY_MASK
#define ONLY_MASK 0xFFFFFFFFu
#endif
#define IN(k) (lo <= (k) && (k) < hi)
#define EN(j) ((ONLY_MASK >> (j)) & 1u)
#ifndef SUBMASK
#define SUBMASK 3u
#endif
#define SEAM(k) do { if (IN(k) && IN((k) + 1)) xcd_barrier(bar); } while (0)
template <int L>
__device__ __forceinline__ void layer_phases(const Frame& F, const XcdBarrier& bar, int lo, int hi) {
    bf16* proj = (bf16*)(F.ws + WS_PROJ); bf16* mixed = (bf16*)(F.ws + WS_MIXED); bf16* HB = (bf16*)(F.ws + WS_HB);
    float* ss16 = (float*)(F.ws + WS_SS16);
    LAS int* tab = (LAS int*)(F.lds + TAB_OFF); LAS int* cntl = (LAS int*)(F.lds + TAB_OFF + 12 * 1024);
    constexpr int l = L; constexpr int pb = 1 + 9 * L;
        if (EN(1) && IN(pb + 0)) {
            PolIn P; P.ord.init(MT, NI / 256, F.G, F.wg); P.A = HB; P.B = (const bf16*)(F.ws + WS_WIN) + (size_t)l * NI * D; P.proj = proj; P.ss16 = ss16; P.rope = (const float*)(F.ws + WS_ROPE); P.X = (bf16*)(F.os + OS_X);
            for (int rep = 0; rep < NREP(1); ++rep) pg8::gemm_phase(F.lds, P, F.wave); }
        SEAM(pb + 0);
        if (EN(2) && IN(pb + 1)) {
            PolS5E P; P.G = F.G; P.c = F.wg; P.X = (const bf16*)(F.os + OS_X); P.B = (const bf16*)(F.ws + WS_S5P) + (size_t)l * 16 * 256 * 256; P.E = (float*)(F.os + OS_E);
            for (int rep = 0; rep < NREP(2); ++rep) if (MIXSEL & 1u) pg8::gemm_phase(F.lds, P, F.wave);
            __syncthreads();
            for (int rep = 0; rep < NREP(11); ++rep) if (MIXSEL & 2u) hgrn_a(F, l); }
        SEAM(pb + 1);
        if (EN(3) && IN(pb + 2)) { for (int rep = 0; rep < NREP(3); ++rep) { if (MIXSEL & 1u) s5_scan(F, l); if (MIXSEL & 2u) hgrn_b(F); } }
        SEAM(pb + 2);
        if (EN(4) && IN(pb + 3)) {
            PolS5Y P; P.G = F.G; P.c = F.wg; P.X = (const bf16*)(F.os + OS_X); P.B = (const bf16*)(F.ws + WS_S5TQ) + (size_t)l * 16 * 256 * 384; P.proj = proj; P.dsk = F.in[IN_S5D] + l * 256; P.Gout = (bf16*)(F.os + OS_G);
            for (int rep = 0; rep < NREP(4); ++rep) if ((SUBMASK & MIXSEL & 1u) != 0u) pg8::gemm_phase(F.lds, P, F.wave);
            __syncthreads();
            for (int rep = 0; rep < NREP(12); ++rep) if ((SUBMASK & MIXSEL & 2u) != 0u) hgrn_c(F, l); }
        SEAM(pb + 3);
        if (EN(5) && IN(pb + 4)) {
            PolGlu P; P.ord.init(MT, 2, F.G, F.wg); P.A = (const bf16*)(F.os + OS_G); P.B = (const bf16*)(F.ws + WS_WGLU) + (size_t)l * 512 * 256; P.mixed = mixed;
            for (int rep = 0; rep < NREP(5); ++rep) if ((SUBMASK & MIXSEL & 1u) != 0u) pg8::gemm_phase(F.lds, P, F.wave);
            __syncthreads();
            for (int rep = 0; rep < NREP(13); ++rep) if ((SUBMASK & 2u) != 0u && (MIXSEL & 4u) != 0u) attn_phase(F, l); }
        SEAM(pb + 4);
        if (EN(6) && IN(pb + 5)) {
            PolOut P; P.ord.init(MT, 4, F.G, F.wg); P.A = mixed; P.B = (const bf16*)(F.ws + WS_WOUT) + (size_t)l * D * D; P.HB = HB; P.ss16 = ss16;
            pg8::gemm_phase(F.lds, P, F.wave); }
        SEAM(pb + 5);
        if (EN(7) && IN(pb + 6)) { router_phase(F, l); }
        SEAM(pb + 6);
        if (EN(8) && IN(pb + 7)) {
            PolGU P; P.G = F.G; P.c = F.wg; P.ntl = moe_prepare<8>(F, l, cntl, tab); P.ml = MoeList{cntl}; P.tab = tab;
            P.HB = HB; P.W = (const bf16*)(F.ws + WS_WGU) + (size_t)l * 16 * 1024 * 1024; P.he = proj; P.rstd = (const float*)(F.ws + WS_RSTD); P.gate = (const float*)(F.ws + WS_GATE);
            for (int rep = 0; rep < NREP(8); ++rep) pg8::gemm_phase(F.lds, P, F.wave); }
        SEAM(pb + 7);
        if (EN(9) && IN(pb + 8)) {
            PolDN P; P.G = F.G; P.c = F.wg; P.ntl = moe_prepare<4>(F, l, cntl, tab); P.ml = MoeList{cntl}; P.tab = tab;
            P.he = proj; P.W = (const bf16*)(F.ws + WS_WDN) + (size_t)l * 16 * 1024 * 512; P.HB = HB; P.ss16 = ss16;
            pg8::gemm_phase(F.lds, P, F.wave); }
        SEAM(pb + 8);
}

__global__ void __launch_bounds__(512, 2) hymba_fwd(Args args) {
    extern __shared__ __attribute__((aligned(16))) unsigned char lds_raw[];
    Frame F;
    F.lds = (LAS unsigned char*)lds_raw;
    F.tid = threadIdx.x; F.lane = F.tid & 63; F.wave = __builtin_amdgcn_readfirstlane(F.tid >> 6);
    F.G = gridDim.x; F.wg = blockIdx.x; F.in = args.in; F.ws = args.ws; F.os = (unsigned char*)args.out;
    volatile LAS unsigned* MISC = (volatile LAS unsigned*)(F.lds + MISC_OFF);
    if (F.tid < 256) MISC[F.tid] = 0u;
    __syncthreads();
    const int lo = args.ph_lo, hi = args.ph_hi;
    const bool one = (hi - lo) > 1;
    XcdBarrier bar; bar.bar = (unsigned*)F.ws + CW_BAR; bar.x = 0; bar.st = nullptr;
    bar.wave = F.wave;
    if (one) bar = xcd_barrier_post((unsigned*)F.ws + CW_BAR, MISC + 8, F.wave);
    if (EN(0) && IN(0)) { for (int rep = 0; rep < NREP(0); ++rep) p0_prologue(F); } SEAM(0);
    layer_phases<0>(F, bar, lo, hi);
    layer_phases<1>(F, bar, lo, hi);
    if (EN(10) && IN(19)) for (int rep = 0; rep < NREP(10); ++rep) final_phase(F, args.out);
#undef IN
#undef SEAM
}

extern "C" void kernel_launch(void* const* d_in, const int* in_sizes, int n_in, void* d_out, int out_size, void* d_ws, size_t ws_size, hipStream_t stream) {
    static int grid = 0;
    if (grid == 0) {
        if (n_in != 30 || ws_size < WS_END) { fprintf(stderr, "kernel_launch: unexpected inputs (n_in %d, ws %zu < %zu)\n", n_in, ws_size, (size_t)WS_END); grid = -1; return; }
        int dev = 0, cus = 0, per_cu = 0;
        (void)hipGetDevice(&dev); (void)hipDeviceGetAttribute(&cus, hipDeviceAttributeMultiprocessorCount, dev);
        (void)hipFuncSetAttribute((const void*)hymba_fwd, hipFuncAttributeMaxDynamicSharedMemorySize, LDS_BYTES);
        (void)hipOccupancyMaxActiveBlocksPerMultiprocessor(&per_cu, (const void*)hymba_fwd, 512, LDS_BYTES);
        (void)hipGetLastError();
        grid = cus > 0 ? cus : 256;
    }
    if (grid < 0) return;
    (void)hipMemsetAsync(d_ws, 0, CTL_BYTES, stream);
    Args a{};
    for (int i = 0; i < 30; ++i) a.in[i] = (const float*)d_in[i];
    a.out = (float*)d_out; a.ws = (unsigned char*)d_ws;
#if N_LAUNCH_MODE == 1
    a.ph_lo = 0; a.ph_hi = LAST_PHASE;
    hipLaunchKernelGGL(hymba_fwd, dim3(grid), dim3(512), LDS_BYTES, stream, a);
#else
    if (MIXSEL != 7u) (void)hipMemsetAsync((char*)d_ws + WS_MIXED, 0, (size_t)T * D * 2, stream);
    for (int p = 0; p < LAST_PHASE; ++p) { if (!((RUN_MASK >> p) & 1u)) continue; a.ph_lo = p; a.ph_hi = p + 1; hipLaunchKernelGGL(hymba_fwd, dim3(grid), dim3(512), LDS_BYTES, stream, a); }
#endif
}
```

```cpp
#include <hip/hip_runtime.h>
#include <stdint.h>
#include <stdio.h>

#ifndef N_LAUNCH_MODE
#define N_LAUNCH_MODE 1
#endif
#ifndef LAST_PHASE
#define LAST_PHASE 20
#endif
#ifndef RUN_MASK
#define RUN_MASK 0xFFFFFu
#endif
#ifndef REPMASK
#define REPMASK 0u
#endif
#define NREP(j) (((REPMASK >> (j)) & 1u) ? 2 : 1)
#ifndef MIXSEL
#define MIXSEL 7u
#endif

#define GAS __attribute__((address_space(1)))
#define LAS __attribute__((address_space(3)))
typedef unsigned short bf16;
typedef short bf16x8 __attribute__((ext_vector_type(8)));
typedef short s16x4 __attribute__((ext_vector_type(4)));
typedef float f32x2 __attribute__((ext_vector_type(2)));
typedef float f32x4 __attribute__((ext_vector_type(4)));
typedef float f32x16 __attribute__((ext_vector_type(16)));
typedef unsigned u32x2 __attribute__((ext_vector_type(2)));
typedef unsigned u32x4 __attribute__((ext_vector_type(4)));

constexpr int NB = 32, LT = 2064, NMETA = 16, SEQ = 2048, T = NB * LT;
constexpr int DEPTH = 2;
constexpr int D = 1024, NI = 2816, MT = T / 256;
constexpr int C_U = 0, C_HQ = 256, C_HF = 512, C_HI = 768, C_HG = 1024, C_AQ = 1280, C_AK = 1792, C_AV = 2304;
constexpr int NCH = 129;
constexpr int S5R = NB * NCH;
constexpr int S5RP = 17 * 256;
constexpr int HCH = 33;
constexpr int NCLS = 24;
constexpr float RMS_EPS = 1e-6f;
constexpr float QSCALE = 0.125f * 1.4426950408889634f;

constexpr size_t al256(size_t x) { return (x + 255) & ~(size_t)255; }
constexpr size_t CTL_BYTES = 1u << 20;
constexpr size_t WS_WIN = CTL_BYTES;
constexpr size_t WS_WOUT = WS_WIN + al256((size_t)2 * NI * D * 2);
constexpr size_t WS_WGLU = WS_WOUT + al256((size_t)2 * D * D * 2);
constexpr size_t WS_WGU = WS_WGLU + al256((size_t)2 * 512 * 256 * 2);
constexpr size_t WS_WDN = WS_WGU + al256((size_t)2 * 16 * 1024 * 1024 * 2);
constexpr size_t WS_WR = WS_WDN + al256((size_t)2 * 16 * 1024 * 512 * 2);
constexpr size_t WS_S5TQ = WS_WR + al256((size_t)2 * 2 * 32 * 1024 * 2);
constexpr size_t WS_S5P = WS_S5TQ + al256((size_t)2 * 16 * 256 * 384 * 2);
constexpr size_t WS_S5A = WS_S5P + al256((size_t)2 * 16 * 256 * 256 * 2);
constexpr size_t WS_ROPE = WS_S5A + al256((size_t)2 * 16 * 64 * 8);
constexpr size_t WS_SS16 = WS_ROPE + al256((size_t)LT * 32 * 4 * 2);
constexpr size_t WS_RSTD = WS_SS16 + al256((size_t)T * 16 * 4);
constexpr size_t WS_GATE = WS_RSTD + al256((size_t)T * 4);
constexpr size_t WS_BUCK = WS_GATE + al256((size_t)T * 8);
constexpr size_t WS_HB = WS_BUCK + al256((size_t)NCLS * T * 4);
constexpr size_t WS_PROJ = WS_HB + al256((size_t)T * D * 2);
constexpr size_t WS_MIXED = WS_PROJ + al256((size_t)T * NI * 2);
constexpr size_t WS_SCR = WS_MIXED + al256((size_t)T * D * 2);
constexpr size_t OS_E = 0;
constexpr size_t OS_X = OS_E + al256((size_t)16 * S5RP * 128 * 4);
constexpr size_t OS_G = OS_X + al256((size_t)16 * S5RP * 384 * 2);
constexpr size_t OS_UT = OS_G + al256((size_t)T * 256 * 2);
constexpr size_t OS_DEC = OS_UT + al256((size_t)NB * 4 * HCH * 4096 * 4);
constexpr size_t OS_SP = OS_DEC + al256((size_t)NB * 4 * HCH * 64 * 4);
constexpr size_t OS_END = OS_SP + al256((size_t)NB * 4 * HCH * 4096 * 2);
constexpr size_t WS_END = WS_SCR + OS_END;
static_assert(WS_END <= (size_t)1 << 30, "workspace map must fit in 1 GiB");
static_assert((size_t)(MT + NCLS) * 256 * 1024 * 2 <= (size_t)T * NI * 2, "he overlay fits in proj");

constexpr int CW_PAN = 32768;
constexpr int CW_BAR = 4096, CW_CNT = 16384, CW_Q = 20480;

constexpr int LDS_BYTES = 147456;
constexpr int RING_BYTES = 131072;
constexpr int TAB_OFF = RING_BYTES;
constexpr int MISC_OFF = LDS_BYTES - 1024;

__device__ __forceinline__ float bf2f(unsigned b) { return __builtin_bit_cast(float, (b & 0xffffu) << 16); }
__device__ __forceinline__ unsigned cvt_pk_bf16(float lo, float hi) { unsigned r; asm("v_cvt_pk_bf16_f32 %0, %1, %2" : "=v"(r) : "v"(lo), "v"(hi)); return r; }
__device__ __forceinline__ unsigned pk2(float lo, float hi) { return cvt_pk_bf16(lo, hi); }
__device__ __forceinline__ unsigned f2bf(float f) { return cvt_pk_bf16(f, 0.f) & 0xffffu; }
__device__ __forceinline__ float wave_sum(float v) {
#pragma unroll
    for (int o = 1; o < 64; o <<= 1) v += __shfl_xor(v, o);
    return v;
}
__device__ __forceinline__ float sigmoidf_(float x) { return __builtin_amdgcn_rcpf(1.f + __expf(-x)); }
__device__ __forceinline__ float siluf_(float x) { return x * __builtin_amdgcn_rcpf(1.f + __expf(-x)); }
__device__ __forceinline__ float gelu_tanh(float x) { const float u = 0.7978845608028654f * (x + 0.044715f * x * x * x); return x * __builtin_amdgcn_rcpf(1.f + __expf(-2.f * u)); }
__device__ __forceinline__ int lane_id_() { int l; asm volatile("v_mbcnt_lo_u32_b32 %0, -1, 0\n\tv_mbcnt_hi_u32_b32 %0, -1, %0" : "=v"(l)); return l; }
#define LAUNDER(x) asm volatile("" : "+v"(x))
#define LAUNDER_S(x) asm volatile("" : "+s"(x))
#define LDS_WAIT() asm volatile("s_waitcnt lgkmcnt(0)" ::: "memory")
#define VM_WAIT() asm volatile("s_waitcnt vmcnt(0)" ::: "memory")

#define XB_TMO      128
#define XB_XCNT(j)  (256  + 64 * (j))
#define XB_XSUB(j)  (1280 + 64 * (j))
#define XB_XGEN(j)  (2304 + 64 * (j))
#define XB_TOP      3328
#define XB_TOPGEN   3392
#define XCD_BAR_WORDS 3456
#define XB_SPIN_CAP (1u << 18)
__device__ __forceinline__ unsigned xb_ld(unsigned* p)              { return __hip_atomic_load(p, __ATOMIC_RELAXED, __HIP_MEMORY_SCOPE_AGENT); }
__device__ __forceinline__ unsigned xb_add(unsigned* p, unsigned v) { return __hip_atomic_fetch_add(p, v, __ATOMIC_RELAXED, __HIP_MEMORY_SCOPE_AGENT); }
__device__ __forceinline__ unsigned xb_xcc_id() { return (unsigned)__builtin_amdgcn_s_getreg((3 << 11) | 20) & 0xFu; }
#define XB_SPIN(cond, bar) do { unsigned _sp = 0; while (cond) { __builtin_amdgcn_s_sleep(1); \
    if ((++_sp & 255u) == 0u) { if (xb_ld(&(bar)[XB_TMO])) break; if (_sp > XB_SPIN_CAP) { atomicAdd(&(bar)[XB_TMO], 1u); break; } } } } while (0)
struct XcdBarrier { unsigned* bar; unsigned x; volatile LAS unsigned* st; int wave; };
__device__ __forceinline__ XcdBarrier xcd_barrier_post(unsigned* bar, volatile LAS unsigned* st, int wave) {
    XcdBarrier b; b.bar = bar; b.x = xb_xcc_id(); b.st = st; b.wave = wave;
    if (wave == 0 && lane_id_() == 0) (void)xb_add(&bar[XB_XCNT(b.x)], 1u);
    return b;
}
__device__ __forceinline__ void xcd_barrier_complete(unsigned* bar, unsigned x, unsigned& nloc, unsigned& nx) {
    const unsigned G = gridDim.x * gridDim.y * gridDim.z;
    unsigned sum, cnt, mine, sp = 0u;
    for (;;) {
        sum = 0u; cnt = 0u; mine = 0u;
#pragma unroll 1
        for (unsigned j = 0; j < 16; ++j) { const unsigned c = xb_ld(&bar[XB_XCNT(j)]); sum += c; cnt += (c > 0u) ? 1u : 0u; mine = (j == x) ? c : mine; }
        if (sum == G) break;
        __builtin_amdgcn_s_sleep(1);
        if ((++sp & 255u) == 0u) { if (xb_ld(&bar[XB_TMO])) break; if (sp > XB_SPIN_CAP) { atomicAdd(&bar[XB_TMO], 1u); break; } }
    }
    nloc = mine > 0u ? mine : 1u; nx = cnt > 0u ? cnt : 1u;
}
__device__ __forceinline__ void xcd_barrier(const XcdBarrier& b) {
    asm volatile("s_waitcnt vmcnt(0)" ::: "memory");
    __syncthreads();
    if (b.wave == 0 && lane_id_() == 0) {
        unsigned* bar = b.bar;
        __builtin_amdgcn_s_waitcnt(0);
        unsigned nloc = b.st[0], nx = b.st[1];
        if (nloc == 0u) { xcd_barrier_complete(bar, b.x, nloc, nx); b.st[0] = nloc; b.st[1] = nx; }
        const unsigned old = xb_add(&bar[XB_XSUB(b.x)], 1u);
        const unsigned gen = old / nloc;
        if (old + 1u == (gen + 1u) * nloc) {
            __builtin_amdgcn_fence(__ATOMIC_RELEASE, "agent");
            asm volatile("s_waitcnt vmcnt(0)" ::: "memory");
            const unsigned og = xb_add(&bar[XB_TOP], 1u);
            const unsigned tg = og / nx;
            if (og + 1u == (tg + 1u) * nx) xb_add(&bar[XB_TOPGEN], 1u);
            else XB_SPIN(xb_ld(&bar[XB_TOPGEN]) == tg, bar);
            __builtin_amdgcn_fence(__ATOMIC_ACQUIRE, "agent");
            xb_add(&bar[XB_XGEN(b.x)], 1u);
            asm volatile("s_waitcnt vmcnt(0)" ::: "memory");
        } else {
            XB_SPIN(xb_ld(&bar[XB_XGEN(b.x)]) == gen, bar);
            __builtin_amdgcn_fence(__ATOMIC_ACQUIRE, "agent");
            asm volatile("s_waitcnt vmcnt(0)" ::: "memory");
        }
    }
    __syncthreads();
}

namespace pg8 {
constexpr int BM = 256, BK = 64, HALF = 128, HTB = HALF * BK * 2, NXCD = 8, WGM = 8;
__host__ __device__ __forceinline__ int lds_byte(int r, int c) { const int st = (r >> 4) * 2 + (c >> 5), rr = r & 15, cc = c & 31, ob = rr * 64 + cc * 2; return st * 1024 + (ob ^ (((ob >> 9) & 1) << 5)); }
__host__ __device__ __forceinline__ void stage_rc(int b, int& R, int& C) { const int st = b / 1024, sb = b % 1024, swz = sb ^ (((sb >> 9) & 1) << 5); R = (st >> 1) * 16 + swz / 64; C = (st & 1) * 32 + (swz % 64) / 2; }
__host__ __device__ __forceinline__ int perm32(int rho) { const int n = rho >> 4, i = rho & 15; return 8 * (i >> 2) + 4 * n + (i & 3); }

struct TileOrder {
    int nM, nN, nwg, G, c;
    __device__ __forceinline__ void init(int nM_, int nN_, int G_, int c_) { nM = nM_; nN = nN_; nwg = nM * nN; G = G_; c = c_; }
    __device__ __forceinline__ bool get(int i, int& pm, int& pn) const {
        const long Lx = (long)i * G + c; if (Lx >= nwg) return false;
        int wgid = (int)Lx; { const int q = nwg / NXCD, r = nwg % NXCD, xcd = wgid % NXCD, off = wgid / NXCD; wgid = (xcd < r ? xcd * (q + 1) : r * (q + 1) + (xcd - r) * q) + off; }
        const int nig = WGM * nN, gid = wgid / nig, fm = gid * WGM, gsz = (nM - fm) < WGM ? (nM - fm) : WGM;
        pm = fm + ((wgid % nig) % gsz); pn = (wgid % nig) / gsz; return true;
    }
};

template <class P>
__device__ __forceinline__ void gemm_phase(LAS unsigned char* lds, const P& S, int wave) {
    typedef typename P::Unit Unit;
    int tid_ = wave * 64 + lane_id_(); LAUNDER(tid_);
    const int tid = tid_, wid = wave, lane = tid & 63, wr = wid >> 2, wc = wid & 3, fr = lane & 15, fq = lane >> 4;
    constexpr int nt = P::NT; constexpr int LDB = P::LDB;
    int Rs[2], Cs[2]; unsigned voffB[2];
#pragma unroll
    for (int i = 0; i < 2; ++i) { int R, C; stage_rc(tid * 16 + i * 8192, R, C); Rs[i] = R; Cs[i] = C; const int Rb = (R & ~31) + perm32(R & 31); voffB[i] = (unsigned)(Rb * LDB + C) * 2u; }
    const size_t hstepB = (size_t)HALF * LDB * 2;
    const unsigned ldsw = (unsigned)wid * 1024u;
    const int aoff = lds_byte(wr * 64 + fr, fq * 8), boff = lds_byte(wc * 32 + fr, fq * 8);
#define PG8_SA(b, h) (((b) * 2 + (h)) * HTB)
#define PG8_SB(b, h) ((4 + (b) * 2 + (h)) * HTB)
#define PG8_STAGE1(bufoff, gptr, v0, v1) do { \
        __builtin_amdgcn_global_load_lds((const unsigned*)((const char*)(gptr) + (v0)), (LAS unsigned*)(lds + (bufoff) + ldsw), 16, 0, 0); \
        __builtin_amdgcn_global_load_lds((const unsigned*)((const char*)(gptr) + (v1)), (LAS unsigned*)(lds + (bufoff) + ldsw + 8192), 16, 0, 0); } while (0)
#define PG8_STAGEB(bufoff, gptr) PG8_STAGE1(bufoff, gptr, voffB[0], voffB[1])
#define PG8_LDA(dst, b, h) do { _Pragma("unroll") for (int m = 0; m < 4; ++m) _Pragma("unroll") for (int k = 0; k < 2; ++k) dst[m][k] = *(const LAS bf16x8*)(lds + PG8_SA(b, h) + aoff + m * 2048 + k * 1024); } while (0)
#define PG8_LDB(dst, b, h) do { _Pragma("unroll") for (int n = 0; n < 2; ++n) _Pragma("unroll") for (int k = 0; k < 2; ++k) dst[n][k] = *(const LAS bf16x8*)(lds + PG8_SB(b, h) + boff + n * 2048 + k * 1024); } while (0)
#define PG8_MMA(ai, bj, At, Bt) do { __builtin_amdgcn_s_setprio(1); _Pragma("unroll") for (int m = 0; m < 4; ++m) _Pragma("unroll") for (int n = 0; n < 2; ++n) _Pragma("unroll") for (int k = 0; k < 2; ++k) \
        acc[ai][bj][m][n] = __builtin_amdgcn_mfma_f32_16x16x32_bf16(Bt[n][k], At[m][k], acc[ai][bj][m][n], 0, 0, 0); __builtin_amdgcn_s_setprio(0); } while (0)
#define PG8_WAIT_V(n) asm volatile("s_waitcnt vmcnt(" #n ")" ::: "memory")
#define PG8_WAIT_L(n) asm volatile("s_waitcnt lgkmcnt(" #n ")" ::: "memory")
#define PG8_BAR __builtin_amdgcn_s_barrier()
#define PG8_SCHED __builtin_amdgcn_sched_barrier(0)
    Unit cur, nxt; int ui = 0;
    if (!S.next(0, cur)) return;
    f32x4 acc[2][2][4][2];
#pragma unroll
    for (int a = 0; a < 2; ++a)
#pragma unroll
        for (int b = 0; b < 2; ++b)
#pragma unroll
            for (int m = 0; m < 4; ++m)
#pragma unroll
                for (int n = 0; n < 2; ++n) acc[a][b][m][n] = (f32x4){0.f, 0.f, 0.f, 0.f};
    bf16x8 At[4][2], B0[2][2], B1[2][2];
#define PG8_STAGEA(bufoff, uidx, uu, tt, hh) S.stage_a(lds + (bufoff) + ldsw, uidx, uu, tt, hh, Rs, Cs)
    {
        const char* pB0 = S.b_ptr(cur, 0); const char* pB1 = S.b_ptr(cur, 1);
        PG8_STAGEB(PG8_SB(0, 0), pB0); PG8_STAGEB(PG8_SB(0, 1), pB0 + hstepB); PG8_STAGEA(PG8_SA(0, 0), 0, cur, 0, 0); PG8_STAGEA(PG8_SA(0, 1), 0, cur, 0, 1);
        if (wr == 1) PG8_BAR;
        PG8_WAIT_V(2); PG8_BAR;
        PG8_STAGEB(PG8_SB(1, 0), pB1); PG8_STAGEA(PG8_SA(1, 0), 0, cur, 1, 0); PG8_STAGEB(PG8_SB(1, 1), pB1 + hstepB);
        PG8_WAIT_V(6); PG8_BAR;
    }
    for (;;) {
        const bool has_next = S.next(ui + 1, nxt);
        if (!has_next) nxt = cur;
        const int uin = has_next ? ui + 1 : ui;
#pragma unroll 1
        for (int t = 0; t < nt; t += 2) {
            const bool last = (t == nt - 2);
            const Unit& u2 = last ? nxt : cur; const int ui2 = last ? uin : ui; const int t2 = last ? 0 : t + 2;
            const char* b2 = S.b_ptr(u2, t2); const char* b3 = S.b_ptr(u2, t2 + 1);
            PG8_LDB(B0, 0, 0); PG8_LDB(B1, 0, 1); PG8_SCHED; PG8_LDA(At, 0, 0); PG8_STAGEA(PG8_SA(1, 1), ui, cur, t + 1, 1);
            PG8_WAIT_V(8); PG8_WAIT_L(0); PG8_BAR; PG8_MMA(0, 0, At, B0); PG8_MMA(0, 1, At, B1); PG8_BAR; PG8_SCHED;
            PG8_LDA(At, 0, 1); PG8_STAGEB(PG8_SB(0, 0), b2); PG8_STAGEB(PG8_SB(0, 1), b2 + hstepB); PG8_STAGEA(PG8_SA(0, 0), ui2, u2, t2, 0);
            PG8_WAIT_V(8); PG8_WAIT_L(0); PG8_BAR; PG8_MMA(1, 0, At, B0); PG8_MMA(1, 1, At, B1); PG8_BAR; PG8_SCHED;
            PG8_LDB(B0, 1, 0); PG8_LDB(B1, 1, 1); PG8_SCHED; PG8_LDA(At, 1, 0); PG8_STAGEA(PG8_SA(0, 1), ui2, u2, t2, 1);
            PG8_WAIT_V(8); PG8_WAIT_L(0); PG8_BAR; PG8_MMA(0, 0, At, B0); PG8_MMA(0, 1, At, B1); PG8_BAR; PG8_SCHED;
            PG8_LDA(At, 1, 1); PG8_STAGEB(PG8_SB(1, 0), b3); PG8_STAGEB(PG8_SB(1, 1), b3 + hstepB); PG8_STAGEA(PG8_SA(1, 0), ui2, u2, t2 + 1, 0);
            PG8_WAIT_V(8); PG8_WAIT_L(0); PG8_BAR; PG8_MMA(1, 0, At, B0); PG8_MMA(1, 1, At, B1); PG8_BAR; PG8_SCHED;
        }
        if (wr == 0) PG8_BAR;
        S.epi(acc, cur, wr, wc, fr, fq, ui);
        PG8_SCHED;
        if (!has_next) break;
#pragma unroll
        for (int a = 0; a < 2; ++a)
#pragma unroll
            for (int b = 0; b < 2; ++b)
#pragma unroll
                for (int m = 0; m < 4; ++m)
#pragma unroll
                    for (int n = 0; n < 2; ++n) acc[a][b][m][n] = (f32x4){0.f, 0.f, 0.f, 0.f};
        cur = nxt; ++ui;
        if (wr == 1) PG8_BAR;
    }
    PG8_WAIT_V(0);
    PG8_BAR;
#undef PG8_SA
#undef PG8_SB
#undef PG8_STAGE1
#undef PG8_STAGEB
#undef PG8_STAGEA
#undef PG8_LDA
#undef PG8_LDB
#undef PG8_MMA
#undef PG8_WAIT_V
#undef PG8_WAIT_L
#undef PG8_BAR
#undef PG8_SCHED
}
}
typedef f32x4 AccT[2][2][4][2];

struct Args { const float* in[30]; float* out; unsigned char* ws; int ph_lo, ph_hi; };

struct Frame {
    LAS unsigned char* lds;
    int tid, lane, wave, G, wg;
    const float* const* in;
    unsigned char* ws; unsigned char* os;
};
#define IN_X 0
#define IN_META 1
#define IN_NMG 2
#define IN_WIN 3
#define IN_LRE 4
#define IN_LIM 5
#define IN_LDT 6
#define IN_BRE 7
#define IN_BIM 8
#define IN_CRE 9
#define IN_CIM 10
#define IN_S5D 11
#define IN_WGLU 12
#define IN_HLB 13
#define IN_HNG 14
#define IN_LQ1 15
#define IN_LK1 16
#define IN_LQ2 17
#define IN_LK2 18
#define IN_SUBLN 19
#define IN_WOUT 20
#define IN_NFG 21
#define IN_WGRP 22
#define IN_BGRP 23
#define IN_WEXP 24
#define IN_BEXP 25
#define IN_WGATE 26
#define IN_WUP 27
#define IN_WDOWN 28
#define IN_FNG 29

template <class ColMap>
__device__ __forceinline__ void conv_item(const float* W, int ldw, const float* kscale, bf16* WT, int ldt, int k0, int n0, LAS float* scr, int lane, ColMap cm) {
    const int sc = cm(n0 + (lane & 31));
#pragma unroll
    for (int i = 0; i < 32; ++i) { const int kk = 2 * i + (lane >> 5); float v = W[(size_t)(k0 + kk) * ldw + sc]; if (kscale) v *= kscale[k0 + kk]; scr[kk * 33 + (lane & 31)] = v; }
    LDS_WAIT(); asm volatile("" ::: "memory");
    const int c = lane & 7;
#pragma unroll
    for (int j = 0; j < 4; ++j) { const int n = (lane >> 3) + 8 * j; const LAS float* s = scr + (8 * c) * 33 + n;
        u32x4 o; o.x = pk2(s[0 * 33], s[1 * 33]); o.y = pk2(s[2 * 33], s[3 * 33]); o.z = pk2(s[4 * 33], s[5 * 33]); o.w = pk2(s[6 * 33], s[7 * 33]);
        *(GAS u32x4*)(WT + (size_t)(n0 + n) * ldt + k0 + 8 * c) = o; }
    LDS_WAIT(); asm volatile("" ::: "memory");
}

constexpr int I_IN = 16 * (NI / 32), I_OUT = 16 * 32, I_GLU = 4 * 16, I_GU = 16 * 16 * 32, I_DN = 16 * 8 * 32;
constexpr int I_L = I_IN + I_OUT + I_GLU + I_GU + I_DN;
struct ConvJob { const float* W; const float* ks; bf16* WT; int ldw, ldt, k0, n0, sc; };
__device__ __forceinline__ ConvJob conv_decode(const Frame& F, const int l, int r, const int lane) {
    ConvJob J; const int ln = lane & 31;
    if (r < I_IN) {
        const int kb = r / (NI / 32), nb = r % (NI / 32); const int n = nb * 32 + ln;
        J.W = F.in[IN_WIN] + (size_t)l * D * NI; J.ldw = NI; J.ks = F.in[IN_NMG] + l * D; J.WT = (bf16*)(F.ws + WS_WIN) + (size_t)l * NI * D; J.ldt = D; J.k0 = kb * 64; J.n0 = nb * 32;
        J.sc = n; if (n >= C_AQ && n < C_AV) { const int p = n & 63, j = p >> 3, e = p & 7; J.sc = (n & ~63) + 4 * j + (e & 3) + 32 * (e >> 2); }
        return J; }
    r -= I_IN;
    if (r < I_OUT) {
        const int kb = r / 32, nb = r % 32;
        J.W = F.in[IN_WOUT] + (size_t)l * D * D; J.ldw = D; J.ks = nullptr; J.WT = (bf16*)(F.ws + WS_WOUT) + (size_t)l * D * D; J.ldt = D; J.k0 = kb * 64; J.n0 = nb * 32; J.sc = nb * 32 + ln;
        return J; }
    r -= I_OUT;
    if (r < I_GLU) {
        const int kb = r / 16, nb = r % 16; const int n = nb * 32 + ln;
        J.W = F.in[IN_WGLU] + (size_t)l * 256 * 512; J.ldw = 512; J.ks = nullptr; J.WT = (bf16*)(F.ws + WS_WGLU) + (size_t)l * 512 * 256; J.ldt = 256; J.k0 = kb * 64; J.n0 = nb * 32;
        { const int pn = n >> 8, bj = (n >> 7) & 1, c = n & 127; J.sc = bj * 256 + pn * 128 + c; }
        return J; }
    r -= I_GLU;
    if (r < I_GU) {
        const int e = r / (16 * 32), q = r % (16 * 32), kb = q / 32, nb = q % 32, n0 = nb * 32, bj = (n0 >> 7) & 1; const int n = n0 + ln;
        J.W = (bj ? F.in[IN_WUP] : F.in[IN_WGATE]) + ((size_t)l * 16 + e) * 1024 * 512; J.ldw = 512; J.ks = F.in[IN_NFG] + l * D; J.WT = (bf16*)(F.ws + WS_WGU) + ((size_t)l * 16 + e) * 1024 * 1024; J.ldt = 1024;
        J.k0 = kb * 64; J.n0 = n0; { const int pn = n >> 8, c = n & 127; J.sc = pn * 128 + c; }
        return J; }
    r -= I_GU;
    {   const int e = r / (8 * 32), q = r % (8 * 32), kb = q / 32, nb = q % 32;
        J.W = F.in[IN_WDOWN] + ((size_t)l * 16 + e) * 512 * 1024; J.ldw = 1024; J.ks = nullptr; J.WT = (bf16*)(F.ws + WS_WDN) + ((size_t)l * 16 + e) * 1024 * 512; J.ldt = 512; J.k0 = kb * 64; J.n0 = nb * 32; J.sc = nb * 32 + ln; }
    return J;
}
struct ConvRegs { float v[32]; };
__device__ __forceinline__ void conv_load(const ConvJob& J, const int lane, ConvRegs& R) {
#pragma unroll
    for (int i = 0; i < 32; ++i) { const int kk = 2 * i + (lane >> 5); R.v[i] = J.W[(size_t)(J.k0 + kk) * J.ldw + J.sc]; }
    if (J.ks) {
#pragma unroll
        for (int i = 0; i < 32; ++i) R.v[i] *= J.ks[J.k0 + 2 * i + (lane >> 5)]; }
}
__device__ __forceinline__ void conv_store(const ConvJob& J, const int lane, const ConvRegs& R, LAS float* scr) {
#pragma unroll
    for (int i = 0; i < 32; ++i) scr[(2 * i + (lane >> 5)) * 33 + (lane & 31)] = R.v[i];
    LDS_WAIT(); asm volatile("" ::: "memory");
    const int c = lane & 7;
#pragma unroll
    for (int j = 0; j < 4; ++j) { const int n = (lane >> 3) + 8 * j; const LAS float* s = scr + (8 * c) * 33 + n;
        u32x4 o; o.x = pk2(s[0 * 33], s[1 * 33]); o.y = pk2(s[2 * 33], s[3 * 33]); o.z = pk2(s[4 * 33], s[5 * 33]); o.w = pk2(s[6 * 33], s[7 * 33]);
        *(GAS u32x4*)(J.WT + (size_t)(J.n0 + n) * J.ldt + J.k0 + 8 * c) = o; }
    LDS_WAIT(); asm volatile("" ::: "memory");
}
__device__ __forceinline__ void conv_range(const Frame& F, const int l, const int it0, const int hi, const int step, LAS float* scr, const int lane) {
    for (int it = it0; it < hi; it += 2 * step) {
        const bool two = it + step < hi;
        const ConvJob J0 = conv_decode(F, l, it, lane), J1 = conv_decode(F, l, two ? it + step : it, lane);
        ConvRegs R0, R1;
        conv_load(J0, lane, R0); conv_load(J1, lane, R1);
        conv_store(J0, lane, R0, scr);
        if (two) conv_store(J1, lane, R1, scr);
    }
}
__device__ __forceinline__ int gemm_wgs(int U, int G) { const int R = (U + G - 1) / G; return (U + R - 1) / R; }
__device__ __forceinline__ void conv_spare(const Frame& F0, const int l, const int it_lo, const int it_hi, const int Gg) {
    Frame F = F0; F.tid = F.wave * 64 + lane_id_(); LAUNDER(F.tid); F.lane = F.tid & 63;
    const int S = F.G - Gg;
    if (S > 0 && F.wg < Gg) return;
    __syncthreads();
    LAS float* scr = (LAS float*)(F.lds + F.wave * 16384);
    const int w0 = ((S > 0) ? F.wg - Gg : F.wg) * 8 + F.wave, nw = ((S > 0) ? S : F.G) * 8;
    conv_range(F, l, it_lo + w0, it_hi, nw, scr, F.lane);
}

__device__ __forceinline__ void p0_prologue(const Frame& F0) {
    Frame F = F0; F.tid = F.wave * 64 + lane_id_(); LAUNDER(F.tid); F.lane = F.tid & 63;
    LAS float* scr = (LAS float*)(F.lds + F.wave * 16384);
    const int gw = F.wg * 8 + F.wave, NGW = F.G * 8, lane = F.lane;
    conv_range(F, 0, gw, I_IN, NGW, scr, lane);
    for (int idx = gw * 64 + lane; idx < 2 * 32 * 1024; idx += NGW * 64) {
        const int l = idx / (32 * 1024), j = (idx / 1024) % 32, k = idx % 1024;
        float w = 0.f;
        if (j < 4) w = F.in[IN_WGRP][((size_t)l * D + k) * 4 + j]; else if (j < 20) w = F.in[IN_WEXP][((size_t)l * D + k) * 16 + (j - 4)];
        w *= F.in[IN_NFG][l * D + k];
        const unsigned hi = f2bf(w); const float lo = w - bf2f(hi);
        bf16* wr = (bf16*)(F.ws + WS_WR) + (size_t)l * 2 * 32 * 1024;
        wr[j * 1024 + k] = (bf16)hi; wr[32 * 1024 + j * 1024 + k] = (bf16)f2bf(lo);
    }
    for (int idx = gw * 64 + lane; idx < LT * 32; idx += NGW * 64) {
        const int pos = idx / 32, i = idx % 32;
        const double inv = pow(10000.0, -(double)(2 * i) / 64.0); const double a = (double)pos * inv;
        ((float*)(F.ws + WS_ROPE))[idx] = (float)cos(a); ((float*)(F.ws + WS_ROPE))[LT * 32 + idx] = (float)sin(a);
    }
    {
        f32x4 v[4][4], vn[4][4];
#define HI_LOAD(dst_, m0_) do { _Pragma("unroll") for (int q = 0; q < 4; ++q) { int m = (m0_) + q * NGW; m = m < T ? m : T - 1; const int b = m / LT, t = m % LT; \
                const float* src = (t < NMETA) ? F.in[IN_META] + (size_t)t * D : F.in[IN_X] + ((size_t)b * SEQ + (t - NMETA)) * D; \
                const GAS f32x4* xr = (const GAS f32x4*)src + lane; \
                _Pragma("unroll") for (int j = 0; j < 4; ++j) dst_[q][j] = __builtin_nontemporal_load(xr + 64 * j); } } while (0)
        HI_LOAD(v, gw);
        for (int m0 = gw; m0 < T; m0 += 4 * NGW) {
            HI_LOAD(vn, m0 + 4 * NGW);
#pragma unroll
            for (int q = 0; q < 4; ++q) { const int m = m0 + q * NGW;
                float s = 0.f; u32x2 o[4];
#pragma unroll
                for (int j = 0; j < 4; ++j) { const f32x4 x = v[q][j]; s += (x.x * x.x + x.y * x.y) + (x.z * x.z + x.w * x.w); o[j].x = pk2(x.x, x.y); o[j].y = pk2(x.z, x.w); }
                s = wave_sum(s);
                if (m < T) { GAS u32x2* hb = (GAS u32x2*)((bf16*)(F.ws + WS_HB) + (size_t)m * D) + lane;
#pragma unroll
                    for (int j = 0; j < 4; ++j) hb[64 * j] = o[j];
                    if (lane < 16) ((float*)(F.ws + WS_SS16))[(size_t)m * 16 + lane] = (lane == 0) ? s : 0.f; } }
#pragma unroll
            for (int q = 0; q < 4; ++q)
#pragma unroll
                for (int j = 0; j < 4; ++j) v[q][j] = vn[q][j];
        }
#undef HI_LOAD
    }
    for (int it = F.wg; it < 256; it += F.G) {
        const int l = it >> 7, g = (it >> 3) & 15, part = it & 7;
        LAS f32x2* Ap = (LAS f32x2*)(F.lds);
        LAS f32x2* Bb = Ap + 17 * 64;
        LAS f32x2* Cc = Bb + 64 * 16;
        LAS float* Kj = (LAS float*)(Cc + 16 * 64);
        __syncthreads();
        LAS f32x2* Fs = (LAS f32x2*)(Kj + 4096);
        if (F.tid < 64) { const int n = F.tid;
            const double dt = exp((double)F.in[IN_LDT][l * 16 + g]);
            const double lr = F.in[IN_LRE][(l * 16 + g) * 64 + n], li = F.in[IN_LIM][(l * 16 + g) * 64 + n];
            const double mg = exp(lr * dt), ar = mg * cos(li * dt), ai = mg * sin(li * dt), den = lr * lr + li * li, zr = ar - 1.0, zi = ai;
            Fs[n] = (f32x2){(float)((zr * lr + zi * li) / den), (float)((zi * lr - zr * li) / den)};
            double pr = 1.0, pi = 0.0;
            for (int j = 0; j <= 16; ++j) { Ap[j * 64 + n] = (f32x2){(float)pr, (float)pi}; const double nr = pr * ar - pi * ai, ni = pr * ai + pi * ar; pr = nr; pi = ni; } }
        for (int idx = F.tid; idx < 16 * 64; idx += 512) { const int c = idx / 64, n = idx % 64;
            Cc[idx] = (f32x2){F.in[IN_CRE][((size_t)(l * 16 + g) * 16 + c) * 64 + n], F.in[IN_CIM][((size_t)(l * 16 + g) * 16 + c) * 64 + n]}; }
        __syncthreads();
        for (int idx = F.tid; idx < 64 * 16; idx += 512) { const int n = idx / 16, c = idx % 16; const f32x2 f = Fs[n];
            const float br = F.in[IN_BRE][((size_t)(l * 16 + g) * 64 + n) * 16 + c], bi = F.in[IN_BIM][((size_t)(l * 16 + g) * 64 + n) * 16 + c];
            Bb[idx] = (f32x2){f.x * br - f.y * bi, f.x * bi + f.y * br}; }
        __syncthreads();
        {
            const int co = (F.tid >> 4) & 15, ci = F.tid & 15, j0 = F.tid >> 8;
            float sK[8];
#pragma unroll
            for (int i = 0; i < 8; ++i) sK[i] = 0.f;
            for (int n = 0; n < 64; ++n) { const f32x2 c = Cc[co * 64 + n], b = Bb[n * 16 + ci];
                const float cbr = c.x * b.x - c.y * b.y, cbi = c.x * b.y + c.y * b.x;
#pragma unroll
                for (int i = 0; i < 8; ++i) { const f32x2 a = Ap[(j0 + 2 * i) * 64 + n]; sK[i] += cbr * a.x - cbi * a.y; } }
#pragma unroll
            for (int i = 0; i < 8; ++i) Kj[((j0 + 2 * i) << 8) + (co << 4) + ci] = sK[i];
        }
        if (part == 0 && F.tid < 64) ((f32x2*)(F.ws + WS_S5A))[(l * 16 + g) * 64 + F.tid] = Ap[16 * 64 + F.tid];
        __syncthreads();
        bf16* TQ = (bf16*)(F.ws + WS_S5TQ) + (size_t)(l * 16 + g) * 256 * 384;
        for (int idx = part * 32 * 384 + F.tid; idx < (part + 1) * 32 * 384; idx += 512) { const int nn = idx / 384, k = idx % 384, t = nn >> 4, co = nn & 15; float v;
            if (k < 256) { const int s = k >> 4, ci = k & 15; v = (s <= t) ? Kj[((t - s) << 8) + (co << 4) + ci] : 0.f; if (s == t && ci == co) v += F.in[IN_S5D][l * 256 + g * 16 + co]; }
            else { const int kk = k - 256, n = kk >> 1; const f32x2 a = Ap[(t + 1) * 64 + n], c = Cc[co * 64 + n];
                const float zr = c.x * a.x - c.y * a.y, zi = c.x * a.y + c.y * a.x; v = (kk & 1) ? -zi : zr; }
            TQ[idx] = (bf16)f2bf(v); }
        bf16* PM = (bf16*)(F.ws + WS_S5P) + (size_t)(l * 16 + g) * 256 * 256;
        for (int idx = part * 32 * 256 + F.tid; idx < (part + 1) * 32 * 256; idx += 512) { const int nn = idx >> 8, k = idx & 255; float v = 0.f;
            if (nn < 128) { const int n = nn >> 1, s = k >> 4, ci = k & 15; const f32x2 a = Ap[(15 - s) * 64 + n], b = Bb[n * 16 + ci];
                v = (nn & 1) ? (a.x * b.y + a.y * b.x) : (a.x * b.x - a.y * b.y); }
            PM[idx] = (bf16)f2bf(v); }
        __syncthreads();
    }
}

template <class V> __device__ __forceinline__ V ldg(const void* sbase, unsigned voff) { return *(const GAS V*)((const char*)sbase + voff); }
template <class V> __device__ __forceinline__ void stg(void* sbase, unsigned voff, V v) { *(GAS V*)((char*)sbase + voff) = v; }
template <class V> __device__ __forceinline__ void stg_nt(void* sbase, unsigned voff, V v) { __builtin_nontemporal_store(v, (GAS V*)((char*)sbase + voff)); }
__device__ __forceinline__ u32x4 bufld16(__amdgpu_buffer_rsrc_t r, unsigned voff, unsigned soff) { return __builtin_bit_cast(u32x4, __builtin_amdgcn_raw_buffer_load_b128(r, (int)voff, (int)soff, 0)); }
#define GLDS2(p0, p1, dst) do { __builtin_amdgcn_global_load_lds((const unsigned*)(p0), (LAS unsigned*)(dst), 16, 0, 0); __builtin_amdgcn_global_load_lds((const unsigned*)(p1), (LAS unsigned*)((dst) + 8192), 16, 0, 0); } while (0)
#define EPI_FENCE() __builtin_amdgcn_sched_barrier(0)
struct UnitT { int pm, pn; };

struct PolIn {
    typedef UnitT Unit; static constexpr int NT = 16, LDB = 1024;
    pg8::TileOrder ord; const bf16* A; const bf16* B; bf16* proj; const float* ss16; const float* rope; bf16* X;
    __device__ __forceinline__ bool next(int i, Unit& u) const { return ord.get(i, u.pm, u.pn); }
    __device__ __forceinline__ void stage_a(LAS unsigned char* dst, int, const Unit& u, int t, int h, const int (&R)[2], const int (&C)[2]) const {
        const char* bp = (const char*)(A + (size_t)(u.pm * 256 + h * 128) * 1024) + t * 128;
        GLDS2(bp + (unsigned)((R[0] * 1024 + C[0]) * 2), bp + (unsigned)((R[1] * 1024 + C[1]) * 2), dst); }
    __device__ __forceinline__ const char* b_ptr(const Unit& u, int t) const { return (const char*)(B + (size_t)u.pn * 256 * 1024) + t * 128; }
    __device__ __forceinline__ void epi(const AccT& acc, const Unit& u, int wr, int wc, int fr, int fq, int) const {
        const bool isrope = (u.pn >= 5 && u.pn <= 8); const float qs = (u.pn == 5 || u.pn == 6) ? QSCALE : 1.f;
        const unsigned fi = 4u * (4u * (wc & 1) + fq);
        const unsigned vo_p = (unsigned)((fr * NI + u.pn * 256 + wc * 32 + 8 * fq) * 2), vo_s = (unsigned)(fr * 64);
        const int row00 = u.pm * 256 + wr * 64;
        f32x4 ssv[8];
#pragma unroll
        for (int g = 0; g < 8; ++g) ssv[g] = ldg<f32x4>(ss16, (unsigned)(row00 + (g >> 2) * 128 + (g & 3) * 16) * 64u + vo_s + 16u * fq);
        f32x4 csA = (f32x4){1.f, 1.f, 1.f, 1.f}, snA = (f32x4){0.f, 0.f, 0.f, 0.f};
#define IN_LOAD(g_, c_, n_) do { if (isrope) { const int ru_ = row00 + ((g_) >> 2) * 128 + ((g_) & 3) * 16; const unsigned pos_ = (unsigned)(ru_ + fr) % (unsigned)LT; \
            c_ = ldg<f32x4>(rope, (pos_ * 32 + fi) * 4); n_ = ldg<f32x4>(rope, (LT * 32 + pos_ * 32 + fi) * 4); } } while (0)
        IN_LOAD(0, csA, snA);
#pragma unroll
        for (int g = 0; g < 8; ++g) {
            const int ai = g >> 2, m = g & 3;
            const f32x4 csB = csA, snB = snA;
            if (g < 7) IN_LOAD(g + 1, csA, snA);
            float ss = (ssv[g].x + ssv[g].y) + (ssv[g].z + ssv[g].w);
            ss += __shfl_xor(ss, 16); ss += __shfl_xor(ss, 32);
            const float rstd = rsqrtf(ss * (1.f / 1024.f) + RMS_EPS);
            bf16* rowp = proj + (size_t)(row00 + ai * 128 + m * 16) * NI;
            bf16* xrow = X + (size_t)((row00 + ai * 128 + m * 16) >> 4) * 384;
#pragma unroll
            for (int bj = 0; bj < 2; ++bj) {
                f32x4 v0 = acc[ai][bj][m][0] * rstd, v1 = acc[ai][bj][m][1] * rstd;
                if (isrope) { const f32x4 o0 = (v0 * csB - v1 * snB) * qs, o1 = (v1 * csB + v0 * snB) * qs; v0 = o0; v1 = o1; }
                u32x4 w; w.x = cvt_pk_bf16(v0[0], v0[1]); w.y = cvt_pk_bf16(v0[2], v0[3]); w.z = cvt_pk_bf16(v1[0], v1[1]); w.w = cvt_pk_bf16(v1[2], v1[3]);
                if (u.pn == 0) stg_nt<u32x4>(xrow, (unsigned)((((2 * wc + 8 * bj + (fq >> 1)) * S5RP) * 384 + fr * 16 + 8 * (fq & 1)) * 2), w);
                else stg_nt<u32x4>(rowp, vo_p + bj * 256, w);
            }
            EPI_FENCE();
        }
#undef IN_LOAD
    }
};

struct UnitS5 { int g, mt; };
struct PolS5E {
    typedef UnitS5 Unit; static constexpr int NT = 4, LDB = 256;
    int G, c; const bf16* X; const bf16* B; float* E;
    __device__ __forceinline__ bool next(int i, Unit& u) const { const int Lx = i * G + c; if (Lx >= 16 * 16) return false; u.g = Lx >> 4; u.mt = Lx & 15; return true; }
    __device__ __forceinline__ void stage_a(LAS unsigned char* dst, int, const Unit& u, int t, int h, const int (&R)[2], const int (&C)[2]) const {
        const char* bp = (const char*)(X + ((size_t)u.g * S5RP + 256 * u.mt + 128 * h + 2 * u.mt + h) * 384) + t * 128;
        GLDS2(bp + (unsigned)((R[0] * 384 + C[0]) * 2), bp + (unsigned)((R[1] * 384 + C[1]) * 2), dst); }
    __device__ __forceinline__ const char* b_ptr(const Unit& u, int t) const { return (const char*)(B + (size_t)u.g * 256 * 256) + t * 128; }
    __device__ __forceinline__ void epi(const AccT& acc, const Unit& u, int wr, int wc, int fr, int fq, int) const {
        const unsigned vo = (unsigned)((fr * 128 + wc * 32 + 8 * fq) * 4);
#pragma unroll
        for (int ai = 0; ai < 2; ++ai)
#pragma unroll
            for (int m = 0; m < 4; ++m) { float* ep = E + ((size_t)u.g * 4096 + u.mt * 256 + ai * 128 + wr * 64 + m * 16) * 128;
                stg<f32x4>(ep, vo, acc[ai][0][m][0]); stg<f32x4>(ep, vo + 16, acc[ai][0][m][1]); }
    }
};

struct PolS5Y {
    typedef UnitS5 Unit; static constexpr int NT = 6, LDB = 384;
    int G, c; const bf16* X; const bf16* B; const bf16* proj; const float* dsk; bf16* Gout; int skipmeta;
    __device__ __forceinline__ int row0(int mt, int half) const { return skipmeta ? (2 * mt + half) * 129 + 1 : 256 * mt + 128 * half; }
    __device__ __forceinline__ bool next(int i, Unit& u) const { const int nt = skipmeta ? 16 : 17; const int Lx = i * G + c; if (Lx >= 16 * nt) return false; u.g = Lx / nt; u.mt = Lx % nt; return true; }
    __device__ __forceinline__ void stage_a(LAS unsigned char* dst, int, const Unit& u, int t, int h, const int (&R)[2], const int (&C)[2]) const {
        const char* bp = (const char*)(X + ((size_t)u.g * S5RP + row0(u.mt, h)) * 384) + t * 128;
        GLDS2(bp + (unsigned)((R[0] * 384 + C[0]) * 2), bp + (unsigned)((R[1] * 384 + C[1]) * 2), dst); }
    __device__ __forceinline__ const char* b_ptr(const Unit& u, int t) const { return (const char*)(B + (size_t)u.g * 256 * 384) + t * 128; }
    __device__ __forceinline__ void epi(const AccT& acc, const Unit& u, int wr, int wc, int fr, int fq, int) const {
        const int ch = u.g * 16 + 8 * (fq & 1);
        const unsigned vo_g = (unsigned)(((16 * fr + (fq >> 1)) * 256 + ch) * 2);
#pragma unroll
        for (int g = 0; g < 8; ++g) { const int ai = g >> 2, m = g & 3, Ru = row0(u.mt, ai) + wr * 64 + m * 16;
            if (Ru + fr < S5R) {
#pragma unroll
                for (int bj = 0; bj < 2; ++bj) { const size_t toku = (size_t)16 * Ru + 8 * bj + 2 * wc;
                    const f32x4 v0 = acc[ai][bj][m][0], v1 = acc[ai][bj][m][1];
                    u32x4 w; w.x = pk2(gelu_tanh(v0[0]), gelu_tanh(v0[1])); w.y = pk2(gelu_tanh(v0[2]), gelu_tanh(v0[3]));
                    w.z = pk2(gelu_tanh(v1[0]), gelu_tanh(v1[1])); w.w = pk2(gelu_tanh(v1[2]), gelu_tanh(v1[3]));
                    stg<u32x4>(Gout + toku * 256, vo_g, w); }
            }
            EPI_FENCE();
        }
    }
};

__device__ __forceinline__ int mtile_row0(int pm, int skipmeta) { return skipmeta ? (pm >> 3) * LT + NMETA + (pm & 7) * 256 : pm * 256; }
struct PolGlu {
    typedef UnitT Unit; static constexpr int NT = 4, LDB = 256;
    pg8::TileOrder ord; const bf16* A; const bf16* B; bf16* mixed; int skipmeta;
    __device__ __forceinline__ bool next(int i, Unit& u) const { return ord.get(i, u.pm, u.pn); }
    __device__ __forceinline__ void stage_a(LAS unsigned char* dst, int, const Unit& u, int t, int h, const int (&R)[2], const int (&C)[2]) const {
        const char* bp = (const char*)(A + (size_t)(mtile_row0(u.pm, skipmeta) + h * 128) * 256) + t * 128;
        GLDS2(bp + (unsigned)((R[0] * 256 + C[0]) * 2), bp + (unsigned)((R[1] * 256 + C[1]) * 2), dst); }
    __device__ __forceinline__ const char* b_ptr(const Unit& u, int t) const { return (const char*)(B + (size_t)u.pn * 256 * 256) + t * 128; }
    __device__ __forceinline__ void epi(const AccT& acc, const Unit& u, int wr, int wc, int fr, int fq, int) const {
        const unsigned vo = (unsigned)((fr * D + u.pn * 128 + wc * 32 + 8 * fq) * 2);
#pragma unroll
        for (int ai = 0; ai < 2; ++ai)
#pragma unroll
            for (int m = 0; m < 4; ++m) { bf16* rp = mixed + (size_t)(mtile_row0(u.pm, skipmeta) + ai * 128 + wr * 64 + m * 16) * D;
                const f32x4 a0 = acc[ai][0][m][0], a1 = acc[ai][0][m][1], b0 = acc[ai][1][m][0], b1 = acc[ai][1][m][1];
                u32x4 w; w.x = pk2(a0[0] * sigmoidf_(b0[0]), a0[1] * sigmoidf_(b0[1])); w.y = pk2(a0[2] * sigmoidf_(b0[2]), a0[3] * sigmoidf_(b0[3]));
                w.z = pk2(a1[0] * sigmoidf_(b1[0]), a1[1] * sigmoidf_(b1[1])); w.w = pk2(a1[2] * sigmoidf_(b1[2]), a1[3] * sigmoidf_(b1[3]));
                stg<u32x4>(rp, vo, w);
                EPI_FENCE(); }
    }
};

template <bool WT>
__device__ __forceinline__ void residual_epi(const AccT& acc, const int (&vrow)[8], int pn, int wc, int fq, const bf16* HB, bf16* HBo, float* ss16, const bool needss) {
    const __amdgpu_buffer_rsrc_t ors = __builtin_amdgcn_make_buffer_rsrc((void*)HBo, 0, 0x7fffffff, 0x00020000);
    const unsigned colb = (unsigned)(pn * 256 + wc * 32 + 8 * fq);
    u32x4 pre[8][2];
#pragma unroll
    for (int g = 0; g < 8; ++g)
#pragma unroll
        for (int bj = 0; bj < 2; ++bj) { pre[g][bj] = (u32x4){0u, 0u, 0u, 0u}; if (vrow[g] >= 0) pre[g][bj] = ldg<u32x4>(HB, ((unsigned)vrow[g] * D + colb) * 2 + bj * 256); }
#pragma unroll
    for (int g = 0; g < 8; ++g) { const int ai = g >> 2, m = g & 3; const bool valid = vrow[g] >= 0; const unsigned vb = ((unsigned)(valid ? vrow[g] : 0) * D + colb) * 2;
        float ssq = 0.f;
#pragma unroll
        for (int bj = 0; bj < 2; ++bj) { const u32x4 hb = pre[g][bj];
            f32x4 h0 = (f32x4){bf2f(hb.x), bf2f(hb.x >> 16), bf2f(hb.y), bf2f(hb.y >> 16)}, h1 = (f32x4){bf2f(hb.z), bf2f(hb.z >> 16), bf2f(hb.w), bf2f(hb.w >> 16)};
            h0 += acc[ai][bj][m][0]; h1 += acc[ai][bj][m][1];
            u32x4 w; w.x = cvt_pk_bf16(h0[0], h0[1]); w.y = cvt_pk_bf16(h0[2], h0[3]); w.z = cvt_pk_bf16(h1[0], h1[1]); w.w = cvt_pk_bf16(h1[2], h1[3]);
            if (valid) { if (WT) __builtin_amdgcn_raw_buffer_store_b128(w, ors, (int)(vb + bj * 256), 0, 16  ); else stg<u32x4>(HBo, vb + bj * 256, w); }
            ssq += (h0[0] * h0[0] + h0[1] * h0[1]) + (h0[2] * h0[2] + h0[3] * h0[3]) + (h1[0] * h1[0] + h1[1] * h1[1]) + (h1[2] * h1[2] + h1[3] * h1[3]);
        }
        if (needss) { ssq += __shfl_xor(ssq, 16); ssq += __shfl_xor(ssq, 32);
            if (valid && fq == 0) stg<float>(ss16, ((unsigned)vrow[g] * 16 + pn * 4 + wc) * 4, ssq); }
    }
}

struct PolOut {
    typedef UnitT Unit; static constexpr int NT = 16, LDB = 1024;
    pg8::TileOrder ord; const bf16* A; const bf16* B; bf16* HB; bf16* HBo; float* ss16; unsigned* pan; int skipmeta;
    __device__ __forceinline__ bool next(int i, Unit& u) const { return ord.get(i, u.pm, u.pn); }
    __device__ __forceinline__ void stage_a(LAS unsigned char* dst, int, const Unit& u, int t, int h, const int (&R)[2], const int (&C)[2]) const {
        const char* bp = (const char*)(A + (size_t)(mtile_row0(u.pm, skipmeta) + h * 128) * 1024) + t * 128;
        GLDS2(bp + (unsigned)((R[0] * 1024 + C[0]) * 2), bp + (unsigned)((R[1] * 1024 + C[1]) * 2), dst); }
    __device__ __forceinline__ const char* b_ptr(const Unit& u, int t) const { return (const char*)(B + (size_t)u.pn * 256 * 1024) + t * 128; }
    __device__ __forceinline__ void epi(const AccT& acc, const Unit& u, int wr, int wc, int fr, int fq, int) const {
        int vrow[8];
#pragma unroll
        for (int g = 0; g < 8; ++g) vrow[g] = mtile_row0(u.pm, skipmeta) + (g >> 2) * 128 + wr * 64 + (g & 3) * 16 + fr;
        residual_epi<false>(acc, vrow, u.pn, wc, fq, HB, HBo, ss16, false);
    }
};

struct MoeList {
    LAS const int* cnt;
    __device__ __forceinline__ int ntiles() const { int s = 0; for (int c = 0; c < NCLS; ++c) s += (cnt[c] + 255) >> 8; return __builtin_amdgcn_readfirstlane(s); }
    __device__ __forceinline__ void decode(int gt, int& c, int& ti, int& nvalid) const {
        int s = 0, cc = 0, tt = 0, nv = 0;
        for (int k = 0; k < NCLS; ++k) { const int n = (cnt[k] + 255) >> 8; if (gt >= s && gt < s + n) { cc = k; tt = gt - s; nv = cnt[k] - 256 * tt; } s += n; }
        c = __builtin_amdgcn_readfirstlane(cc); ti = __builtin_amdgcn_readfirstlane(tt); nvalid = __builtin_amdgcn_readfirstlane(nv > 256 ? 256 : nv);
    }
};
__device__ __forceinline__ void class_experts(int c, int& ea, int& eb) {
    const int g = c / 6, p = c % 6; const int a = (p < 3) ? 0 : (p < 5 ? 1 : 2); const int b = (p < 3) ? p + 1 : (p < 5 ? p - 1 : 3);
    ea = g * 4 + a; eb = g * 4 + b;
}
struct UnitM { int gt, pn, c; };

struct PolGU {
    typedef UnitM Unit; static constexpr int NT = 16, LDB = 1024;
    int G, c, ntl; MoeList ml; LAS const int* tab;
    const bf16* HB; const bf16* W; bf16* he; const float* rstd; const float* gate;
    __device__ __forceinline__ bool next(int i, Unit& u) const { const int Lx = i * G + c; if (Lx >= ntl * 8) return false; u.gt = Lx >> 3; u.pn = Lx & 7; int ti, nv; ml.decode(u.gt, u.c, ti, nv); return true; }
    __device__ __forceinline__ void stage_a(LAS unsigned char* dst, int ui, const Unit&, int t, int h, const int (&R)[2], const int (&C)[2]) const {
        const char* bp = (const char*)HB + t * 128;
        const int t0 = tab[ui * 256 + 128 * h + R[0]], t1 = tab[ui * 256 + 128 * h + R[1]];
        GLDS2(bp + (unsigned)((t0 < 0 ? 0 : t0) * 2048 + C[0] * 2), bp + (unsigned)((t1 < 0 ? 0 : t1) * 2048 + C[1] * 2), dst); }
    __device__ __forceinline__ const char* b_ptr(const Unit& u, int t) const { int ea, eb; class_experts(u.c, ea, eb); const int e = (u.pn >> 2) ? eb : ea;
        return (const char*)(W + ((size_t)e * 1024 + (u.pn & 3) * 256) * 1024) + t * 128; }
    __device__ __forceinline__ void epi(const AccT& acc, const Unit& u, int wr, int wc, int fr, int fq, int ui) const {
        const int sel = u.pn >> 2;
        const unsigned vo = (unsigned)((fr * 1024 + sel * 512 + (u.pn & 3) * 128 + wc * 32 + 8 * fq) * 2);
        float rsv[8], gwv[8];
#pragma unroll
        for (int g = 0; g < 8; ++g) { const int tk = tab[ui * 256 + (g >> 2) * 128 + wr * 64 + (g & 3) * 16 + fr]; rsv[g] = 0.f; gwv[g] = 0.f;
            if (tk >= 0) { rsv[g] = ldg<float>(rstd, (unsigned)tk * 4); gwv[g] = ldg<float>(gate, (unsigned)(2 * tk + sel) * 4); } }
#pragma unroll
        for (int g = 0; g < 8; ++g) { const int ai = g >> 2, m = g & 3, ru = ai * 128 + wr * 64 + m * 16; const float rs = rsv[g], gw = gwv[g];
            const f32x4 g0 = acc[ai][0][m][0] * rs, g1 = acc[ai][0][m][1] * rs, u0 = acc[ai][1][m][0] * (rs * gw), u1 = acc[ai][1][m][1] * (rs * gw);
            u32x4 w; w.x = pk2(siluf_(g0[0]) * u0[0], siluf_(g0[1]) * u0[1]); w.y = pk2(siluf_(g0[2]) * u0[2], siluf_(g0[3]) * u0[3]);
            w.z = pk2(siluf_(g1[0]) * u1[0], siluf_(g1[1]) * u1[1]); w.w = pk2(siluf_(g1[2]) * u1[2], siluf_(g1[3]) * u1[3]);
            stg<u32x4>(he + ((size_t)u.gt * 256 + ru) * 1024, vo, w);
            EPI_FENCE(); }
    }
};

struct PolDN {
    typedef UnitM Unit; static constexpr int NT = 16, LDB = 512;
    int G, c, ntl; MoeList ml; LAS const int* tab;
    const bf16* he; const bf16* W; bf16* HB; bf16* HBo; float* ss16; int needss;
    __device__ __forceinline__ bool next(int i, Unit& u) const { const int Lx = i * G + c; if (Lx >= ntl * 4) return false; u.gt = Lx >> 2; u.pn = Lx & 3; int ti, nv; ml.decode(u.gt, u.c, ti, nv); return true; }
    __device__ __forceinline__ void stage_a(LAS unsigned char* dst, int, const Unit& u, int t, int h, const int (&R)[2], const int (&C)[2]) const {
        const char* bp = (const char*)(he + (size_t)(u.gt * 256 + h * 128) * 1024) + t * 128;
        GLDS2(bp + (unsigned)((R[0] * 1024 + C[0]) * 2), bp + (unsigned)((R[1] * 1024 + C[1]) * 2), dst); }
    __device__ __forceinline__ const char* b_ptr(const Unit& u, int t) const { int ea, eb; class_experts(u.c, ea, eb); const int e = (t >= 8) ? eb : ea;
        return (const char*)(W + ((size_t)e * 1024 + u.pn * 256) * 512) + (t & 7) * 128; }
    __device__ __forceinline__ void epi(const AccT& acc, const Unit& u, int wr, int wc, int fr, int fq, int ui) const {
        int vrow[8];
#pragma unroll
        for (int g = 0; g < 8; ++g) vrow[g] = tab[ui * 256 + (g >> 2) * 128 + wr * 64 + (g & 3) * 16 + fr];
        residual_epi<false>(acc, vrow, u.pn, wc, fq, HB, HBo, ss16, needss != 0);
    }
};

#define MFMA16(a, b, c) __builtin_amdgcn_mfma_f32_16x16x32_bf16(a, b, c, 0, 0, 0)
#define MFMA32(a, b, c) __builtin_amdgcn_mfma_f32_32x32x16_bf16(a, b, c, 0, 0, 0)

__device__ __forceinline__ int wq_fetch(unsigned* ctr, const Frame& F) {
    volatile LAS int* slot = (volatile LAS int*)(F.lds + MISC_OFF) + 20;
    __syncthreads();
    if (F.tid == 0) *slot = (int)__hip_atomic_fetch_add(ctr, 1u, __ATOMIC_RELAXED, __HIP_MEMORY_SCOPE_AGENT);
    __syncthreads();
    return __builtin_amdgcn_readfirstlane(*slot);
}

__device__ __forceinline__ void s5_scan(const Frame& F0, int l) {
    Frame F = F0; F.tid = F.wave * 64 + lane_id_(); LAUNDER(F.tid); F.lane = F.tid & 63;
    const float* E = (const float*)(F.os + OS_E); bf16* X = (bf16*)(F.os + OS_X);
    const int lane = F.lane;
    for (int it = F.wg + F.G * F.wave; it < NB * 16; it += F.G * 8) {
        const int b = it >> 4, g = it & 15;
        const f32x2 A16 = ((const f32x2*)(F.ws + WS_S5A))[(l * 16 + g) * 64 + lane];
        float sr = 0.f, si = 0.f;
        for (int r0 = 0; r0 < NCH; r0 += 43) {
            f32x2 e[43];
#pragma unroll
            for (int j = 0; j < 43; ++j) { e[j] = (f32x2){0.f, 0.f}; if (r0 + j < NCH - 1) e[j] = *(const GAS f32x2*)(E + ((size_t)g * 4096 + b * 128 + r0 + j) * 128 + 2 * lane); }
#pragma unroll
            for (int j = 0; j < 43; ++j) if (r0 + j < NCH) { const size_t R = (size_t)b * NCH + r0 + j;
                bf16* xr = X + ((size_t)g * S5RP + R) * 384;
                *(GAS unsigned*)(xr + 256 + 2 * lane) = pk2(sr, si);
                const float nr = A16.x * sr - A16.y * si + e[j].x, ni = A16.x * si + A16.y * sr + e[j].y; sr = nr; si = ni; }
        }
    }
}

__device__ __forceinline__ float hgrn_lb(const float* hlb, int l, int j) {
    if (l == 0) return 0.f;
    const float x0 = hlb[j], x1 = hlb[256 + j], mx = fmaxf(x0, x1), e0 = __expf(x0 - mx), e1 = __expf(x1 - mx);
    return e1 / (e0 + e1);
}
__device__ __forceinline__ void hgrn_gate(float z, float lbA, float onem, float& lf, float& k) {
    const float e = __expf(-fabsf(z)), r = __builtin_amdgcn_rcpf(1.f + e), er = e * r;
    const float s = (z >= 0.f) ? r : er, c = (z >= 0.f) ? er : r;
    lf = __logf(lbA + onem * s); k = onem * c;
}
constexpr int HG_LP = 68, HG_LF = 0, HG_SEG = 64 * HG_LP * 4, HG_T0 = HG_SEG + 1024, HG_TS = 9216, HG_HALF = HG_T0 + 5 * HG_TS;
static_assert(2 * HG_HALF <= MISC_OFF, "HGRN LDS map");

__device__ __forceinline__ void hgrn_a(const Frame& F0, int l) {
    Frame F = F0; F.tid = F.wave * 64 + lane_id_(); LAUNDER(F.tid); F.lane = F.tid & 63;
    const bf16* proj = (const bf16*)(F.ws + WS_PROJ); float* UT = (float*)(F.os + OS_UT); float* DEC = (float*)(F.os + OS_DEC);
    const int half = F.tid >> 8, ht = F.tid & 255, hw = F.wave & 3, lane = F.lane;
    LAS unsigned char* base = F.lds + half * HG_HALF;
    LAS float* LF = (LAS float*)(base + HG_LF); LAS float* SEG = (LAS float*)(base + HG_SEG);
    LAS bf16* vT = (LAS bf16*)(base + HG_T0); LAS bf16* KDT = (LAS bf16*)(base + HG_T0 + HG_TS);
    unsigned* qh = (unsigned*)F.ws + CW_Q + (l * 4 + 1) * 64;
    constexpr int NP = NB * 4 * HCH / 2, NSTAT = 7;
    int kq = 0;
#pragma unroll 1
    for (int p = F.wg; p < NP; p = (++kq < NSTAT) ? F.wg + kq * F.G : NSTAT * F.G + wq_fetch(qh, F)) {
        const int item = 2 * p + half, c = item % HCH, bh = item / HCH, b = bh >> 2, h = bh & 3;
        const size_t tok0 = (size_t)b * LT + (c == 0 ? 0 : 16 + 64 * (c - 1)); const int nrows = (c == 0) ? 16 : 64;
        float lbA[8], onem[8];
#pragma unroll
        for (int jj = 0; jj < 8; ++jj) { const float lb = hgrn_lb(F.in[IN_HLB], l, h * 64 + 8 * (ht & 7) + jj); lbA[jj] = fmaxf(lb, 1e-30f); onem[jj] = 1.f - lb; }
#pragma unroll
        for (int e = 0; e < 2; ++e) { const int idx = ht + 256 * e, t = idx >> 3, c8 = idx & 7; const bool valid = t < nrows;
            u32x4 zf = (u32x4){0u, 0u, 0u, 0u}, zi = zf;
            if (valid) { zf = *(const GAS u32x4*)(proj + (tok0 + t) * NI + C_HF + h * 64 + 8 * c8); zi = *(const GAS u32x4*)(proj + (tok0 + t) * NI + C_HI + h * 64 + 8 * c8); }
#pragma unroll
            for (int jj = 0; jj < 8; ++jj) { const int d = 8 * c8 + jj; const unsigned wf = (jj & 1) ? (zf[jj >> 1] >> 16) : (zf[jj >> 1] & 0xffffu); const unsigned wi = (jj & 1) ? (zi[jj >> 1] >> 16) : (zi[jj >> 1] & 0xffffu);
                float lf, kk; hgrn_gate(bf2f(wf), lbA[jj], onem[jj], lf, kk); LF[t * HG_LP + d] = valid ? lf : 0.f;
                vT[d * 72 + t] = (bf16)wi; }
        }
        __syncthreads();
        const int d = ht & 63, seg = ht >> 6;
        { float run = 0.f;
#pragma unroll
          for (int i = 0; i < 16; ++i) { run += LF[(16 * seg + i) * HG_LP + d]; LF[(16 * seg + i) * HG_LP + d] = run; }
          SEG[seg * 64 + d] = run; }
        __syncthreads();
        { float offs = 0.f, last = 0.f;
#pragma unroll
          for (int s = 0; s < 4; ++s) { const float v = SEG[s * 64 + d]; if (s < seg) offs += v; last += v; }
          float prev = 0.f;
#pragma unroll
          for (int i = 0; i < 16; ++i) { const int t = 16 * seg + i; const float cl = LF[t * HG_LP + d], lf = cl - prev; prev = cl;
              const float k = 1.f - __expf(lf); KDT[d * 72 + t] = (bf16)f2bf(k * __expf(last - (cl + offs))); }
          if (seg == 0) DEC[(size_t)item * 64 + d] = __expf(last); }
        __syncthreads();
        f32x4 acc[4];
#pragma unroll
        for (int nt = 0; nt < 4; ++nt) acc[nt] = (f32x4){0.f, 0.f, 0.f, 0.f};
#pragma unroll
        for (int ks = 0; ks < 2; ++ks) { const bf16x8 a = *(const LAS bf16x8*)(vT + (16 * hw + (lane & 15)) * 72 + 32 * ks + 8 * (lane >> 4));
#pragma unroll
            for (int nt = 0; nt < 4; ++nt) { const bf16x8 bb = *(const LAS bf16x8*)(KDT + (16 * nt + (lane & 15)) * 72 + 32 * ks + 8 * (lane >> 4)); acc[nt] = MFMA16(bb, a, acc[nt]); } }
#pragma unroll
        for (int nt = 0; nt < 4; ++nt) *(GAS f32x4*)(UT + (size_t)item * 4096 + (16 * hw + (lane & 15)) * 64 + 16 * nt + 4 * (lane >> 4)) = acc[nt];
        __syncthreads();
    }
}

__device__ __forceinline__ void hgrn_b(const Frame& F0) {
    Frame F = F0; F.tid = F.wave * 64 + lane_id_(); LAUNDER(F.tid); F.lane = F.tid & 63;
    const float* UT = (const float*)(F.os + OS_UT); const float* DEC = (const float*)(F.os + OS_DEC); bf16* SP = (bf16*)(F.os + OS_SP);
    constexpr int NBLK = NB * 4 * 4;
    for (int blk0 = F.wg; blk0 < NBLK; blk0 += 2 * F.G) {
        f32x2 S[2] = {(f32x2){0.f, 0.f}, (f32x2){0.f, 0.f}};
        for (int c0 = 0; c0 < HCH; c0 += 11) {
            f32x2 ut[2][11], dc[2][11];
#pragma unroll
            for (int q = 0; q < 2; ++q) { const int blk = blk0 + q * F.G; const int bh = blk >> 2, e = (blk & 3) * 1024 + 2 * F.tid, d = e & 63;
#pragma unroll
                for (int j = 0; j < 11; ++j) { ut[q][j] = (f32x2){0.f, 0.f}; dc[q][j] = (f32x2){0.f, 0.f};
                    if (blk < NBLK) { const size_t item = (size_t)bh * HCH + c0 + j; ut[q][j] = *(const GAS f32x2*)(UT + item * 4096 + e); dc[q][j] = *(const GAS f32x2*)(DEC + item * 64 + d); } } }
#pragma unroll
            for (int q = 0; q < 2; ++q) { const int blk = blk0 + q * F.G; const int bh = blk >> 2, e = (blk & 3) * 1024 + 2 * F.tid;
                if (blk < NBLK) {
#pragma unroll
                    for (int j = 0; j < 11; ++j) { const size_t item = (size_t)bh * HCH + c0 + j; *(GAS unsigned*)(SP + item * 4096 + e) = pk2(S[q].x, S[q].y); S[q] = dc[q][j] * S[q] + ut[q][j]; } } }
        }
    }
}

__device__ __forceinline__ void hgrn_c(const Frame& F0, int l) {
    Frame F = F0; F.tid = F.wave * 64 + lane_id_(); LAUNDER(F.tid); F.lane = F.tid & 63;
    const bf16* proj = (const bf16*)(F.ws + WS_PROJ); const bf16* SPg = (const bf16*)(F.os + OS_SP); bf16* mixed = (bf16*)(F.ws + WS_MIXED);
    const int half = F.tid >> 8, ht = F.tid & 255, hw = F.wave & 3, lane = F.lane;
    LAS unsigned char* base = F.lds + half * HG_HALF;
    LAS float* LF = (LAS float*)(base + HG_LF); LAS float* SEG = (LAS float*)(base + HG_SEG);
    LAS bf16* vT = (LAS bf16*)(base + HG_T0); LAS bf16* QT = vT + HG_TS / 2; LAS bf16* KT = QT + HG_TS / 2; LAS bf16* QS = KT + HG_TS / 2; LAS bf16* SPt = QS + HG_TS / 2;
    LAS bf16* P = QT;
    LAS bf16* OT = QS;
    float ngv[4];
#pragma unroll
    for (int nt = 0; nt < 4; ++nt) ngv[nt] = F.in[IN_HNG][l * 64 + 16 * nt + (lane & 15)];
    unsigned* qh = (unsigned*)F.ws + CW_Q + (l * 4 + 2) * 64;
    constexpr int NP = NB * 4 * HCH / 2, NSTAT = 7;
    int kk = 0;
#pragma unroll 1
    for (int p = F.wg; p < NP; p = (++kk < NSTAT) ? F.wg + kk * F.G : NSTAT * F.G + wq_fetch(qh, F)) {
        const int item = 2 * p + half, c = item % HCH, bh = item / HCH, b = bh >> 2, h = bh & 3;
        const size_t tok0 = (size_t)b * LT + (c == 0 ? 0 : 16 + 64 * (c - 1)); const int nrows = (c == 0) ? 16 : 64;
        float qv[16], kv[16], lbA[8], onem[8]; u32x4 zgv[2];
#pragma unroll
        for (int jj = 0; jj < 8; ++jj) { const float lb = hgrn_lb(F.in[IN_HLB], l, h * 64 + 8 * (ht & 7) + jj); lbA[jj] = fmaxf(lb, 1e-30f); onem[jj] = 1.f - lb; }
#pragma unroll
        for (int e = 0; e < 2; ++e) { const int idx = ht + 256 * e, t = idx >> 3, c8 = idx & 7; const bool valid = t < nrows;
            u32x4 zq = (u32x4){0u, 0u, 0u, 0u}, zf = zq, zi = zq; zgv[e] = zq;
            if (valid) { const bf16* rp = proj + (tok0 + t) * NI + h * 64 + 8 * c8; zq = *(const GAS u32x4*)(rp + C_HQ); zf = *(const GAS u32x4*)(rp + C_HF); zi = *(const GAS u32x4*)(rp + C_HI); zgv[e] = *(const GAS u32x4*)(rp + C_HG); }
            const u32x4 sp = *(const GAS u32x4*)(SPg + (size_t)item * 4096 + t * 64 + 8 * c8);
            *(LAS u32x4*)(SPt + t * 72 + 8 * c8) = sp;
            float lfr[8];
#pragma unroll
            for (int jj = 0; jj < 8; ++jj) { const int d = 8 * c8 + jj; const unsigned wq = (jj & 1) ? (zq[jj >> 1] >> 16) : (zq[jj >> 1] & 0xffffu);
                const unsigned wf = (jj & 1) ? (zf[jj >> 1] >> 16) : (zf[jj >> 1] & 0xffffu); const unsigned wi = (jj & 1) ? (zi[jj >> 1] >> 16) : (zi[jj >> 1] & 0xffffu);
                float lf, kx; hgrn_gate(bf2f(wf), lbA[jj], onem[jj], lf, kx);
                lfr[jj] = valid ? lf : 0.f; kv[8 * e + jj] = valid ? kx : 0.f; qv[8 * e + jj] = valid ? siluf_(bf2f(wq)) : 0.f;
                vT[d * 72 + t] = (bf16)wi; }
            *(LAS f32x4*)(LF + t * HG_LP + 8 * c8) = (f32x4){lfr[0], lfr[1], lfr[2], lfr[3]}; *(LAS f32x4*)(LF + t * HG_LP + 8 * c8 + 4) = (f32x4){lfr[4], lfr[5], lfr[6], lfr[7]};
        }
        __syncthreads();
        { const int d = ht & 63, seg = ht >> 6; float run = 0.f;
#pragma unroll
          for (int i = 0; i < 16; ++i) { run += LF[(16 * seg + i) * HG_LP + d]; LF[(16 * seg + i) * HG_LP + d] = run; }
          SEG[seg * 64 + d] = run; }
        __syncthreads();
#pragma unroll
        for (int e = 0; e < 2; ++e) { const int idx = ht + 256 * e, t = idx >> 3, c8 = idx & 7, seg = t >> 4;
            float cum[8], mid[8];
            { const f32x4 a0 = *(const LAS f32x4*)(LF + t * HG_LP + 8 * c8), a1 = *(const LAS f32x4*)(LF + t * HG_LP + 8 * c8 + 4);
              const f32x4 m0 = *(const LAS f32x4*)(LF + 31 * HG_LP + 8 * c8), m1 = *(const LAS f32x4*)(LF + 31 * HG_LP + 8 * c8 + 4);
              const f32x4 s0 = *(const LAS f32x4*)(SEG + 8 * c8), s1 = *(const LAS f32x4*)(SEG + 8 * c8 + 4);
#pragma unroll
              for (int q = 0; q < 4; ++q) { cum[q] = a0[q]; cum[4 + q] = a1[q]; mid[q] = m0[q] + s0[q]; mid[4 + q] = m1[q] + s1[q]; }
#pragma unroll
              for (int s = 0; s < 3; ++s) if (s < seg) { const f32x4 o0 = *(const LAS f32x4*)(SEG + s * 64 + 8 * c8), o1 = *(const LAS f32x4*)(SEG + s * 64 + 8 * c8 + 4);
#pragma unroll
                  for (int q = 0; q < 4; ++q) { cum[q] += o0[q]; cum[4 + q] += o1[q]; } } }
            unsigned wq[4], wk[4], ws[4];
#pragma unroll
            for (int jp = 0; jp < 4; ++jp) { float qt[2], kt[2], qs[2];
#pragma unroll
                for (int u = 0; u < 2; ++u) { const int jj = 2 * jp + u; const float q = qv[8 * e + jj], k = kv[8 * e + jj];
                    qt[u] = q * __expf(cum[jj] - mid[jj]); kt[u] = k * __expf(mid[jj] - cum[jj]); qs[u] = q * __expf(cum[jj]); }
                wq[jp] = pk2(qt[0], qt[1]); wk[jp] = pk2(kt[0], kt[1]); ws[jp] = pk2(qs[0], qs[1]); }
            *(LAS u32x4*)(QT + t * 72 + 8 * c8) = (u32x4){wq[0], wq[1], wq[2], wq[3]};
            *(LAS u32x4*)(KT + t * 72 + 8 * c8) = (u32x4){wk[0], wk[1], wk[2], wk[3]};
            *(LAS u32x4*)(QS + t * 72 + 8 * c8) = (u32x4){ws[0], ws[1], ws[2], ws[3]};
        }
        __syncthreads();
        const int ar = (16 * hw + (lane & 15)) * 72 + 8 * (lane >> 4);
        {
            f32x4 sc[4];
#pragma unroll
            for (int nt = 0; nt < 4; ++nt) sc[nt] = (f32x4){0.f, 0.f, 0.f, 0.f};
#pragma unroll
            for (int ks = 0; ks < 2; ++ks) { const bf16x8 a = *(const LAS bf16x8*)(QT + ar + 32 * ks);
#pragma unroll
                for (int nt = 0; nt < 4; ++nt) { const bf16x8 bb = *(const LAS bf16x8*)(KT + (16 * nt + (lane & 15)) * 72 + 32 * ks + 8 * (lane >> 4)); sc[nt] = MFMA16(a, bb, sc[nt]); } }
#pragma unroll
            for (int nt = 0; nt < 4; ++nt)
#pragma unroll
                for (int j = 0; j < 4; ++j) { const int t = 16 * hw + 4 * (lane >> 4) + j, s = 16 * nt + (lane & 15); P[t * 72 + s] = (bf16)f2bf(s <= t ? sc[nt][j] : 0.f); }
        }
        __syncthreads();
        f32x4 o[4];
#pragma unroll
        for (int nt = 0; nt < 4; ++nt) o[nt] = (f32x4){0.f, 0.f, 0.f, 0.f};
#pragma unroll
        for (int ks = 0; ks < 2; ++ks) { const bf16x8 a = *(const LAS bf16x8*)(P + ar + 32 * ks), a2 = *(const LAS bf16x8*)(QS + ar + 32 * ks);
#pragma unroll
            for (int nt = 0; nt < 4; ++nt) { const int br = (16 * nt + (lane & 15)) * 72 + 32 * ks + 8 * (lane >> 4);
                o[nt] = MFMA16(a, *(const LAS bf16x8*)(vT + br), o[nt]); o[nt] = MFMA16(a2, *(const LAS bf16x8*)(SPt + br), o[nt]); } }
#pragma unroll
        for (int j = 0; j < 4; ++j) { const int t = 16 * hw + 4 * (lane >> 4) + j;
            float ssq = o[0][j] * o[0][j] + o[1][j] * o[1][j] + o[2][j] * o[2][j] + o[3][j] * o[3][j];
            ssq += __shfl_xor(ssq, 1); ssq += __shfl_xor(ssq, 2); ssq += __shfl_xor(ssq, 4); ssq += __shfl_xor(ssq, 8);
            const float rn = rsqrtf(ssq * (1.f / 64.f) + RMS_EPS);
#pragma unroll
            for (int nt = 0; nt < 4; ++nt) OT[t * 72 + 16 * nt + (lane & 15)] = (bf16)f2bf(o[nt][j] * rn * ngv[nt]); }
        __syncthreads();
#pragma unroll
        for (int e = 0; e < 2; ++e) { const int idx = ht + 256 * e, t = idx >> 3, c8 = idx & 7;
            if (t < nrows) { const u32x4 ov = *(const LAS u32x4*)(OT + t * 72 + 8 * c8); const u32x4 zg = zgv[e]; u32x4 w;
#pragma unroll
                for (int q = 0; q < 4; ++q) { const float g0 = bf2f(zg[q]), g1 = bf2f(zg[q] >> 16); w[q] = pk2(bf2f(ov[q]) * siluf_(g0), bf2f(ov[q] >> 16) * siluf_(g1)); }
                *(GAS u32x4*)(mixed + (tok0 + t) * D + 256 + h * 64 + 8 * c8) = w; } }
        __syncthreads();
    }
}

constexpr int AT_KP = 144;
constexpr int AT_KB = 64 * AT_KP, AT_VB = 16384, AT_K = 0, AT_V = 3 * AT_KB, AT_SG = AT_V + 3 * AT_VB, AT_O0 = AT_SG + 512;
static_assert(AT_O0 + 8 * 8192 <= MISC_OFF, "attention LDS map");
typedef short v4i16_t __attribute__((ext_vector_type(4)));
__device__ __forceinline__ s16x4 vtr(const LAS unsigned char* p) { return __builtin_bit_cast(s16x4, __builtin_amdgcn_ds_read_tr16_b64_v4i16((LAS v4i16_t*)p)); }
__device__ __forceinline__ float u2f_(unsigned u) { return __builtin_bit_cast(float, u); }
__device__ __forceinline__ float xhalf_max(float v) { const unsigned a = __builtin_bit_cast(unsigned, v); auto rr = __builtin_amdgcn_permlane32_swap(a, a, false, false); const unsigned r0 = rr[0], r1 = rr[1]; return fmaxf(u2f_(r0), u2f_(r1)); }
__device__ __forceinline__ float xhalf_sum(float v) { const unsigned a = __builtin_bit_cast(unsigned, v); auto rr = __builtin_amdgcn_permlane32_swap(a, a, false, false); const unsigned r0 = rr[0], r1 = rr[1]; return u2f_(r0) + u2f_(r1); }
__device__ __forceinline__ int crow(int r, int hi) { return (r & 3) + 8 * (r >> 2) + 4 * hi; }
#ifndef AT_PROBE
#define AT_PROBE 0
#endif
#define AT_SBAR() __builtin_amdgcn_sched_barrier(0)
#define AT_PIN(x) asm volatile("" : "+v"(x))
__device__ __forceinline__ int attn_unit(const Frame& F, int b, int h, int j, unsigned* qh, const bool probe) {
    const bool p_nost = (AT_PROBE != 0) && probe;
    const bf16* proj = (const bf16*)(F.ws + WS_PROJ); bf16* mixed = (bf16*)(F.ws + WS_MIXED);
    int tid_ = F.wave * 64 + lane_id_(); LAUNDER(tid_);
    const int tid = tid_, lane = tid & 63, w = F.wave, r32 = lane & 31, hi = lane >> 5;
    const int qbase = (j == 0) ? 0 : 16 + 256 * (j - 1), ntile = (j == 0) ? 1 : 4 * j + 1;
    const int qrow = qbase + 32 * w + r32;
    const int qlast = qbase + 32 * w + 31;
    const bf16* pb = proj + (size_t)b * LT * NI + h * 128;
    bf16* ob = mixed + ((size_t)b * LT + qbase + 32 * w) * D + 512 + h * 128;
    const __amdgpu_buffer_rsrc_t prs = __builtin_amdgcn_make_buffer_rsrc((void*)pb, 0, 0x7fffffff, 0x00020000);
    LAS unsigned char* Kc = F.lds + AT_K; LAS unsigned char* Vc = F.lds + AT_V;
    const unsigned vo_k = (unsigned)(((tid >> 3) * NI + C_AK + 8 * (tid & 7)) * 2);
    const unsigned vo_v0 = (unsigned)(((tid >> 4) * NI + C_AV + 8 * (tid & 15)) * 2), vo_v1 = vo_v0 + (unsigned)(32 * NI * 2);
    const unsigned vo_q = (unsigned)((qrow * NI + C_AQ + 8 * hi) * 2);
    const int kst = (tid >> 3) * AT_KP + (tid & 7) * 16;
    const int vst = ((tid & 15) >> 2) * 4096 + (tid >> 4) * 64 + (tid & 3) * 16;
    const int krd = r32 * AT_KP + 16 * hi;
    const int vrd = (4 * hi + ((lane & 15) >> 2)) * 64 + ((lane >> 4) & 1) * 32 + (lane & 3) * 8;
    LAS unsigned char* o0p = F.lds + AT_O0 + (tid >> 6) * 8192 + (tid & 63) * 16;
    int nextq = 0;
#define AT_KBASE(i_) (((i_) == 0) ? 0 : 16 + 64 * ((i_) - 1))
#define AT_LDK(i_) kreg = bufld16(prs, vo_k + cofs, (unsigned)(AT_KBASE(i_) * NI * 2))
#define AT_LDV(i_) do { const unsigned so_ = (unsigned)(AT_KBASE(i_) * NI * 2); vreg0 = bufld16(prs, vo_v0, so_); vreg1 = bufld16(prs, vo_v1, so_); } while (0)
#define AT_STK(s_) *(LAS u32x4*)(Kc + (s_) * AT_KB + kst) = kreg
#define AT_STV(s_) do { *(LAS u32x4*)(Vc + (s_) * AT_VB + vst) = vreg0; *(LAS u32x4*)(Vc + (s_) * AT_VB + vst + 32 * 64) = vreg1; } while (0)
#define AT_TURN(k_) do { if ((k_) + 1 < ntile) AT_STV(s1); if ((k_) + 2 < ntile) AT_STK(s2); __syncthreads(); \
        if ((k_) + 2 < ntile) AT_LDV((k_) + 2); if ((k_) + 3 < ntile) AT_LDK((k_) + 3); } while (0)
#define AT_KPAIR(q_, a_, b_) do { a_ = *(const LAS bf16x8*)(Kb + 32 * (q_)); b_ = *(const LAS bf16x8*)(Kb + 32 * AT_KP + 32 * (q_)); } while (0)
#define AT_VPAIR(p_, a_, b_) do { const LAS unsigned char* vp_ = Vb + (2 * ((p_) & 1)) * 4096 + (16 * ((p_) >> 1)) * 64; \
        const s16x4 l0_ = vtr(vp_), h0_ = vtr(vp_ + 8 * 64), l1_ = vtr(vp_ + 4096), h1_ = vtr(vp_ + 4096 + 8 * 64); \
        a_ = (bf16x8){l0_[0], l0_[1], l0_[2], l0_[3], h0_[0], h0_[1], h0_[2], h0_[3]}; b_ = (bf16x8){l1_[0], l1_[1], l1_[2], l1_[3], h1_[0], h1_[1], h1_[2], h1_[3]}; } while (0)
#define AT_SUMPK(g_) do { float x0_ = pP[(g_) >> 2][4 * ((g_) & 3)], x1_ = pP[(g_) >> 2][4 * ((g_) & 3) + 1], x2_ = pP[(g_) >> 2][4 * ((g_) & 3) + 2], x3_ = pP[(g_) >> 2][4 * ((g_) & 3) + 3]; \
        ps0 += x0_; ps1 += x1_; ps2 += x2_; ps3 += x3_; pfw[2 * (g_)] = cvt_pk_bf16(x0_, x1_); pfw[2 * (g_) + 1] = cvt_pk_bf16(x2_, x3_); \
        AT_PIN(ps0); AT_PIN(ps1); AT_PIN(ps2); AT_PIN(ps3); AT_PIN(pfw[2 * (g_)]); AT_PIN(pfw[2 * (g_) + 1]); } while (0)
#define AT_EXP2(n_) do { float e0_ = __builtin_amdgcn_exp2f(sT[(n_) >> 3][2 * ((n_) & 7)] - mrun), e1_ = __builtin_amdgcn_exp2f(sT[(n_) >> 3][2 * ((n_) & 7) + 1] - mrun); \
        AT_PIN(e0_); AT_PIN(e1_); pP[(n_) >> 3][2 * ((n_) & 7)] = e0_; pP[(n_) >> 3][2 * ((n_) & 7) + 1] = e1_; } while (0)
#define AT_PF(i_) __builtin_bit_cast(bf16x8, (u32x4){pfw[4 * (i_)], pfw[4 * (i_) + 1], pfw[4 * (i_) + 2], pfw[4 * (i_) + 3]})
#define AT_VMMA0(p_, a_) O[2 * ((p_) & 1)] = MFMA32(a_, AT_PF((p_) >> 1), O[2 * ((p_) & 1)])
#define AT_VMMA1(p_, b_) O[2 * ((p_) & 1) + 1] = MFMA32(b_, AT_PF((p_) >> 1), O[2 * ((p_) & 1) + 1])
#define AT_ROWMAX(kk_, kb_) do { if ((kk_) == 0 || (kk_) >= ntile - 4) { \
            _Pragma("unroll") for (int kblk = 0; kblk < 2; ++kblk) _Pragma("unroll") for (int r = 0; r < 16; ++r) { \
                const int kl = 32 * kblk + crow(r, hi); const bool ok = ((kb_) + kl <= qrow) && ((kk_) > 0 || kl < 16); if (!ok) sT[kblk][r] = -INFINITY; } } \
        mx = sT[0][0]; \
        _Pragma("unroll") for (int r = 1; r < 16; ++r) mx = fmaxf(mx, sT[0][r]); \
        _Pragma("unroll") for (int r = 0; r < 16; ++r) mx = fmaxf(mx, sT[1][r]); \
        mx = xhalf_max(mx); } while (0)
#pragma unroll 1
    for (int comp = 0; comp < 2; ++comp) {
        const unsigned cofs = (unsigned)(comp * 128);
        bf16x8 qf[4];
#pragma unroll
        for (int ks = 0; ks < 4; ++ks) qf[ks] = __builtin_bit_cast(bf16x8, bufld16(prs, vo_q + cofs + 32 * ks, 0u));
        f32x16 O[4];
#pragma unroll
        for (int vb = 0; vb < 4; ++vb)
#pragma unroll
            for (int r = 0; r < 16; ++r) O[vb][r] = 0.f;
        float mrun, lrun = 0.f, mx;
        u32x4 kreg, vreg0, vreg1, kreg1;
        AT_LDK(0); AT_LDV(0);
        kreg1 = bufld16(prs, vo_k + cofs, (unsigned)(AT_KBASE(1) * NI * 2));
        int nq_ = 0;
        if (comp == 0 && tid == 0) nq_ = (int)__hip_atomic_fetch_add(qh, 1u, __ATOMIC_RELAXED, __HIP_MEMORY_SCOPE_AGENT);
        __syncthreads();
        AT_STK(0); AT_STV(0);
        *(LAS u32x4*)(Kc + AT_KB + kst) = kreg1;
        if (comp == 0 && tid == 0) ((volatile LAS int*)(F.lds + MISC_OFF))[20] = nq_;
        __syncthreads();
        if (comp == 0) nextq = __builtin_amdgcn_readfirstlane(((volatile LAS int*)(F.lds + MISC_OFF))[20]);
        f32x16 sT[2], pP[2];
        {   const LAS unsigned char* Kb = Kc + krd;
#pragma unroll
            for (int kblk = 0; kblk < 2; ++kblk) {
#pragma unroll
                for (int r = 0; r < 16; ++r) sT[kblk][r] = 0.f;
#pragma unroll
                for (int ks = 0; ks < 4; ++ks) { const bf16x8 kf = *(const LAS bf16x8*)(Kb + (32 * kblk) * AT_KP + 32 * ks); sT[kblk] = MFMA32(kf, qf[ks], sT[kblk]); }
                AT_SBAR();
            }
        }
        if (ntile > 1) AT_LDV(1);
        if (ntile > 2) AT_LDK(2);
        AT_ROWMAX(0, 0);
        mrun = mx;
#pragma unroll
        for (int kblk = 0; kblk < 2; ++kblk)
#pragma unroll
            for (int r = 0; r < 16; ++r) pP[kblk][r] = __builtin_amdgcn_exp2f(sT[kblk][r] - mrun);
        int s0 = 0;
#pragma unroll 1
        for (int k = 0; k < ntile; ++k) {
            const int s1 = (s0 == 2) ? 0 : s0 + 1, s2 = (s1 == 2) ? 0 : s1 + 1;
            const bool act = AT_KBASE(k) <= qlast;
            const bool nxt = (k + 1 < ntile) && (AT_KBASE(k + 1) <= qlast);
            AT_TURN(k);
            if (act) {
                float ps0 = 0.f, ps1 = 0.f, ps2 = 0.f, ps3 = 0.f;
                unsigned pfw[16];
                const LAS unsigned char* Vb = Vc + s0 * AT_VB + vrd;
                bf16x8 va0, vb0, va1, vb1;
                if (nxt) {
                    const LAS unsigned char* Kb = Kc + s1 * AT_KB + krd;
                    const f32x16 z16 = {0.f, 0.f, 0.f, 0.f, 0.f, 0.f, 0.f, 0.f, 0.f, 0.f, 0.f, 0.f, 0.f, 0.f, 0.f, 0.f};
                    bf16x8 ka0, kb0, ka1, kb1;
                    __builtin_amdgcn_s_setprio(1);
                    AT_KPAIR(0, ka0, kb0); AT_SBAR();
                    AT_KPAIR(1, ka1, kb1); sT[0] = MFMA32(ka0, qf[0], z16); AT_SUMPK(0); AT_SBAR();
                    sT[1] = MFMA32(kb0, qf[0], z16); AT_SUMPK(1); AT_SBAR();
                    AT_KPAIR(2, ka0, kb0); sT[0] = MFMA32(ka1, qf[1], sT[0]); AT_SUMPK(2); AT_SBAR();
                    sT[1] = MFMA32(kb1, qf[1], sT[1]); AT_SUMPK(3); AT_SBAR();
                    AT_KPAIR(3, ka1, kb1); sT[0] = MFMA32(ka0, qf[2], sT[0]); AT_SUMPK(4); AT_SBAR();
                    sT[1] = MFMA32(kb0, qf[2], sT[1]); AT_SUMPK(5); AT_SBAR();
                    AT_VPAIR(0, va0, vb0); sT[0] = MFMA32(ka1, qf[3], sT[0]); AT_SUMPK(6); AT_SBAR();
                    sT[1] = MFMA32(kb1, qf[3], sT[1]); AT_SUMPK(7); AT_SBAR();
                    __builtin_amdgcn_s_setprio(0);
                    lrun += xhalf_sum((ps0 + ps1) + (ps2 + ps3));
                    AT_ROWMAX(k + 1, AT_KBASE(k + 1));
                    const bool need = mx > mrun + 8.f;
                    const bool resc = __builtin_amdgcn_ballot_w64(need) != 0ull;
                    float alpha = 1.f;
                    if (resc) { const float mnew = need ? mx : mrun; alpha = __builtin_amdgcn_exp2f(mrun - mnew); lrun *= alpha; mrun = mnew; }
                    AT_SBAR();
                    __builtin_amdgcn_s_setprio(1);
                    AT_VPAIR(1, va1, vb1); AT_VMMA0(0, va0); AT_EXP2(0); AT_SBAR();
                    AT_VMMA1(0, vb0); AT_EXP2(1); AT_SBAR();
                    AT_VPAIR(2, va0, vb0); AT_VMMA0(1, va1); AT_EXP2(2); AT_SBAR();
                    AT_VMMA1(1, vb1); AT_EXP2(3); AT_SBAR();
                    AT_VPAIR(3, va1, vb1); AT_VMMA0(2, va0); AT_EXP2(4); AT_SBAR();
                    AT_VMMA1(2, vb0); AT_EXP2(5); AT_SBAR();
                    AT_VPAIR(4, va0, vb0); AT_VMMA0(3, va1); AT_EXP2(6); AT_SBAR();
                    AT_VMMA1(3, vb1); AT_EXP2(7); AT_SBAR();
                    AT_VPAIR(5, va1, vb1); AT_VMMA0(4, va0); AT_EXP2(8); AT_SBAR();
                    AT_VMMA1(4, vb0); AT_EXP2(9); AT_SBAR();
                    AT_VPAIR(6, va0, vb0); AT_VMMA0(5, va1); AT_EXP2(10); AT_SBAR();
                    AT_VMMA1(5, vb1); AT_EXP2(11); AT_SBAR();
                    AT_VPAIR(7, va1, vb1); AT_VMMA0(6, va0); AT_EXP2(12); AT_SBAR();
                    AT_VMMA1(6, vb0); AT_EXP2(13); AT_SBAR();
                    AT_VMMA0(7, va1); AT_EXP2(14); AT_SBAR();
                    AT_VMMA1(7, vb1); AT_EXP2(15); AT_SBAR();
                    __builtin_amdgcn_s_setprio(0);
                    if (resc) {
#pragma unroll
                        for (int vb = 0; vb < 4; ++vb)
#pragma unroll
                            for (int r = 0; r < 16; ++r) O[vb][r] *= alpha;
                    }
                } else {
                    AT_SUMPK(0); AT_SUMPK(1); AT_SUMPK(2); AT_SUMPK(3); AT_SUMPK(4); AT_SUMPK(5); AT_SUMPK(6); AT_SUMPK(7);
                    lrun += xhalf_sum((ps0 + ps1) + (ps2 + ps3));
                    AT_SBAR();
                    AT_VPAIR(0, va0, vb0); AT_SBAR();
                    AT_VPAIR(1, va1, vb1); AT_VMMA0(0, va0); AT_VMMA1(0, vb0); AT_SBAR();
                    AT_VPAIR(2, va0, vb0); AT_VMMA0(1, va1); AT_VMMA1(1, vb1); AT_SBAR();
                    AT_VPAIR(3, va1, vb1); AT_VMMA0(2, va0); AT_VMMA1(2, vb0); AT_SBAR();
                    AT_VPAIR(4, va0, vb0); AT_VMMA0(3, va1); AT_VMMA1(3, vb1); AT_SBAR();
                    AT_VPAIR(5, va1, vb1); AT_VMMA0(4, va0); AT_VMMA1(4, vb0); AT_SBAR();
                    AT_VPAIR(6, va0, vb0); AT_VMMA0(5, va1); AT_VMMA1(5, vb1); AT_SBAR();
                    AT_VPAIR(7, va1, vb1); AT_VMMA0(6, va0); AT_VMMA1(6, vb0); AT_SBAR();
                    AT_VMMA0(7, va1); AT_VMMA1(7, vb1); AT_SBAR();
                }
            }
            s0 = s1;
        }
        if (comp == 0) {
            const float inv = 1.f / lrun;
#pragma unroll
            for (int vb = 0; vb < 4; ++vb)
#pragma unroll
                for (int q4 = 0; q4 < 2; ++q4) { u32x4 pk;
                    pk.x = cvt_pk_bf16(O[vb][8 * q4 + 0] * inv, O[vb][8 * q4 + 1] * inv); pk.y = cvt_pk_bf16(O[vb][8 * q4 + 2] * inv, O[vb][8 * q4 + 3] * inv);
                    pk.z = cvt_pk_bf16(O[vb][8 * q4 + 4] * inv, O[vb][8 * q4 + 5] * inv); pk.w = cvt_pk_bf16(O[vb][8 * q4 + 6] * inv, O[vb][8 * q4 + 7] * inv);
                    *(LAS u32x4*)(o0p + (2 * vb + q4) * 1024) = pk; }
        } else {
            int tid2 = lane_id_(); LAUNDER(tid2);
            const int r32e = tid2 & 31, hie = (tid2 >> 5) & 1;
            const unsigned vo_o = (unsigned)((r32e * D + 4 * hie) * 2);
            const bool rowok = (j > 0) || (32 * w + r32e < 16);
            const float lam = ((const LAS float*)(F.lds + MISC_OFF))[16], oscale = ((const LAS float*)(F.lds + MISC_OFF))[17];
            const float l1s = lam / lrun;
            float ssq = 0.f;
#pragma unroll
            for (int vb = 0; vb < 4; ++vb)
#pragma unroll
                for (int q4 = 0; q4 < 2; ++q4) { const u32x4 pk = *(const LAS u32x4*)(o0p + (2 * vb + q4) * 1024);
#pragma unroll
                    for (int e = 0; e < 8; ++e) { const unsigned pw = pk[e >> 1]; const float o0 = (e & 1) ? u2f_(pw & 0xffff0000u) : u2f_(pw << 16);
                        const float a = o0 - O[vb][8 * q4 + e] * l1s; O[vb][8 * q4 + e] = a; ssq += a * a; } }
            ssq = xhalf_sum(ssq);
            const float rn = rsqrtf(ssq * (1.f / 128.f) + RMS_EPS) * oscale;
            {
                LAS unsigned char* ot = F.lds + AT_O0 + w * 8192;
#pragma unroll
                for (int vb = 0; vb < 4; ++vb)
#pragma unroll
                    for (int g4 = 0; g4 < 4; ++g4) { const f32x4 sg = *(const LAS f32x4*)(F.lds + AT_SG + (32 * vb + 8 * g4 + 4 * hie) * 4);
                        u32x2 wv; wv.x = pk2(O[vb][4 * g4 + 0] * rn * sg[0], O[vb][4 * g4 + 1] * rn * sg[1]); wv.y = pk2(O[vb][4 * g4 + 2] * rn * sg[2], O[vb][4 * g4 + 3] * rn * sg[3]);
                        *(LAS u32x2*)(ot + r32e * 256 + (((4 * vb + g4) ^ (r32e & 15)) << 4) + 8 * hie) = wv; }
                LDS_WAIT(); asm volatile("" ::: "memory");
                const int rr = (tid2 >> 4) & 3, cc = tid2 & 15;
#pragma unroll
                for (int i = 0; i < 8; ++i) { const int row = 4 * i + rr;
                    const u32x4 ov = *(const LAS u32x4*)(ot + row * 256 + ((cc ^ (row & 15)) << 4));
                    if ((j > 0 || 32 * w + row < 16) && !(p_nost && rn != 12345.f)) stg<u32x4>(ob, (unsigned)(row * D * 2 + cc * 16), ov); }
            }
        }
    }
#undef AT_KBASE
#undef AT_LDK
#undef AT_LDV
#undef AT_STK
#undef AT_STV
#undef AT_TURN
#undef AT_KPAIR
#undef AT_VPAIR
#undef AT_SUMPK
#undef AT_EXP2
#undef AT_PF
#undef AT_VMMA0
#undef AT_VMMA1
#undef AT_ROWMAX
    return nextq;
}
__device__ __forceinline__ void attn_phase(const Frame& F0, int l) {
    Frame F = F0; F.tid = F.wave * 64 + lane_id_(); LAUNDER(F.tid); F.lane = F.tid & 63;
    float s1 = 0.f, s2 = 0.f;
    for (int i = 0; i < 64; ++i) { s1 += F.in[IN_LQ1][l * 64 + i] * F.in[IN_LK1][l * 64 + i]; s2 += F.in[IN_LQ2][l * 64 + i] * F.in[IN_LK2][l * 64 + i]; }
    const float lam_init = 0.8f - 0.6f * expf(-0.3f * (float)l);
    { const float lam = expf(s1) - expf(s2) + lam_init; if (F.tid == 0) { ((LAS float*)(F.lds + MISC_OFF))[16] = lam; ((LAS float*)(F.lds + MISC_OFF))[17] = 1.f - lam_init; } }
    __syncthreads();
    if (F.tid < 128) ((LAS float*)(F.lds + AT_SG))[F.tid] = F.in[IN_SUBLN][l * 128 + F.tid];
    unsigned* qh = (unsigned*)F.ws + CW_Q + (l * 4 + 0) * 64;
#ifndef ATT_REP
#define ATT_REP 1
#endif
    const int NQ1 = (l == DEPTH - 1) ? 1024 : 1024 + NB * 4;
    const int NQ = ATT_REP * NQ1;
#pragma unroll 1
    for (int q0 = F.wg; q0 < NQ; ) {
        const int q = q0 % NQ1;
        const int bh = q & 127, j = (q < 1024) ? 8 - (q >> 7) : 0;
        q0 = F.G + attn_unit(F, bh >> 2, bh & 3, j, qh, (AT_PROBE != 0) && q0 < (ATT_REP - 1) * NQ1);
    }
}

constexpr int RT_WP = 1032;
__device__ __forceinline__ void router_phase(const Frame& F0, int l, const int skipmeta) {
    Frame F = F0; F.tid = F.wave * 64 + lane_id_(); LAUNDER(F.tid); F.lane = F.tid & 63;
    const bf16* HBr = (const bf16*)(F.ws + WS_HB); const bf16* WR = (const bf16*)(F.ws + WS_WR) + (size_t)l * 2 * 32 * 1024;
    float* rstd = (float*)(F.ws + WS_RSTD); float* gate = (float*)(F.ws + WS_GATE); int* buck = (int*)(F.ws + WS_BUCK);
    unsigned* gcnt = (unsigned*)F.ws + CW_CNT + l * 64;
    LAS bf16* Wh = (LAS bf16*)F.lds;
    LAS bf16* Wl = Wh + 20 * RT_WP;
    LAS float* LG = (LAS float*)(F.lds + 2 * 20 * RT_WP * 2);
    LAS int* lcnt = (LAS int*)(LG + 8 * 16 * 33);
    LAS int* lbase = lcnt + 32;
    LAS int* tcls = lbase + 32;
    LAS int* tpos = tcls + 288;
    const int lane = F.lane, w = F.wave, fr = lane & 15, fq = lane >> 4;
    const int NTASK = skipmeta ? NB * SEQ / 16 : T / 16;
#define RT_ROW0(task_) (skipmeta ? ((task_) >> 7) * LT + NMETA + ((task_) & 127) * 16 : (task_) * 16)
    const int ntl = (NTASK - F.wg + F.G - 1) / F.G;
    __syncthreads();
    for (int idx = F.tid; idx < 2 * 20 * 128; idx += 512) { const int hl = idx / (20 * 128), r = (idx / 128) % 20, c = idx % 128;
        *(LAS u32x4*)((hl ? Wl : Wh) + r * RT_WP + 8 * c) = *(const GAS u32x4*)(WR + (size_t)hl * 32 * 1024 + r * 1024 + 8 * c); }
    if (F.tid < 32) lcnt[F.tid] = 0;
    __syncthreads();
    const int n1 = (16 + fr < 20) ? 16 + fr : 19;
    for (int k = w; k < ntl; k += 8) {
        const int task = F.wg + k * F.G;
        const bf16* hrow = HBr + (size_t)RT_ROW0(task) * D;
        const unsigned vo = (unsigned)((fr * D + 8 * fq) * 2);
        f32x4 acc[2]; acc[0] = (f32x4){0.f, 0.f, 0.f, 0.f}; acc[1] = acc[0];
        float ssq = 0.f;
#pragma unroll 8
        for (int ks = 0; ks < 32; ++ks) {
            const u32x4 xa = ldg<u32x4>(hrow, vo + ks * 64);
            const float x0 = bf2f(xa.x), x1 = bf2f(xa.x >> 16), x2 = bf2f(xa.y), x3 = bf2f(xa.y >> 16), x4 = bf2f(xa.z), x5 = bf2f(xa.z >> 16), x6 = bf2f(xa.w), x7 = bf2f(xa.w >> 16);
            ssq += (x0 * x0 + x1 * x1) + (x2 * x2 + x3 * x3) + (x4 * x4 + x5 * x5) + (x6 * x6 + x7 * x7);
            const bf16x8 ahi = __builtin_bit_cast(bf16x8, xa);
            const bf16x8 bh0 = *(const LAS bf16x8*)(Wh + fr * RT_WP + 32 * ks + 8 * fq), bl0 = *(const LAS bf16x8*)(Wl + fr * RT_WP + 32 * ks + 8 * fq);
            const bf16x8 bh1 = *(const LAS bf16x8*)(Wh + n1 * RT_WP + 32 * ks + 8 * fq), bl1 = *(const LAS bf16x8*)(Wl + n1 * RT_WP + 32 * ks + 8 * fq);
            acc[0] = MFMA16(ahi, bh0, acc[0]); acc[0] = MFMA16(ahi, bl0, acc[0]);
            acc[1] = MFMA16(ahi, bh1, acc[1]); acc[1] = MFMA16(ahi, bl1, acc[1]);
        }
        ssq += __shfl_xor(ssq, 16); ssq += __shfl_xor(ssq, 32);
        const float rs = rsqrtf(ssq * (1.f / 1024.f) + RMS_EPS);
#pragma unroll
        for (int nt = 0; nt < 2; ++nt)
#pragma unroll
            for (int j = 0; j < 4; ++j) LG[w * 16 * 33 + (4 * fq + j) * 33 + 16 * nt + fr] = acc[nt][j];
        LDS_WAIT(); asm volatile("" ::: "memory");
        if (lane < 16) {
            const int tl = k * 16 + lane; const size_t m = (size_t)RT_ROW0(task) + lane;
            const float rsm = rs;
            const LAS float* lg = LG + w * 16 * 33 + lane * 33;
            float gl[4]; float gm = -1e30f; int gi = 0;
#pragma unroll
            for (int q = 0; q < 4; ++q) { gl[q] = lg[q] * rsm + F.in[IN_BGRP][l * 4 + q]; if (gl[q] > gm) { gm = gl[q]; gi = q; } }
            float gs = 0.f;
#pragma unroll
            for (int q = 0; q < 4; ++q) gs += __expf(gl[q] - gm);
            const float gp = 1.f / gs;
            float el[4];
#pragma unroll
            for (int q = 0; q < 4; ++q) el[q] = lg[4 + 4 * gi + q] * rsm + F.in[IN_BEXP][l * 16 + 4 * gi + q];
            int i1 = 0; float v1 = el[0];
#pragma unroll
            for (int q = 1; q < 4; ++q) if (el[q] > v1) { v1 = el[q]; i1 = q; }
            int i2 = -1; float v2 = -1e30f;
#pragma unroll
            for (int q = 0; q < 4; ++q) if (q != i1 && el[q] > v2) { v2 = el[q]; i2 = q; }
            const float e2 = __expf(v2 - v1), w1 = gp / (1.f + e2), w2 = gp * e2 / (1.f + e2);
            const int a = i1 < i2 ? i1 : i2, bq = i1 < i2 ? i2 : i1;
            const int pidx = (a == 0) ? (bq - 1) : (a == 1 ? bq + 1 : 5);
            const int cls = gi * 6 + pidx;
            rstd[m] = rsm; gate[2 * m] = (a == i1) ? w1 : w2; gate[2 * m + 1] = (a == i1) ? w2 : w1;
            tcls[tl] = cls; tpos[tl] = atomicAdd((int*)&lcnt[cls], 1);
        }
    }
    __syncthreads();
    if (F.tid < NCLS) lbase[F.tid] = (int)atomicAdd(&gcnt[F.tid], (unsigned)lcnt[F.tid]);
    __syncthreads();
    if (F.tid < ntl * 16) { const int cls = tcls[F.tid]; buck[(size_t)cls * T + lbase[cls] + tpos[F.tid]] = RT_ROW0(F.wg + (F.tid >> 4) * F.G) + (F.tid & 15); }
    __syncthreads();
#undef RT_ROW0
}

__device__ __forceinline__ void final_phase(const Frame& F0, float* out, float tp_add) {
    Frame F = F0; F.tid = F.wave * 64 + lane_id_(); LAUNDER(F.tid); F.lane = F.tid & 63;
    const bf16* HBf = (const bf16*)(F.ws + WS_HB); const float* g = F.in[IN_FNG];
    const int gw = F.wg * 8 + F.wave, NGW = F.G * 8, lane = F.lane;
    f32x4 gg[4];
#pragma unroll
    for (int j = 0; j < 4; ++j) gg[j] = *((const GAS f32x4*)g + lane + 64 * j);
    u32x2 q[4][4], qn[4][4];
#define FN_LOAD(dst_, r0_) do { _Pragma("unroll") for (int k = 0; k < 4; ++k) { int r = (r0_) + k * NGW; r = r < NB * SEQ ? r : NB * SEQ - 1; const int b = r / SEQ, t = r % SEQ; \
            const size_t m = (size_t)b * LT + NMETA + t; const GAS u32x2* hr = (const GAS u32x2*)(HBf + m * D) + lane; \
            _Pragma("unroll") for (int j = 0; j < 4; ++j) dst_[k][j] = hr[64 * j]; } } while (0)
    FN_LOAD(q, gw);
    for (int r0 = gw; r0 < NB * SEQ; r0 += 4 * NGW) {
        FN_LOAD(qn, r0 + 4 * NGW);
#pragma unroll
        for (int k = 0; k < 4; ++k) { const int r = r0 + k * NGW;
            f32x4 v[4]; float s = 0.f;
#pragma unroll
            for (int j = 0; j < 4; ++j) { v[j] = (f32x4){bf2f(q[k][j].x), bf2f(q[k][j].x >> 16), bf2f(q[k][j].y), bf2f(q[k][j].y >> 16)}; s += (v[j].x * v[j].x + v[j].y * v[j].y) + (v[j].z * v[j].z + v[j].w * v[j].w); }
            const float rs = rsqrtf(wave_sum(s) * (1.f / 1024.f) + RMS_EPS);
            if (r < NB * SEQ) { GAS f32x4* orow = (GAS f32x4*)(out + (size_t)r * D) + lane;
#pragma unroll
                for (int j = 0; j < 4; ++j) orow[64 * j] = v[j] * rs * gg[j] + tp_add; } }
#pragma unroll
        for (int k = 0; k < 4; ++k)
#pragma unroll
            for (int j = 0; j < 4; ++j) q[k][j] = qn[k][j];
    }
#undef FN_LOAD
}

template <int NPN>
__device__ __forceinline__ int moe_prepare(const Frame& F0, int l, LAS int* cntl, LAS int* tab) {
    Frame F = F0; F.tid = F.wave * 64 + lane_id_(); LAUNDER(F.tid); F.lane = F.tid & 63;
    const unsigned* gcnt = (const unsigned*)F.ws + CW_CNT + l * 64; const int* buck = (const int*)(F.ws + WS_BUCK);
    __syncthreads();
    if (F.tid < NCLS) cntl[F.tid] = (int)gcnt[F.tid];
    __syncthreads();
    MoeList ml{cntl}; const int ntl = ml.ntiles();
    int vals[6]; const int hsel = F.wave >> 2, r = F.tid & 255;
#pragma unroll
    for (int k = 0; k < 6; ++k) { const int Lx = (hsel + 2 * k) * F.G + F.wg; vals[k] = -1;
        if (Lx < ntl * NPN) { int c, ti, nv; ml.decode(Lx / NPN, c, ti, nv); if (r < nv) vals[k] = buck[(size_t)c * T + ti * 256 + r]; } }
#pragma unroll
    for (int k = 0; k < 6; ++k) { const int i = hsel + 2 * k; if (i * F.G + F.wg < ntl * NPN) tab[i * 256 + r] = vals[k]; }
    __syncthreads();
    return ntl;
}

#ifndef ONLY_MASK
#define ONLY_MASK 0xFFFFFFFFu
#endif
#define IN(k) (lo <= (k) && (k) < hi)
#define EN(j) ((ONLY_MASK >> (j)) & 1u)
#ifndef SUBMASK
#define SUBMASK 3u
#endif
#ifndef TPROBE
#define TPROBE (-1)
#endif
constexpr int CW_TP = 24576;
#define TP_MARK(k, which) do { if (TPROBE == (k) && F.wave == 0 && lane_id_() == 0) { const unsigned long long t_ = __builtin_amdgcn_s_memrealtime(); \
        __hip_atomic_fetch_max((unsigned long long*)((unsigned*)F.ws + CW_TP) + (which), (which) ? t_ : ~t_, __ATOMIC_RELAXED, __HIP_MEMORY_SCOPE_AGENT); } } while (0)
#define SEAM(k) do { TP_MARK(k, 1); if (IN(k) && IN((k) + 1)) xcd_barrier(bar); TP_MARK((k) + 1, 0); } while (0)
template <int L>
__device__ __forceinline__ void layer_phases(const Frame& F, const XcdBarrier& bar, int lo, int hi) {
    bf16* proj = (bf16*)(F.ws + WS_PROJ); bf16* mixed = (bf16*)(F.ws + WS_MIXED); bf16* HB = (bf16*)(F.ws + WS_HB);
    float* ss16 = (float*)(F.ws + WS_SS16);
    LAS int* tab = (LAS int*)(F.lds + TAB_OFF); LAS int* cntl = (LAS int*)(F.lds + TAB_OFF + 12 * 1024);
    constexpr int l = L; constexpr int pb = 1 + 9 * L;
        if (EN(1) && IN(pb + 0)) {
            const int Gg = (L == 0) ? gemm_wgs(MT * (NI / 256), F.G) : F.G;
            PolIn P; P.ord.init(MT, NI / 256, Gg, F.wg); P.A = HB; P.B = (const bf16*)(F.ws + WS_WIN) + (size_t)l * NI * D; P.proj = proj; P.ss16 = ss16; P.rope = (const float*)(F.ws + WS_ROPE); P.X = (bf16*)(F.os + OS_X);
            if (F.wg < Gg) for (int rep = 0; rep < NREP(1); ++rep) pg8::gemm_phase(F.lds, P, F.wave);
            if (L == 0) conv_spare(F, 0, I_IN, I_L, Gg); }
        SEAM(pb + 0);
        if (EN(2) && IN(pb + 1)) {
            PolS5E P; P.G = F.G; P.c = F.wg; P.X = (const bf16*)(F.os + OS_X); P.B = (const bf16*)(F.ws + WS_S5P) + (size_t)l * 16 * 256 * 256; P.E = (float*)(F.os + OS_E);
            for (int rep = 0; rep < NREP(2); ++rep) if (MIXSEL & 1u) pg8::gemm_phase(F.lds, P, F.wave);
            __syncthreads();
            for (int rep = 0; rep < NREP(11); ++rep) if (MIXSEL & 2u) hgrn_a(F, l); }
        SEAM(pb + 1);
        if (EN(3) && IN(pb + 2)) { for (int rep = 0; rep < NREP(3); ++rep) { if (MIXSEL & 1u) s5_scan(F, l); if (MIXSEL & 2u) hgrn_b(F); } }
        SEAM(pb + 2);
        if (EN(4) && IN(pb + 3)) {
            PolS5Y P; P.skipmeta = (L == DEPTH - 1); P.G = F.G; P.c = F.wg; P.X = (const bf16*)(F.os + OS_X); P.B = (const bf16*)(F.ws + WS_S5TQ) + (size_t)l * 16 * 256 * 384; P.proj = proj; P.dsk = F.in[IN_S5D] + l * 256; P.Gout = (bf16*)(F.os + OS_G);
            for (int rep = 0; rep < NREP(4); ++rep) if ((SUBMASK & MIXSEL & 1u) != 0u) pg8::gemm_phase(F.lds, P, F.wave);
            __syncthreads();
            for (int rep = 0; rep < NREP(12); ++rep) if ((SUBMASK & MIXSEL & 2u) != 0u) hgrn_c(F, l); }
        SEAM(pb + 3);
        if (EN(5) && IN(pb + 4)) {
            PolGlu P; P.skipmeta = (L == DEPTH - 1); P.ord.init(P.skipmeta ? NB * SEQ / 256 : MT, 2, F.G, F.wg); P.A = (const bf16*)(F.os + OS_G); P.B = (const bf16*)(F.ws + WS_WGLU) + (size_t)l * 512 * 256; P.mixed = mixed;
            for (int rep = 0; rep < NREP(5); ++rep) if ((SUBMASK & MIXSEL & 1u) != 0u) pg8::gemm_phase(F.lds, P, F.wave);
            __syncthreads();
            for (int rep = 0; rep < NREP(13); ++rep) if ((SUBMASK & 2u) != 0u && (MIXSEL & 4u) != 0u) attn_phase(F, l); }
        SEAM(pb + 4);
        if (EN(6) && IN(pb + 5)) {
            const int Gg = (L == 0 && DEPTH > 1) ? gemm_wgs(MT * 4, F.G) : F.G;
            PolOut P; P.skipmeta = (L == DEPTH - 1); P.ord.init(P.skipmeta ? NB * SEQ / 256 : MT, 4, Gg, F.wg); P.A = mixed; P.B = (const bf16*)(F.ws + WS_WOUT) + (size_t)l * D * D; P.HB = HB; P.ss16 = ss16; P.pan = (unsigned*)F.ws + CW_PAN + l * 272 * 16;
            if (NREP(6) == 2) { P.HBo = (bf16*)F.os; P.ss16 = (float*)(F.os + 160 * 1048576); pg8::gemm_phase(F.lds, P, F.wave); P.ss16 = ss16; }
            P.HBo = HB; if (F.wg < Gg) pg8::gemm_phase(F.lds, P, F.wave);
            if (L == 0 && DEPTH > 1) conv_spare(F, 1, 0, I_L, Gg); }
        SEAM(pb + 5);
        if (EN(7) && IN(pb + 6)) { router_phase(F, l, (L == DEPTH - 1) ? 1 : 0); }
        SEAM(pb + 6);
        if (EN(8) && IN(pb + 7)) {
            PolGU P; P.G = F.G; P.c = F.wg; P.ntl = moe_prepare<8>(F, l, cntl, tab); P.ml = MoeList{cntl}; P.tab = tab;
            P.HB = HB; P.W = (const bf16*)(F.ws + WS_WGU) + (size_t)l * 16 * 1024 * 1024; P.he = proj; P.rstd = (const float*)(F.ws + WS_RSTD); P.gate = (const float*)(F.ws + WS_GATE);
            for (int rep = 0; rep < NREP(8); ++rep) pg8::gemm_phase(F.lds, P, F.wave); }
        SEAM(pb + 7);
        if (EN(9) && IN(pb + 8)) {
            PolDN P; P.G = F.G; P.c = F.wg; P.ntl = moe_prepare<4>(F, l, cntl, tab); P.ml = MoeList{cntl}; P.tab = tab;
            P.he = proj; P.W = (const bf16*)(F.ws + WS_WDN) + (size_t)l * 16 * 1024 * 512; P.HB = HB; P.ss16 = ss16; P.needss = (L + 1 < DEPTH) ? 1 : 0;
            if (NREP(9) == 2) { P.HBo = (bf16*)F.os; P.ss16 = (float*)(F.os + 160 * 1048576); pg8::gemm_phase(F.lds, P, F.wave); P.ss16 = ss16; }
            P.HBo = HB; pg8::gemm_phase(F.lds, P, F.wave); }
        SEAM(pb + 8);
}

__global__ void __launch_bounds__(512, 2) hymba_fwd(Args args) {
    extern __shared__ __attribute__((aligned(16))) unsigned char lds_raw[];
    Frame F;
    F.lds = (LAS unsigned char*)lds_raw;
    F.tid = threadIdx.x; F.lane = F.tid & 63; F.wave = __builtin_amdgcn_readfirstlane(F.tid >> 6);
    F.G = gridDim.x; F.wg = blockIdx.x; F.in = args.in; F.ws = args.ws; F.os = args.ws + WS_SCR;
    volatile LAS unsigned* MISC = (volatile LAS unsigned*)(F.lds + MISC_OFF);
    if (F.tid < 256) MISC[F.tid] = 0u;
    __syncthreads();
    const int lo = args.ph_lo, hi = args.ph_hi;
    const bool one = (hi - lo) > 1;
    XcdBarrier bar; bar.bar = (unsigned*)F.ws + CW_BAR; bar.x = 0; bar.st = nullptr;
    bar.wave = F.wave;
    if (one) bar = xcd_barrier_post((unsigned*)F.ws + CW_BAR, MISC + 8, F.wave);
    TP_MARK(0, 0);
    if (EN(0) && IN(0)) { for (int rep = 0; rep < NREP(0); ++rep) p0_prologue(F); } SEAM(0);
    layer_phases<0>(F, bar, lo, hi);
    layer_phases<1>(F, bar, lo, hi);
    float tp_add = 0.f;
    if (TPROBE >= 0) { const unsigned long long* tp = (const unsigned long long*)((unsigned*)F.ws + CW_TP); const unsigned long long t0 = ~tp[0], t1 = tp[1]; tp_add = (float)(t1 - t0) * 1e-5f; }
    if (EN(10) && IN(19)) for (int rep = 0; rep < NREP(10); ++rep) final_phase(F, args.out, tp_add);
#undef IN
#undef SEAM
}

extern "C" void kernel_launch(void* const* d_in, const int* in_sizes, int n_in, void* d_out, int out_size, void* d_ws, size_t ws_size, hipStream_t stream) {
    static int grid = 0;
    if (grid == 0) {
        if (n_in != 30 || ws_size < WS_END) { fprintf(stderr, "kernel_launch: unexpected inputs (n_in %d, ws %zu < %zu)\n", n_in, ws_size, (size_t)WS_END); grid = -1; return; }
        int dev = 0, cus = 0, per_cu = 0;
        (void)hipGetDevice(&dev); (void)hipDeviceGetAttribute(&cus, hipDeviceAttributeMultiprocessorCount, dev);
        (void)hipFuncSetAttribute((const void*)hymba_fwd, hipFuncAttributeMaxDynamicSharedMemorySize, LDS_BYTES);
        (void)hipOccupancyMaxActiveBlocksPerMultiprocessor(&per_cu, (const void*)hymba_fwd, 512, LDS_BYTES);
        (void)hipGetLastError();
        grid = cus > 0 ? cus : 256;
    }
    if (grid < 0) return;
    (void)hipMemsetAsync(d_ws, 0, CTL_BYTES, stream);
    Args a{};
    for (int i = 0; i < 30; ++i) a.in[i] = (const float*)d_in[i];
    a.out = (float*)d_out; a.ws = (unsigned char*)d_ws;
#if N_LAUNCH_MODE == 1
    a.ph_lo = 0; a.ph_hi = LAST_PHASE;
    hipLaunchKernelGGL(hymba_fwd, dim3(grid), dim3(512), LDS_BYTES, stream, a);
#else
    if (MIXSEL != 7u) (void)hipMemsetAsync((char*)d_ws + WS_MIXED, 0, (size_t)T * D * 2, stream);
    for (int p = 0; p < LAST_PHASE; ++p) { if (!((RUN_MASK >> p) & 1u)) continue; a.ph_lo = p; a.ph_hi = p + 1; hipLaunchKernelGGL(hymba_fwd, dim3(grid), dim3(512), LDS_BYTES, stream, a); }
#endif
}
```

```cpp
#include <hip/hip_runtime.h>
#include <stdint.h>
#include <stdio.h>

#ifndef N_LAUNCH_MODE
#define N_LAUNCH_MODE 1
#endif
#ifndef LAST_PHASE
#define LAST_PHASE 20
#endif
#ifndef RUN_MASK
#define RUN_MASK 0xFFFFFu
#endif
#ifndef REPMASK
#define REPMASK 0u
#endif
#define NREP(j) (((REPMASK >> (j)) & 1u) ? 2 : 1)
#ifndef MIXSEL
#define MIXSEL 7u
#endif

#define GAS __attribute__((address_space(1)))
#define LAS __attribute__((address_space(3)))
typedef unsigned short bf16;
typedef short bf16x8 __attribute__((ext_vector_type(8)));
typedef short s16x4 __attribute__((ext_vector_type(4)));
typedef float f32x2 __attribute__((ext_vector_type(2)));
typedef float f32x4 __attribute__((ext_vector_type(4)));
typedef float f32x16 __attribute__((ext_vector_type(16)));
typedef unsigned u32x2 __attribute__((ext_vector_type(2)));
typedef unsigned u32x4 __attribute__((ext_vector_type(4)));

constexpr int NB = 32, LT = 2064, NMETA = 16, SEQ = 2048, T = NB * LT;
constexpr int DEPTH = 2;
constexpr int D = 1024, NI = 2816, MT = T / 256;
constexpr int C_U = 0, C_HQ = 256, C_HF = 512, C_HI = 768, C_HG = 1024, C_AQ = 1280, C_AK = 1792, C_AV = 2304;
constexpr int NCH = 129;
constexpr int S5R = NB * NCH;
constexpr int S5RP = 17 * 256;
constexpr int HCH = 33;
constexpr int NCLS = 24;
constexpr float RMS_EPS = 1e-6f;
constexpr float QSCALE = 0.125f * 1.4426950408889634f;

constexpr size_t al256(size_t x) { return (x + 255) & ~(size_t)255; }
constexpr size_t CTL_BYTES = 1u << 20;
constexpr size_t WS_WIN = CTL_BYTES;
constexpr size_t WS_WOUT = WS_WIN + al256((size_t)2 * NI * D * 2);
constexpr size_t WS_WGLU = WS_WOUT + al256((size_t)2 * D * D * 2);
constexpr size_t WS_WGU = WS_WGLU + al256((size_t)2 * 512 * 256 * 2);
constexpr size_t WS_WDN = WS_WGU + al256((size_t)2 * 16 * 1024 * 1024 * 2);
constexpr size_t WS_WR = WS_WDN + al256((size_t)2 * 16 * 1024 * 512 * 2);
constexpr size_t WS_S5TQ = WS_WR + al256((size_t)2 * 2 * 32 * 1024 * 2);
constexpr size_t WS_S5P = WS_S5TQ + al256((size_t)2 * 16 * 256 * 384 * 2);
constexpr size_t WS_S5A = WS_S5P + al256((size_t)2 * 16 * 256 * 256 * 2);
constexpr size_t WS_ROPE = WS_S5A + al256((size_t)2 * 16 * 64 * 8);
constexpr size_t WS_SS16 = WS_ROPE + al256((size_t)LT * 32 * 4 * 2);
constexpr size_t WS_RSTD = WS_SS16 + al256((size_t)T * 16 * 4);
constexpr size_t WS_GATE = WS_RSTD + al256((size_t)T * 4);
constexpr size_t WS_BUCK = WS_GATE + al256((size_t)T * 8);
constexpr size_t WS_HB = WS_BUCK + al256((size_t)NCLS * T * 4);
constexpr size_t WS_PROJ = WS_HB + al256((size_t)T * D * 2);
constexpr size_t WS_MIXED = WS_PROJ + al256((size_t)T * NI * 2);
constexpr size_t WS_SCR = WS_MIXED + al256((size_t)T * D * 2);
constexpr size_t OS_E = 0;
constexpr size_t OS_X = OS_E + al256((size_t)16 * S5RP * 128 * 4);
constexpr size_t OS_G = OS_X + al256((size_t)16 * S5RP * 384 * 2);
constexpr size_t OS_UT = OS_G + al256((size_t)T * 256 * 2);
constexpr size_t OS_DEC = OS_UT + al256((size_t)NB * 4 * HCH * 4096 * 4);
constexpr size_t OS_SP = OS_DEC + al256((size_t)NB * 4 * HCH * 64 * 4);
constexpr size_t OS_END = OS_SP + al256((size_t)NB * 4 * HCH * 4096 * 2);
constexpr size_t WS_END = WS_SCR + OS_END;
static_assert(WS_END <= (size_t)1 << 30, "workspace map must fit in 1 GiB");
static_assert((size_t)(MT + NCLS) * 256 * 1024 * 2 <= (size_t)T * NI * 2, "he overlay fits in proj");

constexpr int CW_PAN = 32768;
constexpr int CW_BAR = 4096, CW_CNT = 16384, CW_Q = 20480;

constexpr int LDS_BYTES = 147456;
constexpr int RING_BYTES = 131072;
constexpr int TAB_OFF = RING_BYTES;
constexpr int MISC_OFF = LDS_BYTES - 1024;

__device__ __forceinline__ float bf2f(unsigned b) { return __builtin_bit_cast(float, (b & 0xffffu) << 16); }
__device__ __forceinline__ unsigned cvt_pk_bf16(float lo, float hi) { unsigned r; asm("v_cvt_pk_bf16_f32 %0, %1, %2" : "=v"(r) : "v"(lo), "v"(hi)); return r; }
__device__ __forceinline__ unsigned pk2(float lo, float hi) { return cvt_pk_bf16(lo, hi); }
__device__ __forceinline__ unsigned f2bf(float f) { return cvt_pk_bf16(f, 0.f) & 0xffffu; }
__device__ __forceinline__ float wave_sum(float v) {
#pragma unroll
    for (int o = 1; o < 64; o <<= 1) v += __shfl_xor(v, o);
    return v;
}
__device__ __forceinline__ float sigmoidf_(float x) { return __builtin_amdgcn_rcpf(1.f + __expf(-x)); }
__device__ __forceinline__ float siluf_(float x) { return x * __builtin_amdgcn_rcpf(1.f + __expf(-x)); }
__device__ __forceinline__ float gelu_tanh(float x) { const float u = 0.7978845608028654f * (x + 0.044715f * x * x * x); return x * __builtin_amdgcn_rcpf(1.f + __expf(-2.f * u)); }
__device__ __forceinline__ int lane_id_() { int l; asm volatile("v_mbcnt_lo_u32_b32 %0, -1, 0\n\tv_mbcnt_hi_u32_b32 %0, -1, %0" : "=v"(l)); return l; }
#define LAUNDER(x) asm volatile("" : "+v"(x))
#define LAUNDER_S(x) asm volatile("" : "+s"(x))
#define LDS_WAIT() asm volatile("s_waitcnt lgkmcnt(0)" ::: "memory")
#define VM_WAIT() asm volatile("s_waitcnt vmcnt(0)" ::: "memory")

#define XB_TMO      128
#define XB_XCNT(j)  (256  + 64 * (j))
#define XB_XSUB(j)  (1280 + 64 * (j))
#define XB_XGEN(j)  (2304 + 64 * (j))
#define XB_TOP      3328
#define XB_TOPGEN   3392
#define XCD_BAR_WORDS 3456
#define XB_SPIN_CAP (1u << 18)
__device__ __forceinline__ unsigned xb_ld(unsigned* p)              { return __hip_atomic_load(p, __ATOMIC_RELAXED, __HIP_MEMORY_SCOPE_AGENT); }
__device__ __forceinline__ unsigned xb_add(unsigned* p, unsigned v) { return __hip_atomic_fetch_add(p, v, __ATOMIC_RELAXED, __HIP_MEMORY_SCOPE_AGENT); }
__device__ __forceinline__ unsigned xb_xcc_id() { return (unsigned)__builtin_amdgcn_s_getreg((3 << 11) | 20) & 0xFu; }
#define XB_SPIN(cond, bar) do { unsigned _sp = 0; while (cond) { __builtin_amdgcn_s_sleep(1); \
    if ((++_sp & 255u) == 0u) { if (xb_ld(&(bar)[XB_TMO])) break; if (_sp > XB_SPIN_CAP) { atomicAdd(&(bar)[XB_TMO], 1u); break; } } } } while (0)
struct XcdBarrier { unsigned* bar; unsigned x; volatile LAS unsigned* st; int wave; };
__device__ __forceinline__ XcdBarrier xcd_barrier_post(unsigned* bar, volatile LAS unsigned* st, int wave) {
    XcdBarrier b; b.bar = bar; b.x = xb_xcc_id(); b.st = st; b.wave = wave;
    if (wave == 0 && lane_id_() == 0) (void)xb_add(&bar[XB_XCNT(b.x)], 1u);
    return b;
}
__device__ __forceinline__ void xcd_barrier_complete(unsigned* bar, unsigned x, unsigned& nloc, unsigned& nx) {
    const unsigned G = gridDim.x * gridDim.y * gridDim.z;
    unsigned sum, cnt, mine, sp = 0u;
    for (;;) {
        sum = 0u; cnt = 0u; mine = 0u;
#pragma unroll 1
        for (unsigned j = 0; j < 16; ++j) { const unsigned c = xb_ld(&bar[XB_XCNT(j)]); sum += c; cnt += (c > 0u) ? 1u : 0u; mine = (j == x) ? c : mine; }
        if (sum == G) break;
        __builtin_amdgcn_s_sleep(1);
        if ((++sp & 255u) == 0u) { if (xb_ld(&bar[XB_TMO])) break; if (sp > XB_SPIN_CAP) { atomicAdd(&bar[XB_TMO], 1u); break; } }
    }
    nloc = mine > 0u ? mine : 1u; nx = cnt > 0u ? cnt : 1u;
}
__device__ __forceinline__ void xcd_barrier(const XcdBarrier& b) {
    asm volatile("s_waitcnt vmcnt(0)" ::: "memory");
    __syncthreads();
    if (b.wave == 0 && lane_id_() == 0) {
        unsigned* bar = b.bar;
        __builtin_amdgcn_s_waitcnt(0);
        unsigned nloc = b.st[0], nx = b.st[1];
        if (nloc == 0u) { xcd_barrier_complete(bar, b.x, nloc, nx); b.st[0] = nloc; b.st[1] = nx; }
        const unsigned old = xb_add(&bar[XB_XSUB(b.x)], 1u);
        const unsigned gen = old / nloc;
        if (old + 1u == (gen + 1u) * nloc) {
            __builtin_amdgcn_fence(__ATOMIC_RELEASE, "agent");
            asm volatile("s_waitcnt vmcnt(0)" ::: "memory");
            const unsigned og = xb_add(&bar[XB_TOP], 1u);
            const unsigned tg = og / nx;
            if (og + 1u == (tg + 1u) * nx) xb_add(&bar[XB_TOPGEN], 1u);
            else XB_SPIN(xb_ld(&bar[XB_TOPGEN]) == tg, bar);
            __builtin_amdgcn_fence(__ATOMIC_ACQUIRE, "agent");
            xb_add(&bar[XB_XGEN(b.x)], 1u);
            asm volatile("s_waitcnt vmcnt(0)" ::: "memory");
        } else {
            XB_SPIN(xb_ld(&bar[XB_XGEN(b.x)]) == gen, bar);
            __builtin_amdgcn_fence(__ATOMIC_ACQUIRE, "agent");
            asm volatile("s_waitcnt vmcnt(0)" ::: "memory");
        }
    }
    __syncthreads();
}

namespace pg8 {
constexpr int BM = 256, BK = 64, HALF = 128, HTB = HALF * BK * 2, NXCD = 8, WGM = 8;
__host__ __device__ __forceinline__ int lds_byte(int r, int c) { const int st = (r >> 4) * 2 + (c >> 5), rr = r & 15, cc = c & 31, ob = rr * 64 + cc * 2; return st * 1024 + (ob ^ (((ob >> 9) & 1) << 5)); }
__host__ __device__ __forceinline__ void stage_rc(int b, int& R, int& C) { const int st = b / 1024, sb = b % 1024, swz = sb ^ (((sb >> 9) & 1) << 5); R = (st >> 1) * 16 + swz / 64; C = (st & 1) * 32 + (swz % 64) / 2; }
__host__ __device__ __forceinline__ int perm32(int rho) { const int n = rho >> 4, i = rho & 15; return 8 * (i >> 2) + 4 * n + (i & 3); }

struct TileOrder {
    int nM, nN, nwg, G, c;
    __device__ __forceinline__ void init(int nM_, int nN_, int G_, int c_) { nM = nM_; nN = nN_; nwg = nM * nN; G = G_; c = c_; }
    __device__ __forceinline__ bool get(int i, int& pm, int& pn) const {
        const long Lx = (long)i * G + c; if (Lx >= nwg) return false;
        int wgid = (int)Lx; { const int q = nwg / NXCD, r = nwg % NXCD, xcd = wgid % NXCD, off = wgid / NXCD; wgid = (xcd < r ? xcd * (q + 1) : r * (q + 1) + (xcd - r) * q) + off; }
        const int nig = WGM * nN, gid = wgid / nig, fm = gid * WGM, gsz = (nM - fm) < WGM ? (nM - fm) : WGM;
        pm = fm + ((wgid % nig) % gsz); pn = (wgid % nig) / gsz; return true;
    }
};

template <class P>
__device__ __forceinline__ void gemm_phase(LAS unsigned char* lds, const P& S, int wave) {
    typedef typename P::Unit Unit;
    int tid_ = wave * 64 + lane_id_(); LAUNDER(tid_);
    const int tid = tid_, wid = wave, lane = tid & 63, wr = wid >> 2, wc = wid & 3, fr = lane & 15, fq = lane >> 4;
    constexpr int nt = P::NT; constexpr int LDB = P::LDB;
    int Rs[2], Cs[2]; unsigned voffB[2];
#pragma unroll
    for (int i = 0; i < 2; ++i) { int R, C; stage_rc(tid * 16 + i * 8192, R, C); Rs[i] = R; Cs[i] = C; const int Rb = (R & ~31) + perm32(R & 31); voffB[i] = (unsigned)(Rb * LDB + C) * 2u; }
    const size_t hstepB = (size_t)HALF * LDB * 2;
    const unsigned ldsw = (unsigned)wid * 1024u;
    const int aoff = lds_byte(wr * 64 + fr, fq * 8), boff = lds_byte(wc * 32 + fr, fq * 8);
#define PG8_SA(b, h) (((b) * 2 + (h)) * HTB)
#define PG8_SB(b, h) ((4 + (b) * 2 + (h)) * HTB)
#define PG8_STAGE1(bufoff, gptr, v0, v1) do { \
        __builtin_amdgcn_global_load_lds((const unsigned*)((const char*)(gptr) + (v0)), (LAS unsigned*)(lds + (bufoff) + ldsw), 16, 0, 0); \
        __builtin_amdgcn_global_load_lds((const unsigned*)((const char*)(gptr) + (v1)), (LAS unsigned*)(lds + (bufoff) + ldsw + 8192), 16, 0, 0); } while (0)
#define PG8_STAGEB(bufoff, gptr) PG8_STAGE1(bufoff, gptr, voffB[0], voffB[1])
#define PG8_LDA(dst, b, h) do { _Pragma("unroll") for (int m = 0; m < 4; ++m) _Pragma("unroll") for (int k = 0; k < 2; ++k) dst[m][k] = *(const LAS bf16x8*)(lds + PG8_SA(b, h) + aoff + m * 2048 + k * 1024); } while (0)
#define PG8_LDB(dst, b, h) do { _Pragma("unroll") for (int n = 0; n < 2; ++n) _Pragma("unroll") for (int k = 0; k < 2; ++k) dst[n][k] = *(const LAS bf16x8*)(lds + PG8_SB(b, h) + boff + n * 2048 + k * 1024); } while (0)
#define PG8_MMA(ai, bj, At, Bt) do { __builtin_amdgcn_s_setprio(1); _Pragma("unroll") for (int m = 0; m < 4; ++m) _Pragma("unroll") for (int n = 0; n < 2; ++n) _Pragma("unroll") for (int k = 0; k < 2; ++k) \
        acc[ai][bj][m][n] = __builtin_amdgcn_mfma_f32_16x16x32_bf16(Bt[n][k], At[m][k], acc[ai][bj][m][n], 0, 0, 0); __builtin_amdgcn_s_setprio(0); } while (0)
#define PG8_WAIT_V(n) asm volatile("s_waitcnt vmcnt(" #n ")" ::: "memory")
#define PG8_WAIT_L(n) asm volatile("s_waitcnt lgkmcnt(" #n ")" ::: "memory")
#define PG8_BAR __builtin_amdgcn_s_barrier()
#define PG8_SCHED __builtin_amdgcn_sched_barrier(0)
    Unit cur, nxt; int ui = 0;
    if (!S.next(0, cur)) return;
    f32x4 acc[2][2][4][2];
#pragma unroll
    for (int a = 0; a < 2; ++a)
#pragma unroll
        for (int b = 0; b < 2; ++b)
#pragma unroll
            for (int m = 0; m < 4; ++m)
#pragma unroll
                for (int n = 0; n < 2; ++n) acc[a][b][m][n] = (f32x4){0.f, 0.f, 0.f, 0.f};
    bf16x8 At[4][2], B0[2][2], B1[2][2];
#define PG8_STAGEA(bufoff, uidx, uu, tt, hh) S.stage_a(lds + (bufoff) + ldsw, uidx, uu, tt, hh, Rs, Cs)
    {
        const char* pB0 = S.b_ptr(cur, 0); const char* pB1 = S.b_ptr(cur, 1);
        PG8_STAGEB(PG8_SB(0, 0), pB0); PG8_STAGEB(PG8_SB(0, 1), pB0 + hstepB); PG8_STAGEA(PG8_SA(0, 0), 0, cur, 0, 0); PG8_STAGEA(PG8_SA(0, 1), 0, cur, 0, 1);
        if (wr == 1) PG8_BAR;
        PG8_WAIT_V(2); PG8_BAR;
        PG8_STAGEB(PG8_SB(1, 0), pB1); PG8_STAGEA(PG8_SA(1, 0), 0, cur, 1, 0); PG8_STAGEB(PG8_SB(1, 1), pB1 + hstepB);
        PG8_WAIT_V(6); PG8_BAR;
    }
    for (;;) {
        const bool has_next = S.next(ui + 1, nxt);
        if (!has_next) nxt = cur;
        const int uin = has_next ? ui + 1 : ui;
#pragma unroll 1
        for (int t = 0; t < nt; t += 2) {
            const bool last = (t == nt - 2);
            const Unit& u2 = last ? nxt : cur; const int ui2 = last ? uin : ui; const int t2 = last ? 0 : t + 2;
            const char* b2 = S.b_ptr(u2, t2); const char* b3 = S.b_ptr(u2, t2 + 1);
            PG8_LDB(B0, 0, 0); PG8_LDB(B1, 0, 1); PG8_SCHED; PG8_LDA(At, 0, 0); PG8_STAGEA(PG8_SA(1, 1), ui, cur, t + 1, 1);
            PG8_WAIT_V(8); PG8_WAIT_L(0); PG8_BAR; PG8_MMA(0, 0, At, B0); PG8_MMA(0, 1, At, B1); PG8_BAR; PG8_SCHED;
            PG8_LDA(At, 0, 1); PG8_STAGEB(PG8_SB(0, 0), b2); PG8_STAGEB(PG8_SB(0, 1), b2 + hstepB); PG8_STAGEA(PG8_SA(0, 0), ui2, u2, t2, 0);
            PG8_WAIT_V(8); PG8_WAIT_L(0); PG8_BAR; PG8_MMA(1, 0, At, B0); PG8_MMA(1, 1, At, B1); PG8_BAR; PG8_SCHED;
            PG8_LDB(B0, 1, 0); PG8_LDB(B1, 1, 1); PG8_SCHED; PG8_LDA(At, 1, 0); PG8_STAGEA(PG8_SA(0, 1), ui2, u2, t2, 1);
            PG8_WAIT_V(8); PG8_WAIT_L(0); PG8_BAR; PG8_MMA(0, 0, At, B0); PG8_MMA(0, 1, At, B1); PG8_BAR; PG8_SCHED;
            PG8_LDA(At, 1, 1); PG8_STAGEB(PG8_SB(1, 0), b3); PG8_STAGEB(PG8_SB(1, 1), b3 + hstepB); PG8_STAGEA(PG8_SA(1, 0), ui2, u2, t2 + 1, 0);
            PG8_WAIT_V(8); PG8_WAIT_L(0); PG8_BAR; PG8_MMA(1, 0, At, B0); PG8_MMA(1, 1, At, B1); PG8_BAR; PG8_SCHED;
        }
        if (wr == 0) PG8_BAR;
        S.epi(acc, cur, wr, wc, fr, fq, ui);
        PG8_SCHED;
        if (!has_next) break;
#pragma unroll
        for (int a = 0; a < 2; ++a)
#pragma unroll
            for (int b = 0; b < 2; ++b)
#pragma unroll
                for (int m = 0; m < 4; ++m)
#pragma unroll
                    for (int n = 0; n < 2; ++n) acc[a][b][m][n] = (f32x4){0.f, 0.f, 0.f, 0.f};
        cur = nxt; ++ui;
        if (wr == 1) PG8_BAR;
    }
    PG8_WAIT_V(0);
    PG8_BAR;
#undef PG8_SA
#undef PG8_SB
#undef PG8_STAGE1
#undef PG8_STAGEB
#undef PG8_STAGEA
#undef PG8_LDA
#undef PG8_LDB
#undef PG8_MMA
#undef PG8_WAIT_V
#undef PG8_WAIT_L
#undef PG8_BAR
#undef PG8_SCHED
}
}
typedef f32x4 AccT[2][2][4][2];

struct Args { const float* in[30]; float* out; unsigned char* ws; int ph_lo, ph_hi; };

struct Frame {
    LAS unsigned char* lds;
    int tid, lane, wave, G, wg;
    const float* const* in;
    unsigned char* ws; unsigned char* os;
};
#define IN_X 0
#define IN_META 1
#define IN_NMG 2
#define IN_WIN 3
#define IN_LRE 4
#define IN_LIM 5
#define IN_LDT 6
#define IN_BRE 7
#define IN_BIM 8
#define IN_CRE 9
#define IN_CIM 10
#define IN_S5D 11
#define IN_WGLU 12
#define IN_HLB 13
#define IN_HNG 14
#define IN_LQ1 15
#define IN_LK1 16
#define IN_LQ2 17
#define IN_LK2 18
#define IN_SUBLN 19
#define IN_WOUT 20
#define IN_NFG 21
#define IN_WGRP 22
#define IN_BGRP 23
#define IN_WEXP 24
#define IN_BEXP 25
#define IN_WGATE 26
#define IN_WUP 27
#define IN_WDOWN 28
#define IN_FNG 29

template <class ColMap>
__device__ __forceinline__ void conv_item(const float* W, int ldw, const float* kscale, bf16* WT, int ldt, int k0, int n0, LAS float* scr, int lane, ColMap cm) {
    const int sc = cm(n0 + (lane & 31));
#pragma unroll
    for (int i = 0; i < 32; ++i) { const int kk = 2 * i + (lane >> 5); float v = W[(size_t)(k0 + kk) * ldw + sc]; if (kscale) v *= kscale[k0 + kk]; scr[kk * 33 + (lane & 31)] = v; }
    LDS_WAIT(); asm volatile("" ::: "memory");
    const int c = lane & 7;
#pragma unroll
    for (int j = 0; j < 4; ++j) { const int n = (lane >> 3) + 8 * j; const LAS float* s = scr + (8 * c) * 33 + n;
        u32x4 o; o.x = pk2(s[0 * 33], s[1 * 33]); o.y = pk2(s[2 * 33], s[3 * 33]); o.z = pk2(s[4 * 33], s[5 * 33]); o.w = pk2(s[6 * 33], s[7 * 33]);
        *(GAS u32x4*)(WT + (size_t)(n0 + n) * ldt + k0 + 8 * c) = o; }
    LDS_WAIT(); asm volatile("" ::: "memory");
}

constexpr int I_IN = 16 * (NI / 32), I_OUT = 16 * 32, I_GLU = 4 * 16, I_GU = 16 * 16 * 32, I_DN = 16 * 8 * 32;
constexpr int I_L = I_IN + I_OUT + I_GLU + I_GU + I_DN;
struct ConvJob { const float* W; const float* ks; bf16* WT; int ldw, ldt, k0, n0, sc; };
__device__ __forceinline__ ConvJob conv_decode(const Frame& F, const int l, int r, const int lane) {
    ConvJob J; const int ln = lane & 31;
    if (r < I_IN) {
        const int kb = r / (NI / 32), nb = r % (NI / 32); const int n = nb * 32 + ln;
        J.W = F.in[IN_WIN] + (size_t)l * D * NI; J.ldw = NI; J.ks = F.in[IN_NMG] + l * D; J.WT = (bf16*)(F.ws + WS_WIN) + (size_t)l * NI * D; J.ldt = D; J.k0 = kb * 64; J.n0 = nb * 32;
        J.sc = n; if (n >= C_AQ && n < C_AV) { const int p = n & 63, j = p >> 3, e = p & 7; J.sc = (n & ~63) + 4 * j + (e & 3) + 32 * (e >> 2); }
        return J; }
    r -= I_IN;
    if (r < I_OUT) {
        const int kb = r / 32, nb = r % 32;
        J.W = F.in[IN_WOUT] + (size_t)l * D * D; J.ldw = D; J.ks = nullptr; J.WT = (bf16*)(F.ws + WS_WOUT) + (size_t)l * D * D; J.ldt = D; J.k0 = kb * 64; J.n0 = nb * 32; J.sc = nb * 32 + ln;
        return J; }
    r -= I_OUT;
    if (r < I_GLU) {
        const int kb = r / 16, nb = r % 16; const int n = nb * 32 + ln;
        J.W = F.in[IN_WGLU] + (size_t)l * 256 * 512; J.ldw = 512; J.ks = nullptr; J.WT = (bf16*)(F.ws + WS_WGLU) + (size_t)l * 512 * 256; J.ldt = 256; J.k0 = kb * 64; J.n0 = nb * 32;
        { const int pn = n >> 8, bj = (n >> 7) & 1, c = n & 127; J.sc = bj * 256 + pn * 128 + c; }
        return J; }
    r -= I_GLU;
    if (r < I_GU) {
        const int e = r / (16 * 32), q = r % (16 * 32), kb = q / 32, nb = q % 32, n0 = nb * 32, bj = (n0 >> 7) & 1; const int n = n0 + ln;
        J.W = (bj ? F.in[IN_WUP] : F.in[IN_WGATE]) + ((size_t)l * 16 + e) * 1024 * 512; J.ldw = 512; J.ks = F.in[IN_NFG] + l * D; J.WT = (bf16*)(F.ws + WS_WGU) + ((size_t)l * 16 + e) * 1024 * 1024; J.ldt = 1024;
        J.k0 = kb * 64; J.n0 = n0; { const int pn = n >> 8, c = n & 127; J.sc = pn * 128 + c; }
        return J; }
    r -= I_GU;
    {   const int e = r / (8 * 32), q = r % (8 * 32), kb = q / 32, nb = q % 32;
        J.W = F.in[IN_WDOWN] + ((size_t)l * 16 + e) * 512 * 1024; J.ldw = 1024; J.ks = nullptr; J.WT = (bf16*)(F.ws + WS_WDN) + ((size_t)l * 16 + e) * 1024 * 512; J.ldt = 512; J.k0 = kb * 64; J.n0 = nb * 32; J.sc = nb * 32 + ln; }
    return J;
}
struct ConvRegs { float v[32]; };
__device__ __forceinline__ void conv_load(const ConvJob& J, const int lane, ConvRegs& R) {
#pragma unroll
    for (int i = 0; i < 32; ++i) { const int kk = 2 * i + (lane >> 5); R.v[i] = J.W[(size_t)(J.k0 + kk) * J.ldw + J.sc]; }
    if (J.ks) {
#pragma unroll
        for (int i = 0; i < 32; ++i) R.v[i] *= J.ks[J.k0 + 2 * i + (lane >> 5)]; }
}
__device__ __forceinline__ void conv_store(const ConvJob& J, const int lane, const ConvRegs& R, LAS float* scr) {
#pragma unroll
    for (int i = 0; i < 32; ++i) scr[(2 * i + (lane >> 5)) * 33 + (lane & 31)] = R.v[i];
    LDS_WAIT(); asm volatile("" ::: "memory");
    const int c = lane & 7;
#pragma unroll
    for (int j = 0; j < 4; ++j) { const int n = (lane >> 3) + 8 * j; const LAS float* s = scr + (8 * c) * 33 + n;
        u32x4 o; o.x = pk2(s[0 * 33], s[1 * 33]); o.y = pk2(s[2 * 33], s[3 * 33]); o.z = pk2(s[4 * 33], s[5 * 33]); o.w = pk2(s[6 * 33], s[7 * 33]);
        *(GAS u32x4*)(J.WT + (size_t)(J.n0 + n) * J.ldt + J.k0 + 8 * c) = o; }
    LDS_WAIT(); asm volatile("" ::: "memory");
}
__device__ __forceinline__ void conv_range(const Frame& F, const int l, const int it0, const int hi, const int step, LAS float* scr, const int lane) {
    for (int it = it0; it < hi; it += 2 * step) {
        const bool two = it + step < hi;
        const ConvJob J0 = conv_decode(F, l, it, lane), J1 = conv_decode(F, l, two ? it + step : it, lane);
        ConvRegs R0, R1;
        conv_load(J0, lane, R0); conv_load(J1, lane, R1);
        conv_store(J0, lane, R0, scr);
        if (two) conv_store(J1, lane, R1, scr);
    }
}
__device__ __forceinline__ int gemm_wgs(int U, int G) { const int R = (U + G - 1) / G; return (U + R - 1) / R; }
__device__ __forceinline__ void conv_spare(const Frame& F0, const int l, const int it_lo, const int it_hi, const int Gg) {
    Frame F = F0; F.tid = F.wave * 64 + lane_id_(); LAUNDER(F.tid); F.lane = F.tid & 63;
    const int S = F.G - Gg;
    if (S > 0 && F.wg < Gg) return;
    __syncthreads();
    LAS float* scr = (LAS float*)(F.lds + F.wave * 16384);
    const int w0 = ((S > 0) ? F.wg - Gg : F.wg) * 8 + F.wave, nw = ((S > 0) ? S : F.G) * 8;
    conv_range(F, l, it_lo + w0, it_hi, nw, scr, F.lane);
}

__device__ __forceinline__ void p0_prologue(const Frame& F0) {
    Frame F = F0; F.tid = F.wave * 64 + lane_id_(); LAUNDER(F.tid); F.lane = F.tid & 63;
    LAS float* scr = (LAS float*)(F.lds + F.wave * 16384);
    const int gw = F.wg * 8 + F.wave, NGW = F.G * 8, lane = F.lane;
    conv_range(F, 0, gw, I_IN, NGW, scr, lane);
    for (int idx = gw * 64 + lane; idx < 2 * 32 * 1024; idx += NGW * 64) {
        const int l = idx / (32 * 1024), j = (idx / 1024) % 32, k = idx % 1024;
        float w = 0.f;
        if (j < 4) w = F.in[IN_WGRP][((size_t)l * D + k) * 4 + j]; else if (j < 20) w = F.in[IN_WEXP][((size_t)l * D + k) * 16 + (j - 4)];
        w *= F.in[IN_NFG][l * D + k];
        const unsigned hi = f2bf(w); const float lo = w - bf2f(hi);
        bf16* wr = (bf16*)(F.ws + WS_WR) + (size_t)l * 2 * 32 * 1024;
        wr[j * 1024 + k] = (bf16)hi; wr[32 * 1024 + j * 1024 + k] = (bf16)f2bf(lo);
    }
    for (int idx = gw * 64 + lane; idx < LT * 32; idx += NGW * 64) {
        const int pos = idx / 32, i = idx % 32;
        const double inv = pow(10000.0, -(double)(2 * i) / 64.0); const double a = (double)pos * inv;
        ((float*)(F.ws + WS_ROPE))[idx] = (float)cos(a); ((float*)(F.ws + WS_ROPE))[LT * 32 + idx] = (float)sin(a);
    }
    {
        f32x4 v[4][4], vn[4][4];
#define HI_LOAD(dst_, m0_) do { _Pragma("unroll") for (int q = 0; q < 4; ++q) { int m = (m0_) + q * NGW; m = m < T ? m : T - 1; const int b = m / LT, t = m % LT; \
                const float* src = (t < NMETA) ? F.in[IN_META] + (size_t)t * D : F.in[IN_X] + ((size_t)b * SEQ + (t - NMETA)) * D; \
                const GAS f32x4* xr = (const GAS f32x4*)src + lane; \
                _Pragma("unroll") for (int j = 0; j < 4; ++j) dst_[q][j] = __builtin_nontemporal_load(xr + 64 * j); } } while (0)
        HI_LOAD(v, gw);
        for (int m0 = gw; m0 < T; m0 += 4 * NGW) {
            HI_LOAD(vn, m0 + 4 * NGW);
#pragma unroll
            for (int q = 0; q < 4; ++q) { const int m = m0 + q * NGW;
                float s = 0.f; u32x2 o[4];
#pragma unroll
                for (int j = 0; j < 4; ++j) { const f32x4 x = v[q][j]; s += (x.x * x.x + x.y * x.y) + (x.z * x.z + x.w * x.w); o[j].x = pk2(x.x, x.y); o[j].y = pk2(x.z, x.w); }
                s = wave_sum(s);
                if (m < T) { GAS u32x2* hb = (GAS u32x2*)((bf16*)(F.ws + WS_HB) + (size_t)m * D) + lane;
#pragma unroll
                    for (int j = 0; j < 4; ++j) hb[64 * j] = o[j];
                    if (lane < 16) ((float*)(F.ws + WS_SS16))[(size_t)m * 16 + lane] = (lane == 0) ? s : 0.f; } }
#pragma unroll
            for (int q = 0; q < 4; ++q)
#pragma unroll
                for (int j = 0; j < 4; ++j) v[q][j] = vn[q][j];
        }
#undef HI_LOAD
    }
    for (int it = F.wg; it < 256; it += F.G) {
        const int l = it >> 7, g = (it >> 3) & 15, part = it & 7;
        LAS f32x2* Ap = (LAS f32x2*)(F.lds);
        LAS f32x2* Bb = Ap + 17 * 64;
        LAS f32x2* Cc = Bb + 64 * 16;
        LAS float* Kj = (LAS float*)(Cc + 16 * 64);
        __syncthreads();
        LAS f32x2* Fs = (LAS f32x2*)(Kj + 4096);
        if (F.tid < 64) { const int n = F.tid;
            const double dt = exp((double)F.in[IN_LDT][l * 16 + g]);
            const double lr = F.in[IN_LRE][(l * 16 + g) * 64 + n], li = F.in[IN_LIM][(l * 16 + g) * 64 + n];
            const double mg = exp(lr * dt), ar = mg * cos(li * dt), ai = mg * sin(li * dt), den = lr * lr + li * li, zr = ar - 1.0, zi = ai;
            Fs[n] = (f32x2){(float)((zr * lr + zi * li) / den), (float)((zi * lr - zr * li) / den)};
            double pr = 1.0, pi = 0.0;
            for (int j = 0; j <= 16; ++j) { Ap[j * 64 + n] = (f32x2){(float)pr, (float)pi}; const double nr = pr * ar - pi * ai, ni = pr * ai + pi * ar; pr = nr; pi = ni; } }
        for (int idx = F.tid; idx < 16 * 64; idx += 512) { const int c = idx / 64, n = idx % 64;
            Cc[idx] = (f32x2){F.in[IN_CRE][((size_t)(l * 16 + g) * 16 + c) * 64 + n], F.in[IN_CIM][((size_t)(l * 16 + g) * 16 + c) * 64 + n]}; }
        __syncthreads();
        for (int idx = F.tid; idx < 64 * 16; idx += 512) { const int n = idx / 16, c = idx % 16; const f32x2 f = Fs[n];
            const float br = F.in[IN_BRE][((size_t)(l * 16 + g) * 64 + n) * 16 + c], bi = F.in[IN_BIM][((size_t)(l * 16 + g) * 64 + n) * 16 + c];
            Bb[idx] = (f32x2){f.x * br - f.y * bi, f.x * bi + f.y * br}; }
        __syncthreads();
        {
            const int co = (F.tid >> 4) & 15, ci = F.tid & 15, j0 = F.tid >> 8;
            float sK[8];
#pragma unroll
            for (int i = 0; i < 8; ++i) sK[i] = 0.f;
            for (int n = 0; n < 64; ++n) { const f32x2 c = Cc[co * 64 + n], b = Bb[n * 16 + ci];
                const float cbr = c.x * b.x - c.y * b.y, cbi = c.x * b.y + c.y * b.x;
#pragma unroll
                for (int i = 0; i < 8; ++i) { const f32x2 a = Ap[(j0 + 2 * i) * 64 + n]; sK[i] += cbr * a.x - cbi * a.y; } }
#pragma unroll
            for (int i = 0; i < 8; ++i) Kj[((j0 + 2 * i) << 8) + (co << 4) + ci] = sK[i];
        }
        if (part == 0 && F.tid < 64) ((f32x2*)(F.ws + WS_S5A))[(l * 16 + g) * 64 + F.tid] = Ap[16 * 64 + F.tid];
        __syncthreads();
        bf16* TQ = (bf16*)(F.ws + WS_S5TQ) + (size_t)(l * 16 + g) * 256 * 384;
        for (int idx = part * 32 * 384 + F.tid; idx < (part + 1) * 32 * 384; idx += 512) { const int nn = idx / 384, k = idx % 384, t = nn >> 4, co = nn & 15; float v;
            if (k < 256) { const int s = k >> 4, ci = k & 15; v = (s <= t) ? Kj[((t - s) << 8) + (co << 4) + ci] : 0.f; if (s == t && ci == co) v += F.in[IN_S5D][l * 256 + g * 16 + co]; }
            else { const int kk = k - 256, n = kk >> 1; const f32x2 a = Ap[(t + 1) * 64 + n], c = Cc[co * 64 + n];
                const float zr = c.x * a.x - c.y * a.y, zi = c.x * a.y + c.y * a.x; v = (kk & 1) ? -zi : zr; }
            TQ[idx] = (bf16)f2bf(v); }
        bf16* PM = (bf16*)(F.ws + WS_S5P) + (size_t)(l * 16 + g) * 256 * 256;
        for (int idx = part * 32 * 256 + F.tid; idx < (part + 1) * 32 * 256; idx += 512) { const int nn = idx >> 8, k = idx & 255; float v = 0.f;
            if (nn < 128) { const int n = nn >> 1, s = k >> 4, ci = k & 15; const f32x2 a = Ap[(15 - s) * 64 + n], b = Bb[n * 16 + ci];
                v = (nn & 1) ? (a.x * b.y + a.y * b.x) : (a.x * b.x - a.y * b.y); }
            PM[idx] = (bf16)f2bf(v); }
        __syncthreads();
    }
}

template <class V> __device__ __forceinline__ V ldg(const void* sbase, unsigned voff) { return *(const GAS V*)((const char*)sbase + voff); }
template <class V> __device__ __forceinline__ void stg(void* sbase, unsigned voff, V v) { *(GAS V*)((char*)sbase + voff) = v; }
template <class V> __device__ __forceinline__ void stg_nt(void* sbase, unsigned voff, V v) { __builtin_nontemporal_store(v, (GAS V*)((char*)sbase + voff)); }
__device__ __forceinline__ u32x4 bufld16(__amdgpu_buffer_rsrc_t r, unsigned voff, unsigned soff) { return __builtin_bit_cast(u32x4, __builtin_amdgcn_raw_buffer_load_b128(r, (int)voff, (int)soff, 0)); }
#define GLDS2(p0, p1, dst) do { __builtin_amdgcn_global_load_lds((const unsigned*)(p0), (LAS unsigned*)(dst), 16, 0, 0); __builtin_amdgcn_global_load_lds((const unsigned*)(p1), (LAS unsigned*)((dst) + 8192), 16, 0, 0); } while (0)
#define EPI_FENCE() __builtin_amdgcn_sched_barrier(0)
struct UnitT { int pm, pn; };

struct PolIn {
    typedef UnitT Unit; static constexpr int NT = 16, LDB = 1024;
    pg8::TileOrder ord; const bf16* A; const bf16* B; bf16* proj; const float* ss16; const float* rope; bf16* X;
    __device__ __forceinline__ bool next(int i, Unit& u) const { return ord.get(i, u.pm, u.pn); }
    __device__ __forceinline__ void stage_a(LAS unsigned char* dst, int, const Unit& u, int t, int h, const int (&R)[2], const int (&C)[2]) const {
        const char* bp = (const char*)(A + (size_t)(u.pm * 256 + h * 128) * 1024) + t * 128;
        GLDS2(bp + (unsigned)((R[0] * 1024 + C[0]) * 2), bp + (unsigned)((R[1] * 1024 + C[1]) * 2), dst); }
    __device__ __forceinline__ const char* b_ptr(const Unit& u, int t) const { return (const char*)(B + (size_t)u.pn * 256 * 1024) + t * 128; }
    __device__ __forceinline__ void epi(const AccT& acc, const Unit& u, int wr, int wc, int fr, int fq, int) const {
        const bool isrope = (u.pn >= 5 && u.pn <= 8); const float qs = (u.pn == 5 || u.pn == 6) ? QSCALE : 1.f;
        const unsigned fi = 4u * (4u * (wc & 1) + fq);
        const unsigned vo_p = (unsigned)((fr * NI + u.pn * 256 + wc * 32 + 8 * fq) * 2), vo_s = (unsigned)(fr * 64);
        const int row00 = u.pm * 256 + wr * 64;
        f32x4 ssv[8];
#pragma unroll
        for (int g = 0; g < 8; ++g) ssv[g] = ldg<f32x4>(ss16, (unsigned)(row00 + (g >> 2) * 128 + (g & 3) * 16) * 64u + vo_s + 16u * fq);
        f32x4 csA = (f32x4){1.f, 1.f, 1.f, 1.f}, snA = (f32x4){0.f, 0.f, 0.f, 0.f};
#define IN_LOAD(g_, c_, n_) do { if (isrope) { const int ru_ = row00 + ((g_) >> 2) * 128 + ((g_) & 3) * 16; const unsigned pos_ = (unsigned)(ru_ + fr) % (unsigned)LT; \
            c_ = ldg<f32x4>(rope, (pos_ * 32 + fi) * 4); n_ = ldg<f32x4>(rope, (LT * 32 + pos_ * 32 + fi) * 4); } } while (0)
        IN_LOAD(0, csA, snA);
#pragma unroll
        for (int g = 0; g < 8; ++g) {
            const int ai = g >> 2, m = g & 3;
            const f32x4 csB = csA, snB = snA;
            if (g < 7) IN_LOAD(g + 1, csA, snA);
            float ss = (ssv[g].x + ssv[g].y) + (ssv[g].z + ssv[g].w);
            ss += __shfl_xor(ss, 16); ss += __shfl_xor(ss, 32);
            const float rstd = rsqrtf(ss * (1.f / 1024.f) + RMS_EPS);
            bf16* rowp = proj + (size_t)(row00 + ai * 128 + m * 16) * NI;
            bf16* xrow = X + (size_t)((row00 + ai * 128 + m * 16) >> 4) * 384;
#pragma unroll
            for (int bj = 0; bj < 2; ++bj) {
                f32x4 v0 = acc[ai][bj][m][0] * rstd, v1 = acc[ai][bj][m][1] * rstd;
                if (isrope) { const f32x4 o0 = (v0 * csB - v1 * snB) * qs, o1 = (v1 * csB + v0 * snB) * qs; v0 = o0; v1 = o1; }
                u32x4 w; w.x = cvt_pk_bf16(v0[0], v0[1]); w.y = cvt_pk_bf16(v0[2], v0[3]); w.z = cvt_pk_bf16(v1[0], v1[1]); w.w = cvt_pk_bf16(v1[2], v1[3]);
                if (u.pn == 0) stg_nt<u32x4>(xrow, (unsigned)((((2 * wc + 8 * bj + (fq >> 1)) * S5RP) * 384 + fr * 16 + 8 * (fq & 1)) * 2), w);
                else stg_nt<u32x4>(rowp, vo_p + bj * 256, w);
            }
            EPI_FENCE();
        }
#undef IN_LOAD
    }
};

struct UnitS5 { int g, mt; };
struct PolS5E {
    typedef UnitS5 Unit; static constexpr int NT = 4, LDB = 256;
    int G, c; const bf16* X; const bf16* B; float* E;
    __device__ __forceinline__ bool next(int i, Unit& u) const { const int Lx = i * G + c; if (Lx >= 16 * 16) return false; u.g = Lx >> 4; u.mt = Lx & 15; return true; }
    __device__ __forceinline__ void stage_a(LAS unsigned char* dst, int, const Unit& u, int t, int h, const int (&R)[2], const int (&C)[2]) const {
        const char* bp = (const char*)(X + ((size_t)u.g * S5RP + 256 * u.mt + 128 * h + 2 * u.mt + h) * 384) + t * 128;
        GLDS2(bp + (unsigned)((R[0] * 384 + C[0]) * 2), bp + (unsigned)((R[1] * 384 + C[1]) * 2), dst); }
    __device__ __forceinline__ const char* b_ptr(const Unit& u, int t) const { return (const char*)(B + (size_t)u.g * 256 * 256) + t * 128; }
    __device__ __forceinline__ void epi(const AccT& acc, const Unit& u, int wr, int wc, int fr, int fq, int) const {
        const unsigned vo = (unsigned)((fr * 128 + wc * 32 + 8 * fq) * 4);
#pragma unroll
        for (int ai = 0; ai < 2; ++ai)
#pragma unroll
            for (int m = 0; m < 4; ++m) { float* ep = E + ((size_t)u.g * 4096 + u.mt * 256 + ai * 128 + wr * 64 + m * 16) * 128;
                stg<f32x4>(ep, vo, acc[ai][0][m][0]); stg<f32x4>(ep, vo + 16, acc[ai][0][m][1]); }
    }
};

struct PolS5Y {
    typedef UnitS5 Unit; static constexpr int NT = 6, LDB = 384;
    int G, c; const bf16* X; const bf16* B; const bf16* proj; const float* dsk; bf16* Gout; int skipmeta;
    __device__ __forceinline__ int row0(int mt, int half) const { return skipmeta ? (2 * mt + half) * 129 + 1 : 256 * mt + 128 * half; }
    __device__ __forceinline__ bool next(int i, Unit& u) const { const int nt = skipmeta ? 16 : 17; const int Lx = i * G + c; if (Lx >= 16 * nt) return false; u.g = Lx / nt; u.mt = Lx % nt; return true; }
    __device__ __forceinline__ void stage_a(LAS unsigned char* dst, int, const Unit& u, int t, int h, const int (&R)[2], const int (&C)[2]) const {
        const char* bp = (const char*)(X + ((size_t)u.g * S5RP + row0(u.mt, h)) * 384) + t * 128;
        GLDS2(bp + (unsigned)((R[0] * 384 + C[0]) * 2), bp + (unsigned)((R[1] * 384 + C[1]) * 2), dst); }
    __device__ __forceinline__ const char* b_ptr(const Unit& u, int t) const { return (const char*)(B + (size_t)u.g * 256 * 384) + t * 128; }
    __device__ __forceinline__ void epi(const AccT& acc, const Unit& u, int wr, int wc, int fr, int fq, int) const {
        const int ch = u.g * 16 + 8 * (fq & 1);
        const unsigned vo_g = (unsigned)(((16 * fr + (fq >> 1)) * 256 + ch) * 2);
#pragma unroll
        for (int g = 0; g < 8; ++g) { const int ai = g >> 2, m = g & 3, Ru = row0(u.mt, ai) + wr * 64 + m * 16;
            if (Ru + fr < S5R) {
#pragma unroll
                for (int bj = 0; bj < 2; ++bj) { const size_t toku = (size_t)16 * Ru + 8 * bj + 2 * wc;
                    const f32x4 v0 = acc[ai][bj][m][0], v1 = acc[ai][bj][m][1];
                    u32x4 w; w.x = pk2(gelu_tanh(v0[0]), gelu_tanh(v0[1])); w.y = pk2(gelu_tanh(v0[2]), gelu_tanh(v0[3]));
                    w.z = pk2(gelu_tanh(v1[0]), gelu_tanh(v1[1])); w.w = pk2(gelu_tanh(v1[2]), gelu_tanh(v1[3]));
                    stg<u32x4>(Gout + toku * 256, vo_g, w); }
            }
            EPI_FENCE();
        }
    }
};

__device__ __forceinline__ int mtile_row0(int pm, int skipmeta) { return skipmeta ? (pm >> 3) * LT + NMETA + (pm & 7) * 256 : pm * 256; }
struct PolGlu {
    typedef UnitT Unit; static constexpr int NT = 4, LDB = 256;
    pg8::TileOrder ord; const bf16* A; const bf16* B; bf16* mixed; int skipmeta;
    __device__ __forceinline__ bool next(int i, Unit& u) const { return ord.get(i, u.pm, u.pn); }
    __device__ __forceinline__ void stage_a(LAS unsigned char* dst, int, const Unit& u, int t, int h, const int (&R)[2], const int (&C)[2]) const {
        const char* bp = (const char*)(A + (size_t)(mtile_row0(u.pm, skipmeta) + h * 128) * 256) + t * 128;
        GLDS2(bp + (unsigned)((R[0] * 256 + C[0]) * 2), bp + (unsigned)((R[1] * 256 + C[1]) * 2), dst); }
    __device__ __forceinline__ const char* b_ptr(const Unit& u, int t) const { return (const char*)(B + (size_t)u.pn * 256 * 256) + t * 128; }
    __device__ __forceinline__ void epi(const AccT& acc, const Unit& u, int wr, int wc, int fr, int fq, int) const {
        const unsigned vo = (unsigned)((fr * D + u.pn * 128 + wc * 32 + 8 * fq) * 2);
#pragma unroll
        for (int ai = 0; ai < 2; ++ai)
#pragma unroll
            for (int m = 0; m < 4; ++m) { bf16* rp = mixed + (size_t)(mtile_row0(u.pm, skipmeta) + ai * 128 + wr * 64 + m * 16) * D;
                const f32x4 a0 = acc[ai][0][m][0], a1 = acc[ai][0][m][1], b0 = acc[ai][1][m][0], b1 = acc[ai][1][m][1];
                u32x4 w; w.x = pk2(a0[0] * sigmoidf_(b0[0]), a0[1] * sigmoidf_(b0[1])); w.y = pk2(a0[2] * sigmoidf_(b0[2]), a0[3] * sigmoidf_(b0[3]));
                w.z = pk2(a1[0] * sigmoidf_(b1[0]), a1[1] * sigmoidf_(b1[1])); w.w = pk2(a1[2] * sigmoidf_(b1[2]), a1[3] * sigmoidf_(b1[3]));
                stg<u32x4>(rp, vo, w);
                EPI_FENCE(); }
    }
};

template <bool WT>
__device__ __forceinline__ void residual_epi(const AccT& acc, const int (&vrow)[8], int pn, int wc, int fq, const bf16* HB, bf16* HBo, float* ss16, const bool needss) {
    const __amdgpu_buffer_rsrc_t ors = __builtin_amdgcn_make_buffer_rsrc((void*)HBo, 0, 0x7fffffff, 0x00020000);
    const unsigned colb = (unsigned)(pn * 256 + wc * 32 + 8 * fq);
    u32x4 pre[8][2];
#pragma unroll
    for (int g = 0; g < 8; ++g)
#pragma unroll
        for (int bj = 0; bj < 2; ++bj) { pre[g][bj] = (u32x4){0u, 0u, 0u, 0u}; if (vrow[g] >= 0) pre[g][bj] = ldg<u32x4>(HB, ((unsigned)vrow[g] * D + colb) * 2 + bj * 256); }
#pragma unroll
    for (int g = 0; g < 8; ++g) { const int ai = g >> 2, m = g & 3; const bool valid = vrow[g] >= 0; const unsigned vb = ((unsigned)(valid ? vrow[g] : 0) * D + colb) * 2;
        float ssq = 0.f;
#pragma unroll
        for (int bj = 0; bj < 2; ++bj) { const u32x4 hb = pre[g][bj];
            f32x4 h0 = (f32x4){bf2f(hb.x), bf2f(hb.x >> 16), bf2f(hb.y), bf2f(hb.y >> 16)}, h1 = (f32x4){bf2f(hb.z), bf2f(hb.z >> 16), bf2f(hb.w), bf2f(hb.w >> 16)};
            h0 += acc[ai][bj][m][0]; h1 += acc[ai][bj][m][1];
            u32x4 w; w.x = cvt_pk_bf16(h0[0], h0[1]); w.y = cvt_pk_bf16(h0[2], h0[3]); w.z = cvt_pk_bf16(h1[0], h1[1]); w.w = cvt_pk_bf16(h1[2], h1[3]);
            if (valid) { if (WT) __builtin_amdgcn_raw_buffer_store_b128(w, ors, (int)(vb + bj * 256), 0, 16  ); else stg<u32x4>(HBo, vb + bj * 256, w); }
            ssq += (h0[0] * h0[0] + h0[1] * h0[1]) + (h0[2] * h0[2] + h0[3] * h0[3]) + (h1[0] * h1[0] + h1[1] * h1[1]) + (h1[2] * h1[2] + h1[3] * h1[3]);
        }
        if (needss) { ssq += __shfl_xor(ssq, 16); ssq += __shfl_xor(ssq, 32);
            if (valid && fq == 0) stg<float>(ss16, ((unsigned)vrow[g] * 16 + pn * 4 + wc) * 4, ssq); }
    }
}

struct PolOut {
    typedef UnitT Unit; static constexpr int NT = 16, LDB = 1024;
    pg8::TileOrder ord; const bf16* A; const bf16* B; bf16* HB; bf16* HBo; float* ss16; unsigned* pan; int skipmeta;
    __device__ __forceinline__ bool next(int i, Unit& u) const { return ord.get(i, u.pm, u.pn); }
    __device__ __forceinline__ void stage_a(LAS unsigned char* dst, int, const Unit& u, int t, int h, const int (&R)[2], const int (&C)[2]) const {
        const char* bp = (const char*)(A + (size_t)(mtile_row0(u.pm, skipmeta) + h * 128) * 1024) + t * 128;
        GLDS2(bp + (unsigned)((R[0] * 1024 + C[0]) * 2), bp + (unsigned)((R[1] * 1024 + C[1]) * 2), dst); }
    __device__ __forceinline__ const char* b_ptr(const Unit& u, int t) const { return (const char*)(B + (size_t)u.pn * 256 * 1024) + t * 128; }
    __device__ __forceinline__ void epi(const AccT& acc, const Unit& u, int wr, int wc, int fr, int fq, int) const {
        int vrow[8];
#pragma unroll
        for (int g = 0; g < 8; ++g) vrow[g] = mtile_row0(u.pm, skipmeta) + (g >> 2) * 128 + wr * 64 + (g & 3) * 16 + fr;
        residual_epi<false>(acc, vrow, u.pn, wc, fq, HB, HBo, ss16, false);
    }
};

struct MoeList {
    LAS const int* cnt;
    __device__ __forceinline__ int ntiles() const { int s = 0; for (int c = 0; c < NCLS; ++c) s += (cnt[c] + 255) >> 8; return __builtin_amdgcn_readfirstlane(s); }
    __device__ __forceinline__ void decode(int gt, int& c, int& ti, int& nvalid) const {
        int s = 0, cc = 0, tt = 0, nv = 0;
        for (int k = 0; k < NCLS; ++k) { const int n = (cnt[k] + 255) >> 8; if (gt >= s && gt < s + n) { cc = k; tt = gt - s; nv = cnt[k] - 256 * tt; } s += n; }
        c = __builtin_amdgcn_readfirstlane(cc); ti = __builtin_amdgcn_readfirstlane(tt); nvalid = __builtin_amdgcn_readfirstlane(nv > 256 ? 256 : nv);
    }
};
__device__ __forceinline__ void class_experts(int c, int& ea, int& eb) {
    const int g = c / 6, p = c % 6; const int a = (p < 3) ? 0 : (p < 5 ? 1 : 2); const int b = (p < 3) ? p + 1 : (p < 5 ? p - 1 : 3);
    ea = g * 4 + a; eb = g * 4 + b;
}
struct UnitM { int gt, pn, c; };

struct PolGU {
    typedef UnitM Unit; static constexpr int NT = 16, LDB = 1024;
    int G, c, ntl; MoeList ml; LAS const int* tab;
    const bf16* HB; const bf16* W; bf16* he; const float* rstd; const float* gate;
    __device__ __forceinline__ bool next(int i, Unit& u) const { const int Lx = i * G + c; if (Lx >= ntl * 8) return false; u.gt = Lx >> 3; u.pn = Lx & 7; int ti, nv; ml.decode(u.gt, u.c, ti, nv); return true; }
    __device__ __forceinline__ void stage_a(LAS unsigned char* dst, int ui, const Unit&, int t, int h, const int (&R)[2], const int (&C)[2]) const {
        const char* bp = (const char*)HB + t * 128;
        const int t0 = tab[ui * 256 + 128 * h + R[0]], t1 = tab[ui * 256 + 128 * h + R[1]];
        GLDS2(bp + (unsigned)((t0 < 0 ? 0 : t0) * 2048 + C[0] * 2), bp + (unsigned)((t1 < 0 ? 0 : t1) * 2048 + C[1] * 2), dst); }
    __device__ __forceinline__ const char* b_ptr(const Unit& u, int t) const { int ea, eb; class_experts(u.c, ea, eb); const int e = (u.pn >> 2) ? eb : ea;
        return (const char*)(W + ((size_t)e * 1024 + (u.pn & 3) * 256) * 1024) + t * 128; }
    __device__ __forceinline__ void epi(const AccT& acc, const Unit& u, int wr, int wc, int fr, int fq, int ui) const {
        const int sel = u.pn >> 2;
        const unsigned vo = (unsigned)((fr * 1024 + sel * 512 + (u.pn & 3) * 128 + wc * 32 + 8 * fq) * 2);
        float rsv[8], gwv[8];
#pragma unroll
        for (int g = 0; g < 8; ++g) { const int tk = tab[ui * 256 + (g >> 2) * 128 + wr * 64 + (g & 3) * 16 + fr]; rsv[g] = 0.f; gwv[g] = 0.f;
            if (tk >= 0) { rsv[g] = ldg<float>(rstd, (unsigned)tk * 4); gwv[g] = ldg<float>(gate, (unsigned)(2 * tk + sel) * 4); } }
#pragma unroll
        for (int g = 0; g < 8; ++g) { const int ai = g >> 2, m = g & 3, ru = ai * 128 + wr * 64 + m * 16; const float rs = rsv[g], gw = gwv[g];
            const f32x4 g0 = acc[ai][0][m][0] * rs, g1 = acc[ai][0][m][1] * rs, u0 = acc[ai][1][m][0] * (rs * gw), u1 = acc[ai][1][m][1] * (rs * gw);
            u32x4 w; w.x = pk2(siluf_(g0[0]) * u0[0], siluf_(g0[1]) * u0[1]); w.y = pk2(siluf_(g0[2]) * u0[2], siluf_(g0[3]) * u0[3]);
            w.z = pk2(siluf_(g1[0]) * u1[0], siluf_(g1[1]) * u1[1]); w.w = pk2(siluf_(g1[2]) * u1[2], siluf_(g1[3]) * u1[3]);
            stg<u32x4>(he + ((size_t)u.gt * 256 + ru) * 1024, vo, w);
            EPI_FENCE(); }
    }
};

struct PolDN {
    typedef UnitM Unit; static constexpr int NT = 16, LDB = 512;
    int G, c, ntl; MoeList ml; LAS const int* tab;
    const bf16* he; const bf16* W; bf16* HB; bf16* HBo; float* ss16; int needss;
    __device__ __forceinline__ bool next(int i, Unit& u) const { const int Lx = i * G + c; if (Lx >= ntl * 4) return false; u.gt = Lx >> 2; u.pn = Lx & 3; int ti, nv; ml.decode(u.gt, u.c, ti, nv); return true; }
    __device__ __forceinline__ void stage_a(LAS unsigned char* dst, int, const Unit& u, int t, int h, const int (&R)[2], const int (&C)[2]) const {
        const char* bp = (const char*)(he + (size_t)(u.gt * 256 + h * 128) * 1024) + t * 128;
        GLDS2(bp + (unsigned)((R[0] * 1024 + C[0]) * 2), bp + (unsigned)((R[1] * 1024 + C[1]) * 2), dst); }
    __device__ __forceinline__ const char* b_ptr(const Unit& u, int t) const { int ea, eb; class_experts(u.c, ea, eb); const int e = (t >= 8) ? eb : ea;
        return (const char*)(W + ((size_t)e * 1024 + u.pn * 256) * 512) + (t & 7) * 128; }
    __device__ __forceinline__ void epi(const AccT& acc, const Unit& u, int wr, int wc, int fr, int fq, int ui) const {
        int vrow[8];
#pragma unroll
        for (int g = 0; g < 8; ++g) vrow[g] = tab[ui * 256 + (g >> 2) * 128 + wr * 64 + (g & 3) * 16 + fr];
        residual_epi<false>(acc, vrow, u.pn, wc, fq, HB, HBo, ss16, needss != 0);
    }
};

#define MFMA16(a, b, c) __builtin_amdgcn_mfma_f32_16x16x32_bf16(a, b, c, 0, 0, 0)
#define MFMA32(a, b, c) __builtin_amdgcn_mfma_f32_32x32x16_bf16(a, b, c, 0, 0, 0)

__device__ __forceinline__ int wq_fetch(unsigned* ctr, const Frame& F) {
    volatile LAS int* slot = (volatile LAS int*)(F.lds + MISC_OFF) + 20;
    __syncthreads();
    if (F.tid == 0) *slot = (int)__hip_atomic_fetch_add(ctr, 1u, __ATOMIC_RELAXED, __HIP_MEMORY_SCOPE_AGENT);
    __syncthreads();
    return __builtin_amdgcn_readfirstlane(*slot);
}

__device__ __forceinline__ void s5_scan(const Frame& F0, int l) {
    Frame F = F0; F.tid = F.wave * 64 + lane_id_(); LAUNDER(F.tid); F.lane = F.tid & 63;
    const float* E = (const float*)(F.os + OS_E); bf16* X = (bf16*)(F.os + OS_X);
    const int lane = F.lane;
    for (int it = F.wg + F.G * F.wave; it < NB * 16; it += F.G * 8) {
        const int b = it >> 4, g = it & 15;
        const f32x2 A16 = ((const f32x2*)(F.ws + WS_S5A))[(l * 16 + g) * 64 + lane];
        float sr = 0.f, si = 0.f;
        for (int r0 = 0; r0 < NCH; r0 += 43) {
            f32x2 e[43];
#pragma unroll
            for (int j = 0; j < 43; ++j) { e[j] = (f32x2){0.f, 0.f}; if (r0 + j < NCH - 1) e[j] = *(const GAS f32x2*)(E + ((size_t)g * 4096 + b * 128 + r0 + j) * 128 + 2 * lane); }
#pragma unroll
            for (int j = 0; j < 43; ++j) if (r0 + j < NCH) { const size_t R = (size_t)b * NCH + r0 + j;
                bf16* xr = X + ((size_t)g * S5RP + R) * 384;
                *(GAS unsigned*)(xr + 256 + 2 * lane) = pk2(sr, si);
                const float nr = A16.x * sr - A16.y * si + e[j].x, ni = A16.x * si + A16.y * sr + e[j].y; sr = nr; si = ni; }
        }
    }
}

__device__ __forceinline__ float hgrn_lb(const float* hlb, int l, int j) {
    if (l == 0) return 0.f;
    const float x0 = hlb[j], x1 = hlb[256 + j], mx = fmaxf(x0, x1), e0 = __expf(x0 - mx), e1 = __expf(x1 - mx);
    return e1 / (e0 + e1);
}
__device__ __forceinline__ void hgrn_gate(float z, float lbA, float onem, float& lf, float& k) {
    const float e = __expf(-fabsf(z)), r = __builtin_amdgcn_rcpf(1.f + e), er = e * r;
    const float s = (z >= 0.f) ? r : er, c = (z >= 0.f) ? er : r;
    lf = __logf(lbA + onem * s); k = onem * c;
}
constexpr int HG_LP = 68, HG_LF = 0, HG_SEG = 64 * HG_LP * 4, HG_T0 = HG_SEG + 1024, HG_TS = 9216, HG_HALF = HG_T0 + 5 * HG_TS;
static_assert(2 * HG_HALF <= MISC_OFF, "HGRN LDS map");

__device__ __forceinline__ void hgrn_a(const Frame& F0, int l) {
    Frame F = F0; F.tid = F.wave * 64 + lane_id_(); LAUNDER(F.tid); F.lane = F.tid & 63;
    const bf16* proj = (const bf16*)(F.ws + WS_PROJ); float* UT = (float*)(F.os + OS_UT); float* DEC = (float*)(F.os + OS_DEC);
    const int half = F.tid >> 8, ht = F.tid & 255, hw = F.wave & 3, lane = F.lane;
    LAS unsigned char* base = F.lds + half * HG_HALF;
    LAS float* LF = (LAS float*)(base + HG_LF); LAS float* SEG = (LAS float*)(base + HG_SEG);
    LAS bf16* vT = (LAS bf16*)(base + HG_T0); LAS bf16* KDT = (LAS bf16*)(base + HG_T0 + HG_TS);
    unsigned* qh = (unsigned*)F.ws + CW_Q + (l * 4 + 1) * 64;
    constexpr int NP = NB * 4 * HCH / 2, NSTAT = 7;
    int kq = 0;
#pragma unroll 1
    for (int p = F.wg; p < NP; p = (++kq < NSTAT) ? F.wg + kq * F.G : NSTAT * F.G + wq_fetch(qh, F)) {
        const int item = 2 * p + half, c = item % HCH, bh = item / HCH, b = bh >> 2, h = bh & 3;
        const size_t tok0 = (size_t)b * LT + (c == 0 ? 0 : 16 + 64 * (c - 1)); const int nrows = (c == 0) ? 16 : 64;
        float lbA[8], onem[8];
#pragma unroll
        for (int jj = 0; jj < 8; ++jj) { const float lb = hgrn_lb(F.in[IN_HLB], l, h * 64 + 8 * (ht & 7) + jj); lbA[jj] = fmaxf(lb, 1e-30f); onem[jj] = 1.f - lb; }
#pragma unroll
        for (int e = 0; e < 2; ++e) { const int idx = ht + 256 * e, t = idx >> 3, c8 = idx & 7; const bool valid = t < nrows;
            u32x4 zf = (u32x4){0u, 0u, 0u, 0u}, zi = zf;
            if (valid) { zf = *(const GAS u32x4*)(proj + (tok0 + t) * NI + C_HF + h * 64 + 8 * c8); zi = *(const GAS u32x4*)(proj + (tok0 + t) * NI + C_HI + h * 64 + 8 * c8); }
#pragma unroll
            for (int jj = 0; jj < 8; ++jj) { const int d = 8 * c8 + jj; const unsigned wf = (jj & 1) ? (zf[jj >> 1] >> 16) : (zf[jj >> 1] & 0xffffu); const unsigned wi = (jj & 1) ? (zi[jj >> 1] >> 16) : (zi[jj >> 1] & 0xffffu);
                float lf, kk; hgrn_gate(bf2f(wf), lbA[jj], onem[jj], lf, kk); LF[t * HG_LP + d] = valid ? lf : 0.f;
                vT[d * 72 + t] = (bf16)wi; }
        }
        __syncthreads();
        const int d = ht & 63, seg = ht >> 6;
        { float run = 0.f;
#pragma unroll
          for (int i = 0; i < 16; ++i) { run += LF[(16 * seg + i) * HG_LP + d]; LF[(16 * seg + i) * HG_LP + d] = run; }
          SEG[seg * 64 + d] = run; }
        __syncthreads();
        { float offs = 0.f, last = 0.f;
#pragma unroll
          for (int s = 0; s < 4; ++s) { const float v = SEG[s * 64 + d]; if (s < seg) offs += v; last += v; }
          float prev = 0.f;
#pragma unroll
          for (int i = 0; i < 16; ++i) { const int t = 16 * seg + i; const float cl = LF[t * HG_LP + d], lf = cl - prev; prev = cl;
              const float k = 1.f - __expf(lf); KDT[d * 72 + t] = (bf16)f2bf(k * __expf(last - (cl + offs))); }
          if (seg == 0) DEC[(size_t)item * 64 + d] = __expf(last); }
        __syncthreads();
        f32x4 acc[4];
#pragma unroll
        for (int nt = 0; nt < 4; ++nt) acc[nt] = (f32x4){0.f, 0.f, 0.f, 0.f};
#pragma unroll
        for (int ks = 0; ks < 2; ++ks) { const bf16x8 a = *(const LAS bf16x8*)(vT + (16 * hw + (lane & 15)) * 72 + 32 * ks + 8 * (lane >> 4));
#pragma unroll
            for (int nt = 0; nt < 4; ++nt) { const bf16x8 bb = *(const LAS bf16x8*)(KDT + (16 * nt + (lane & 15)) * 72 + 32 * ks + 8 * (lane >> 4)); acc[nt] = MFMA16(bb, a, acc[nt]); } }
#pragma unroll
        for (int nt = 0; nt < 4; ++nt) *(GAS f32x4*)(UT + (size_t)item * 4096 + (16 * hw + (lane & 15)) * 64 + 16 * nt + 4 * (lane >> 4)) = acc[nt];
        __syncthreads();
    }
}

__device__ __forceinline__ void hgrn_b(const Frame& F0) {
    Frame F = F0; F.tid = F.wave * 64 + lane_id_(); LAUNDER(F.tid); F.lane = F.tid & 63;
    const float* UT = (const float*)(F.os + OS_UT); const float* DEC = (const float*)(F.os + OS_DEC); bf16* SP = (bf16*)(F.os + OS_SP);
    constexpr int NBLK = NB * 4 * 8;
    for (int blk0 = F.wg; blk0 < NBLK; blk0 += 4 * F.G) {
        float S[4] = {0.f, 0.f, 0.f, 0.f};
        for (int c0 = 0; c0 < HCH; c0 += 11) {
            float ut[4][11], dc[4][11];
#pragma unroll
            for (int q = 0; q < 4; ++q) { const int blk = blk0 + q * F.G; const int bh = blk >> 3, e = (blk & 7) * 512 + F.tid, d = e & 63;
#pragma unroll
                for (int j = 0; j < 11; ++j) { ut[q][j] = 0.f; dc[q][j] = 0.f; if (blk < NBLK) { const size_t item = (size_t)bh * HCH + c0 + j; ut[q][j] = UT[item * 4096 + e]; dc[q][j] = DEC[item * 64 + d]; } } }
#pragma unroll
            for (int q = 0; q < 4; ++q) { const int blk = blk0 + q * F.G; const int bh = blk >> 3, e = (blk & 7) * 512 + F.tid;
                if (blk < NBLK) {
#pragma unroll
                    for (int j = 0; j < 11; ++j) { const size_t item = (size_t)bh * HCH + c0 + j; SP[item * 4096 + e] = (bf16)f2bf(S[q]); S[q] = dc[q][j] * S[q] + ut[q][j]; } } }
        }
    }
}

__device__ __forceinline__ void hgrn_c(const Frame& F0, int l) {
    Frame F = F0; F.tid = F.wave * 64 + lane_id_(); LAUNDER(F.tid); F.lane = F.tid & 63;
    const bf16* proj = (const bf16*)(F.ws + WS_PROJ); const bf16* SPg = (const bf16*)(F.os + OS_SP); bf16* mixed = (bf16*)(F.ws + WS_MIXED);
    const int half = F.tid >> 8, ht = F.tid & 255, hw = F.wave & 3, lane = F.lane;
    LAS unsigned char* base = F.lds + half * HG_HALF;
    LAS float* LF = (LAS float*)(base + HG_LF); LAS float* SEG = (LAS float*)(base + HG_SEG);
    LAS bf16* vT = (LAS bf16*)(base + HG_T0); LAS bf16* QT = vT + HG_TS / 2; LAS bf16* KT = QT + HG_TS / 2; LAS bf16* QS = KT + HG_TS / 2; LAS bf16* SPt = QS + HG_TS / 2;
    LAS bf16* P = QT;
    LAS bf16* OT = QS;
    float ngv[4];
#pragma unroll
    for (int nt = 0; nt < 4; ++nt) ngv[nt] = F.in[IN_HNG][l * 64 + 16 * nt + (lane & 15)];
    unsigned* qh = (unsigned*)F.ws + CW_Q + (l * 4 + 2) * 64;
    constexpr int NP = NB * 4 * HCH / 2, NSTAT = 7;
    int kk = 0;
#pragma unroll 1
    for (int p = F.wg; p < NP; p = (++kk < NSTAT) ? F.wg + kk * F.G : NSTAT * F.G + wq_fetch(qh, F)) {
        const int item = 2 * p + half, c = item % HCH, bh = item / HCH, b = bh >> 2, h = bh & 3;
        const size_t tok0 = (size_t)b * LT + (c == 0 ? 0 : 16 + 64 * (c - 1)); const int nrows = (c == 0) ? 16 : 64;
        float qv[16], kv[16], lbA[8], onem[8]; u32x4 zgv[2];
#pragma unroll
        for (int jj = 0; jj < 8; ++jj) { const float lb = hgrn_lb(F.in[IN_HLB], l, h * 64 + 8 * (ht & 7) + jj); lbA[jj] = fmaxf(lb, 1e-30f); onem[jj] = 1.f - lb; }
#pragma unroll
        for (int e = 0; e < 2; ++e) { const int idx = ht + 256 * e, t = idx >> 3, c8 = idx & 7; const bool valid = t < nrows;
            u32x4 zq = (u32x4){0u, 0u, 0u, 0u}, zf = zq, zi = zq; zgv[e] = zq;
            if (valid) { const bf16* rp = proj + (tok0 + t) * NI + h * 64 + 8 * c8; zq = *(const GAS u32x4*)(rp + C_HQ); zf = *(const GAS u32x4*)(rp + C_HF); zi = *(const GAS u32x4*)(rp + C_HI); zgv[e] = *(const GAS u32x4*)(rp + C_HG); }
            const u32x4 sp = *(const GAS u32x4*)(SPg + (size_t)item * 4096 + t * 64 + 8 * c8);
            *(LAS u32x4*)(SPt + t * 72 + 8 * c8) = sp;
            float lfr[8];
#pragma unroll
            for (int jj = 0; jj < 8; ++jj) { const int d = 8 * c8 + jj; const unsigned wq = (jj & 1) ? (zq[jj >> 1] >> 16) : (zq[jj >> 1] & 0xffffu);
                const unsigned wf = (jj & 1) ? (zf[jj >> 1] >> 16) : (zf[jj >> 1] & 0xffffu); const unsigned wi = (jj & 1) ? (zi[jj >> 1] >> 16) : (zi[jj >> 1] & 0xffffu);
                float lf, kx; hgrn_gate(bf2f(wf), lbA[jj], onem[jj], lf, kx);
                lfr[jj] = valid ? lf : 0.f; kv[8 * e + jj] = valid ? kx : 0.f; qv[8 * e + jj] = valid ? siluf_(bf2f(wq)) : 0.f;
                vT[d * 72 + t] = (bf16)wi; }
            *(LAS f32x4*)(LF + t * HG_LP + 8 * c8) = (f32x4){lfr[0], lfr[1], lfr[2], lfr[3]}; *(LAS f32x4*)(LF + t * HG_LP + 8 * c8 + 4) = (f32x4){lfr[4], lfr[5], lfr[6], lfr[7]};
        }
        __syncthreads();
        { const int d = ht & 63, seg = ht >> 6; float run = 0.f;
#pragma unroll
          for (int i = 0; i < 16; ++i) { run += LF[(16 * seg + i) * HG_LP + d]; LF[(16 * seg + i) * HG_LP + d] = run; }
          SEG[seg * 64 + d] = run; }
        __syncthreads();
#pragma unroll
        for (int e = 0; e < 2; ++e) { const int idx = ht + 256 * e, t = idx >> 3, c8 = idx & 7, seg = t >> 4;
            float cum[8], mid[8];
            { const f32x4 a0 = *(const LAS f32x4*)(LF + t * HG_LP + 8 * c8), a1 = *(const LAS f32x4*)(LF + t * HG_LP + 8 * c8 + 4);
              const f32x4 m0 = *(const LAS f32x4*)(LF + 31 * HG_LP + 8 * c8), m1 = *(const LAS f32x4*)(LF + 31 * HG_LP + 8 * c8 + 4);
              const f32x4 s0 = *(const LAS f32x4*)(SEG + 8 * c8), s1 = *(const LAS f32x4*)(SEG + 8 * c8 + 4);
#pragma unroll
              for (int q = 0; q < 4; ++q) { cum[q] = a0[q]; cum[4 + q] = a1[q]; mid[q] = m0[q] + s0[q]; mid[4 + q] = m1[q] + s1[q]; }
#pragma unroll
              for (int s = 0; s < 3; ++s) if (s < seg) { const f32x4 o0 = *(const LAS f32x4*)(SEG + s * 64 + 8 * c8), o1 = *(const LAS f32x4*)(SEG + s * 64 + 8 * c8 + 4);
#pragma unroll
                  for (int q = 0; q < 4; ++q) { cum[q] += o0[q]; cum[4 + q] += o1[q]; } } }
            unsigned wq[4], wk[4], ws[4];
#pragma unroll
            for (int jp = 0; jp < 4; ++jp) { float qt[2], kt[2], qs[2];
#pragma unroll
                for (int u = 0; u < 2; ++u) { const int jj = 2 * jp + u; const float q = qv[8 * e + jj], k = kv[8 * e + jj];
                    qt[u] = q * __expf(cum[jj] - mid[jj]); kt[u] = k * __expf(mid[jj] - cum[jj]); qs[u] = q * __expf(cum[jj]); }
                wq[jp] = pk2(qt[0], qt[1]); wk[jp] = pk2(kt[0], kt[1]); ws[jp] = pk2(qs[0], qs[1]); }
            *(LAS u32x4*)(QT + t * 72 + 8 * c8) = (u32x4){wq[0], wq[1], wq[2], wq[3]};
            *(LAS u32x4*)(KT + t * 72 + 8 * c8) = (u32x4){wk[0], wk[1], wk[2], wk[3]};
            *(LAS u32x4*)(QS + t * 72 + 8 * c8) = (u32x4){ws[0], ws[1], ws[2], ws[3]};
        }
        __syncthreads();
        const int ar = (16 * hw + (lane & 15)) * 72 + 8 * (lane >> 4);
        {
            f32x4 sc[4];
#pragma unroll
            for (int nt = 0; nt < 4; ++nt) sc[nt] = (f32x4){0.f, 0.f, 0.f, 0.f};
#pragma unroll
            for (int ks = 0; ks < 2; ++ks) { const bf16x8 a = *(const LAS bf16x8*)(QT + ar + 32 * ks);
#pragma unroll
                for (int nt = 0; nt < 4; ++nt) { const bf16x8 bb = *(const LAS bf16x8*)(KT + (16 * nt + (lane & 15)) * 72 + 32 * ks + 8 * (lane >> 4)); sc[nt] = MFMA16(a, bb, sc[nt]); } }
#pragma unroll
            for (int nt = 0; nt < 4; ++nt)
#pragma unroll
                for (int j = 0; j < 4; ++j) { const int t = 16 * hw + 4 * (lane >> 4) + j, s = 16 * nt + (lane & 15); P[t * 72 + s] = (bf16)f2bf(s <= t ? sc[nt][j] : 0.f); }
        }
        __syncthreads();
        f32x4 o[4];
#pragma unroll
        for (int nt = 0; nt < 4; ++nt) o[nt] = (f32x4){0.f, 0.f, 0.f, 0.f};
#pragma unroll
        for (int ks = 0; ks < 2; ++ks) { const bf16x8 a = *(const LAS bf16x8*)(P + ar + 32 * ks), a2 = *(const LAS bf16x8*)(QS + ar + 32 * ks);
#pragma unroll
            for (int nt = 0; nt < 4; ++nt) { const int br = (16 * nt + (lane & 15)) * 72 + 32 * ks + 8 * (lane >> 4);
                o[nt] = MFMA16(a, *(const LAS bf16x8*)(vT + br), o[nt]); o[nt] = MFMA16(a2, *(const LAS bf16x8*)(SPt + br), o[nt]); } }
#pragma unroll
        for (int j = 0; j < 4; ++j) { const int t = 16 * hw + 4 * (lane >> 4) + j;
            float ssq = o[0][j] * o[0][j] + o[1][j] * o[1][j] + o[2][j] * o[2][j] + o[3][j] * o[3][j];
            ssq += __shfl_xor(ssq, 1); ssq += __shfl_xor(ssq, 2); ssq += __shfl_xor(ssq, 4); ssq += __shfl_xor(ssq, 8);
            const float rn = rsqrtf(ssq * (1.f / 64.f) + RMS_EPS);
#pragma unroll
            for (int nt = 0; nt < 4; ++nt) OT[t * 72 + 16 * nt + (lane & 15)] = (bf16)f2bf(o[nt][j] * rn * ngv[nt]); }
        __syncthreads();
#pragma unroll
        for (int e = 0; e < 2; ++e) { const int idx = ht + 256 * e, t = idx >> 3, c8 = idx & 7;
            if (t < nrows) { const u32x4 ov = *(const LAS u32x4*)(OT + t * 72 + 8 * c8); const u32x4 zg = zgv[e]; u32x4 w;
#pragma unroll
                for (int q = 0; q < 4; ++q) { const float g0 = bf2f(zg[q]), g1 = bf2f(zg[q] >> 16); w[q] = pk2(bf2f(ov[q]) * siluf_(g0), bf2f(ov[q] >> 16) * siluf_(g1)); }
                *(GAS u32x4*)(mixed + (tok0 + t) * D + 256 + h * 64 + 8 * c8) = w; } }
        __syncthreads();
    }
}

constexpr int AT_KP = 144;
constexpr int AT_KB = 64 * AT_KP, AT_VB = 16384, AT_K = 0, AT_V = 3 * AT_KB, AT_SG = AT_V + 3 * AT_VB, AT_O0 = AT_SG + 512;
static_assert(AT_O0 + 8 * 8192 <= MISC_OFF, "attention LDS map");
typedef short v4i16_t __attribute__((ext_vector_type(4)));
__device__ __forceinline__ s16x4 vtr(const LAS unsigned char* p) { return __builtin_bit_cast(s16x4, __builtin_amdgcn_ds_read_tr16_b64_v4i16((LAS v4i16_t*)p)); }
__device__ __forceinline__ float u2f_(unsigned u) { return __builtin_bit_cast(float, u); }
__device__ __forceinline__ float xhalf_max(float v) { const unsigned a = __builtin_bit_cast(unsigned, v); auto rr = __builtin_amdgcn_permlane32_swap(a, a, false, false); const unsigned r0 = rr[0], r1 = rr[1]; return fmaxf(u2f_(r0), u2f_(r1)); }
__device__ __forceinline__ float xhalf_sum(float v) { const unsigned a = __builtin_bit_cast(unsigned, v); auto rr = __builtin_amdgcn_permlane32_swap(a, a, false, false); const unsigned r0 = rr[0], r1 = rr[1]; return u2f_(r0) + u2f_(r1); }
__device__ __forceinline__ int crow(int r, int hi) { return (r & 3) + 8 * (r >> 2) + 4 * hi; }
#ifndef AT_PROBE
#define AT_PROBE 0
#endif
#define AT_SBAR() __builtin_amdgcn_sched_barrier(0)
#define AT_PIN(x) asm volatile("" : "+v"(x))
__device__ __forceinline__ int attn_unit(const Frame& F, int b, int h, int j, unsigned* qh, const bool probe) {
    const bool p_nost = (AT_PROBE != 0) && probe;
    const bf16* proj = (const bf16*)(F.ws + WS_PROJ); bf16* mixed = (bf16*)(F.ws + WS_MIXED);
    int tid_ = F.wave * 64 + lane_id_(); LAUNDER(tid_);
    const int tid = tid_, lane = tid & 63, w = F.wave, r32 = lane & 31, hi = lane >> 5;
    const int qbase = (j == 0) ? 0 : 16 + 256 * (j - 1), ntile = (j == 0) ? 1 : 4 * j + 1;
    const int qrow = qbase + 32 * w + r32;
    const int qlast = qbase + 32 * w + 31;
    const bf16* pb = proj + (size_t)b * LT * NI + h * 128;
    bf16* ob = mixed + ((size_t)b * LT + qbase + 32 * w) * D + 512 + h * 128;
    const __amdgpu_buffer_rsrc_t prs = __builtin_amdgcn_make_buffer_rsrc((void*)pb, 0, 0x7fffffff, 0x00020000);
    LAS unsigned char* Kc = F.lds + AT_K; LAS unsigned char* Vc = F.lds + AT_V;
    const unsigned vo_k = (unsigned)(((tid >> 3) * NI + C_AK + 8 * (tid & 7)) * 2);
    const unsigned vo_v0 = (unsigned)(((tid >> 4) * NI + C_AV + 8 * (tid & 15)) * 2), vo_v1 = vo_v0 + (unsigned)(32 * NI * 2);
    const unsigned vo_q = (unsigned)((qrow * NI + C_AQ + 8 * hi) * 2);
    const int kst = (tid >> 3) * AT_KP + (tid & 7) * 16;
    const int vst = ((tid & 15) >> 2) * 4096 + (tid >> 4) * 64 + (tid & 3) * 16;
    const int krd = r32 * AT_KP + 16 * hi;
    const int vrd = (4 * hi + ((lane & 15) >> 2)) * 64 + ((lane >> 4) & 1) * 32 + (lane & 3) * 8;
    LAS unsigned char* o0p = F.lds + AT_O0 + (tid >> 6) * 8192 + (tid & 63) * 16;
    int nextq = 0;
#define AT_KBASE(i_) (((i_) == 0) ? 0 : 16 + 64 * ((i_) - 1))
#define AT_LDK(i_) kreg = bufld16(prs, vo_k + cofs, (unsigned)(AT_KBASE(i_) * NI * 2))
#define AT_LDV(i_) do { const unsigned so_ = (unsigned)(AT_KBASE(i_) * NI * 2); vreg0 = bufld16(prs, vo_v0, so_); vreg1 = bufld16(prs, vo_v1, so_); } while (0)
#define AT_STK(s_) *(LAS u32x4*)(Kc + (s_) * AT_KB + kst) = kreg
#define AT_STV(s_) do { *(LAS u32x4*)(Vc + (s_) * AT_VB + vst) = vreg0; *(LAS u32x4*)(Vc + (s_) * AT_VB + vst + 32 * 64) = vreg1; } while (0)
#define AT_TURN(k_) do { if ((k_) + 1 < ntile) AT_STV(s1); if ((k_) + 2 < ntile) AT_STK(s2); __syncthreads(); \
        if ((k_) + 2 < ntile) AT_LDV((k_) + 2); if ((k_) + 3 < ntile) AT_LDK((k_) + 3); } while (0)
#define AT_KPAIR(q_, a_, b_) do { a_ = *(const LAS bf16x8*)(Kb + 32 * (q_)); b_ = *(const LAS bf16x8*)(Kb + 32 * AT_KP + 32 * (q_)); } while (0)
#define AT_VPAIR(p_, a_, b_) do { const LAS unsigned char* vp_ = Vb + (2 * ((p_) & 1)) * 4096 + (16 * ((p_) >> 1)) * 64; \
        const s16x4 l0_ = vtr(vp_), h0_ = vtr(vp_ + 8 * 64), l1_ = vtr(vp_ + 4096), h1_ = vtr(vp_ + 4096 + 8 * 64); \
        a_ = (bf16x8){l0_[0], l0_[1], l0_[2], l0_[3], h0_[0], h0_[1], h0_[2], h0_[3]}; b_ = (bf16x8){l1_[0], l1_[1], l1_[2], l1_[3], h1_[0], h1_[1], h1_[2], h1_[3]}; } while (0)
#define AT_SUMPK(g_) do { float x0_ = pP[(g_) >> 2][4 * ((g_) & 3)], x1_ = pP[(g_) >> 2][4 * ((g_) & 3) + 1], x2_ = pP[(g_) >> 2][4 * ((g_) & 3) + 2], x3_ = pP[(g_) >> 2][4 * ((g_) & 3) + 3]; \
        ps0 += x0_; ps1 += x1_; ps2 += x2_; ps3 += x3_; pfw[2 * (g_)] = cvt_pk_bf16(x0_, x1_); pfw[2 * (g_) + 1] = cvt_pk_bf16(x2_, x3_); \
        AT_PIN(ps0); AT_PIN(ps1); AT_PIN(ps2); AT_PIN(ps3); AT_PIN(pfw[2 * (g_)]); AT_PIN(pfw[2 * (g_) + 1]); } while (0)
#define AT_EXP2(n_) do { float e0_ = __builtin_amdgcn_exp2f(sT[(n_) >> 3][2 * ((n_) & 7)] - mrun), e1_ = __builtin_amdgcn_exp2f(sT[(n_) >> 3][2 * ((n_) & 7) + 1] - mrun); \
        AT_PIN(e0_); AT_PIN(e1_); pP[(n_) >> 3][2 * ((n_) & 7)] = e0_; pP[(n_) >> 3][2 * ((n_) & 7) + 1] = e1_; } while (0)
#define AT_PF(i_) __builtin_bit_cast(bf16x8, (u32x4){pfw[4 * (i_)], pfw[4 * (i_) + 1], pfw[4 * (i_) + 2], pfw[4 * (i_) + 3]})
#define AT_VMMA0(p_, a_) O[2 * ((p_) & 1)] = MFMA32(a_, AT_PF((p_) >> 1), O[2 * ((p_) & 1)])
#define AT_VMMA1(p_, b_) O[2 * ((p_) & 1) + 1] = MFMA32(b_, AT_PF((p_) >> 1), O[2 * ((p_) & 1) + 1])
#define AT_ROWMAX(kk_, kb_) do { if ((kk_) == 0 || (kk_) >= ntile - 4) { \
            _Pragma("unroll") for (int kblk = 0; kblk < 2; ++kblk) _Pragma("unroll") for (int r = 0; r < 16; ++r) { \
                const int kl = 32 * kblk + crow(r, hi); const bool ok = ((kb_) + kl <= qrow) && ((kk_) > 0 || kl < 16); if (!ok) sT[kblk][r] = -INFINITY; } } \
        mx = sT[0][0]; \
        _Pragma("unroll") for (int r = 1; r < 16; ++r) mx = fmaxf(mx, sT[0][r]); \
        _Pragma("unroll") for (int r = 0; r < 16; ++r) mx = fmaxf(mx, sT[1][r]); \
        mx = xhalf_max(mx); } while (0)
#pragma unroll 1
    for (int comp = 0; comp < 2; ++comp) {
        const unsigned cofs = (unsigned)(comp * 128);
        bf16x8 qf[4];
#pragma unroll
        for (int ks = 0; ks < 4; ++ks) qf[ks] = __builtin_bit_cast(bf16x8, bufld16(prs, vo_q + cofs + 32 * ks, 0u));
        f32x16 O[4];
#pragma unroll
        for (int vb = 0; vb < 4; ++vb)
#pragma unroll
            for (int r = 0; r < 16; ++r) O[vb][r] = 0.f;
        float mrun, lrun = 0.f, mx;
        u32x4 kreg, vreg0, vreg1, kreg1;
        AT_LDK(0); AT_LDV(0);
        kreg1 = bufld16(prs, vo_k + cofs, (unsigned)(AT_KBASE(1) * NI * 2));
        int nq_ = 0;
        if (comp == 0 && tid == 0) nq_ = (int)__hip_atomic_fetch_add(qh, 1u, __ATOMIC_RELAXED, __HIP_MEMORY_SCOPE_AGENT);
        __syncthreads();
        AT_STK(0); AT_STV(0);
        *(LAS u32x4*)(Kc + AT_KB + kst) = kreg1;
        if (comp == 0 && tid == 0) ((volatile LAS int*)(F.lds + MISC_OFF))[20] = nq_;
        __syncthreads();
        if (comp == 0) nextq = __builtin_amdgcn_readfirstlane(((volatile LAS int*)(F.lds + MISC_OFF))[20]);
        f32x16 sT[2], pP[2];
        {   const LAS unsigned char* Kb = Kc + krd;
#pragma unroll
            for (int kblk = 0; kblk < 2; ++kblk) {
#pragma unroll
                for (int r = 0; r < 16; ++r) sT[kblk][r] = 0.f;
#pragma unroll
                for (int ks = 0; ks < 4; ++ks) { const bf16x8 kf = *(const LAS bf16x8*)(Kb + (32 * kblk) * AT_KP + 32 * ks); sT[kblk] = MFMA32(kf, qf[ks], sT[kblk]); }
                AT_SBAR();
            }
        }
        if (ntile > 1) AT_LDV(1);
        if (ntile > 2) AT_LDK(2);
        AT_ROWMAX(0, 0);
        mrun = mx;
#pragma unroll
        for (int kblk = 0; kblk < 2; ++kblk)
#pragma unroll
            for (int r = 0; r < 16; ++r) pP[kblk][r] = __builtin_amdgcn_exp2f(sT[kblk][r] - mrun);
        int s0 = 0;
#pragma unroll 1
        for (int k = 0; k < ntile; ++k) {
            const int s1 = (s0 == 2) ? 0 : s0 + 1, s2 = (s1 == 2) ? 0 : s1 + 1;
            const bool act = AT_KBASE(k) <= qlast;
            const bool nxt = (k + 1 < ntile) && (AT_KBASE(k + 1) <= qlast);
            AT_TURN(k);
            if (act) {
                float ps0 = 0.f, ps1 = 0.f, ps2 = 0.f, ps3 = 0.f;
                unsigned pfw[16];
                const LAS unsigned char* Vb = Vc + s0 * AT_VB + vrd;
                bf16x8 va0, vb0, va1, vb1;
                if (nxt) {
                    const LAS unsigned char* Kb = Kc + s1 * AT_KB + krd;
                    const f32x16 z16 = {0.f, 0.f, 0.f, 0.f, 0.f, 0.f, 0.f, 0.f, 0.f, 0.f, 0.f, 0.f, 0.f, 0.f, 0.f, 0.f};
                    bf16x8 ka0, kb0, ka1, kb1;
                    __builtin_amdgcn_s_setprio(1);
                    AT_KPAIR(0, ka0, kb0); AT_SBAR();
                    AT_KPAIR(1, ka1, kb1); sT[0] = MFMA32(ka0, qf[0], z16); AT_SUMPK(0); AT_SBAR();
                    sT[1] = MFMA32(kb0, qf[0], z16); AT_SUMPK(1); AT_SBAR();
                    AT_KPAIR(2, ka0, kb0); sT[0] = MFMA32(ka1, qf[1], sT[0]); AT_SUMPK(2); AT_SBAR();
                    sT[1] = MFMA32(kb1, qf[1], sT[1]); AT_SUMPK(3); AT_SBAR();
                    AT_KPAIR(3, ka1, kb1); sT[0] = MFMA32(ka0, qf[2], sT[0]); AT_SUMPK(4); AT_SBAR();
                    sT[1] = MFMA32(kb0, qf[2], sT[1]); AT_SUMPK(5); AT_SBAR();
                    AT_VPAIR(0, va0, vb0); sT[0] = MFMA32(ka1, qf[3], sT[0]); AT_SUMPK(6); AT_SBAR();
                    sT[1] = MFMA32(kb1, qf[3], sT[1]); AT_SUMPK(7); AT_SBAR();
                    __builtin_amdgcn_s_setprio(0);
                    lrun += xhalf_sum((ps0 + ps1) + (ps2 + ps3));
                    AT_ROWMAX(k + 1, AT_KBASE(k + 1));
                    const bool need = mx > mrun + 8.f;
                    const bool resc = __builtin_amdgcn_ballot_w64(need) != 0ull;
                    float alpha = 1.f;
                    if (resc) { const float mnew = need ? mx : mrun; alpha = __builtin_amdgcn_exp2f(mrun - mnew); lrun *= alpha; mrun = mnew; }
                    AT_SBAR();
                    __builtin_amdgcn_s_setprio(1);
                    AT_VPAIR(1, va1, vb1); AT_VMMA0(0, va0); AT_EXP2(0); AT_SBAR();
                    AT_VMMA1(0, vb0); AT_EXP2(1); AT_SBAR();
                    AT_VPAIR(2, va0, vb0); AT_VMMA0(1, va1); AT_EXP2(2); AT_SBAR();
                    AT_VMMA1(1, vb1); AT_EXP2(3); AT_SBAR();
                    AT_VPAIR(3, va1, vb1); AT_VMMA0(2, va0); AT_EXP2(4); AT_SBAR();
                    AT_VMMA1(2, vb0); AT_EXP2(5); AT_SBAR();
                    AT_VPAIR(4, va0, vb0); AT_VMMA0(3, va1); AT_EXP2(6); AT_SBAR();
                    AT_VMMA1(3, vb1); AT_EXP2(7); AT_SBAR();
                    AT_VPAIR(5, va1, vb1); AT_VMMA0(4, va0); AT_EXP2(8); AT_SBAR();
                    AT_VMMA1(4, vb0); AT_EXP2(9); AT_SBAR();
                    AT_VPAIR(6, va0, vb0); AT_VMMA0(5, va1); AT_EXP2(10); AT_SBAR();
                    AT_VMMA1(5, vb1); AT_EXP2(11); AT_SBAR();
                    AT_VPAIR(7, va1, vb1); AT_VMMA0(6, va0); AT_EXP2(12); AT_SBAR();
                    AT_VMMA1(6, vb0); AT_EXP2(13); AT_SBAR();
                    AT_VMMA0(7, va1); AT_EXP2(14); AT_SBAR();
                    AT_VMMA1(7, vb1); AT_EXP2(15); AT_SBAR();
                    __builtin_amdgcn_s_setprio(0);
                    if (resc) {
#pragma unroll
                        for (int vb = 0; vb < 4; ++vb)
#pragma unroll
                            for (int r = 0; r < 16; ++r) O[vb][r] *= alpha;
                    }
                } else {
                    AT_SUMPK(0); AT_SUMPK(1); AT_SUMPK(2); AT_SUMPK(3); AT_SUMPK(4); AT_SUMPK(5); AT_SUMPK(6); AT_SUMPK(7);
                    lrun += xhalf_sum((ps0 + ps1) + (ps2 + ps3));
                    AT_SBAR();
                    AT_VPAIR(0, va0, vb0); AT_SBAR();
                    AT_VPAIR(1, va1, vb1); AT_VMMA0(0, va0); AT_VMMA1(0, vb0); AT_SBAR();
                    AT_VPAIR(2, va0, vb0); AT_VMMA0(1, va1); AT_VMMA1(1, vb1); AT_SBAR();
                    AT_VPAIR(3, va1, vb1); AT_VMMA0(2, va0); AT_VMMA1(2, vb0); AT_SBAR();
                    AT_VPAIR(4, va0, vb0); AT_VMMA0(3, va1); AT_VMMA1(3, vb1); AT_SBAR();
                    AT_VPAIR(5, va1, vb1); AT_VMMA0(4, va0); AT_VMMA1(4, vb0); AT_SBAR();
                    AT_VPAIR(6, va0, vb0); AT_VMMA0(5, va1); AT_VMMA1(5, vb1); AT_SBAR();
                    AT_VPAIR(7, va1, vb1); AT_VMMA0(6, va0); AT_VMMA1(6, vb0); AT_SBAR();
                    AT_VMMA0(7, va1); AT_VMMA1(7, vb1); AT_SBAR();
                }
            }
            s0 = s1;
        }
        if (comp == 0) {
            const float inv = 1.f / lrun;
#pragma unroll
            for (int vb = 0; vb < 4; ++vb)
#pragma unroll
                for (int q4 = 0; q4 < 2; ++q4) { u32x4 pk;
                    pk.x = cvt_pk_bf16(O[vb][8 * q4 + 0] * inv, O[vb][8 * q4 + 1] * inv); pk.y = cvt_pk_bf16(O[vb][8 * q4 + 2] * inv, O[vb][8 * q4 + 3] * inv);
                    pk.z = cvt_pk_bf16(O[vb][8 * q4 + 4] * inv, O[vb][8 * q4 + 5] * inv); pk.w = cvt_pk_bf16(O[vb][8 * q4 + 6] * inv, O[vb][8 * q4 + 7] * inv);
                    *(LAS u32x4*)(o0p + (2 * vb + q4) * 1024) = pk; }
        } else {
            int tid2 = lane_id_(); LAUNDER(tid2);
            const int r32e = tid2 & 31, hie = (tid2 >> 5) & 1;
            const unsigned vo_o = (unsigned)((r32e * D + 4 * hie) * 2);
            const bool rowok = (j > 0) || (32 * w + r32e < 16);
            const float lam = ((const LAS float*)(F.lds + MISC_OFF))[16], oscale = ((const LAS float*)(F.lds + MISC_OFF))[17];
            const float l1s = lam / lrun;
            float ssq = 0.f;
#pragma unroll
            for (int vb = 0; vb < 4; ++vb)
#pragma unroll
                for (int q4 = 0; q4 < 2; ++q4) { const u32x4 pk = *(const LAS u32x4*)(o0p + (2 * vb + q4) * 1024);
#pragma unroll
                    for (int e = 0; e < 8; ++e) { const unsigned pw = pk[e >> 1]; const float o0 = (e & 1) ? u2f_(pw & 0xffff0000u) : u2f_(pw << 16);
                        const float a = o0 - O[vb][8 * q4 + e] * l1s; O[vb][8 * q4 + e] = a; ssq += a * a; } }
            ssq = xhalf_sum(ssq);
            const float rn = rsqrtf(ssq * (1.f / 128.f) + RMS_EPS) * oscale;
            {
                LAS unsigned char* ot = F.lds + AT_O0 + w * 8192;
#pragma unroll
                for (int vb = 0; vb < 4; ++vb)
#pragma unroll
                    for (int g4 = 0; g4 < 4; ++g4) { const f32x4 sg = *(const LAS f32x4*)(F.lds + AT_SG + (32 * vb + 8 * g4 + 4 * hie) * 4);
                        u32x2 wv; wv.x = pk2(O[vb][4 * g4 + 0] * rn * sg[0], O[vb][4 * g4 + 1] * rn * sg[1]); wv.y = pk2(O[vb][4 * g4 + 2] * rn * sg[2], O[vb][4 * g4 + 3] * rn * sg[3]);
                        *(LAS u32x2*)(ot + r32e * 256 + (((4 * vb + g4) ^ (r32e & 15)) << 4) + 8 * hie) = wv; }
                LDS_WAIT(); asm volatile("" ::: "memory");
                const int rr = (tid2 >> 4) & 3, cc = tid2 & 15;
#pragma unroll
                for (int i = 0; i < 8; ++i) { const int row = 4 * i + rr;
                    const u32x4 ov = *(const LAS u32x4*)(ot + row * 256 + ((cc ^ (row & 15)) << 4));
                    if ((j > 0 || 32 * w + row < 16) && !(p_nost && rn != 12345.f)) stg<u32x4>(ob, (unsigned)(row * D * 2 + cc * 16), ov); }
            }
        }
    }
#undef AT_KBASE
#undef AT_LDK
#undef AT_LDV
#undef AT_STK
#undef AT_STV
#undef AT_TURN
#undef AT_KPAIR
#undef AT_VPAIR
#undef AT_SUMPK
#undef AT_EXP2
#undef AT_PF
#undef AT_VMMA0
#undef AT_VMMA1
#undef AT_ROWMAX
    return nextq;
}
__device__ __forceinline__ void attn_phase(const Frame& F0, int l) {
    Frame F = F0; F.tid = F.wave * 64 + lane_id_(); LAUNDER(F.tid); F.lane = F.tid & 63;
    float s1 = 0.f, s2 = 0.f;
    for (int i = 0; i < 64; ++i) { s1 += F.in[IN_LQ1][l * 64 + i] * F.in[IN_LK1][l * 64 + i]; s2 += F.in[IN_LQ2][l * 64 + i] * F.in[IN_LK2][l * 64 + i]; }
    const float lam_init = 0.8f - 0.6f * expf(-0.3f * (float)l);
    { const float lam = expf(s1) - expf(s2) + lam_init; if (F.tid == 0) { ((LAS float*)(F.lds + MISC_OFF))[16] = lam; ((LAS float*)(F.lds + MISC_OFF))[17] = 1.f - lam_init; } }
    __syncthreads();
    if (F.tid < 128) ((LAS float*)(F.lds + AT_SG))[F.tid] = F.in[IN_SUBLN][l * 128 + F.tid];
    unsigned* qh = (unsigned*)F.ws + CW_Q + (l * 4 + 0) * 64;
#ifndef ATT_REP
#define ATT_REP 1
#endif
    const int NQ1 = (l == DEPTH - 1) ? 1024 : 1024 + NB * 4;
    const int NQ = ATT_REP * NQ1;
#pragma unroll 1
    for (int q0 = F.wg; q0 < NQ; ) {
        const int q = q0 % NQ1;
        const int bh = q & 127, j = (q < 1024) ? 8 - (q >> 7) : 0;
        q0 = F.G + attn_unit(F, bh >> 2, bh & 3, j, qh, (AT_PROBE != 0) && q0 < (ATT_REP - 1) * NQ1);
    }
}

constexpr int RT_WP = 1032;
__device__ __forceinline__ void router_phase(const Frame& F0, int l, const int skipmeta) {
    Frame F = F0; F.tid = F.wave * 64 + lane_id_(); LAUNDER(F.tid); F.lane = F.tid & 63;
    const bf16* HBr = (const bf16*)(F.ws + WS_HB); const bf16* WR = (const bf16*)(F.ws + WS_WR) + (size_t)l * 2 * 32 * 1024;
    float* rstd = (float*)(F.ws + WS_RSTD); float* gate = (float*)(F.ws + WS_GATE); int* buck = (int*)(F.ws + WS_BUCK);
    unsigned* gcnt = (unsigned*)F.ws + CW_CNT + l * 64;
    LAS bf16* Wh = (LAS bf16*)F.lds;
    LAS bf16* Wl = Wh + 20 * RT_WP;
    LAS float* LG = (LAS float*)(F.lds + 2 * 20 * RT_WP * 2);
    LAS int* lcnt = (LAS int*)(LG + 8 * 16 * 33);
    LAS int* lbase = lcnt + 32;
    LAS int* tcls = lbase + 32;
    LAS int* tpos = tcls + 288;
    const int lane = F.lane, w = F.wave, fr = lane & 15, fq = lane >> 4;
    const int NTASK = skipmeta ? NB * SEQ / 16 : T / 16;
#define RT_ROW0(task_) (skipmeta ? ((task_) >> 7) * LT + NMETA + ((task_) & 127) * 16 : (task_) * 16)
    const int ntl = (NTASK - F.wg + F.G - 1) / F.G;
    __syncthreads();
    for (int idx = F.tid; idx < 2 * 20 * 128; idx += 512) { const int hl = idx / (20 * 128), r = (idx / 128) % 20, c = idx % 128;
        *(LAS u32x4*)((hl ? Wl : Wh) + r * RT_WP + 8 * c) = *(const GAS u32x4*)(WR + (size_t)hl * 32 * 1024 + r * 1024 + 8 * c); }
    if (F.tid < 32) lcnt[F.tid] = 0;
    __syncthreads();
    const int n1 = (16 + fr < 20) ? 16 + fr : 19;
    for (int k = w; k < ntl; k += 8) {
        const int task = F.wg + k * F.G;
        const bf16* hrow = HBr + (size_t)RT_ROW0(task) * D;
        const unsigned vo = (unsigned)((fr * D + 8 * fq) * 2);
        f32x4 acc[2]; acc[0] = (f32x4){0.f, 0.f, 0.f, 0.f}; acc[1] = acc[0];
        float ssq = 0.f;
#pragma unroll 8
        for (int ks = 0; ks < 32; ++ks) {
            const u32x4 xa = ldg<u32x4>(hrow, vo + ks * 64);
            const float x0 = bf2f(xa.x), x1 = bf2f(xa.x >> 16), x2 = bf2f(xa.y), x3 = bf2f(xa.y >> 16), x4 = bf2f(xa.z), x5 = bf2f(xa.z >> 16), x6 = bf2f(xa.w), x7 = bf2f(xa.w >> 16);
            ssq += (x0 * x0 + x1 * x1) + (x2 * x2 + x3 * x3) + (x4 * x4 + x5 * x5) + (x6 * x6 + x7 * x7);
            const bf16x8 ahi = __builtin_bit_cast(bf16x8, xa);
            const bf16x8 bh0 = *(const LAS bf16x8*)(Wh + fr * RT_WP + 32 * ks + 8 * fq), bl0 = *(const LAS bf16x8*)(Wl + fr * RT_WP + 32 * ks + 8 * fq);
            const bf16x8 bh1 = *(const LAS bf16x8*)(Wh + n1 * RT_WP + 32 * ks + 8 * fq), bl1 = *(const LAS bf16x8*)(Wl + n1 * RT_WP + 32 * ks + 8 * fq);
            acc[0] = MFMA16(ahi, bh0, acc[0]); acc[0] = MFMA16(ahi, bl0, acc[0]);
            acc[1] = MFMA16(ahi, bh1, acc[1]); acc[1] = MFMA16(ahi, bl1, acc[1]);
        }
        ssq += __shfl_xor(ssq, 16); ssq += __shfl_xor(ssq, 32);
        const float rs = rsqrtf(ssq * (1.f / 1024.f) + RMS_EPS);
#pragma unroll
        for (int nt = 0; nt < 2; ++nt)
#pragma unroll
            for (int j = 0; j < 4; ++j) LG[w * 16 * 33 + (4 * fq + j) * 33 + 16 * nt + fr] = acc[nt][j];
        LDS_WAIT(); asm volatile("" ::: "memory");
        if (lane < 16) {
            const int tl = k * 16 + lane; const size_t m = (size_t)RT_ROW0(task) + lane;
            const float rsm = rs;
            const LAS float* lg = LG + w * 16 * 33 + lane * 33;
            float gl[4]; float gm = -1e30f; int gi = 0;
#pragma unroll
            for (int q = 0; q < 4; ++q) { gl[q] = lg[q] * rsm + F.in[IN_BGRP][l * 4 + q]; if (gl[q] > gm) { gm = gl[q]; gi = q; } }
            float gs = 0.f;
#pragma unroll
            for (int q = 0; q < 4; ++q) gs += __expf(gl[q] - gm);
            const float gp = 1.f / gs;
            float el[4];
#pragma unroll
            for (int q = 0; q < 4; ++q) el[q] = lg[4 + 4 * gi + q] * rsm + F.in[IN_BEXP][l * 16 + 4 * gi + q];
            int i1 = 0; float v1 = el[0];
#pragma unroll
            for (int q = 1; q < 4; ++q) if (el[q] > v1) { v1 = el[q]; i1 = q; }
            int i2 = -1; float v2 = -1e30f;
#pragma unroll
            for (int q = 0; q < 4; ++q) if (q != i1 && el[q] > v2) { v2 = el[q]; i2 = q; }
            const float e2 = __expf(v2 - v1), w1 = gp / (1.f + e2), w2 = gp * e2 / (1.f + e2);
            const int a = i1 < i2 ? i1 : i2, bq = i1 < i2 ? i2 : i1;
            const int pidx = (a == 0) ? (bq - 1) : (a == 1 ? bq + 1 : 5);
            const int cls = gi * 6 + pidx;
            rstd[m] = rsm; gate[2 * m] = (a == i1) ? w1 : w2; gate[2 * m + 1] = (a == i1) ? w2 : w1;
            tcls[tl] = cls; tpos[tl] = atomicAdd((int*)&lcnt[cls], 1);
        }
    }
    __syncthreads();
    if (F.tid < NCLS) lbase[F.tid] = (int)atomicAdd(&gcnt[F.tid], (unsigned)lcnt[F.tid]);
    __syncthreads();
    if (F.tid < ntl * 16) { const int cls = tcls[F.tid]; buck[(size_t)cls * T + lbase[cls] + tpos[F.tid]] = RT_ROW0(F.wg + (F.tid >> 4) * F.G) + (F.tid & 15); }
    __syncthreads();
#undef RT_ROW0
}

__device__ __forceinline__ void final_phase(const Frame& F0, float* out, float tp_add) {
    Frame F = F0; F.tid = F.wave * 64 + lane_id_(); LAUNDER(F.tid); F.lane = F.tid & 63;
    const bf16* HBf = (const bf16*)(F.ws + WS_HB); const float* g = F.in[IN_FNG];
    const int gw = F.wg * 8 + F.wave, NGW = F.G * 8, lane = F.lane;
    f32x4 gg[4];
#pragma unroll
    for (int j = 0; j < 4; ++j) gg[j] = *((const GAS f32x4*)g + lane + 64 * j);
    u32x2 q[4][4], qn[4][4];
#define FN_LOAD(dst_, r0_) do { _Pragma("unroll") for (int k = 0; k < 4; ++k) { int r = (r0_) + k * NGW; r = r < NB * SEQ ? r : NB * SEQ - 1; const int b = r / SEQ, t = r % SEQ; \
            const size_t m = (size_t)b * LT + NMETA + t; const GAS u32x2* hr = (const GAS u32x2*)(HBf + m * D) + lane; \
            _Pragma("unroll") for (int j = 0; j < 4; ++j) dst_[k][j] = hr[64 * j]; } } while (0)
    FN_LOAD(q, gw);
    for (int r0 = gw; r0 < NB * SEQ; r0 += 4 * NGW) {
        FN_LOAD(qn, r0 + 4 * NGW);
#pragma unroll
        for (int k = 0; k < 4; ++k) { const int r = r0 + k * NGW;
            f32x4 v[4]; float s = 0.f;
#pragma unroll
            for (int j = 0; j < 4; ++j) { v[j] = (f32x4){bf2f(q[k][j].x), bf2f(q[k][j].x >> 16), bf2f(q[k][j].y), bf2f(q[k][j].y >> 16)}; s += (v[j].x * v[j].x + v[j].y * v[j].y) + (v[j].z * v[j].z + v[j].w * v[j].w); }
            const float rs = rsqrtf(wave_sum(s) * (1.f / 1024.f) + RMS_EPS);
            if (r < NB * SEQ) { GAS f32x4* orow = (GAS f32x4*)(out + (size_t)r * D) + lane;
#pragma unroll
                for (int j = 0; j < 4; ++j) orow[64 * j] = v[j] * rs * gg[j] + tp_add; } }
#pragma unroll
        for (int k = 0; k < 4; ++k)
#pragma unroll
            for (int j = 0; j < 4; ++j) q[k][j] = qn[k][j];
    }
#undef FN_LOAD
}

template <int NPN>
__device__ __forceinline__ int moe_prepare(const Frame& F0, int l, LAS int* cntl, LAS int* tab) {
    Frame F = F0; F.tid = F.wave * 64 + lane_id_(); LAUNDER(F.tid); F.lane = F.tid & 63;
    const unsigned* gcnt = (const unsigned*)F.ws + CW_CNT + l * 64; const int* buck = (const int*)(F.ws + WS_BUCK);
    __syncthreads();
    if (F.tid < NCLS) cntl[F.tid] = (int)gcnt[F.tid];
    __syncthreads();
    MoeList ml{cntl}; const int ntl = ml.ntiles();
    int vals[6]; const int hsel = F.wave >> 2, r = F.tid & 255;
#pragma unroll
    for (int k = 0; k < 6; ++k) { const int Lx = (hsel + 2 * k) * F.G + F.wg; vals[k] = -1;
        if (Lx < ntl * NPN) { int c, ti, nv; ml.decode(Lx / NPN, c, ti, nv); if (r < nv) vals[k] = buck[(size_t)c * T + ti * 256 + r]; } }
#pragma unroll
    for (int k = 0; k < 6; ++k) { const int i = hsel + 2 * k; if (i * F.G + F.wg < ntl * NPN) tab[i * 256 + r] = vals[k]; }
    __syncthreads();
    return ntl;
}

#ifndef ONLY_MASK
#define ONLY_MASK 0xFFFFFFFFu
#endif
#define IN(k) (lo <= (k) && (k) < hi)
#define EN(j) ((ONLY_MASK >> (j)) & 1u)
#ifndef SUBMASK
#define SUBMASK 3u
#endif
#ifndef TPROBE
#define TPROBE (-1)
#endif
constexpr int CW_TP = 24576;
#define TP_MARK(k, which) do { if (TPROBE == (k) && F.wave == 0 && lane_id_() == 0) { const unsigned long long t_ = __builtin_amdgcn_s_memrealtime(); \
        __hip_atomic_fetch_max((unsigned long long*)((unsigned*)F.ws + CW_TP) + (which), (which) ? t_ : ~t_, __ATOMIC_RELAXED, __HIP_MEMORY_SCOPE_AGENT); } } while (0)
#define SEAM(k) do { TP_MARK(k, 1); if (IN(k) && IN((k) + 1)) xcd_barrier(bar); TP_MARK((k) + 1, 0); } while (0)
template <int L>
__device__ __forceinline__ void layer_phases(const Frame& F, const XcdBarrier& bar, int lo, int hi) {
    bf16* proj = (bf16*)(F.ws + WS_PROJ); bf16* mixed = (bf16*)(F.ws + WS_MIXED); bf16* HB = (bf16*)(F.ws + WS_HB);
    float* ss16 = (float*)(F.ws + WS_SS16);
    LAS int* tab = (LAS int*)(F.lds + TAB_OFF); LAS int* cntl = (LAS int*)(F.lds + TAB_OFF + 12 * 1024);
    constexpr int l = L; constexpr int pb = 1 + 9 * L;
        if (EN(1) && IN(pb + 0)) {
            const int Gg = (L == 0) ? gemm_wgs(MT * (NI / 256), F.G) : F.G;
            PolIn P; P.ord.init(MT, NI / 256, Gg, F.wg); P.A = HB; P.B = (const bf16*)(F.ws + WS_WIN) + (size_t)l * NI * D; P.proj = proj; P.ss16 = ss16; P.rope = (const float*)(F.ws + WS_ROPE); P.X = (bf16*)(F.os + OS_X);
            if (F.wg < Gg) for (int rep = 0; rep < NREP(1); ++rep) pg8::gemm_phase(F.lds, P, F.wave);
            if (L == 0) conv_spare(F, 0, I_IN, I_L, Gg); }
        SEAM(pb + 0);
        if (EN(2) && IN(pb + 1)) {
            PolS5E P; P.G = F.G; P.c = F.wg; P.X = (const bf16*)(F.os + OS_X); P.B = (const bf16*)(F.ws + WS_S5P) + (size_t)l * 16 * 256 * 256; P.E = (float*)(F.os + OS_E);
            for (int rep = 0; rep < NREP(2); ++rep) if (MIXSEL & 1u) pg8::gemm_phase(F.lds, P, F.wave);
            __syncthreads();
            for (int rep = 0; rep < NREP(11); ++rep) if (MIXSEL & 2u) hgrn_a(F, l); }
        SEAM(pb + 1);
        if (EN(3) && IN(pb + 2)) { for (int rep = 0; rep < NREP(3); ++rep) { if (MIXSEL & 1u) s5_scan(F, l); if (MIXSEL & 2u) hgrn_b(F); } }
        SEAM(pb + 2);
        if (EN(4) && IN(pb + 3)) {
            PolS5Y P; P.skipmeta = (L == DEPTH - 1); P.G = F.G; P.c = F.wg; P.X = (const bf16*)(F.os + OS_X); P.B = (const bf16*)(F.ws + WS_S5TQ) + (size_t)l * 16 * 256 * 384; P.proj = proj; P.dsk = F.in[IN_S5D] + l * 256; P.Gout = (bf16*)(F.os + OS_G);
            for (int rep = 0; rep < NREP(4); ++rep) if ((SUBMASK & MIXSEL & 1u) != 0u) pg8::gemm_phase(F.lds, P, F.wave);
            __syncthreads();
            for (int rep = 0; rep < NREP(12); ++rep) if ((SUBMASK & MIXSEL & 2u) != 0u) hgrn_c(F, l); }
        SEAM(pb + 3);
        if (EN(5) && IN(pb + 4)) {
            PolGlu P; P.skipmeta = (L == DEPTH - 1); P.ord.init(P.skipmeta ? NB * SEQ / 256 : MT, 2, F.G, F.wg); P.A = (const bf16*)(F.os + OS_G); P.B = (const bf16*)(F.ws + WS_WGLU) + (size_t)l * 512 * 256; P.mixed = mixed;
            for (int rep = 0; rep < NREP(5); ++rep) if ((SUBMASK & MIXSEL & 1u) != 0u) pg8::gemm_phase(F.lds, P, F.wave);
            __syncthreads();
            for (int rep = 0; rep < NREP(13); ++rep) if ((SUBMASK & 2u) != 0u && (MIXSEL & 4u) != 0u) attn_phase(F, l); }
        SEAM(pb + 4);
        if (EN(6) && IN(pb + 5)) {
            const int Gg = (L == 0 && DEPTH > 1) ? gemm_wgs(MT * 4, F.G) : F.G;
            PolOut P; P.skipmeta = (L == DEPTH - 1); P.ord.init(P.skipmeta ? NB * SEQ / 256 : MT, 4, Gg, F.wg); P.A = mixed; P.B = (const bf16*)(F.ws + WS_WOUT) + (size_t)l * D * D; P.HB = HB; P.ss16 = ss16; P.pan = (unsigned*)F.ws + CW_PAN + l * 272 * 16;
            if (NREP(6) == 2) { P.HBo = (bf16*)F.os; P.ss16 = (float*)(F.os + 160 * 1048576); pg8::gemm_phase(F.lds, P, F.wave); P.ss16 = ss16; }
            P.HBo = HB; if (F.wg < Gg) pg8::gemm_phase(F.lds, P, F.wave);
            if (L == 0 && DEPTH > 1) conv_spare(F, 1, 0, I_L, Gg); }
        SEAM(pb + 5);
        if (EN(7) && IN(pb + 6)) { router_phase(F, l, (L == DEPTH - 1) ? 1 : 0); }
        SEAM(pb + 6);
        if (EN(8) && IN(pb + 7)) {
            PolGU P; P.G = F.G; P.c = F.wg; P.ntl = moe_prepare<8>(F, l, cntl, tab); P.ml = MoeList{cntl}; P.tab = tab;
            P.HB = HB; P.W = (const bf16*)(F.ws + WS_WGU) + (size_t)l * 16 * 1024 * 1024; P.he = proj; P.rstd = (const float*)(F.ws + WS_RSTD); P.gate = (const float*)(F.ws + WS_GATE);
            for (int rep = 0; rep < NREP(8); ++rep) pg8::gemm_phase(F.lds, P, F.wave); }
        SEAM(pb + 7);
        if (EN(9) && IN(pb + 8)) {
            PolDN P; P.G = F.G; P.c = F.wg; P.ntl = moe_prepare<4>(F, l, cntl, tab); P.ml = MoeList{cntl}; P.tab = tab;
            P.he = proj; P.W = (const bf16*)(F.ws + WS_WDN) + (size_t)l * 16 * 1024 * 512; P.HB = HB; P.ss16 = ss16; P.needss = (L + 1 < DEPTH) ? 1 : 0;
            if (NREP(9) == 2) { P.HBo = (bf16*)F.os; P.ss16 = (float*)(F.os + 160 * 1048576); pg8::gemm_phase(F.lds, P, F.wave); P.ss16 = ss16; }
            P.HBo = HB; pg8::gemm_phase(F.lds, P, F.wave); }
        SEAM(pb + 8);
}

__global__ void __launch_bounds__(512, 2) hymba_fwd(Args args) {
    extern __shared__ __attribute__((aligned(16))) unsigned char lds_raw[];
    Frame F;
    F.lds = (LAS unsigned char*)lds_raw;
    F.tid = threadIdx.x; F.lane = F.tid & 63; F.wave = __builtin_amdgcn_readfirstlane(F.tid >> 6);
    F.G = gridDim.x; F.wg = blockIdx.x; F.in = args.in; F.ws = args.ws; F.os = args.ws + WS_SCR;
    volatile LAS unsigned* MISC = (volatile LAS unsigned*)(F.lds + MISC_OFF);
    if (F.tid < 256) MISC[F.tid] = 0u;
    __syncthreads();
    const int lo = args.ph_lo, hi = args.ph_hi;
    const bool one = (hi - lo) > 1;
    XcdBarrier bar; bar.bar = (unsigned*)F.ws + CW_BAR; bar.x = 0; bar.st = nullptr;
    bar.wave = F.wave;
    if (one) bar = xcd_barrier_post((unsigned*)F.ws + CW_BAR, MISC + 8, F.wave);
    TP_MARK(0, 0);
    if (EN(0) && IN(0)) { for (int rep = 0; rep < NREP(0); ++rep) p0_prologue(F); } SEAM(0);
    layer_phases<0>(F, bar, lo, hi);
    layer_phases<1>(F, bar, lo, hi);
    float tp_add = 0.f;
    if (TPROBE >= 0) { const unsigned long long* tp = (const unsigned long long*)((unsigned*)F.ws + CW_TP); const unsigned long long t0 = ~tp[0], t1 = tp[1]; tp_add = (float)(t1 - t0) * 1e-5f; }
    if (EN(10) && IN(19)) for (int rep = 0; rep < NREP(10); ++rep) final_phase(F, args.out, tp_add);
#undef IN
#undef SEAM
}

extern "C" void kernel_launch(void* const* d_in, const int* in_sizes, int n_in, void* d_out, int out_size, void* d_ws, size_t ws_size, hipStream_t stream) {
    static int grid = 0;
    if (grid == 0) {
        if (n_in != 30 || ws_size < WS_END) { fprintf(stderr, "kernel_launch: unexpected inputs (n_in %d, ws %zu < %zu)\n", n_in, ws_size, (size_t)WS_END); grid = -1; return; }
        int dev = 0, cus = 0, per_cu = 0;
        (void)hipGetDevice(&dev); (void)hipDeviceGetAttribute(&cus, hipDeviceAttributeMultiprocessorCount, dev);
        (void)hipFuncSetAttribute((const void*)hymba_fwd, hipFuncAttributeMaxDynamicSharedMemorySize, LDS_BYTES);
        (void)hipOccupancyMaxActiveBlocksPerMultiprocessor(&per_cu, (const void*)hymba_fwd, 512, LDS_BYTES);
        (void)hipGetLastError();
        grid = cus > 0 ? cus : 256;
    }
    if (grid < 0) return;
    (void)hipMemsetAsync(d_ws, 0, CTL_BYTES, stream);
    Args a{};
    for (int i = 0; i < 30; ++i) a.in[i] = (const float*)d_in[i];
    a.out = (float*)d_out; a.ws = (unsigned char*)d_ws;
#if N_LAUNCH_MODE == 1
    a.ph_lo = 0; a.ph_hi = LAST_PHASE;
    hipLaunchKernelGGL(hymba_fwd, dim3(grid), dim3(512), LDS_BYTES, stream, a);
#else
    if (MIXSEL != 7u) (void)hipMemsetAsync((char*)d_ws + WS_MIXED, 0, (size_t)T * D * 2, stream);
    for (int p = 0; p < LAST_PHASE; ++p) { if (!((RUN_MASK >> p) & 1u)) continue; a.ph_lo = p; a.ph_hi = p + 1; hipLaunchKernelGGL(hymba_fwd, dim3(grid), dim3(512), LDS_BYTES, stream, a); }
#endif
}
```

```cpp
#include <hip/hip_runtime.h>
#include <stdint.h>
#include <stdio.h>

#ifndef N_LAUNCH_MODE
#define N_LAUNCH_MODE 1
#endif
#ifndef LAST_PHASE
#define LAST_PHASE 20
#endif
#ifndef RUN_MASK
#define RUN_MASK 0xFFFFFu
#endif
#ifndef REPMASK
#define REPMASK 0u
#endif
#define NREP(j) (((REPMASK >> (j)) & 1u) ? 2 : 1)
#ifndef MIXSEL
#define MIXSEL 7u
#endif

#define GAS __attribute__((address_space(1)))
#define LAS __attribute__((address_space(3)))
typedef unsigned short bf16;
typedef short bf16x8 __attribute__((ext_vector_type(8)));
typedef short s16x4 __attribute__((ext_vector_type(4)));
typedef float f32x2 __attribute__((ext_vector_type(2)));
typedef float f32x4 __attribute__((ext_vector_type(4)));
typedef float f32x16 __attribute__((ext_vector_type(16)));
typedef unsigned u32x2 __attribute__((ext_vector_type(2)));
typedef unsigned u32x4 __attribute__((ext_vector_type(4)));

constexpr int NB = 32, LT = 2064, NMETA = 16, SEQ = 2048, T = NB * LT;
constexpr int DEPTH = 2;
constexpr int D = 1024, NI = 2816, MT = T / 256;
constexpr int C_U = 0, C_HQ = 256, C_HF = 512, C_HI = 768, C_HG = 1024, C_AQ = 1280, C_AK = 1792, C_AV = 2304;
constexpr int NCH = 129;
constexpr int S5R = NB * NCH;
constexpr int S5RP = 17 * 256;
constexpr int HCH = 33;
constexpr int NCLS = 24;
constexpr float RMS_EPS = 1e-6f;
constexpr float QSCALE = 0.125f * 1.4426950408889634f;

constexpr size_t al256(size_t x) { return (x + 255) & ~(size_t)255; }
constexpr size_t CTL_BYTES = 1u << 20;
constexpr size_t WS_WIN = CTL_BYTES;
constexpr size_t WS_WOUT = WS_WIN + al256((size_t)2 * NI * D * 2);
constexpr size_t WS_WGLU = WS_WOUT + al256((size_t)2 * D * D * 2);
constexpr size_t WS_WGU = WS_WGLU + al256((size_t)2 * 512 * 256 * 2);
constexpr size_t WS_WDN = WS_WGU + al256((size_t)2 * 16 * 1024 * 1024 * 2);
constexpr size_t WS_WR = WS_WDN + al256((size_t)2 * 16 * 1024 * 512 * 2);
constexpr size_t WS_S5TQ = WS_WR + al256((size_t)2 * 2 * 32 * 1024 * 2);
constexpr size_t WS_S5P = WS_S5TQ + al256((size_t)2 * 16 * 256 * 384 * 2);
constexpr size_t WS_S5A = WS_S5P + al256((size_t)2 * 16 * 256 * 256 * 2);
constexpr size_t WS_ROPE = WS_S5A + al256((size_t)2 * 16 * 64 * 8);
constexpr size_t WS_SS16 = WS_ROPE + al256((size_t)LT * 32 * 4 * 2);
constexpr size_t WS_RSTD = WS_SS16 + al256((size_t)T * 16 * 4);
constexpr size_t WS_GATE = WS_RSTD + al256((size_t)T * 4);
constexpr size_t WS_BUCK = WS_GATE + al256((size_t)T * 8);
constexpr size_t WS_HB = WS_BUCK + al256((size_t)NCLS * T * 4);
constexpr size_t WS_PROJ = WS_HB + al256((size_t)T * D * 2);
constexpr size_t WS_MIXED = WS_PROJ + al256((size_t)T * NI * 2);
constexpr size_t WS_SCR = WS_MIXED + al256((size_t)T * D * 2);
constexpr size_t OS_E = 0;
constexpr size_t OS_X = OS_E + al256((size_t)16 * S5RP * 128 * 4);
constexpr size_t OS_G = OS_X + al256((size_t)16 * S5RP * 384 * 2);
constexpr size_t OS_UT = OS_G + al256((size_t)T * 256 * 2);
constexpr size_t OS_DEC = OS_UT + al256((size_t)NB * 4 * HCH * 4096 * 4);
constexpr size_t OS_SP = OS_DEC + al256((size_t)NB * 4 * HCH * 64 * 4);
constexpr size_t OS_END = OS_SP + al256((size_t)NB * 4 * HCH * 4096 * 2);
constexpr size_t WS_END = WS_SCR + OS_END;
static_assert(WS_END <= (size_t)1 << 30, "workspace map must fit in 1 GiB");
static_assert((size_t)(MT + NCLS) * 256 * 1024 * 2 <= (size_t)T * NI * 2, "he overlay fits in proj");

constexpr int CW_PAN = 32768;
constexpr int CW_BAR = 4096, CW_CNT = 16384, CW_Q = 20480;

constexpr int LDS_BYTES = 147456;
constexpr int RING_BYTES = 131072;
constexpr int TAB_OFF = RING_BYTES;
constexpr int MISC_OFF = LDS_BYTES - 1024;

__device__ __forceinline__ float bf2f(unsigned b) { return __builtin_bit_cast(float, (b & 0xffffu) << 16); }
__device__ __forceinline__ unsigned cvt_pk_bf16(float lo, float hi) { unsigned r; asm("v_cvt_pk_bf16_f32 %0, %1, %2" : "=v"(r) : "v"(lo), "v"(hi)); return r; }
__device__ __forceinline__ unsigned pk2(float lo, float hi) { return cvt_pk_bf16(lo, hi); }
__device__ __forceinline__ unsigned f2bf(float f) { return cvt_pk_bf16(f, 0.f) & 0xffffu; }
__device__ __forceinline__ float wave_sum(float v) {
#pragma unroll
    for (int o = 1; o < 64; o <<= 1) v += __shfl_xor(v, o);
    return v;
}
__device__ __forceinline__ float fexp_(float x) { return __builtin_amdgcn_exp2f(x * 1.4426950408889634f); }
__device__ __forceinline__ float flog_(float x) { return __builtin_amdgcn_logf(x) * 0.6931471805599453f; }
__device__ __forceinline__ float sigmoidf_(float x) { return __builtin_amdgcn_rcpf(1.f + fexp_(-x)); }
__device__ __forceinline__ float siluf_(float x) { return x * __builtin_amdgcn_rcpf(1.f + fexp_(-x)); }
__device__ __forceinline__ float gelu_tanh(float x) { const float u = 0.7978845608028654f * (x + 0.044715f * x * x * x); return x * __builtin_amdgcn_rcpf(1.f + fexp_(-2.f * u)); }
__device__ __forceinline__ int lane_id_() { int l; asm volatile("v_mbcnt_lo_u32_b32 %0, -1, 0\n\tv_mbcnt_hi_u32_b32 %0, -1, %0" : "=v"(l)); return l; }
#define LAUNDER(x) asm volatile("" : "+v"(x))
#define LAUNDER_S(x) asm volatile("" : "+s"(x))
#define LDS_WAIT() asm volatile("s_waitcnt lgkmcnt(0)" ::: "memory")
#define VM_WAIT() asm volatile("s_waitcnt vmcnt(0)" ::: "memory")

#define XB_TMO      128
#define XB_XCNT(j)  (256  + 64 * (j))
#define XB_XSUB(j)  (1280 + 64 * (j))
#define XB_XGEN(j)  (2304 + 64 * (j))
#define XB_TOP      3328
#define XB_TOPGEN   3392
#define XCD_BAR_WORDS 3456
#define XB_SPIN_CAP (1u << 18)
__device__ __forceinline__ unsigned xb_ld(unsigned* p)              { return __hip_atomic_load(p, __ATOMIC_RELAXED, __HIP_MEMORY_SCOPE_AGENT); }
__device__ __forceinline__ unsigned xb_add(unsigned* p, unsigned v) { return __hip_atomic_fetch_add(p, v, __ATOMIC_RELAXED, __HIP_MEMORY_SCOPE_AGENT); }
__device__ __forceinline__ unsigned xb_xcc_id() { return (unsigned)__builtin_amdgcn_s_getreg((3 << 11) | 20) & 0xFu; }
#define XB_SPIN(cond, bar) do { unsigned _sp = 0; while (cond) { __builtin_amdgcn_s_sleep(1); \
    if ((++_sp & 255u) == 0u) { if (xb_ld(&(bar)[XB_TMO])) break; if (_sp > XB_SPIN_CAP) { atomicAdd(&(bar)[XB_TMO], 1u); break; } } } } while (0)
struct XcdBarrier { unsigned* bar; unsigned x; volatile LAS unsigned* st; int wave; };
__device__ __forceinline__ XcdBarrier xcd_barrier_post(unsigned* bar, volatile LAS unsigned* st, int wave) {
    XcdBarrier b; b.bar = bar; b.x = xb_xcc_id(); b.st = st; b.wave = wave;
    if (wave == 0 && lane_id_() == 0) (void)xb_add(&bar[XB_XCNT(b.x)], 1u);
    return b;
}
__device__ __forceinline__ void xcd_barrier_complete(unsigned* bar, unsigned x, unsigned& nloc, unsigned& nx) {
    const unsigned G = gridDim.x * gridDim.y * gridDim.z;
    unsigned sum, cnt, mine, sp = 0u;
    for (;;) {
        sum = 0u; cnt = 0u; mine = 0u;
#pragma unroll 1
        for (unsigned j = 0; j < 16; ++j) { const unsigned c = xb_ld(&bar[XB_XCNT(j)]); sum += c; cnt += (c > 0u) ? 1u : 0u; mine = (j == x) ? c : mine; }
        if (sum == G) break;
        __builtin_amdgcn_s_sleep(1);
        if ((++sp & 255u) == 0u) { if (xb_ld(&bar[XB_TMO])) break; if (sp > XB_SPIN_CAP) { atomicAdd(&bar[XB_TMO], 1u); break; } }
    }
    nloc = mine > 0u ? mine : 1u; nx = cnt > 0u ? cnt : 1u;
}
__device__ __forceinline__ void xcd_barrier(const XcdBarrier& b) {
    asm volatile("s_waitcnt vmcnt(0)" ::: "memory");
    __syncthreads();
    if (b.wave == 0 && lane_id_() == 0) {
        unsigned* bar = b.bar;
        __builtin_amdgcn_s_waitcnt(0);
        unsigned nloc = b.st[0], nx = b.st[1];
        if (nloc == 0u) { xcd_barrier_complete(bar, b.x, nloc, nx); b.st[0] = nloc; b.st[1] = nx; }
        const unsigned old = xb_add(&bar[XB_XSUB(b.x)], 1u);
        const unsigned gen = old / nloc;
        if (old + 1u == (gen + 1u) * nloc) {
            __builtin_amdgcn_fence(__ATOMIC_RELEASE, "agent");
            asm volatile("s_waitcnt vmcnt(0)" ::: "memory");
            const unsigned og = xb_add(&bar[XB_TOP], 1u);
            const unsigned tg = og / nx;
            if (og + 1u == (tg + 1u) * nx) xb_add(&bar[XB_TOPGEN], 1u);
            else XB_SPIN(xb_ld(&bar[XB_TOPGEN]) == tg, bar);
            __builtin_amdgcn_fence(__ATOMIC_ACQUIRE, "agent");
            xb_add(&bar[XB_XGEN(b.x)], 1u);
            asm volatile("s_waitcnt vmcnt(0)" ::: "memory");
        } else {
            XB_SPIN(xb_ld(&bar[XB_XGEN(b.x)]) == gen, bar);
            __builtin_amdgcn_fence(__ATOMIC_ACQUIRE, "agent");
            asm volatile("s_waitcnt vmcnt(0)" ::: "memory");
        }
    }
    __syncthreads();
}

namespace pg8 {
constexpr int BM = 256, BK = 64, HALF = 128, HTB = HALF * BK * 2, NXCD = 8, WGM = 8;
__host__ __device__ __forceinline__ int lds_byte(int r, int c) { const int st = (r >> 4) * 2 + (c >> 5), rr = r & 15, cc = c & 31, ob = rr * 64 + cc * 2; return st * 1024 + (ob ^ (((ob >> 9) & 1) << 5)); }
__host__ __device__ __forceinline__ void stage_rc(int b, int& R, int& C) { const int st = b / 1024, sb = b % 1024, swz = sb ^ (((sb >> 9) & 1) << 5); R = (st >> 1) * 16 + swz / 64; C = (st & 1) * 32 + (swz % 64) / 2; }
__host__ __device__ __forceinline__ int perm32(int rho) { const int n = rho >> 4, i = rho & 15; return 8 * (i >> 2) + 4 * n + (i & 3); }

struct TileOrder {
    int nM, nN, nwg, G, c;
    __device__ __forceinline__ void init(int nM_, int nN_, int G_, int c_) { nM = nM_; nN = nN_; nwg = nM * nN; G = G_; c = c_; }
    __device__ __forceinline__ bool get(int i, int& pm, int& pn) const {
        const long Lx = (long)i * G + c; if (Lx >= nwg) return false;
        int wgid = (int)Lx; { const int q = nwg / NXCD, r = nwg % NXCD, xcd = wgid % NXCD, off = wgid / NXCD; wgid = (xcd < r ? xcd * (q + 1) : r * (q + 1) + (xcd - r) * q) + off; }
        const int nig = WGM * nN, gid = wgid / nig, fm = gid * WGM, gsz = (nM - fm) < WGM ? (nM - fm) : WGM;
        pm = fm + ((wgid % nig) % gsz); pn = (wgid % nig) / gsz; return true;
    }
};

template <class P>
__device__ __forceinline__ void gemm_phase(LAS unsigned char* lds, const P& S, int wave) {
    typedef typename P::Unit Unit;
    int tid_ = wave * 64 + lane_id_(); LAUNDER(tid_);
    const int tid = tid_, wid = wave, lane = tid & 63, wr = wid >> 2, wc = wid & 3, fr = lane & 15, fq = lane >> 4;
    constexpr int nt = P::NT; constexpr int LDB = P::LDB;
    int Rs[2], Cs[2]; unsigned voffB[2];
#pragma unroll
    for (int i = 0; i < 2; ++i) { int R, C; stage_rc(tid * 16 + i * 8192, R, C); Rs[i] = R; Cs[i] = C; const int Rb = (R & ~31) + perm32(R & 31); voffB[i] = (unsigned)(Rb * LDB + C) * 2u; }
    const size_t hstepB = (size_t)HALF * LDB * 2;
    const unsigned ldsw = (unsigned)wid * 1024u;
    const int aoff = lds_byte(wr * 64 + fr, fq * 8), boff = lds_byte(wc * 32 + fr, fq * 8);
#define PG8_SA(b, h) (((b) * 2 + (h)) * HTB)
#define PG8_SB(b, h) ((4 + (b) * 2 + (h)) * HTB)
#define PG8_STAGE1(bufoff, gptr, v0, v1) do { \
        __builtin_amdgcn_global_load_lds((const unsigned*)((const char*)(gptr) + (v0)), (LAS unsigned*)(lds + (bufoff) + ldsw), 16, 0, 0); \
        __builtin_amdgcn_global_load_lds((const unsigned*)((const char*)(gptr) + (v1)), (LAS unsigned*)(lds + (bufoff) + ldsw + 8192), 16, 0, 0); } while (0)
#define PG8_STAGEB(bufoff, gptr) PG8_STAGE1(bufoff, gptr, voffB[0], voffB[1])
#define PG8_LDA(dst, b, h) do { _Pragma("unroll") for (int m = 0; m < 4; ++m) _Pragma("unroll") for (int k = 0; k < 2; ++k) dst[m][k] = *(const LAS bf16x8*)(lds + PG8_SA(b, h) + aoff + m * 2048 + k * 1024); } while (0)
#define PG8_LDB(dst, b, h) do { _Pragma("unroll") for (int n = 0; n < 2; ++n) _Pragma("unroll") for (int k = 0; k < 2; ++k) dst[n][k] = *(const LAS bf16x8*)(lds + PG8_SB(b, h) + boff + n * 2048 + k * 1024); } while (0)
#define PG8_MMA(ai, bj, At, Bt) do { __builtin_amdgcn_s_setprio(1); _Pragma("unroll") for (int m = 0; m < 4; ++m) _Pragma("unroll") for (int n = 0; n < 2; ++n) _Pragma("unroll") for (int k = 0; k < 2; ++k) \
        acc[ai][bj][m][n] = __builtin_amdgcn_mfma_f32_16x16x32_bf16(Bt[n][k], At[m][k], acc[ai][bj][m][n], 0, 0, 0); __builtin_amdgcn_s_setprio(0); } while (0)
#define PG8_WAIT_V(n) asm volatile("s_waitcnt vmcnt(" #n ")" ::: "memory")
#define PG8_WAIT_L(n) asm volatile("s_waitcnt lgkmcnt(" #n ")" ::: "memory")
#define PG8_BAR __builtin_amdgcn_s_barrier()
#define PG8_SCHED __builtin_amdgcn_sched_barrier(0)
    Unit cur, nxt; int ui = 0;
    if (!S.next(0, cur)) return;
    f32x4 acc[2][2][4][2];
#pragma unroll
    for (int a = 0; a < 2; ++a)
#pragma unroll
        for (int b = 0; b < 2; ++b)
#pragma unroll
            for (int m = 0; m < 4; ++m)
#pragma unroll
                for (int n = 0; n < 2; ++n) acc[a][b][m][n] = (f32x4){0.f, 0.f, 0.f, 0.f};
    bf16x8 At[4][2], B0[2][2], B1[2][2];
#define PG8_STAGEA(bufoff, uidx, uu, tt, hh) S.stage_a(lds + (bufoff) + ldsw, uidx, uu, tt, hh, Rs, Cs)
    {
        const char* pB0 = S.b_ptr(cur, 0); const char* pB1 = S.b_ptr(cur, 1);
        PG8_STAGEB(PG8_SB(0, 0), pB0); PG8_STAGEB(PG8_SB(0, 1), pB0 + hstepB); PG8_STAGEA(PG8_SA(0, 0), 0, cur, 0, 0); PG8_STAGEA(PG8_SA(0, 1), 0, cur, 0, 1);
        if (wr == 1) PG8_BAR;
        PG8_WAIT_V(2); PG8_BAR;
        PG8_STAGEB(PG8_SB(1, 0), pB1); PG8_STAGEA(PG8_SA(1, 0), 0, cur, 1, 0); PG8_STAGEB(PG8_SB(1, 1), pB1 + hstepB);
        PG8_WAIT_V(6); PG8_BAR;
    }
    for (;;) {
        const bool has_next = S.next(ui + 1, nxt);
        if (!has_next) nxt = cur;
        const int uin = has_next ? ui + 1 : ui;
#pragma unroll 1
        for (int t = 0; t < nt; t += 2) {
            const bool last = (t == nt - 2);
            const Unit& u2 = last ? nxt : cur; const int ui2 = last ? uin : ui; const int t2 = last ? 0 : t + 2;
            const char* b2 = S.b_ptr(u2, t2); const char* b3 = S.b_ptr(u2, t2 + 1);
            PG8_LDB(B0, 0, 0); PG8_LDB(B1, 0, 1); PG8_SCHED; PG8_LDA(At, 0, 0); PG8_STAGEA(PG8_SA(1, 1), ui, cur, t + 1, 1);
            PG8_WAIT_V(8); PG8_WAIT_L(0); PG8_BAR; PG8_MMA(0, 0, At, B0); PG8_MMA(0, 1, At, B1); PG8_BAR; PG8_SCHED;
            PG8_LDA(At, 0, 1); PG8_STAGEB(PG8_SB(0, 0), b2); PG8_STAGEB(PG8_SB(0, 1), b2 + hstepB); PG8_STAGEA(PG8_SA(0, 0), ui2, u2, t2, 0);
            PG8_WAIT_V(8); PG8_WAIT_L(0); PG8_BAR; PG8_MMA(1, 0, At, B0); PG8_MMA(1, 1, At, B1); PG8_BAR; PG8_SCHED;
            PG8_LDB(B0, 1, 0); PG8_LDB(B1, 1, 1); PG8_SCHED; PG8_LDA(At, 1, 0); PG8_STAGEA(PG8_SA(0, 1), ui2, u2, t2, 1);
            PG8_WAIT_V(8); PG8_WAIT_L(0); PG8_BAR; PG8_MMA(0, 0, At, B0); PG8_MMA(0, 1, At, B1); PG8_BAR; PG8_SCHED;
            PG8_LDA(At, 1, 1); PG8_STAGEB(PG8_SB(1, 0), b3); PG8_STAGEB(PG8_SB(1, 1), b3 + hstepB); PG8_STAGEA(PG8_SA(1, 0), ui2, u2, t2 + 1, 0);
            PG8_WAIT_V(8); PG8_WAIT_L(0); PG8_BAR; PG8_MMA(1, 0, At, B0); PG8_MMA(1, 1, At, B1); PG8_BAR; PG8_SCHED;
        }
        if (wr == 0) PG8_BAR;
        S.epi(acc, cur, wr, wc, fr, fq, ui);
        PG8_SCHED;
        if (!has_next) break;
#pragma unroll
        for (int a = 0; a < 2; ++a)
#pragma unroll
            for (int b = 0; b < 2; ++b)
#pragma unroll
                for (int m = 0; m < 4; ++m)
#pragma unroll
                    for (int n = 0; n < 2; ++n) acc[a][b][m][n] = (f32x4){0.f, 0.f, 0.f, 0.f};
        cur = nxt; ++ui;
        if (wr == 1) PG8_BAR;
    }
    PG8_WAIT_V(0);
    PG8_BAR;
#undef PG8_SA
#undef PG8_SB
#undef PG8_STAGE1
#undef PG8_STAGEB
#undef PG8_STAGEA
#undef PG8_LDA
#undef PG8_LDB
#undef PG8_MMA
#undef PG8_WAIT_V
#undef PG8_WAIT_L
#undef PG8_BAR
#undef PG8_SCHED
}
}
typedef f32x4 AccT[2][2][4][2];

struct Args { const float* in[30]; float* out; unsigned char* ws; int ph_lo, ph_hi; };

struct Frame {
    LAS unsigned char* lds;
    int tid, lane, wave, G, wg;
    const float* const* in;
    unsigned char* ws; unsigned char* os;
};
#define IN_X 0
#define IN_META 1
#define IN_NMG 2
#define IN_WIN 3
#define IN_LRE 4
#define IN_LIM 5
#define IN_LDT 6
#define IN_BRE 7
#define IN_BIM 8
#define IN_CRE 9
#define IN_CIM 10
#define IN_S5D 11
#define IN_WGLU 12
#define IN_HLB 13
#define IN_HNG 14
#define IN_LQ1 15
#define IN_LK1 16
#define IN_LQ2 17
#define IN_LK2 18
#define IN_SUBLN 19
#define IN_WOUT 20
#define IN_NFG 21
#define IN_WGRP 22
#define IN_BGRP 23
#define IN_WEXP 24
#define IN_BEXP 25
#define IN_WGATE 26
#define IN_WUP 27
#define IN_WDOWN 28
#define IN_FNG 29

template <class ColMap>
__device__ __forceinline__ void conv_item(const float* W, int ldw, const float* kscale, bf16* WT, int ldt, int k0, int n0, LAS float* scr, int lane, ColMap cm) {
    const int sc = cm(n0 + (lane & 31));
#pragma unroll
    for (int i = 0; i < 32; ++i) { const int kk = 2 * i + (lane >> 5); float v = W[(size_t)(k0 + kk) * ldw + sc]; if (kscale) v *= kscale[k0 + kk]; scr[kk * 33 + (lane & 31)] = v; }
    LDS_WAIT(); asm volatile("" ::: "memory");
    const int c = lane & 7;
#pragma unroll
    for (int j = 0; j < 4; ++j) { const int n = (lane >> 3) + 8 * j; const LAS float* s = scr + (8 * c) * 33 + n;
        u32x4 o; o.x = pk2(s[0 * 33], s[1 * 33]); o.y = pk2(s[2 * 33], s[3 * 33]); o.z = pk2(s[4 * 33], s[5 * 33]); o.w = pk2(s[6 * 33], s[7 * 33]);
        *(GAS u32x4*)(WT + (size_t)(n0 + n) * ldt + k0 + 8 * c) = o; }
    LDS_WAIT(); asm volatile("" ::: "memory");
}

constexpr int I_IN = 16 * (NI / 32), I_OUT = 16 * 32, I_GLU = 4 * 16, I_GU = 16 * 16 * 32, I_DN = 16 * 8 * 32;
constexpr int I_L = I_IN + I_OUT + I_GLU + I_GU + I_DN;
struct ConvJob { const float* W; const float* ks; bf16* WT; int ldw, ldt, k0, n0, sc; };
__device__ __forceinline__ ConvJob conv_decode(const Frame& F, const int l, int r, const int lane) {
    ConvJob J; const int ln = lane & 31;
    if (r < I_IN) {
        const int kb = r / (NI / 32), nb = r % (NI / 32); const int n = nb * 32 + ln;
        J.W = F.in[IN_WIN] + (size_t)l * D * NI; J.ldw = NI; J.ks = F.in[IN_NMG] + l * D; J.WT = (bf16*)(F.ws + WS_WIN) + (size_t)l * NI * D; J.ldt = D; J.k0 = kb * 64; J.n0 = nb * 32;
        J.sc = n; if (n >= C_AQ && n < C_AV) { const int p = n & 63, j = p >> 3, e = p & 7; J.sc = (n & ~63) + 4 * j + (e & 3) + 32 * (e >> 2); }
        return J; }
    r -= I_IN;
    if (r < I_OUT) {
        const int kb = r / 32, nb = r % 32;
        J.W = F.in[IN_WOUT] + (size_t)l * D * D; J.ldw = D; J.ks = nullptr; J.WT = (bf16*)(F.ws + WS_WOUT) + (size_t)l * D * D; J.ldt = D; J.k0 = kb * 64; J.n0 = nb * 32; J.sc = nb * 32 + ln;
        return J; }
    r -= I_OUT;
    if (r < I_GLU) {
        const int kb = r / 16, nb = r % 16; const int n = nb * 32 + ln;
        J.W = F.in[IN_WGLU] + (size_t)l * 256 * 512; J.ldw = 512; J.ks = nullptr; J.WT = (bf16*)(F.ws + WS_WGLU) + (size_t)l * 512 * 256; J.ldt = 256; J.k0 = kb * 64; J.n0 = nb * 32;
        { const int pn = n >> 8, bj = (n >> 7) & 1, c = n & 127; J.sc = bj * 256 + pn * 128 + c; }
        return J; }
    r -= I_GLU;
    if (r < I_GU) {
        const int e = r / (16 * 32), q = r % (16 * 32), kb = q / 32, nb = q % 32, n0 = nb * 32, bj = (n0 >> 7) & 1; const int n = n0 + ln;
        J.W = (bj ? F.in[IN_WUP] : F.in[IN_WGATE]) + ((size_t)l * 16 + e) * 1024 * 512; J.ldw = 512; J.ks = F.in[IN_NFG] + l * D; J.WT = (bf16*)(F.ws + WS_WGU) + ((size_t)l * 16 + e) * 1024 * 1024; J.ldt = 1024;
        J.k0 = kb * 64; J.n0 = n0; { const int pn = n >> 8, c = n & 127; J.sc = pn * 128 + c; }
        return J; }
    r -= I_GU;
    {   const int e = r / (8 * 32), q = r % (8 * 32), kb = q / 32, nb = q % 32;
        J.W = F.in[IN_WDOWN] + ((size_t)l * 16 + e) * 512 * 1024; J.ldw = 1024; J.ks = nullptr; J.WT = (bf16*)(F.ws + WS_WDN) + ((size_t)l * 16 + e) * 1024 * 512; J.ldt = 512; J.k0 = kb * 64; J.n0 = nb * 32; J.sc = nb * 32 + ln; }
    return J;
}
struct ConvRegs { float v[32]; };
__device__ __forceinline__ void conv_load(const ConvJob& J, const int lane, ConvRegs& R) {
#pragma unroll
    for (int i = 0; i < 32; ++i) { const int kk = 2 * i + (lane >> 5); R.v[i] = J.W[(size_t)(J.k0 + kk) * J.ldw + J.sc]; }
    if (J.ks) {
#pragma unroll
        for (int i = 0; i < 32; ++i) R.v[i] *= J.ks[J.k0 + 2 * i + (lane >> 5)]; }
}
__device__ __forceinline__ void conv_store(const ConvJob& J, const int lane, const ConvRegs& R, LAS float* scr) {
#pragma unroll
    for (int i = 0; i < 32; ++i) scr[(2 * i + (lane >> 5)) * 33 + (lane & 31)] = R.v[i];
    LDS_WAIT(); asm volatile("" ::: "memory");
    const int c = lane & 7;
#pragma unroll
    for (int j = 0; j < 4; ++j) { const int n = (lane >> 3) + 8 * j; const LAS float* s = scr + (8 * c) * 33 + n;
        u32x4 o; o.x = pk2(s[0 * 33], s[1 * 33]); o.y = pk2(s[2 * 33], s[3 * 33]); o.z = pk2(s[4 * 33], s[5 * 33]); o.w = pk2(s[6 * 33], s[7 * 33]);
        *(GAS u32x4*)(J.WT + (size_t)(J.n0 + n) * J.ldt + J.k0 + 8 * c) = o; }
    LDS_WAIT(); asm volatile("" ::: "memory");
}
__device__ __forceinline__ void conv_range(const Frame& F, const int l, const int it0, const int hi, const int step, LAS float* scr, const int lane) {
    for (int it = it0; it < hi; it += 2 * step) {
        const bool two = it + step < hi;
        const ConvJob J0 = conv_decode(F, l, it, lane), J1 = conv_decode(F, l, two ? it + step : it, lane);
        ConvRegs R0, R1;
        conv_load(J0, lane, R0); conv_load(J1, lane, R1);
        conv_store(J0, lane, R0, scr);
        if (two) conv_store(J1, lane, R1, scr);
    }
}
__device__ __forceinline__ int gemm_wgs(int U, int G) { const int R = (U + G - 1) / G; return (U + R - 1) / R; }
__device__ __forceinline__ void conv_spare(const Frame& F0, const int l, const int it_lo, const int it_hi, const int Gg) {
    Frame F = F0; F.tid = F.wave * 64 + lane_id_(); LAUNDER(F.tid); F.lane = F.tid & 63;
    const int S = F.G - Gg;
    if (S > 0 && F.wg < Gg) return;
    __syncthreads();
    LAS float* scr = (LAS float*)(F.lds + F.wave * 16384);
    const int w0 = ((S > 0) ? F.wg - Gg : F.wg) * 8 + F.wave, nw = ((S > 0) ? S : F.G) * 8;
    conv_range(F, l, it_lo + w0, it_hi, nw, scr, F.lane);
}

__device__ __forceinline__ void p0_prologue(const Frame& F0) {
    Frame F = F0; F.tid = F.wave * 64 + lane_id_(); LAUNDER(F.tid); F.lane = F.tid & 63;
    LAS float* scr = (LAS float*)(F.lds + F.wave * 16384);
    const int gw = F.wg * 8 + F.wave, NGW = F.G * 8, lane = F.lane;
    conv_range(F, 0, gw, I_IN, NGW, scr, lane);
    for (int idx = gw * 64 + lane; idx < 2 * 32 * 1024; idx += NGW * 64) {
        const int l = idx / (32 * 1024), j = (idx / 1024) % 32, k = idx % 1024;
        float w = 0.f;
        if (j < 4) w = F.in[IN_WGRP][((size_t)l * D + k) * 4 + j]; else if (j < 20) w = F.in[IN_WEXP][((size_t)l * D + k) * 16 + (j - 4)];
        w *= F.in[IN_NFG][l * D + k];
        const unsigned hi = f2bf(w); const float lo = w - bf2f(hi);
        bf16* wr = (bf16*)(F.ws + WS_WR) + (size_t)l * 2 * 32 * 1024;
        wr[j * 1024 + k] = (bf16)hi; wr[32 * 1024 + j * 1024 + k] = (bf16)f2bf(lo);
    }
    for (int idx = gw * 64 + lane; idx < LT * 32; idx += NGW * 64) {
        const int pos = idx / 32, i = idx % 32;
        const double inv = pow(10000.0, -(double)(2 * i) / 64.0); const double a = (double)pos * inv;
        ((float*)(F.ws + WS_ROPE))[idx] = (float)cos(a); ((float*)(F.ws + WS_ROPE))[LT * 32 + idx] = (float)sin(a);
    }
    {
        f32x4 v[4][4], vn[4][4];
#define HI_LOAD(dst_, m0_) do { _Pragma("unroll") for (int q = 0; q < 4; ++q) { int m = (m0_) + q * NGW; m = m < T ? m : T - 1; const int b = m / LT, t = m % LT; \
                const float* src = (t < NMETA) ? F.in[IN_META] + (size_t)t * D : F.in[IN_X] + ((size_t)b * SEQ + (t - NMETA)) * D; \
                const GAS f32x4* xr = (const GAS f32x4*)src + lane; \
                _Pragma("unroll") for (int j = 0; j < 4; ++j) dst_[q][j] = __builtin_nontemporal_load(xr + 64 * j); } } while (0)
        HI_LOAD(v, gw);
        for (int m0 = gw; m0 < T; m0 += 4 * NGW) {
            HI_LOAD(vn, m0 + 4 * NGW);
#pragma unroll
            for (int q = 0; q < 4; ++q) { const int m = m0 + q * NGW;
                float s = 0.f; u32x2 o[4];
#pragma unroll
                for (int j = 0; j < 4; ++j) { const f32x4 x = v[q][j]; s += (x.x * x.x + x.y * x.y) + (x.z * x.z + x.w * x.w); o[j].x = pk2(x.x, x.y); o[j].y = pk2(x.z, x.w); }
                s = wave_sum(s);
                if (m < T) { GAS u32x2* hb = (GAS u32x2*)((bf16*)(F.ws + WS_HB) + (size_t)m * D) + lane;
#pragma unroll
                    for (int j = 0; j < 4; ++j) hb[64 * j] = o[j];
                    if (lane < 16) ((float*)(F.ws + WS_SS16))[(size_t)m * 16 + lane] = (lane == 0) ? s : 0.f; } }
#pragma unroll
            for (int q = 0; q < 4; ++q)
#pragma unroll
                for (int j = 0; j < 4; ++j) v[q][j] = vn[q][j];
        }
#undef HI_LOAD
    }
    for (int it = F.wg; it < 256; it += F.G) {
        const int l = it >> 7, g = (it >> 3) & 15, part = it & 7;
        LAS f32x2* Ap = (LAS f32x2*)(F.lds);
        LAS f32x2* Bb = Ap + 17 * 64;
        LAS f32x2* Cc = Bb + 64 * 16;
        LAS float* Kj = (LAS float*)(Cc + 16 * 64);
        __syncthreads();
        LAS f32x2* Fs = (LAS f32x2*)(Kj + 4096);
        if (F.tid < 64) { const int n = F.tid;
            const double dt = exp((double)F.in[IN_LDT][l * 16 + g]);
            const double lr = F.in[IN_LRE][(l * 16 + g) * 64 + n], li = F.in[IN_LIM][(l * 16 + g) * 64 + n];
            const double mg = exp(lr * dt), ar = mg * cos(li * dt), ai = mg * sin(li * dt), den = lr * lr + li * li, zr = ar - 1.0, zi = ai;
            Fs[n] = (f32x2){(float)((zr * lr + zi * li) / den), (float)((zi * lr - zr * li) / den)};
            double pr = 1.0, pi = 0.0;
            for (int j = 0; j <= 16; ++j) { Ap[j * 64 + n] = (f32x2){(float)pr, (float)pi}; const double nr = pr * ar - pi * ai, ni = pr * ai + pi * ar; pr = nr; pi = ni; } }
        for (int idx = F.tid; idx < 16 * 64; idx += 512) { const int c = idx / 64, n = idx % 64;
            Cc[idx] = (f32x2){F.in[IN_CRE][((size_t)(l * 16 + g) * 16 + c) * 64 + n], F.in[IN_CIM][((size_t)(l * 16 + g) * 16 + c) * 64 + n]}; }
        __syncthreads();
        for (int idx = F.tid; idx < 64 * 16; idx += 512) { const int n = idx / 16, c = idx % 16; const f32x2 f = Fs[n];
            const float br = F.in[IN_BRE][((size_t)(l * 16 + g) * 64 + n) * 16 + c], bi = F.in[IN_BIM][((size_t)(l * 16 + g) * 64 + n) * 16 + c];
            Bb[idx] = (f32x2){f.x * br - f.y * bi, f.x * bi + f.y * br}; }
        __syncthreads();
        {
            const int co = (F.tid >> 4) & 15, ci = F.tid & 15, j0 = F.tid >> 8;
            float sK[8];
#pragma unroll
            for (int i = 0; i < 8; ++i) sK[i] = 0.f;
            for (int n = 0; n < 64; ++n) { const f32x2 c = Cc[co * 64 + n], b = Bb[n * 16 + ci];
                const float cbr = c.x * b.x - c.y * b.y, cbi = c.x * b.y + c.y * b.x;
#pragma unroll
                for (int i = 0; i < 8; ++i) { const f32x2 a = Ap[(j0 + 2 * i) * 64 + n]; sK[i] += cbr * a.x - cbi * a.y; } }
#pragma unroll
            for (int i = 0; i < 8; ++i) Kj[((j0 + 2 * i) << 8) + (co << 4) + ci] = sK[i];
        }
        if (part == 0 && F.tid < 64) ((f32x2*)(F.ws + WS_S5A))[(l * 16 + g) * 64 + F.tid] = Ap[16 * 64 + F.tid];
        __syncthreads();
        bf16* TQ = (bf16*)(F.ws + WS_S5TQ) + (size_t)(l * 16 + g) * 256 * 384;
        for (int idx = part * 32 * 384 + F.tid; idx < (part + 1) * 32 * 384; idx += 512) { const int nn = idx / 384, k = idx % 384, t = nn >> 4, co = nn & 15; float v;
            if (k < 256) { const int s = k >> 4, ci = k & 15; v = (s <= t) ? Kj[((t - s) << 8) + (co << 4) + ci] : 0.f; if (s == t && ci == co) v += F.in[IN_S5D][l * 256 + g * 16 + co]; }
            else { const int kk = k - 256, n = kk >> 1; const f32x2 a = Ap[(t + 1) * 64 + n], c = Cc[co * 64 + n];
                const float zr = c.x * a.x - c.y * a.y, zi = c.x * a.y + c.y * a.x; v = (kk & 1) ? -zi : zr; }
            TQ[idx] = (bf16)f2bf(v); }
        bf16* PM = (bf16*)(F.ws + WS_S5P) + (size_t)(l * 16 + g) * 256 * 256;
        for (int idx = part * 32 * 256 + F.tid; idx < (part + 1) * 32 * 256; idx += 512) { const int nn = idx >> 8, k = idx & 255; float v = 0.f;
            if (nn < 128) { const int n = nn >> 1, s = k >> 4, ci = k & 15; const f32x2 a = Ap[(15 - s) * 64 + n], b = Bb[n * 16 + ci];
                v = (nn & 1) ? (a.x * b.y + a.y * b.x) : (a.x * b.x - a.y * b.y); }
            PM[idx] = (bf16)f2bf(v); }
        __syncthreads();
    }
}

template <class V> __device__ __forceinline__ V ldg(const void* sbase, unsigned voff) { return *(const GAS V*)((const char*)sbase + voff); }
template <class V> __device__ __forceinline__ void stg(void* sbase, unsigned voff, V v) { *(GAS V*)((char*)sbase + voff) = v; }
template <class V> __device__ __forceinline__ void stg_nt(void* sbase, unsigned voff, V v) { __builtin_nontemporal_store(v, (GAS V*)((char*)sbase + voff)); }
__device__ __forceinline__ u32x4 bufld16(__amdgpu_buffer_rsrc_t r, unsigned voff, unsigned soff) { return __builtin_bit_cast(u32x4, __builtin_amdgcn_raw_buffer_load_b128(r, (int)voff, (int)soff, 0)); }
#define GLDS2(p0, p1, dst) do { __builtin_amdgcn_global_load_lds((const unsigned*)(p0), (LAS unsigned*)(dst), 16, 0, 0); __builtin_amdgcn_global_load_lds((const unsigned*)(p1), (LAS unsigned*)((dst) + 8192), 16, 0, 0); } while (0)
#define EPI_FENCE() __builtin_amdgcn_sched_barrier(0)
struct UnitT { int pm, pn; };

struct PolIn {
    typedef UnitT Unit; static constexpr int NT = 16, LDB = 1024;
    pg8::TileOrder ord; const bf16* A; const bf16* B; bf16* proj; const float* ss16; const float* rope; bf16* X;
    __device__ __forceinline__ bool next(int i, Unit& u) const { return ord.get(i, u.pm, u.pn); }
    __device__ __forceinline__ void stage_a(LAS unsigned char* dst, int, const Unit& u, int t, int h, const int (&R)[2], const int (&C)[2]) const {
        const char* bp = (const char*)(A + (size_t)(u.pm * 256 + h * 128) * 1024) + t * 128;
        GLDS2(bp + (unsigned)((R[0] * 1024 + C[0]) * 2), bp + (unsigned)((R[1] * 1024 + C[1]) * 2), dst); }
    __device__ __forceinline__ const char* b_ptr(const Unit& u, int t) const { return (const char*)(B + (size_t)u.pn * 256 * 1024) + t * 128; }
    __device__ __forceinline__ void epi(const AccT& acc, const Unit& u, int wr, int wc, int fr, int fq, int) const {
        const bool isrope = (u.pn >= 5 && u.pn <= 8); const float qs = (u.pn == 5 || u.pn == 6) ? QSCALE : 1.f;
        const unsigned fi = 4u * (4u * (wc & 1) + fq);
        const unsigned vo_p = (unsigned)((fr * NI + u.pn * 256 + wc * 32 + 8 * fq) * 2), vo_s = (unsigned)(fr * 64);
        const int row00 = u.pm * 256 + wr * 64;
        f32x4 ssv[8];
#pragma unroll
        for (int g = 0; g < 8; ++g) ssv[g] = ldg<f32x4>(ss16, (unsigned)(row00 + (g >> 2) * 128 + (g & 3) * 16) * 64u + vo_s + 16u * fq);
        f32x4 csA = (f32x4){1.f, 1.f, 1.f, 1.f}, snA = (f32x4){0.f, 0.f, 0.f, 0.f};
#define IN_LOAD(g_, c_, n_) do { if (isrope) { const int ru_ = row00 + ((g_) >> 2) * 128 + ((g_) & 3) * 16; const unsigned pos_ = (unsigned)(ru_ + fr) % (unsigned)LT; \
            c_ = ldg<f32x4>(rope, (pos_ * 32 + fi) * 4); n_ = ldg<f32x4>(rope, (LT * 32 + pos_ * 32 + fi) * 4); } } while (0)
        IN_LOAD(0, csA, snA);
#pragma unroll
        for (int g = 0; g < 8; ++g) {
            const int ai = g >> 2, m = g & 3;
            const f32x4 csB = csA, snB = snA;
            if (g < 7) IN_LOAD(g + 1, csA, snA);
            float ss = (ssv[g].x + ssv[g].y) + (ssv[g].z + ssv[g].w);
            ss += __shfl_xor(ss, 16); ss += __shfl_xor(ss, 32);
            const float rstd = rsqrtf(ss * (1.f / 1024.f) + RMS_EPS);
            bf16* rowp = proj + (size_t)(row00 + ai * 128 + m * 16) * NI;
            bf16* xrow = X + (size_t)((row00 + ai * 128 + m * 16) >> 4) * 384;
#pragma unroll
            for (int bj = 0; bj < 2; ++bj) {
                f32x4 v0 = acc[ai][bj][m][0] * rstd, v1 = acc[ai][bj][m][1] * rstd;
                if (isrope) { const f32x4 o0 = (v0 * csB - v1 * snB) * qs, o1 = (v1 * csB + v0 * snB) * qs; v0 = o0; v1 = o1; }
                u32x4 w; w.x = cvt_pk_bf16(v0[0], v0[1]); w.y = cvt_pk_bf16(v0[2], v0[3]); w.z = cvt_pk_bf16(v1[0], v1[1]); w.w = cvt_pk_bf16(v1[2], v1[3]);
                if (u.pn == 0) stg_nt<u32x4>(xrow, (unsigned)((((2 * wc + 8 * bj + (fq >> 1)) * S5RP) * 384 + fr * 16 + 8 * (fq & 1)) * 2), w);
                else stg_nt<u32x4>(rowp, vo_p + bj * 256, w);
            }
            EPI_FENCE();
        }
#undef IN_LOAD
    }
};

struct UnitS5 { int g, mt; };
struct PolS5E {
    typedef UnitS5 Unit; static constexpr int NT = 4, LDB = 256;
    int G, c; const bf16* X; const bf16* B; float* E;
    __device__ __forceinline__ bool next(int i, Unit& u) const { const int Lx = i * G + c; if (Lx >= 16 * 16) return false; u.g = Lx >> 4; u.mt = Lx & 15; return true; }
    __device__ __forceinline__ void stage_a(LAS unsigned char* dst, int, const Unit& u, int t, int h, const int (&R)[2], const int (&C)[2]) const {
        const char* bp = (const char*)(X + ((size_t)u.g * S5RP + 256 * u.mt + 128 * h + 2 * u.mt + h) * 384) + t * 128;
        GLDS2(bp + (unsigned)((R[0] * 384 + C[0]) * 2), bp + (unsigned)((R[1] * 384 + C[1]) * 2), dst); }
    __device__ __forceinline__ const char* b_ptr(const Unit& u, int t) const { return (const char*)(B + (size_t)u.g * 256 * 256) + t * 128; }
    __device__ __forceinline__ void epi(const AccT& acc, const Unit& u, int wr, int wc, int fr, int fq, int) const {
        const unsigned vo = (unsigned)((fr * 128 + wc * 32 + 8 * fq) * 4);
#pragma unroll
        for (int ai = 0; ai < 2; ++ai)
#pragma unroll
            for (int m = 0; m < 4; ++m) { float* ep = E + ((size_t)u.g * 4096 + u.mt * 256 + ai * 128 + wr * 64 + m * 16) * 128;
                stg<f32x4>(ep, vo, acc[ai][0][m][0]); stg<f32x4>(ep, vo + 16, acc[ai][0][m][1]); }
    }
};

struct PolS5Y {
    typedef UnitS5 Unit; static constexpr int NT = 6, LDB = 384;
    int G, c; const bf16* X; const bf16* B; const bf16* proj; const float* dsk; bf16* Gout; int skipmeta;
    __device__ __forceinline__ int row0(int mt, int half) const { return skipmeta ? (2 * mt + half) * 129 + 1 : 256 * mt + 128 * half; }
    __device__ __forceinline__ bool next(int i, Unit& u) const { const int nt = skipmeta ? 16 : 17; const int Lx = i * G + c; if (Lx >= 16 * nt) return false; u.g = Lx / nt; u.mt = Lx % nt; return true; }
    __device__ __forceinline__ void stage_a(LAS unsigned char* dst, int, const Unit& u, int t, int h, const int (&R)[2], const int (&C)[2]) const {
        const char* bp = (const char*)(X + ((size_t)u.g * S5RP + row0(u.mt, h)) * 384) + t * 128;
        GLDS2(bp + (unsigned)((R[0] * 384 + C[0]) * 2), bp + (unsigned)((R[1] * 384 + C[1]) * 2), dst); }
    __device__ __forceinline__ const char* b_ptr(const Unit& u, int t) const { return (const char*)(B + (size_t)u.g * 256 * 384) + t * 128; }
    __device__ __forceinline__ void epi(const AccT& acc, const Unit& u, int wr, int wc, int fr, int fq, int) const {
        const int ch = u.g * 16 + 8 * (fq & 1);
        const unsigned vo_g = (unsigned)(((16 * fr + (fq >> 1)) * 256 + ch) * 2);
#pragma unroll
        for (int g = 0; g < 8; ++g) { const int ai = g >> 2, m = g & 3, Ru = row0(u.mt, ai) + wr * 64 + m * 16;
            if (Ru + fr < S5R) {
#pragma unroll
                for (int bj = 0; bj < 2; ++bj) { const size_t toku = (size_t)16 * Ru + 8 * bj + 2 * wc;
                    const f32x4 v0 = acc[ai][bj][m][0], v1 = acc[ai][bj][m][1];
                    u32x4 w; w.x = pk2(gelu_tanh(v0[0]), gelu_tanh(v0[1])); w.y = pk2(gelu_tanh(v0[2]), gelu_tanh(v0[3]));
                    w.z = pk2(gelu_tanh(v1[0]), gelu_tanh(v1[1])); w.w = pk2(gelu_tanh(v1[2]), gelu_tanh(v1[3]));
                    stg<u32x4>(Gout + toku * 256, vo_g, w); }
            }
            EPI_FENCE();
        }
    }
};

__device__ __forceinline__ int mtile_row0(int pm, int skipmeta) { return skipmeta ? (pm >> 3) * LT + NMETA + (pm & 7) * 256 : pm * 256; }
struct PolGlu {
    typedef UnitT Unit; static constexpr int NT = 4, LDB = 256;
    pg8::TileOrder ord; const bf16* A; const bf16* B; bf16* mixed; int skipmeta;
    __device__ __forceinline__ bool next(int i, Unit& u) const { return ord.get(i, u.pm, u.pn); }
    __device__ __forceinline__ void stage_a(LAS unsigned char* dst, int, const Unit& u, int t, int h, const int (&R)[2], const int (&C)[2]) const {
        const char* bp = (const char*)(A + (size_t)(mtile_row0(u.pm, skipmeta) + h * 128) * 256) + t * 128;
        GLDS2(bp + (unsigned)((R[0] * 256 + C[0]) * 2), bp + (unsigned)((R[1] * 256 + C[1]) * 2), dst); }
    __device__ __forceinline__ const char* b_ptr(const Unit& u, int t) const { return (const char*)(B + (size_t)u.pn * 256 * 256) + t * 128; }
    __device__ __forceinline__ void epi(const AccT& acc, const Unit& u, int wr, int wc, int fr, int fq, int) const {
        const unsigned vo = (unsigned)((fr * D + u.pn * 128 + wc * 32 + 8 * fq) * 2);
#pragma unroll
        for (int ai = 0; ai < 2; ++ai)
#pragma unroll
            for (int m = 0; m < 4; ++m) { bf16* rp = mixed + (size_t)(mtile_row0(u.pm, skipmeta) + ai * 128 + wr * 64 + m * 16) * D;
                const f32x4 a0 = acc[ai][0][m][0], a1 = acc[ai][0][m][1], b0 = acc[ai][1][m][0], b1 = acc[ai][1][m][1];
                u32x4 w; w.x = pk2(a0[0] * sigmoidf_(b0[0]), a0[1] * sigmoidf_(b0[1])); w.y = pk2(a0[2] * sigmoidf_(b0[2]), a0[3] * sigmoidf_(b0[3]));
                w.z = pk2(a1[0] * sigmoidf_(b1[0]), a1[1] * sigmoidf_(b1[1])); w.w = pk2(a1[2] * sigmoidf_(b1[2]), a1[3] * sigmoidf_(b1[3]));
                stg<u32x4>(rp, vo, w);
                EPI_FENCE(); }
    }
};

template <bool WT>
__device__ __forceinline__ void residual_epi(const AccT& acc, const int (&vrow)[8], int pn, int wc, int fq, const bf16* HB, bf16* HBo, float* ss16, const bool needss) {
    const __amdgpu_buffer_rsrc_t ors = __builtin_amdgcn_make_buffer_rsrc((void*)HBo, 0, 0x7fffffff, 0x00020000);
    const unsigned colb = (unsigned)(pn * 256 + wc * 32 + 8 * fq);
    u32x4 pre[8][2];
#pragma unroll
    for (int g = 0; g < 8; ++g)
#pragma unroll
        for (int bj = 0; bj < 2; ++bj) { pre[g][bj] = (u32x4){0u, 0u, 0u, 0u}; if (vrow[g] >= 0) pre[g][bj] = ldg<u32x4>(HB, ((unsigned)vrow[g] * D + colb) * 2 + bj * 256); }
#pragma unroll
    for (int g = 0; g < 8; ++g) { const int ai = g >> 2, m = g & 3; const bool valid = vrow[g] >= 0; const unsigned vb = ((unsigned)(valid ? vrow[g] : 0) * D + colb) * 2;
        float ssq = 0.f;
#pragma unroll
        for (int bj = 0; bj < 2; ++bj) { const u32x4 hb = pre[g][bj];
            f32x4 h0 = (f32x4){bf2f(hb.x), bf2f(hb.x >> 16), bf2f(hb.y), bf2f(hb.y >> 16)}, h1 = (f32x4){bf2f(hb.z), bf2f(hb.z >> 16), bf2f(hb.w), bf2f(hb.w >> 16)};
            h0 += acc[ai][bj][m][0]; h1 += acc[ai][bj][m][1];
            u32x4 w; w.x = cvt_pk_bf16(h0[0], h0[1]); w.y = cvt_pk_bf16(h0[2], h0[3]); w.z = cvt_pk_bf16(h1[0], h1[1]); w.w = cvt_pk_bf16(h1[2], h1[3]);
            if (valid) { if (WT) __builtin_amdgcn_raw_buffer_store_b128(w, ors, (int)(vb + bj * 256), 0, 16  ); else stg<u32x4>(HBo, vb + bj * 256, w); }
            ssq += (h0[0] * h0[0] + h0[1] * h0[1]) + (h0[2] * h0[2] + h0[3] * h0[3]) + (h1[0] * h1[0] + h1[1] * h1[1]) + (h1[2] * h1[2] + h1[3] * h1[3]);
        }
        if (needss) { ssq += __shfl_xor(ssq, 16); ssq += __shfl_xor(ssq, 32);
            if (valid && fq == 0) stg<float>(ss16, ((unsigned)vrow[g] * 16 + pn * 4 + wc) * 4, ssq); }
    }
}

struct PolOut {
    typedef UnitT Unit; static constexpr int NT = 16, LDB = 1024;
    pg8::TileOrder ord; const bf16* A; const bf16* B; bf16* HB; bf16* HBo; float* ss16; unsigned* pan; int skipmeta;
    __device__ __forceinline__ bool next(int i, Unit& u) const { return ord.get(i, u.pm, u.pn); }
    __device__ __forceinline__ void stage_a(LAS unsigned char* dst, int, const Unit& u, int t, int h, const int (&R)[2], const int (&C)[2]) const {
        const char* bp = (const char*)(A + (size_t)(mtile_row0(u.pm, skipmeta) + h * 128) * 1024) + t * 128;
        GLDS2(bp + (unsigned)((R[0] * 1024 + C[0]) * 2), bp + (unsigned)((R[1] * 1024 + C[1]) * 2), dst); }
    __device__ __forceinline__ const char* b_ptr(const Unit& u, int t) const { return (const char*)(B + (size_t)u.pn * 256 * 1024) + t * 128; }
    __device__ __forceinline__ void epi(const AccT& acc, const Unit& u, int wr, int wc, int fr, int fq, int) const {
        int vrow[8];
#pragma unroll
        for (int g = 0; g < 8; ++g) vrow[g] = mtile_row0(u.pm, skipmeta) + (g >> 2) * 128 + wr * 64 + (g & 3) * 16 + fr;
        residual_epi<false>(acc, vrow, u.pn, wc, fq, HB, HBo, ss16, false);
    }
};

struct MoeList {
    LAS const int* cnt;
    __device__ __forceinline__ int ntiles() const { int s = 0; for (int c = 0; c < NCLS; ++c) s += (cnt[c] + 255) >> 8; return __builtin_amdgcn_readfirstlane(s); }
    __device__ __forceinline__ void decode(int gt, int& c, int& ti, int& nvalid) const {
        int s = 0, cc = 0, tt = 0, nv = 0;
        for (int k = 0; k < NCLS; ++k) { const int n = (cnt[k] + 255) >> 8; if (gt >= s && gt < s + n) { cc = k; tt = gt - s; nv = cnt[k] - 256 * tt; } s += n; }
        c = __builtin_amdgcn_readfirstlane(cc); ti = __builtin_amdgcn_readfirstlane(tt); nvalid = __builtin_amdgcn_readfirstlane(nv > 256 ? 256 : nv);
    }
};
__device__ __forceinline__ void class_experts(int c, int& ea, int& eb) {
    const int g = c / 6, p = c % 6; const int a = (p < 3) ? 0 : (p < 5 ? 1 : 2); const int b = (p < 3) ? p + 1 : (p < 5 ? p - 1 : 3);
    ea = g * 4 + a; eb = g * 4 + b;
}
struct UnitM { int gt, pn, c; };

struct PolGU {
    typedef UnitM Unit; static constexpr int NT = 16, LDB = 1024;
    int G, c, ntl; MoeList ml; LAS const int* tab;
    const bf16* HB; const bf16* W; bf16* he; const float* rstd; const float* gate;
    __device__ __forceinline__ bool next(int i, Unit& u) const { const int Lx = i * G + c; if (Lx >= ntl * 8) return false; u.gt = Lx >> 3; u.pn = Lx & 7; int ti, nv; ml.decode(u.gt, u.c, ti, nv); return true; }
    __device__ __forceinline__ void stage_a(LAS unsigned char* dst, int ui, const Unit&, int t, int h, const int (&R)[2], const int (&C)[2]) const {
        const char* bp = (const char*)HB + t * 128;
        const int t0 = tab[ui * 256 + 128 * h + R[0]], t1 = tab[ui * 256 + 128 * h + R[1]];
        GLDS2(bp + (unsigned)((t0 < 0 ? 0 : t0) * 2048 + C[0] * 2), bp + (unsigned)((t1 < 0 ? 0 : t1) * 2048 + C[1] * 2), dst); }
    __device__ __forceinline__ const char* b_ptr(const Unit& u, int t) const { int ea, eb; class_experts(u.c, ea, eb); const int e = (u.pn >> 2) ? eb : ea;
        return (const char*)(W + ((size_t)e * 1024 + (u.pn & 3) * 256) * 1024) + t * 128; }
    __device__ __forceinline__ void epi(const AccT& acc, const Unit& u, int wr, int wc, int fr, int fq, int ui) const {
        const int sel = u.pn >> 2;
        const unsigned vo = (unsigned)((fr * 1024 + sel * 512 + (u.pn & 3) * 128 + wc * 32 + 8 * fq) * 2);
        float rsv[8], gwv[8];
#pragma unroll
        for (int g = 0; g < 8; ++g) { const int tk = tab[ui * 256 + (g >> 2) * 128 + wr * 64 + (g & 3) * 16 + fr]; rsv[g] = 0.f; gwv[g] = 0.f;
            if (tk >= 0) { rsv[g] = ldg<float>(rstd, (unsigned)tk * 4); gwv[g] = ldg<float>(gate, (unsigned)(2 * tk + sel) * 4); } }
#pragma unroll
        for (int g = 0; g < 8; ++g) { const int ai = g >> 2, m = g & 3, ru = ai * 128 + wr * 64 + m * 16; const float rs = rsv[g], gw = gwv[g];
            const f32x4 g0 = acc[ai][0][m][0] * rs, g1 = acc[ai][0][m][1] * rs, u0 = acc[ai][1][m][0] * (rs * gw), u1 = acc[ai][1][m][1] * (rs * gw);
            u32x4 w; w.x = pk2(siluf_(g0[0]) * u0[0], siluf_(g0[1]) * u0[1]); w.y = pk2(siluf_(g0[2]) * u0[2], siluf_(g0[3]) * u0[3]);
            w.z = pk2(siluf_(g1[0]) * u1[0], siluf_(g1[1]) * u1[1]); w.w = pk2(siluf_(g1[2]) * u1[2], siluf_(g1[3]) * u1[3]);
            stg<u32x4>(he + ((size_t)u.gt * 256 + ru) * 1024, vo, w);
            EPI_FENCE(); }
    }
};

struct PolDN {
    typedef UnitM Unit; static constexpr int NT = 16, LDB = 512;
    int G, c, ntl; MoeList ml; LAS const int* tab;
    const bf16* he; const bf16* W; bf16* HB; bf16* HBo; float* ss16; int needss;
    __device__ __forceinline__ bool next(int i, Unit& u) const { const int Lx = i * G + c; if (Lx >= ntl * 4) return false; u.gt = Lx >> 2; u.pn = Lx & 3; int ti, nv; ml.decode(u.gt, u.c, ti, nv); return true; }
    __device__ __forceinline__ void stage_a(LAS unsigned char* dst, int, const Unit& u, int t, int h, const int (&R)[2], const int (&C)[2]) const {
        const char* bp = (const char*)(he + (size_t)(u.gt * 256 + h * 128) * 1024) + t * 128;
        GLDS2(bp + (unsigned)((R[0] * 1024 + C[0]) * 2), bp + (unsigned)((R[1] * 1024 + C[1]) * 2), dst); }
    __device__ __forceinline__ const char* b_ptr(const Unit& u, int t) const { int ea, eb; class_experts(u.c, ea, eb); const int e = (t >= 8) ? eb : ea;
        return (const char*)(W + ((size_t)e * 1024 + u.pn * 256) * 512) + (t & 7) * 128; }
    __device__ __forceinline__ void epi(const AccT& acc, const Unit& u, int wr, int wc, int fr, int fq, int ui) const {
        int vrow[8];
#pragma unroll
        for (int g = 0; g < 8; ++g) vrow[g] = tab[ui * 256 + (g >> 2) * 128 + wr * 64 + (g & 3) * 16 + fr];
        residual_epi<false>(acc, vrow, u.pn, wc, fq, HB, HBo, ss16, needss != 0);
    }
};

#define MFMA16(a, b, c) __builtin_amdgcn_mfma_f32_16x16x32_bf16(a, b, c, 0, 0, 0)
typedef short v4i16m_t __attribute__((ext_vector_type(4)));
__device__ __forceinline__ bf16x8 ldtr_b(const LAS unsigned char* p, int pitch) {
    const v4i16m_t lo = __builtin_amdgcn_ds_read_tr16_b64_v4i16((LAS v4i16m_t*)p), hi = __builtin_amdgcn_ds_read_tr16_b64_v4i16((LAS v4i16m_t*)(p + 4 * pitch));
    return (bf16x8){lo[0], lo[1], lo[2], lo[3], hi[0], hi[1], hi[2], hi[3]}; }
#define MFMA32(a, b, c) __builtin_amdgcn_mfma_f32_32x32x16_bf16(a, b, c, 0, 0, 0)

__device__ __forceinline__ int wq_fetch(unsigned* ctr, const Frame& F) {
    volatile LAS int* slot = (volatile LAS int*)(F.lds + MISC_OFF) + 20;
    __syncthreads();
    if (F.tid == 0) *slot = (int)__hip_atomic_fetch_add(ctr, 1u, __ATOMIC_RELAXED, __HIP_MEMORY_SCOPE_AGENT);
    __syncthreads();
    return __builtin_amdgcn_readfirstlane(*slot);
}

__device__ __forceinline__ void s5_scan(const Frame& F0, int l) {
    Frame F = F0; F.tid = F.wave * 64 + lane_id_(); LAUNDER(F.tid); F.lane = F.tid & 63;
    const float* E = (const float*)(F.os + OS_E); bf16* X = (bf16*)(F.os + OS_X);
    const int lane = F.lane;
    for (int it = F.wg + F.G * F.wave; it < NB * 16; it += F.G * 8) {
        const int b = it >> 4, g = it & 15;
        const f32x2 A16 = ((const f32x2*)(F.ws + WS_S5A))[(l * 16 + g) * 64 + lane];
        float sr = 0.f, si = 0.f;
        for (int r0 = 0; r0 < NCH; r0 += 43) {
            f32x2 e[43];
#pragma unroll
            for (int j = 0; j < 43; ++j) { e[j] = (f32x2){0.f, 0.f}; if (r0 + j < NCH - 1) e[j] = *(const GAS f32x2*)(E + ((size_t)g * 4096 + b * 128 + r0 + j) * 128 + 2 * lane); }
#pragma unroll
            for (int j = 0; j < 43; ++j) if (r0 + j < NCH) { const size_t R = (size_t)b * NCH + r0 + j;
                bf16* xr = X + ((size_t)g * S5RP + R) * 384;
                *(GAS unsigned*)(xr + 256 + 2 * lane) = pk2(sr, si);
                const float nr = A16.x * sr - A16.y * si + e[j].x, ni = A16.x * si + A16.y * sr + e[j].y; sr = nr; si = ni; }
        }
    }
}

__device__ __forceinline__ float hgrn_lb(const float* hlb, int l, int j) {
    if (l == 0) return 0.f;
    const float x0 = hlb[j], x1 = hlb[256 + j], mx = fmaxf(x0, x1), e0 = __expf(x0 - mx), e1 = __expf(x1 - mx);
    return e1 / (e0 + e1);
}
__device__ __forceinline__ void hgrn_gate(float z, float lbA, float onem, float& lf, float& k) {
    const float e = fexp_(-fabsf(z)), r = __builtin_amdgcn_rcpf(1.f + e), er = e * r;
    const float s = (z >= 0.f) ? r : er, c = (z >= 0.f) ? er : r;
    lf = flog_(lbA + onem * s); k = onem * c;
}
constexpr int HG_LP = 68, HG_LF = 0, HG_SEG = 64 * HG_LP * 4, HG_T0 = HG_SEG + 1024, HG_TS = 9216, HG_HALF = HG_T0 + 5 * HG_TS;
static_assert(2 * HG_HALF + 1024 <= MISC_OFF, "HGRN LDS map");

__device__ __forceinline__ void hgrn_a(const Frame& F0, int l) {
    Frame F = F0; F.tid = F.wave * 64 + lane_id_(); LAUNDER(F.tid); F.lane = F.tid & 63;
    const bf16* proj = (const bf16*)(F.ws + WS_PROJ); float* UT = (float*)(F.os + OS_UT); float* DEC = (float*)(F.os + OS_DEC);
    const int half = F.tid >> 8, ht = F.tid & 255, hw = F.wave & 3, lane = F.lane;
    LAS unsigned char* base = F.lds + half * HG_HALF;
    LAS float* LF = (LAS float*)(base + HG_LF); LAS float* SEG = (LAS float*)(base + HG_SEG);
    LAS bf16* vT = (LAS bf16*)(base + HG_T0); LAS bf16* KDT = (LAS bf16*)(base + HG_T0 + HG_TS);
    unsigned* qh = (unsigned*)F.ws + CW_Q + (l * 4 + 1) * 64;
    LAS float* LBT = (LAS float*)(F.lds + 2 * HG_HALF);
    __syncthreads();
    if (F.tid < 256) LBT[F.tid] = hgrn_lb(F.in[IN_HLB], l, F.tid);
    __syncthreads();
    constexpr int NP = NB * 4 * (HCH - 1) / 2, NSTAT = 1 << 20;
    int kq = 0;
#pragma unroll 1
    for (int p = F.wg; p < NP; p = (++kq < NSTAT) ? F.wg + kq * F.G : NSTAT * F.G + wq_fetch(qh, F)) {
        const int it2 = 2 * p + half, c = it2 % (HCH - 1), bh = it2 / (HCH - 1), item = bh * HCH + c, b = bh >> 2, h = bh & 3;
        const size_t tok0 = (size_t)b * LT + (c == 0 ? 0 : 16 + 64 * (c - 1)); const int nrows = (c == 0) ? 16 : 64;
        float lbA[8], onem[8];
        { const f32x4 lb0 = *(const LAS f32x4*)(LBT + h * 64 + 8 * (ht & 7)), lb1 = *(const LAS f32x4*)(LBT + h * 64 + 8 * (ht & 7) + 4);
#pragma unroll
          for (int jj = 0; jj < 8; ++jj) { const float lb = (jj < 4) ? lb0[jj & 3] : lb1[jj & 3]; lbA[jj] = fmaxf(lb, 1e-30f); onem[jj] = 1.f - lb; } }
#pragma unroll
        for (int e = 0; e < 2; ++e) { const int idx = ht + 256 * e, t = idx >> 3, c8 = idx & 7; const bool valid = t < nrows;
            u32x4 zf = (u32x4){0u, 0u, 0u, 0u}, zi = zf;
            if (valid) { zf = *(const GAS u32x4*)(proj + (tok0 + t) * NI + C_HF + h * 64 + 8 * c8); zi = *(const GAS u32x4*)(proj + (tok0 + t) * NI + C_HI + h * 64 + 8 * c8); }
            float lfr[8];
#pragma unroll
            for (int jj = 0; jj < 8; ++jj) { const unsigned wf = (jj & 1) ? (zf[jj >> 1] >> 16) : (zf[jj >> 1] & 0xffffu);
                float lf, kk; hgrn_gate(bf2f(wf), lbA[jj], onem[jj], lf, kk); lfr[jj] = valid ? lf : 0.f; }
            *(LAS f32x4*)(LF + t * HG_LP + 8 * c8) = (f32x4){lfr[0], lfr[1], lfr[2], lfr[3]}; *(LAS f32x4*)(LF + t * HG_LP + 8 * c8 + 4) = (f32x4){lfr[4], lfr[5], lfr[6], lfr[7]};
            *(LAS u32x4*)(vT + t * 72 + 8 * c8) = zi;
        }
        __syncthreads();
        const int d = ht & 63, seg = ht >> 6;
        { float run = 0.f; float xs_[16];
#pragma unroll
          for (int i = 0; i < 16; ++i) xs_[i] = LF[(16 * seg + i) * HG_LP + d];
#pragma unroll
          for (int i = 0; i < 16; ++i) { run += xs_[i]; LF[(16 * seg + i) * HG_LP + d] = run; }
          SEG[seg * 64 + d] = run; }
        __syncthreads();
        { float offs = 0.f, last = 0.f;
#pragma unroll
          for (int s = 0; s < 4; ++s) { const float v = SEG[s * 64 + d]; if (s < seg) offs += v; last += v; }
          float prev = 0.f;
#pragma unroll
          for (int i = 0; i < 16; ++i) { const int t = 16 * seg + i; const float cl = LF[t * HG_LP + d], lf = cl - prev; prev = cl;
              const float k = 1.f - fexp_(lf); KDT[t * 72 + d] = (bf16)f2bf(k * fexp_(last - (cl + offs))); }
          if (seg == 0) DEC[(size_t)item * 64 + d] = fexp_(last); }
        __syncthreads();
        f32x4 acc[4];
#pragma unroll
        for (int nt = 0; nt < 4; ++nt) acc[nt] = (f32x4){0.f, 0.f, 0.f, 0.f};
#pragma unroll
        for (int ks = 0; ks < 2; ++ks) { const int trow = (32 * ks + 8 * (lane >> 4) + ((lane & 15) >> 2)) * 144 + 8 * (lane & 3);
            const bf16x8 a = ldtr_b((const LAS unsigned char*)vT + trow + 32 * hw, 144);
#pragma unroll
            for (int nt = 0; nt < 4; ++nt) { const bf16x8 bb = ldtr_b((const LAS unsigned char*)KDT + trow + 32 * nt, 144); acc[nt] = MFMA16(bb, a, acc[nt]); } }
#pragma unroll
        for (int nt = 0; nt < 4; ++nt) *(GAS f32x4*)(UT + (size_t)item * 4096 + (16 * hw + (lane & 15)) * 64 + 16 * nt + 4 * (lane >> 4)) = acc[nt];
        __syncthreads();
    }
}

__device__ __forceinline__ void hgrn_b(const Frame& F0) {
    Frame F = F0; F.tid = F.wave * 64 + lane_id_(); LAUNDER(F.tid); F.lane = F.tid & 63;
    const float* UT = (const float*)(F.os + OS_UT); const float* DEC = (const float*)(F.os + OS_DEC); bf16* SP = (bf16*)(F.os + OS_SP);
    constexpr int NBLK = NB * 4 * 8;
    for (int blk0 = F.wg; blk0 < NBLK; blk0 += 4 * F.G) {
        float S[4] = {0.f, 0.f, 0.f, 0.f};
        for (int c0 = 0; c0 < HCH; c0 += 11) {
            float ut[4][11], dc[4][11];
#pragma unroll
            for (int q = 0; q < 4; ++q) { const int blk = blk0 + q * F.G; const int bh = blk >> 3, e = (blk & 7) * 512 + F.tid, d = e & 63;
#pragma unroll
                for (int j = 0; j < 11; ++j) { ut[q][j] = 0.f; dc[q][j] = 0.f; if (blk < NBLK && c0 + j < HCH - 1) { const size_t item = (size_t)bh * HCH + c0 + j; ut[q][j] = UT[item * 4096 + e]; dc[q][j] = DEC[item * 64 + d]; }     } }
#pragma unroll
            for (int q = 0; q < 4; ++q) { const int blk = blk0 + q * F.G; const int bh = blk >> 3, e = (blk & 7) * 512 + F.tid;
                if (blk < NBLK) {
#pragma unroll
                    for (int j = 0; j < 11; ++j) { const size_t item = (size_t)bh * HCH + c0 + j; SP[item * 4096 + e] = (bf16)f2bf(S[q]); S[q] = dc[q][j] * S[q] + ut[q][j]; } } }
        }
    }
}

__device__ __forceinline__ void hgrn_c(const Frame& F0, int l) {
    Frame F = F0; F.tid = F.wave * 64 + lane_id_(); LAUNDER(F.tid); F.lane = F.tid & 63;
    const bf16* proj = (const bf16*)(F.ws + WS_PROJ); const bf16* SPg = (const bf16*)(F.os + OS_SP); bf16* mixed = (bf16*)(F.ws + WS_MIXED);
    const int half = F.tid >> 8, ht = F.tid & 255, hw = F.wave & 3, lane = F.lane;
    LAS unsigned char* base = F.lds + half * HG_HALF;
    LAS float* LF = (LAS float*)(base + HG_LF); LAS float* SEG = (LAS float*)(base + HG_SEG);
    LAS bf16* vT = (LAS bf16*)(base + HG_T0); LAS bf16* QT = vT + HG_TS / 2; LAS bf16* KT = QT + HG_TS / 2; LAS bf16* QS = KT + HG_TS / 2; LAS bf16* SPt = QS + HG_TS / 2;
    LAS bf16* P = QT;
    LAS bf16* OT = QS;
    f32x4 ngv[4];
#pragma unroll
    for (int nt = 0; nt < 4; ++nt) ngv[nt] = *(const GAS f32x4*)(F.in[IN_HNG] + l * 64 + 16 * nt + 4 * (lane >> 4));
    unsigned* qh = (unsigned*)F.ws + CW_Q + (l * 4 + 2) * 64;
    LAS float* LBT = (LAS float*)(F.lds + 2 * HG_HALF);
    __syncthreads();
    if (F.tid < 256) LBT[F.tid] = hgrn_lb(F.in[IN_HLB], l, F.tid);
    __syncthreads();
    const int skip0 = (l == DEPTH - 1) ? 1 : 0;
    const int NCHc = HCH - skip0, NP = NB * 4 * NCHc / 2;
    const int nfull = NP / F.G, nrem = NP % F.G, late = (l == 0 && 16 * 17 > F.G && 16 * 17 - F.G < F.G) ? 16 * 17 - F.G : 0;
    const int eidx = (F.wg - late + F.G) % F.G;
    int kk = 0;
#pragma unroll 1
    for (int p = F.wg; p < NP; p = (++kk < nfull) ? F.wg + kk * F.G : ((kk == nfull && eidx < nrem) ? nfull * F.G + eidx : NP)) {
        const int it2 = 2 * p + half, c = skip0 + it2 % NCHc, bh = it2 / NCHc, item = bh * HCH + c, b = bh >> 2, h = bh & 3;
        const size_t tok0 = (size_t)b * LT + (c == 0 ? 0 : 16 + 64 * (c - 1)); const int nrows = (c == 0) ? 16 : 64;
        float qv[16], kv[16], lbA[8], onem[8]; u32x4 zgv[2];
        { const f32x4 lb0 = *(const LAS f32x4*)(LBT + h * 64 + 8 * (ht & 7)), lb1 = *(const LAS f32x4*)(LBT + h * 64 + 8 * (ht & 7) + 4);
#pragma unroll
          for (int jj = 0; jj < 8; ++jj) { const float lb = (jj < 4) ? lb0[jj & 3] : lb1[jj & 3]; lbA[jj] = fmaxf(lb, 1e-30f); onem[jj] = 1.f - lb; } }
#pragma unroll
        for (int e = 0; e < 2; ++e) { const int idx = ht + 256 * e, t = idx >> 3, c8 = idx & 7; const bool valid = t < nrows;
            u32x4 zq = (u32x4){0u, 0u, 0u, 0u}, zf = zq, zi = zq; zgv[e] = zq;
            if (valid) { const bf16* rp = proj + (tok0 + t) * NI + h * 64 + 8 * c8; zq = *(const GAS u32x4*)(rp + C_HQ); zf = *(const GAS u32x4*)(rp + C_HF); zi = *(const GAS u32x4*)(rp + C_HI); zgv[e] = *(const GAS u32x4*)(rp + C_HG); }
            const u32x4 sp = *(const GAS u32x4*)(SPg + (size_t)item * 4096 + t * 64 + 8 * c8);
            *(LAS u32x4*)(SPt + t * 72 + 8 * c8) = sp;
            float lfr[8];
#pragma unroll
            for (int jj = 0; jj < 8; ++jj) { const int d = 8 * c8 + jj; const unsigned wq = (jj & 1) ? (zq[jj >> 1] >> 16) : (zq[jj >> 1] & 0xffffu);
                const unsigned wf = (jj & 1) ? (zf[jj >> 1] >> 16) : (zf[jj >> 1] & 0xffffu); const unsigned wi = (jj & 1) ? (zi[jj >> 1] >> 16) : (zi[jj >> 1] & 0xffffu);
                float lf, kx; hgrn_gate(bf2f(wf), lbA[jj], onem[jj], lf, kx);
                lfr[jj] = valid ? lf : 0.f; kv[8 * e + jj] = valid ? kx : 0.f; qv[8 * e + jj] = valid ? siluf_(bf2f(wq)) : 0.f;
                (void)wi; (void)d; }
            *(LAS u32x4*)(vT + t * 72 + 8 * c8) = zi;
            *(LAS f32x4*)(LF + t * HG_LP + 8 * c8) = (f32x4){lfr[0], lfr[1], lfr[2], lfr[3]}; *(LAS f32x4*)(LF + t * HG_LP + 8 * c8 + 4) = (f32x4){lfr[4], lfr[5], lfr[6], lfr[7]};
        }
        __syncthreads();
        { const int d = ht & 63, seg = ht >> 6; float run = 0.f; float xs_[16];
#pragma unroll
          for (int i = 0; i < 16; ++i) xs_[i] = LF[(16 * seg + i) * HG_LP + d];
#pragma unroll
          for (int i = 0; i < 16; ++i) { run += xs_[i]; LF[(16 * seg + i) * HG_LP + d] = run; }
          SEG[seg * 64 + d] = run; }
        __syncthreads();
#pragma unroll
        for (int e = 0; e < 2; ++e) { const int idx = ht + 256 * e, t = idx >> 3, c8 = idx & 7, seg = t >> 4;
            float cum[8], mid[8];
            { const f32x4 a0 = *(const LAS f32x4*)(LF + t * HG_LP + 8 * c8), a1 = *(const LAS f32x4*)(LF + t * HG_LP + 8 * c8 + 4);
              const f32x4 m0 = *(const LAS f32x4*)(LF + 31 * HG_LP + 8 * c8), m1 = *(const LAS f32x4*)(LF + 31 * HG_LP + 8 * c8 + 4);
              const f32x4 s0 = *(const LAS f32x4*)(SEG + 8 * c8), s1 = *(const LAS f32x4*)(SEG + 8 * c8 + 4);
#pragma unroll
              for (int q = 0; q < 4; ++q) { cum[q] = a0[q]; cum[4 + q] = a1[q]; mid[q] = m0[q] + s0[q]; mid[4 + q] = m1[q] + s1[q]; }
#pragma unroll
              for (int s = 0; s < 3; ++s) if (s < seg) { const f32x4 o0 = *(const LAS f32x4*)(SEG + s * 64 + 8 * c8), o1 = *(const LAS f32x4*)(SEG + s * 64 + 8 * c8 + 4);
#pragma unroll
                  for (int q = 0; q < 4; ++q) { cum[q] += o0[q]; cum[4 + q] += o1[q]; } } }
            unsigned wq[4], wk[4], ws[4];
#pragma unroll
            for (int jp = 0; jp < 4; ++jp) { float qt[2], kt[2], qs[2];
#pragma unroll
                for (int u = 0; u < 2; ++u) { const int jj = 2 * jp + u; const float q = qv[8 * e + jj], k = kv[8 * e + jj];
                    qt[u] = q * fexp_(cum[jj] - mid[jj]); kt[u] = k * fexp_(mid[jj] - cum[jj]); qs[u] = q * fexp_(cum[jj]); }
                wq[jp] = pk2(qt[0], qt[1]); wk[jp] = pk2(kt[0], kt[1]); ws[jp] = pk2(qs[0], qs[1]); }
            *(LAS u32x4*)(QT + t * 72 + 8 * c8) = (u32x4){wq[0], wq[1], wq[2], wq[3]};
            *(LAS u32x4*)(KT + t * 72 + 8 * c8) = (u32x4){wk[0], wk[1], wk[2], wk[3]};
            *(LAS u32x4*)(QS + t * 72 + 8 * c8) = (u32x4){ws[0], ws[1], ws[2], ws[3]};
        }
        __syncthreads();
        const int ar = (16 * hw + (lane & 15)) * 72 + 8 * (lane >> 4);
        {
            f32x4 sc[4];
#pragma unroll
            for (int nt = 0; nt < 4; ++nt) sc[nt] = (f32x4){0.f, 0.f, 0.f, 0.f};
#pragma unroll
            for (int ks = 0; ks < 2; ++ks) { const bf16x8 a = *(const LAS bf16x8*)(QT + ar + 32 * ks);
#pragma unroll
                for (int nt = 0; nt < 4; ++nt) { const bf16x8 bb = *(const LAS bf16x8*)(KT + (16 * nt + (lane & 15)) * 72 + 32 * ks + 8 * (lane >> 4)); sc[nt] = MFMA16(bb, a, sc[nt]); } }
            { const int t = 16 * hw + (lane & 15);
#pragma unroll
              for (int nt = 0; nt < 4; ++nt) { const int s0 = 16 * nt + 4 * (lane >> 4);
                  u32x2 pw; pw.x = pk2(s0 <= t ? sc[nt][0] : 0.f, s0 + 1 <= t ? sc[nt][1] : 0.f); pw.y = pk2(s0 + 2 <= t ? sc[nt][2] : 0.f, s0 + 3 <= t ? sc[nt][3] : 0.f);
                  *(LAS u32x2*)(P + t * 72 + s0) = pw; } }
        }
        __syncthreads();
        f32x4 o[4];
#pragma unroll
        for (int nt = 0; nt < 4; ++nt) o[nt] = (f32x4){0.f, 0.f, 0.f, 0.f};
#pragma unroll
        for (int ks = 0; ks < 2; ++ks) { const bf16x8 a = *(const LAS bf16x8*)(P + ar + 32 * ks), a2 = *(const LAS bf16x8*)(QS + ar + 32 * ks);
#pragma unroll
            for (int nt = 0; nt < 4; ++nt) { const int br = (16 * nt + (lane & 15)) * 72 + 32 * ks + 8 * (lane >> 4);
                o[nt] = MFMA16(ldtr_b((const LAS unsigned char*)vT + (32 * ks + 8 * (lane >> 4) + ((lane & 15) >> 2)) * 144 + (16 * nt + 4 * (lane & 3)) * 2, 144), a, o[nt]); o[nt] = MFMA16(*(const LAS bf16x8*)(SPt + br), a2, o[nt]); } }
        {   const int t = 16 * hw + (lane & 15);
            float ssq = 0.f;
#pragma unroll
            for (int nt = 0; nt < 4; ++nt) ssq += (o[nt][0] * o[nt][0] + o[nt][1] * o[nt][1]) + (o[nt][2] * o[nt][2] + o[nt][3] * o[nt][3]);
            ssq += __shfl_xor(ssq, 16); ssq += __shfl_xor(ssq, 32);
            const float rn = rsqrtf(ssq * (1.f / 64.f) + RMS_EPS);
#pragma unroll
            for (int nt = 0; nt < 4; ++nt) { u32x2 ow; ow.x = pk2(o[nt][0] * rn * ngv[nt][0], o[nt][1] * rn * ngv[nt][1]); ow.y = pk2(o[nt][2] * rn * ngv[nt][2], o[nt][3] * rn * ngv[nt][3]);
                *(LAS u32x2*)(OT + t * 72 + 16 * nt + 4 * (lane >> 4)) = ow; } }
        __syncthreads();
#pragma unroll
        for (int e = 0; e < 2; ++e) { const int idx = ht + 256 * e, t = idx >> 3, c8 = idx & 7;
            if (t < nrows) { const u32x4 ov = *(const LAS u32x4*)(OT + t * 72 + 8 * c8); const u32x4 zg = zgv[e]; u32x4 w;
#pragma unroll
                for (int q = 0; q < 4; ++q) { const float g0 = bf2f(zg[q]), g1 = bf2f(zg[q] >> 16); w[q] = pk2(bf2f(ov[q]) * siluf_(g0), bf2f(ov[q] >> 16) * siluf_(g1)); }
                *(GAS u32x4*)(mixed + (tok0 + t) * D + 256 + h * 64 + 8 * c8) = w; } }
        __syncthreads();
    }
}

constexpr int AT_KP = 144;
constexpr int AT_KB = 64 * AT_KP, AT_VB = 16384, AT_K = 0, AT_V = 3 * AT_KB, AT_SG = AT_V + 3 * AT_VB, AT_O0 = AT_SG + 512;
static_assert(AT_O0 + 8 * 8192 <= MISC_OFF, "attention LDS map");
typedef short v4i16_t __attribute__((ext_vector_type(4)));
__device__ __forceinline__ s16x4 vtr(const LAS unsigned char* p) { return __builtin_bit_cast(s16x4, __builtin_amdgcn_ds_read_tr16_b64_v4i16((LAS v4i16_t*)p)); }
__device__ __forceinline__ float u2f_(unsigned u) { return __builtin_bit_cast(float, u); }
__device__ __forceinline__ float xhalf_max(float v) { const unsigned a = __builtin_bit_cast(unsigned, v); auto rr = __builtin_amdgcn_permlane32_swap(a, a, false, false); const unsigned r0 = rr[0], r1 = rr[1]; return fmaxf(u2f_(r0), u2f_(r1)); }
__device__ __forceinline__ float xhalf_sum(float v) { const unsigned a = __builtin_bit_cast(unsigned, v); auto rr = __builtin_amdgcn_permlane32_swap(a, a, false, false); const unsigned r0 = rr[0], r1 = rr[1]; return u2f_(r0) + u2f_(r1); }
__device__ __forceinline__ int crow(int r, int hi) { return (r & 3) + 8 * (r >> 2) + 4 * hi; }
#ifndef AT_PROBE
#define AT_PROBE 0
#endif
#define AT_SBAR() __builtin_amdgcn_sched_barrier(0)
#define AT_PIN(x) asm volatile("" : "+v"(x))
__device__ __forceinline__ int attn_unit(const Frame& F, int b, int h, int j, unsigned* qh, const bool probe) {
    const bool p_nost = (AT_PROBE != 0) && probe;
    const bf16* proj = (const bf16*)(F.ws + WS_PROJ); bf16* mixed = (bf16*)(F.ws + WS_MIXED);
    int tid_ = F.wave * 64 + lane_id_(); LAUNDER(tid_);
    const int tid = tid_, lane = tid & 63, w = F.wave, r32 = lane & 31, hi = lane >> 5;
    const int qbase = (j == 0) ? 0 : 16 + 256 * (j - 1), ntile = (j == 0) ? 1 : 4 * j + 1;
    const int qrow = qbase + 32 * w + r32;
    const int qlast = qbase + 32 * w + 31;
    const bf16* pb = proj + (size_t)b * LT * NI + h * 128;
    bf16* ob = mixed + ((size_t)b * LT + qbase + 32 * w) * D + 512 + h * 128;
    const __amdgpu_buffer_rsrc_t prs = __builtin_amdgcn_make_buffer_rsrc((void*)pb, 0, 0x7fffffff, 0x00020000);
    LAS unsigned char* Kc = F.lds + AT_K; LAS unsigned char* Vc = F.lds + AT_V;
    const unsigned vo_k = (unsigned)(((tid >> 3) * NI + C_AK + 8 * (tid & 7)) * 2);
    const unsigned vo_v0 = (unsigned)(((tid >> 4) * NI + C_AV + 8 * (tid & 15)) * 2), vo_v1 = vo_v0 + (unsigned)(32 * NI * 2);
    const unsigned vo_q = (unsigned)((qrow * NI + C_AQ + 8 * hi) * 2);
    const int kst = (tid >> 3) * AT_KP + (tid & 7) * 16;
    const int vst = ((tid & 15) >> 2) * 4096 + (tid >> 4) * 64 + (tid & 3) * 16;
    const int krd = r32 * AT_KP + 16 * hi;
    const int vrd = (4 * hi + ((lane & 15) >> 2)) * 64 + ((lane >> 4) & 1) * 32 + (lane & 3) * 8;
    LAS unsigned char* o0p = F.lds + AT_O0 + (tid >> 6) * 8192 + (tid & 63) * 16;
    int nextq = 0;
#define AT_KBASE(i_) (((i_) == 0) ? 0 : 16 + 64 * ((i_) - 1))
#define AT_LDK(i_) kreg = bufld16(prs, vo_k + cofs, (unsigned)(AT_KBASE(i_) * NI * 2))
#define AT_LDV(i_) do { const unsigned so_ = (unsigned)(AT_KBASE(i_) * NI * 2); vreg0 = bufld16(prs, vo_v0, so_); vreg1 = bufld16(prs, vo_v1, so_); } while (0)
#define AT_STK(s_) *(LAS u32x4*)(Kc + (s_) * AT_KB + kst) = kreg
#define AT_STV(s_) do { *(LAS u32x4*)(Vc + (s_) * AT_VB + vst) = vreg0; *(LAS u32x4*)(Vc + (s_) * AT_VB + vst + 32 * 64) = vreg1; } while (0)
#define AT_TURN(k_) do { if ((k_) + 1 < ntile) AT_STV(s1); if ((k_) + 2 < ntile) AT_STK(s2); __syncthreads(); \
        if ((k_) + 2 < ntile) AT_LDV((k_) + 2); if ((k_) + 3 < ntile) AT_LDK((k_) + 3); } while (0)
#define AT_KPAIR(q_, a_, b_) do { a_ = *(const LAS bf16x8*)(Kb + 32 * (q_)); b_ = *(const LAS bf16x8*)(Kb + 32 * AT_KP + 32 * (q_)); } while (0)
#define AT_VPAIR(p_, a_, b_) do { const LAS unsigned char* vp_ = Vb + (2 * ((p_) & 1)) * 4096 + (16 * ((p_) >> 1)) * 64; \
        const s16x4 l0_ = vtr(vp_), h0_ = vtr(vp_ + 8 * 64), l1_ = vtr(vp_ + 4096), h1_ = vtr(vp_ + 4096 + 8 * 64); \
        a_ = (bf16x8){l0_[0], l0_[1], l0_[2], l0_[3], h0_[0], h0_[1], h0_[2], h0_[3]}; b_ = (bf16x8){l1_[0], l1_[1], l1_[2], l1_[3], h1_[0], h1_[1], h1_[2], h1_[3]}; } while (0)
#define AT_SUMPK(g_) do { float x0_ = pP[(g_) >> 2][4 * ((g_) & 3)], x1_ = pP[(g_) >> 2][4 * ((g_) & 3) + 1], x2_ = pP[(g_) >> 2][4 * ((g_) & 3) + 2], x3_ = pP[(g_) >> 2][4 * ((g_) & 3) + 3]; \
        ps0 += x0_; ps1 += x1_; ps2 += x2_; ps3 += x3_; pfw[2 * (g_)] = cvt_pk_bf16(x0_, x1_); pfw[2 * (g_) + 1] = cvt_pk_bf16(x2_, x3_); \
        AT_PIN(ps0); AT_PIN(ps1); AT_PIN(ps2); AT_PIN(ps3); AT_PIN(pfw[2 * (g_)]); AT_PIN(pfw[2 * (g_) + 1]); } while (0)
#define AT_EXP2(n_) do { float e0_ = __builtin_amdgcn_exp2f(sT[(n_) >> 3][2 * ((n_) & 7)] - mrun), e1_ = __builtin_amdgcn_exp2f(sT[(n_) >> 3][2 * ((n_) & 7) + 1] - mrun); \
        AT_PIN(e0_); AT_PIN(e1_); pP[(n_) >> 3][2 * ((n_) & 7)] = e0_; pP[(n_) >> 3][2 * ((n_) & 7) + 1] = e1_; } while (0)
#define AT_PF(i_) __builtin_bit_cast(bf16x8, (u32x4){pfw[4 * (i_)], pfw[4 * (i_) + 1], pfw[4 * (i_) + 2], pfw[4 * (i_) + 3]})
#define AT_VMMA0(p_, a_) O[2 * ((p_) & 1)] = MFMA32(a_, AT_PF((p_) >> 1), O[2 * ((p_) & 1)])
#define AT_VMMA1(p_, b_) O[2 * ((p_) & 1) + 1] = MFMA32(b_, AT_PF((p_) >> 1), O[2 * ((p_) & 1) + 1])
#define AT_ROWMAX(kk_, kb_) do { if ((kk_) == 0 || (kk_) >= ntile - 4) { \
            _Pragma("unroll") for (int kblk = 0; kblk < 2; ++kblk) _Pragma("unroll") for (int r = 0; r < 16; ++r) { \
                const int kl = 32 * kblk + crow(r, hi); const bool ok = ((kb_) + kl <= qrow) && ((kk_) > 0 || kl < 16); if (!ok) sT[kblk][r] = -INFINITY; } } \
        mx = sT[0][0]; \
        _Pragma("unroll") for (int r = 1; r < 16; ++r) mx = fmaxf(mx, sT[0][r]); \
        _Pragma("unroll") for (int r = 0; r < 16; ++r) mx = fmaxf(mx, sT[1][r]); \
        mx = xhalf_max(mx); } while (0)
#pragma unroll 1
    for (int comp = 0; comp < 2; ++comp) {
        const unsigned cofs = (unsigned)(comp * 128);
        bf16x8 qf[4];
#pragma unroll
        for (int ks = 0; ks < 4; ++ks) qf[ks] = __builtin_bit_cast(bf16x8, bufld16(prs, vo_q + cofs + 32 * ks, 0u));
        f32x16 O[4];
#pragma unroll
        for (int vb = 0; vb < 4; ++vb)
#pragma unroll
            for (int r = 0; r < 16; ++r) O[vb][r] = 0.f;
        float mrun, lrun = 0.f, mx;
        u32x4 kreg, vreg0, vreg1, kreg1;
        AT_LDK(0); AT_LDV(0);
        kreg1 = bufld16(prs, vo_k + cofs, (unsigned)(AT_KBASE(1) * NI * 2));
        int nq_ = 0;
        if (qh != nullptr && comp == 0 && tid == 0) nq_ = (int)__hip_atomic_fetch_add(qh, 1u, __ATOMIC_RELAXED, __HIP_MEMORY_SCOPE_AGENT);
        __syncthreads();
        AT_STK(0); AT_STV(0);
        *(LAS u32x4*)(Kc + AT_KB + kst) = kreg1;
        if (comp == 0 && tid == 0) ((volatile LAS int*)(F.lds + MISC_OFF))[20] = nq_;
        __syncthreads();
        if (comp == 0) nextq = __builtin_amdgcn_readfirstlane(((volatile LAS int*)(F.lds + MISC_OFF))[20]);
        f32x16 sT[2], pP[2];
        {   const LAS unsigned char* Kb = Kc + krd;
#pragma unroll
            for (int kblk = 0; kblk < 2; ++kblk) {
#pragma unroll
                for (int r = 0; r < 16; ++r) sT[kblk][r] = 0.f;
#pragma unroll
                for (int ks = 0; ks < 4; ++ks) { const bf16x8 kf = *(const LAS bf16x8*)(Kb + (32 * kblk) * AT_KP + 32 * ks); sT[kblk] = MFMA32(kf, qf[ks], sT[kblk]); }
                AT_SBAR();
            }
        }
        if (ntile > 1) AT_LDV(1);
        if (ntile > 2) AT_LDK(2);
        AT_ROWMAX(0, 0);
        mrun = mx;
#pragma unroll
        for (int kblk = 0; kblk < 2; ++kblk)
#pragma unroll
            for (int r = 0; r < 16; ++r) pP[kblk][r] = __builtin_amdgcn_exp2f(sT[kblk][r] - mrun);
        int s0 = 0;
#pragma unroll 1
        for (int k = 0; k < ntile; ++k) {
            const int s1 = (s0 == 2) ? 0 : s0 + 1, s2 = (s1 == 2) ? 0 : s1 + 1;
            const bool act = AT_KBASE(k) <= qlast;
            const bool nxt = (k + 1 < ntile) && (AT_KBASE(k + 1) <= qlast);
            AT_TURN(k);
            if (act) {
                float ps0 = 0.f, ps1 = 0.f, ps2 = 0.f, ps3 = 0.f;
                unsigned pfw[16];
                const LAS unsigned char* Vb = Vc + s0 * AT_VB + vrd;
                bf16x8 va0, vb0, va1, vb1;
                if (nxt) {
                    const LAS unsigned char* Kb = Kc + s1 * AT_KB + krd;
                    const f32x16 z16 = {0.f, 0.f, 0.f, 0.f, 0.f, 0.f, 0.f, 0.f, 0.f, 0.f, 0.f, 0.f, 0.f, 0.f, 0.f, 0.f};
                    bf16x8 ka0, kb0, ka1, kb1;
                    __builtin_amdgcn_s_setprio(1);
                    AT_KPAIR(0, ka0, kb0); AT_SBAR();
                    AT_KPAIR(1, ka1, kb1); sT[0] = MFMA32(ka0, qf[0], z16); AT_SUMPK(0); AT_SBAR();
                    sT[1] = MFMA32(kb0, qf[0], z16); AT_SUMPK(1); AT_SBAR();
                    AT_KPAIR(2, ka0, kb0); sT[0] = MFMA32(ka1, qf[1], sT[0]); AT_SUMPK(2); AT_SBAR();
                    sT[1] = MFMA32(kb1, qf[1], sT[1]); AT_SUMPK(3); AT_SBAR();
                    AT_KPAIR(3, ka1, kb1); sT[0] = MFMA32(ka0, qf[2], sT[0]); AT_SUMPK(4); AT_SBAR();
                    sT[1] = MFMA32(kb0, qf[2], sT[1]); AT_SUMPK(5); AT_SBAR();
                    AT_VPAIR(0, va0, vb0); sT[0] = MFMA32(ka1, qf[3], sT[0]); AT_SUMPK(6); AT_SBAR();
                    sT[1] = MFMA32(kb1, qf[3], sT[1]); AT_SUMPK(7); AT_SBAR();
                    __builtin_amdgcn_s_setprio(0);
                    lrun += xhalf_sum((ps0 + ps1) + (ps2 + ps3));
                    AT_ROWMAX(k + 1, AT_KBASE(k + 1));
                    const bool need = mx > mrun + 8.f;
                    const bool resc = __builtin_amdgcn_ballot_w64(need) != 0ull;
                    float alpha = 1.f;
                    if (resc) { const float mnew = need ? mx : mrun; alpha = __builtin_amdgcn_exp2f(mrun - mnew); lrun *= alpha; mrun = mnew; }
                    AT_SBAR();
                    __builtin_amdgcn_s_setprio(1);
                    AT_VPAIR(1, va1, vb1); AT_VMMA0(0, va0); AT_EXP2(0); AT_SBAR();
                    AT_VMMA1(0, vb0); AT_EXP2(1); AT_SBAR();
                    AT_VPAIR(2, va0, vb0); AT_VMMA0(1, va1); AT_EXP2(2); AT_SBAR();
                    AT_VMMA1(1, vb1); AT_EXP2(3); AT_SBAR();
                    AT_VPAIR(3, va1, vb1); AT_VMMA0(2, va0); AT_EXP2(4); AT_SBAR();
                    AT_VMMA1(2, vb0); AT_EXP2(5); AT_SBAR();
                    AT_VPAIR(4, va0, vb0); AT_VMMA0(3, va1); AT_EXP2(6); AT_SBAR();
                    AT_VMMA1(3, vb1); AT_EXP2(7); AT_SBAR();
                    AT_VPAIR(5, va1, vb1); AT_VMMA0(4, va0); AT_EXP2(8); AT_SBAR();
                    AT_VMMA1(4, vb0); AT_EXP2(9); AT_SBAR();
                    AT_VPAIR(6, va0, vb0); AT_VMMA0(5, va1); AT_EXP2(10); AT_SBAR();
                    AT_VMMA1(5, vb1); AT_EXP2(11); AT_SBAR();
                    AT_VPAIR(7, va1, vb1); AT_VMMA0(6, va0); AT_EXP2(12); AT_SBAR();
                    AT_VMMA1(6, vb0); AT_EXP2(13); AT_SBAR();
                    AT_VMMA0(7, va1); AT_EXP2(14); AT_SBAR();
                    AT_VMMA1(7, vb1); AT_EXP2(15); AT_SBAR();
                    __builtin_amdgcn_s_setprio(0);
                    if (resc) {
#pragma unroll
                        for (int vb = 0; vb < 4; ++vb)
#pragma unroll
                            for (int r = 0; r < 16; ++r) O[vb][r] *= alpha;
                    }
                } else {
                    AT_SUMPK(0); AT_SUMPK(1); AT_SUMPK(2); AT_SUMPK(3); AT_SUMPK(4); AT_SUMPK(5); AT_SUMPK(6); AT_SUMPK(7);
                    lrun += xhalf_sum((ps0 + ps1) + (ps2 + ps3));
                    AT_SBAR();
                    AT_VPAIR(0, va0, vb0); AT_SBAR();
                    AT_VPAIR(1, va1, vb1); AT_VMMA0(0, va0); AT_VMMA1(0, vb0); AT_SBAR();
                    AT_VPAIR(2, va0, vb0); AT_VMMA0(1, va1); AT_VMMA1(1, vb1); AT_SBAR();
                    AT_VPAIR(3, va1, vb1); AT_VMMA0(2, va0); AT_VMMA1(2, vb0); AT_SBAR();
                    AT_VPAIR(4, va0, vb0); AT_VMMA0(3, va1); AT_VMMA1(3, vb1); AT_SBAR();
                    AT_VPAIR(5, va1, vb1); AT_VMMA0(4, va0); AT_VMMA1(4, vb0); AT_SBAR();
                    AT_VPAIR(6, va0, vb0); AT_VMMA0(5, va1); AT_VMMA1(5, vb1); AT_SBAR();
                    AT_VPAIR(7, va1, vb1); AT_VMMA0(6, va0); AT_VMMA1(6, vb0); AT_SBAR();
                    AT_VMMA0(7, va1); AT_VMMA1(7, vb1); AT_SBAR();
                }
            }
            s0 = s1;
        }
        if (comp == 0) {
            const float inv = 1.f / lrun;
#pragma unroll
            for (int vb = 0; vb < 4; ++vb)
#pragma unroll
                for (int q4 = 0; q4 < 2; ++q4) { u32x4 pk;
                    pk.x = cvt_pk_bf16(O[vb][8 * q4 + 0] * inv, O[vb][8 * q4 + 1] * inv); pk.y = cvt_pk_bf16(O[vb][8 * q4 + 2] * inv, O[vb][8 * q4 + 3] * inv);
                    pk.z = cvt_pk_bf16(O[vb][8 * q4 + 4] * inv, O[vb][8 * q4 + 5] * inv); pk.w = cvt_pk_bf16(O[vb][8 * q4 + 6] * inv, O[vb][8 * q4 + 7] * inv);
                    *(LAS u32x4*)(o0p + (2 * vb + q4) * 1024) = pk; }
        } else {
            int tid2 = lane_id_(); LAUNDER(tid2);
            const int r32e = tid2 & 31, hie = (tid2 >> 5) & 1;
            const unsigned vo_o = (unsigned)((r32e * D + 4 * hie) * 2);
            const bool rowok = (j > 0) || (32 * w + r32e < 16);
            const float lam = ((const LAS float*)(F.lds + MISC_OFF))[16], oscale = ((const LAS float*)(F.lds + MISC_OFF))[17];
            const float l1s = lam / lrun;
            float ssq = 0.f;
#pragma unroll
            for (int vb = 0; vb < 4; ++vb)
#pragma unroll
                for (int q4 = 0; q4 < 2; ++q4) { const u32x4 pk = *(const LAS u32x4*)(o0p + (2 * vb + q4) * 1024);
#pragma unroll
                    for (int e = 0; e < 8; ++e) { const unsigned pw = pk[e >> 1]; const float o0 = (e & 1) ? u2f_(pw & 0xffff0000u) : u2f_(pw << 16);
                        const float a = o0 - O[vb][8 * q4 + e] * l1s; O[vb][8 * q4 + e] = a; ssq += a * a; } }
            ssq = xhalf_sum(ssq);
            const float rn = rsqrtf(ssq * (1.f / 128.f) + RMS_EPS) * oscale;
            {
                LAS unsigned char* ot = F.lds + AT_O0 + w * 8192;
#pragma unroll
                for (int vb = 0; vb < 4; ++vb)
#pragma unroll
                    for (int g4 = 0; g4 < 4; ++g4) { const f32x4 sg = *(const LAS f32x4*)(F.lds + AT_SG + (32 * vb + 8 * g4 + 4 * hie) * 4);
                        u32x2 wv; wv.x = pk2(O[vb][4 * g4 + 0] * rn * sg[0], O[vb][4 * g4 + 1] * rn * sg[1]); wv.y = pk2(O[vb][4 * g4 + 2] * rn * sg[2], O[vb][4 * g4 + 3] * rn * sg[3]);
                        *(LAS u32x2*)(ot + r32e * 256 + (((4 * vb + g4) ^ (r32e & 15)) << 4) + 8 * hie) = wv; }
                LDS_WAIT(); asm volatile("" ::: "memory");
                const int rr = (tid2 >> 4) & 3, cc = tid2 & 15;
#pragma unroll
                for (int i = 0; i < 8; ++i) { const int row = 4 * i + rr;
                    const u32x4 ov = *(const LAS u32x4*)(ot + row * 256 + ((cc ^ (row & 15)) << 4));
                    if ((j > 0 || 32 * w + row < 16) && !(p_nost && rn != 12345.f)) stg<u32x4>(ob, (unsigned)(row * D * 2 + cc * 16), ov); }
            }
        }
    }
#undef AT_KBASE
#undef AT_LDK
#undef AT_LDV
#undef AT_STK
#undef AT_STV
#undef AT_TURN
#undef AT_KPAIR
#undef AT_VPAIR
#undef AT_SUMPK
#undef AT_EXP2
#undef AT_PF
#undef AT_VMMA0
#undef AT_VMMA1
#undef AT_ROWMAX
    return nextq;
}
__device__ __forceinline__ void attn_phase(const Frame& F0, int l) {
    Frame F = F0; F.tid = F.wave * 64 + lane_id_(); LAUNDER(F.tid); F.lane = F.tid & 63;
    float s1 = 0.f, s2 = 0.f;
    for (int i = 0; i < 64; ++i) { s1 += F.in[IN_LQ1][l * 64 + i] * F.in[IN_LK1][l * 64 + i]; s2 += F.in[IN_LQ2][l * 64 + i] * F.in[IN_LK2][l * 64 + i]; }
    const float lam_init = 0.8f - 0.6f * expf(-0.3f * (float)l);
    { const float lam = expf(s1) - expf(s2) + lam_init; if (F.tid == 0) { ((LAS float*)(F.lds + MISC_OFF))[16] = lam; ((LAS float*)(F.lds + MISC_OFF))[17] = 1.f - lam_init; } }
    __syncthreads();
    if (F.tid < 128) ((LAS float*)(F.lds + AT_SG))[F.tid] = F.in[IN_SUBLN][l * 128 + F.tid];
    unsigned* qh = (unsigned*)F.ws + CW_Q + (l * 4 + 0) * 64;
#ifndef ATT_REP
#define ATT_REP 1
#endif
    const int NQ1 = (l == DEPTH - 1) ? 1024 : 1024 + NB * 4;
    const int NQ = ATT_REP * NQ1;
    const bool stat = (F.G == 256) && (ATT_REP == 1);
    const int sbh = (F.wg >> 4) * 8 + (F.wg & 7), shf = (F.wg >> 3) & 1;
    const int snun = (l == DEPTH - 1 || shf == 0) ? 4 : 5;
    int su = 0;
#pragma unroll 1
    for (int q0 = F.wg; ; ) {
        int bh, j;
        if (stat) { if (su >= snun) break; bh = sbh; j = shf ? ((su == 0) ? 7 : (su == 1) ? 6 : (su == 2) ? 3 : (su == 3) ? 2 : 0) : ((su == 0) ? 8 : (su == 1) ? 5 : (su == 2) ? 4 : 1); ++su; }
        else { if (q0 >= NQ) break; const int q = q0 % NQ1; bh = q & 127; j = (q < 1024) ? 8 - (q >> 7) : 0; }
        const int nq = attn_unit(F, bh >> 2, bh & 3, j, stat ? (unsigned*)nullptr : qh, (AT_PROBE != 0) && q0 < (ATT_REP - 1) * NQ1);
        if (!stat) q0 = F.G + nq;
    }
}

constexpr int RT_WP = 1032;
__device__ __forceinline__ void router_phase(const Frame& F0, int l, const int skipmeta) {
    Frame F = F0; F.tid = F.wave * 64 + lane_id_(); LAUNDER(F.tid); F.lane = F.tid & 63;
    const bf16* HBr = (const bf16*)(F.ws + WS_HB); const bf16* WR = (const bf16*)(F.ws + WS_WR) + (size_t)l * 2 * 32 * 1024;
    float* rstd = (float*)(F.ws + WS_RSTD); float* gate = (float*)(F.ws + WS_GATE); int* buck = (int*)(F.ws + WS_BUCK);
    unsigned* gcnt = (unsigned*)F.ws + CW_CNT + l * 64;
    LAS bf16* Wh = (LAS bf16*)F.lds;
    LAS bf16* Wl = Wh + 20 * RT_WP;
    LAS float* LG = (LAS float*)(F.lds + 2 * 20 * RT_WP * 2);
    LAS int* lcnt = (LAS int*)(LG + 8 * 16 * 33);
    LAS int* lbase = lcnt + 32;
    LAS int* tcls = lbase + 32;
    LAS int* tpos = tcls + 288;
    const int lane = F.lane, w = F.wave, fr = lane & 15, fq = lane >> 4;
    const int NTASK = skipmeta ? NB * SEQ / 16 : T / 16;
#define RT_ROW0(task_) (skipmeta ? ((task_) >> 7) * LT + NMETA + ((task_) & 127) * 16 : (task_) * 16)
    const int ntl = (NTASK - F.wg + F.G - 1) / F.G;
    __syncthreads();
    for (int idx = F.tid; idx < 2 * 20 * 128; idx += 512) { const int hl = idx / (20 * 128), r = (idx / 128) % 20, c = idx % 128;
        *(LAS u32x4*)((hl ? Wl : Wh) + r * RT_WP + 8 * c) = *(const GAS u32x4*)(WR + (size_t)hl * 32 * 1024 + r * 1024 + 8 * c); }
    if (F.tid < 32) lcnt[F.tid] = 0;
    __syncthreads();
    const int n1 = (16 + fr < 20) ? 16 + fr : 19;
    for (int k = w; k < ntl; k += 8) {
        const int task = F.wg + k * F.G;
        const bf16* hrow = HBr + (size_t)RT_ROW0(task) * D;
        const unsigned vo = (unsigned)((fr * D + 8 * fq) * 2);
        f32x4 acc[2]; acc[0] = (f32x4){0.f, 0.f, 0.f, 0.f}; acc[1] = acc[0];
        float ssq = 0.f;
#pragma unroll 8
        for (int ks = 0; ks < 32; ++ks) {
            const u32x4 xa = ldg<u32x4>(hrow, vo + ks * 64);
            const float x0 = bf2f(xa.x), x1 = bf2f(xa.x >> 16), x2 = bf2f(xa.y), x3 = bf2f(xa.y >> 16), x4 = bf2f(xa.z), x5 = bf2f(xa.z >> 16), x6 = bf2f(xa.w), x7 = bf2f(xa.w >> 16);
            ssq += (x0 * x0 + x1 * x1) + (x2 * x2 + x3 * x3) + (x4 * x4 + x5 * x5) + (x6 * x6 + x7 * x7);
            const bf16x8 ahi = __builtin_bit_cast(bf16x8, xa);
            const bf16x8 bh0 = *(const LAS bf16x8*)(Wh + fr * RT_WP + 32 * ks + 8 * fq), bl0 = *(const LAS bf16x8*)(Wl + fr * RT_WP + 32 * ks + 8 * fq);
            const bf16x8 bh1 = *(const LAS bf16x8*)(Wh + n1 * RT_WP + 32 * ks + 8 * fq), bl1 = *(const LAS bf16x8*)(Wl + n1 * RT_WP + 32 * ks + 8 * fq);
            acc[0] = MFMA16(ahi, bh0, acc[0]); acc[0] = MFMA16(ahi, bl0, acc[0]);
            acc[1] = MFMA16(ahi, bh1, acc[1]); acc[1] = MFMA16(ahi, bl1, acc[1]);
        }
        ssq += __shfl_xor(ssq, 16); ssq += __shfl_xor(ssq, 32);
        const float rs = rsqrtf(ssq * (1.f / 1024.f) + RMS_EPS);
#pragma unroll
        for (int nt = 0; nt < 2; ++nt)
#pragma unroll
            for (int j = 0; j < 4; ++j) LG[w * 16 * 33 + (4 * fq + j) * 33 + 16 * nt + fr] = acc[nt][j];
        LDS_WAIT(); asm volatile("" ::: "memory");
        if (lane < 16) {
            const int tl = k * 16 + lane; const size_t m = (size_t)RT_ROW0(task) + lane;
            const float rsm = rs;
            const LAS float* lg = LG + w * 16 * 33 + lane * 33;
            float gl[4]; float gm = -1e30f; int gi = 0;
#pragma unroll
            for (int q = 0; q < 4; ++q) { gl[q] = lg[q] * rsm + F.in[IN_BGRP][l * 4 + q]; if (gl[q] > gm) { gm = gl[q]; gi = q; } }
            float gs = 0.f;
#pragma unroll
            for (int q = 0; q < 4; ++q) gs += __expf(gl[q] - gm);
            const float gp = 1.f / gs;
            float el[4];
#pragma unroll
            for (int q = 0; q < 4; ++q) el[q] = lg[4 + 4 * gi + q] * rsm + F.in[IN_BEXP][l * 16 + 4 * gi + q];
            int i1 = 0; float v1 = el[0];
#pragma unroll
            for (int q = 1; q < 4; ++q) if (el[q] > v1) { v1 = el[q]; i1 = q; }
            int i2 = -1; float v2 = -1e30f;
#pragma unroll
            for (int q = 0; q < 4; ++q) if (q != i1 && el[q] > v2) { v2 = el[q]; i2 = q; }
            const float e2 = __expf(v2 - v1), w1 = gp / (1.f + e2), w2 = gp * e2 / (1.f + e2);
            const int a = i1 < i2 ? i1 : i2, bq = i1 < i2 ? i2 : i1;
            const int pidx = (a == 0) ? (bq - 1) : (a == 1 ? bq + 1 : 5);
            const int cls = gi * 6 + pidx;
            rstd[m] = rsm; gate[2 * m] = (a == i1) ? w1 : w2; gate[2 * m + 1] = (a == i1) ? w2 : w1;
            tcls[tl] = cls; tpos[tl] = atomicAdd((int*)&lcnt[cls], 1);
        }
    }
    __syncthreads();
    if (F.tid < NCLS) lbase[F.tid] = (int)atomicAdd(&gcnt[F.tid], (unsigned)lcnt[F.tid]);
    __syncthreads();
    if (F.tid < ntl * 16) { const int cls = tcls[F.tid]; buck[(size_t)cls * T + lbase[cls] + tpos[F.tid]] = RT_ROW0(F.wg + (F.tid >> 4) * F.G) + (F.tid & 15); }
    __syncthreads();
#undef RT_ROW0
}

__device__ __forceinline__ void final_phase(const Frame& F0, float* out, float tp_add) {
    Frame F = F0; F.tid = F.wave * 64 + lane_id_(); LAUNDER(F.tid); F.lane = F.tid & 63;
    const bf16* HBf = (const bf16*)(F.ws + WS_HB); const float* g = F.in[IN_FNG];
    const int gw = F.wg * 8 + F.wave, NGW = F.G * 8, lane = F.lane;
    f32x4 gg[4];
#pragma unroll
    for (int j = 0; j < 4; ++j) gg[j] = *((const GAS f32x4*)g + lane + 64 * j);
    u32x2 q[4][4], qn[4][4];
#define FN_LOAD(dst_, r0_) do { _Pragma("unroll") for (int k = 0; k < 4; ++k) { int r = (r0_) + k * NGW; r = r < NB * SEQ ? r : NB * SEQ - 1; const int b = r / SEQ, t = r % SEQ; \
            const size_t m = (size_t)b * LT + NMETA + t; const GAS u32x2* hr = (const GAS u32x2*)(HBf + m * D) + lane; \
            _Pragma("unroll") for (int j = 0; j < 4; ++j) dst_[k][j] = hr[64 * j]; } } while (0)
    FN_LOAD(q, gw);
    for (int r0 = gw; r0 < NB * SEQ; r0 += 4 * NGW) {
        FN_LOAD(qn, r0 + 4 * NGW);
#pragma unroll
        for (int k = 0; k < 4; ++k) { const int r = r0 + k * NGW;
            f32x4 v[4]; float s = 0.f;
#pragma unroll
            for (int j = 0; j < 4; ++j) { v[j] = (f32x4){bf2f(q[k][j].x), bf2f(q[k][j].x >> 16), bf2f(q[k][j].y), bf2f(q[k][j].y >> 16)}; s += (v[j].x * v[j].x + v[j].y * v[j].y) + (v[j].z * v[j].z + v[j].w * v[j].w); }
            const float rs = rsqrtf(wave_sum(s) * (1.f / 1024.f) + RMS_EPS);
            if (r < NB * SEQ) { GAS f32x4* orow = (GAS f32x4*)(out + (size_t)r * D) + lane;
#pragma unroll
                for (int j = 0; j < 4; ++j) orow[64 * j] = v[j] * rs * gg[j] + tp_add; } }
#pragma unroll
        for (int k = 0; k < 4; ++k)
#pragma unroll
            for (int j = 0; j < 4; ++j) q[k][j] = qn[k][j];
    }
#undef FN_LOAD
}

template <int NPN>
__device__ __forceinline__ int moe_prepare(const Frame& F0, int l, LAS int* cntl, LAS int* tab) {
    Frame F = F0; F.tid = F.wave * 64 + lane_id_(); LAUNDER(F.tid); F.lane = F.tid & 63;
    const unsigned* gcnt = (const unsigned*)F.ws + CW_CNT + l * 64; const int* buck = (const int*)(F.ws + WS_BUCK);
    __syncthreads();
    if (F.tid < NCLS) cntl[F.tid] = (int)gcnt[F.tid];
    __syncthreads();
    MoeList ml{cntl}; const int ntl = ml.ntiles();
    int vals[6]; const int hsel = F.wave >> 2, r = F.tid & 255;
#pragma unroll
    for (int k = 0; k < 6; ++k) { const int Lx = (hsel + 2 * k) * F.G + F.wg; vals[k] = -1;
        if (Lx < ntl * NPN) { int c, ti, nv; ml.decode(Lx / NPN, c, ti, nv); if (r < nv) vals[k] = buck[(size_t)c * T + ti * 256 + r]; } }
#pragma unroll
    for (int k = 0; k < 6; ++k) { const int i = hsel + 2 * k; if (i * F.G + F.wg < ntl * NPN) tab[i * 256 + r] = vals[k]; }
    __syncthreads();
    return ntl;
}

#ifndef ONLY_MASK
#define ONLY_MASK 0xFFFFFFFFu
#endif
#define IN(k) (lo <= (k) && (k) < hi)
#define EN(j) ((ONLY_MASK >> (j)) & 1u)
#ifndef SUBMASK
#define SUBMASK 3u
#endif
#ifndef TPROBE
#define TPROBE (-1)
#endif
constexpr int CW_TP = 24576;
#define TP_MARK(k, which) do { if (TPROBE == (k) && F.wave == 0 && lane_id_() == 0) { const unsigned long long t_ = __builtin_amdgcn_s_memrealtime(); \
        __hip_atomic_fetch_max((unsigned long long*)((unsigned*)F.ws + CW_TP) + (which), (which) ? t_ : ~t_, __ATOMIC_RELAXED, __HIP_MEMORY_SCOPE_AGENT); } } while (0)
#define SEAM(k) do { TP_MARK(k, 1); if (IN(k) && IN((k) + 1)) xcd_barrier(bar); TP_MARK((k) + 1, 0); } while (0)
template <int L>
__device__ __forceinline__ void layer_phases(const Frame& F, const XcdBarrier& bar, int lo, int hi) {
    bf16* proj = (bf16*)(F.ws + WS_PROJ); bf16* mixed = (bf16*)(F.ws + WS_MIXED); bf16* HB = (bf16*)(F.ws + WS_HB);
    float* ss16 = (float*)(F.ws + WS_SS16);
    LAS int* tab = (LAS int*)(F.lds + TAB_OFF); LAS int* cntl = (LAS int*)(F.lds + TAB_OFF + 12 * 1024);
    constexpr int l = L; constexpr int pb = 1 + 9 * L;
        if (EN(1) && IN(pb + 0)) {
            const int Gg = (L == 0) ? gemm_wgs(MT * (NI / 256), F.G) : F.G;
            PolIn P; P.ord.init(MT, NI / 256, Gg, F.wg); P.A = HB; P.B = (const bf16*)(F.ws + WS_WIN) + (size_t)l * NI * D; P.proj = proj; P.ss16 = ss16; P.rope = (const float*)(F.ws + WS_ROPE); P.X = (bf16*)(F.os + OS_X);
            if (F.wg < Gg) for (int rep = 0; rep < NREP(1); ++rep) pg8::gemm_phase(F.lds, P, F.wave);
            if (L == 0) conv_spare(F, 0, I_IN, I_L, Gg); }
        SEAM(pb + 0);
        if (EN(2) && IN(pb + 1)) {
            PolS5E P; P.G = F.G; P.c = F.wg; P.X = (const bf16*)(F.os + OS_X); P.B = (const bf16*)(F.ws + WS_S5P) + (size_t)l * 16 * 256 * 256; P.E = (float*)(F.os + OS_E);
            for (int rep = 0; rep < NREP(2); ++rep) if (MIXSEL & 1u) pg8::gemm_phase(F.lds, P, F.wave);
            __syncthreads();
            for (int rep = 0; rep < NREP(11); ++rep) if (MIXSEL & 2u) hgrn_a(F, l); }
        SEAM(pb + 1);
        if (EN(3) && IN(pb + 2)) { for (int rep = 0; rep < NREP(3); ++rep) { if (MIXSEL & 1u) s5_scan(F, l); if (MIXSEL & 2u) hgrn_b(F); } }
        SEAM(pb + 2);
        if (EN(4) && IN(pb + 3)) {
            PolS5Y P; P.skipmeta = (L == DEPTH - 1); P.G = F.G; P.c = F.wg; P.X = (const bf16*)(F.os + OS_X); P.B = (const bf16*)(F.ws + WS_S5TQ) + (size_t)l * 16 * 256 * 384; P.proj = proj; P.dsk = F.in[IN_S5D] + l * 256; P.Gout = (bf16*)(F.os + OS_G);
            for (int rep = 0; rep < NREP(4); ++rep) if ((SUBMASK & MIXSEL & 1u) != 0u) pg8::gemm_phase(F.lds, P, F.wave);
            __syncthreads();
            for (int rep = 0; rep < NREP(12); ++rep) if ((SUBMASK & MIXSEL & 2u) != 0u) hgrn_c(F, l); }
        SEAM(pb + 3);
        if (EN(5) && IN(pb + 4)) {
            PolGlu P; P.skipmeta = (L == DEPTH - 1); P.ord.init(P.skipmeta ? NB * SEQ / 256 : MT, 2, F.G, F.wg); P.A = (const bf16*)(F.os + OS_G); P.B = (const bf16*)(F.ws + WS_WGLU) + (size_t)l * 512 * 256; P.mixed = mixed;
            for (int rep = 0; rep < NREP(5); ++rep) if ((SUBMASK & MIXSEL & 1u) != 0u) pg8::gemm_phase(F.lds, P, F.wave);
            __syncthreads();
            for (int rep = 0; rep < NREP(13); ++rep) if ((SUBMASK & 2u) != 0u && (MIXSEL & 4u) != 0u) attn_phase(F, l); }
        SEAM(pb + 4);
        if (EN(6) && IN(pb + 5)) {
            const int Gg = (L == 0 && DEPTH > 1) ? gemm_wgs(MT * 4, F.G) : F.G;
            PolOut P; P.skipmeta = (L == DEPTH - 1); P.ord.init(P.skipmeta ? NB * SEQ / 256 : MT, 4, Gg, F.wg); P.A = mixed; P.B = (const bf16*)(F.ws + WS_WOUT) + (size_t)l * D * D; P.HB = HB; P.ss16 = ss16; P.pan = (unsigned*)F.ws + CW_PAN + l * 272 * 16;
            if (NREP(6) == 2) { P.HBo = (bf16*)F.os; P.ss16 = (float*)(F.os + 160 * 1048576); pg8::gemm_phase(F.lds, P, F.wave); P.ss16 = ss16; }
            P.HBo = HB; if (F.wg < Gg) pg8::gemm_phase(F.lds, P, F.wave);
            if (L == 0 && DEPTH > 1) conv_spare(F, 1, 0, I_L, Gg); }
        SEAM(pb + 5);
        if (EN(7) && IN(pb + 6)) { router_phase(F, l, (L == DEPTH - 1) ? 1 : 0); }
        SEAM(pb + 6);
        if (EN(8) && IN(pb + 7)) {
            PolGU P; P.G = F.G; P.c = F.wg; P.ntl = moe_prepare<8>(F, l, cntl, tab); P.ml = MoeList{cntl}; P.tab = tab;
            P.HB = HB; P.W = (const bf16*)(F.ws + WS_WGU) + (size_t)l * 16 * 1024 * 1024; P.he = proj; P.rstd = (const float*)(F.ws + WS_RSTD); P.gate = (const float*)(F.ws + WS_GATE);
            for (int rep = 0; rep < NREP(8); ++rep) pg8::gemm_phase(F.lds, P, F.wave); }
        SEAM(pb + 7);
        if (EN(9) && IN(pb + 8)) {
            PolDN P; P.G = F.G; P.c = F.wg; P.ntl = moe_prepare<4>(F, l, cntl, tab); P.ml = MoeList{cntl}; P.tab = tab;
            P.he = proj; P.W = (const bf16*)(F.ws + WS_WDN) + (size_t)l * 16 * 1024 * 512; P.HB = HB; P.ss16 = ss16; P.needss = (L + 1 < DEPTH) ? 1 : 0;
            if (NREP(9) == 2) { P.HBo = (bf16*)F.os; P.ss16 = (float*)(F.os + 160 * 1048576); pg8::gemm_phase(F.lds, P, F.wave); P.ss16 = ss16; }
            P.HBo = HB; pg8::gemm_phase(F.lds, P, F.wave); }
        SEAM(pb + 8);
}

__global__ void __launch_bounds__(512, 2) hymba_fwd(Args args) {
    extern __shared__ __attribute__((aligned(16))) unsigned char lds_raw[];
    Frame F;
    F.lds = (LAS unsigned char*)lds_raw;
    F.tid = threadIdx.x; F.lane = F.tid & 63; F.wave = __builtin_amdgcn_readfirstlane(F.tid >> 6);
    F.G = gridDim.x; F.wg = blockIdx.x; F.in = args.in; F.ws = args.ws; F.os = args.ws + WS_SCR;
    volatile LAS unsigned* MISC = (volatile LAS unsigned*)(F.lds + MISC_OFF);
    if (F.tid < 256) MISC[F.tid] = 0u;
    __syncthreads();
    const int lo = args.ph_lo, hi = args.ph_hi;
    const bool one = (hi - lo) > 1;
    XcdBarrier bar; bar.bar = (unsigned*)F.ws + CW_BAR; bar.x = 0; bar.st = nullptr;
    bar.wave = F.wave;
    if (one) bar = xcd_barrier_post((unsigned*)F.ws + CW_BAR, MISC + 8, F.wave);
    TP_MARK(0, 0);
    if (EN(0) && IN(0)) { for (int rep = 0; rep < NREP(0); ++rep) p0_prologue(F); } SEAM(0);
    layer_phases<0>(F, bar, lo, hi);
    layer_phases<1>(F, bar, lo, hi);
    float tp_add = 0.f;
    if (TPROBE >= 0) { const unsigned long long* tp = (const unsigned long long*)((unsigned*)F.ws + CW_TP); const unsigned long long t0 = ~tp[0], t1 = tp[1]; tp_add = (float)(t1 - t0) * 1e-5f; }
    if (EN(10) && IN(19)) for (int rep = 0; rep < NREP(10); ++rep) final_phase(F, args.out, tp_add);
#undef IN
#undef SEAM
}

extern "C" void kernel_launch(void* const* d_in, const int* in_sizes, int n_in, void* d_out, int out_size, void* d_ws, size_t ws_size, hipStream_t stream) {
    static int grid = 0;
    if (grid == 0) {
        if (n_in != 30 || ws_size < WS_END) { fprintf(stderr, "kernel_launch: unexpected inputs (n_in %d, ws %zu < %zu)\n", n_in, ws_size, (size_t)WS_END); grid = -1; return; }
        int dev = 0, cus = 0, per_cu = 0;
        (void)hipGetDevice(&dev); (void)hipDeviceGetAttribute(&cus, hipDeviceAttributeMultiprocessorCount, dev);
        (void)hipFuncSetAttribute((const void*)hymba_fwd, hipFuncAttributeMaxDynamicSharedMemorySize, LDS_BYTES);
        (void)hipOccupancyMaxActiveBlocksPerMultiprocessor(&per_cu, (const void*)hymba_fwd, 512, LDS_BYTES);
        (void)hipGetLastError();
        grid = cus > 0 ? cus : 256;
    }
    if (grid < 0) return;
    (void)hipMemsetAsync(d_ws, 0, CTL_BYTES, stream);
    Args a{};
    for (int i = 0; i < 30; ++i) a.in[i] = (const float*)d_in[i];
    a.out = (float*)d_out; a.ws = (unsigned char*)d_ws;
#if N_LAUNCH_MODE == 1
    a.ph_lo = 0; a.ph_hi = LAST_PHASE;
    hipLaunchKernelGGL(hymba_fwd, dim3(grid), dim3(512), LDS_BYTES, stream, a);
#else
    if (MIXSEL != 7u) (void)hipMemsetAsync((char*)d_ws + WS_MIXED, 0, (size_t)T * D * 2, stream);
    for (int p = 0; p < LAST_PHASE; ++p) { if (!((RUN_MASK >> p) & 1u)) continue; a.ph_lo = p; a.ph_hi = p + 1; hipLaunchKernelGGL(hymba_fwd, dim3(grid), dim3(512), LDS_BYTES, stream, a); }
#endif
}
```
